# Optimizing an MI355X kernel written in HIP

```python
import jax, jax.numpy as jnp
from jax import lax
import numpy as np

D_MODEL = 1024
BATCH = 8
SEQ = 8192
DEPTH = 2
DEC_BATCH = 16
DEC_SEQ = 4096
PAST_LEN = 128

GRID_W = 64
N_BRANCH = 3

NA_HEADS = 8
NA_HEAD_DIM = 64
NA_WIDTH = NA_HEADS * NA_HEAD_DIM
NA_WIN_ROWS = 8
NA_WIN_COLS = 16
NA_COL_BLOCK = 16
NA_KEY_COLS = 2 * NA_COL_BLOCK
NA_RPB_ROWS = 2 * NA_WIN_ROWS - 1
NA_RPB_COLS = 2 * NA_WIN_COLS - 1

MLA_HEADS = 8
MLA_NOPE = 64
MLA_ROPE = 32
MLA_QK = MLA_NOPE + MLA_ROPE
MLA_V = 64
MLA_WIDTH = MLA_HEADS * MLA_V
MLA_Q_RANK = 256
MLA_KV_RANK = 128
MLA_Q_BLOCK = 128
ROPE_THETA = 10000.0

RW_HEADS = 8
RW_HEAD_DIM = 64
RW_WIDTH = RW_HEADS * RW_HEAD_DIM
RW_DECAY_RANK = 64
RW_A_RANK = 64
RW_G_RANK = 128
RW_LN_EPS = 64e-5
RW_IN = 3 * RW_WIDTH + 2 * RW_DECAY_RANK + 2 * RW_A_RANK + RW_G_RANK
RW_SPLITS = (RW_WIDTH, 2 * RW_WIDTH, 3 * RW_WIDTH, 3 * RW_WIDTH + 2 * RW_DECAY_RANK, 3 * RW_WIDTH + 2 * RW_DECAY_RANK + 2 * RW_A_RANK)

D_FF = ((8 * D_MODEL // 3 + 255) // 256) * 256

IN_SIZES = (NA_WIDTH, NA_WIDTH, NA_WIDTH, MLA_Q_RANK, MLA_KV_RANK, MLA_ROPE, RW_IN, N_BRANCH * D_MODEL)
D_IN = sum(IN_SIZES)
IN_SPLITS = tuple(int(s) for s in np.cumsum(IN_SIZES)[:-1])
NORM_EPS = 1e-6

kernel_name = 'hybrid_na_mla_rwkv7_encoder'


def rms_norm(x, g):
    xf = x.astype(jnp.float32)
    y = xf * lax.rsqrt(jnp.mean(xf * xf, axis=-1, keepdims=True) + NORM_EPS)
    return (y * g.astype(jnp.float32)).astype(x.dtype)


def axial_rope(seq_len):
    t = jnp.arange(seq_len, dtype=jnp.int32)
    row = (t // GRID_W).astype(jnp.float32)
    col = (t % GRID_W).astype(jnp.float32)
    n_freq = MLA_ROPE // 4
    inv_freq = ROPE_THETA ** (-jnp.arange(n_freq, dtype=jnp.float32) / n_freq)
    ang = jnp.concatenate([row[:, None] * inv_freq, col[:, None] * inv_freq], axis=-1)
    return jnp.cos(ang), jnp.sin(ang)


def apply_rope(x, cos, sin):
    half = x.shape[-1] // 2
    xf = x.astype(jnp.float32)
    x1, x2 = xf[..., :half], xf[..., half:]
    c = cos[None, :, None, :]
    s = sin[None, :, None, :]
    return jnp.concatenate([x1 * c - x2 * s, x1 * s + x2 * c], axis=-1).astype(x.dtype)


def neighbourhood_attention(q, k, v, rpb):
    b, L, h, dh = q.shape
    rows = L // GRID_W
    wr = min(NA_WIN_ROWS, rows)
    ncb = GRID_W // NA_COL_BLOCK
    qg = q.reshape(b, rows, ncb, NA_COL_BLOCK, h, dh)
    kg = k.reshape(b, rows, GRID_W, h, dh)
    vg = v.reshape(b, rows, GRID_W, h, dh)
    j = np.arange(ncb)
    kc_start = np.clip(j * NA_COL_BLOCK - NA_WIN_COLS // 2, 0, GRID_W - NA_KEY_COLS)
    key_cols = kc_start[:, None] + np.arange(NA_KEY_COLS)[None, :]
    q_cols = j[:, None] * NA_COL_BLOCK + np.arange(NA_COL_BLOCK)[None, :]
    win_start = np.clip(q_cols - NA_WIN_COLS // 2, 0, GRID_W - NA_WIN_COLS)
    kc = key_cols[:, None, :]
    col_ok = (kc >= win_start[:, :, None]) & (kc < win_start[:, :, None] + NA_WIN_COLS)
    dc_idx = np.clip(kc - q_cols[:, :, None] + NA_WIN_COLS - 1, 0, NA_RPB_COLS - 1)
    col_bias = rpb.astype(jnp.float32)[:, :, dc_idx]
    col_mask = jnp.asarray(col_ok)[None, None, :, :, None, :]
    scale = dh ** -0.5

    def one_row(r):
        rs = jnp.clip(r - wr // 2, 0, rows - wr)
        k_rows = lax.dynamic_slice_in_dim(kg, rs, wr, axis=1)
        v_rows = lax.dynamic_slice_in_dim(vg, rs, wr, axis=1)
        k_blk = k_rows[:, :, key_cols]
        v_blk = v_rows[:, :, key_cols]
        q_row = lax.dynamic_index_in_dim(qg, r, axis=1, keepdims=False)
        s = jnp.einsum('bjqhd,bwjkhd->bhjqwk', q_row, k_blk, preferred_element_type=jnp.float32) * scale
        dr_idx = rs + jnp.arange(wr) - r + NA_WIN_ROWS - 1
        bias = jnp.transpose(jnp.take(col_bias, dr_idx, axis=1), (0, 2, 3, 1, 4))
        s = jnp.where(col_mask, s + bias[None], -jnp.inf)
        p = jax.nn.softmax(s.reshape(b, h, ncb, NA_COL_BLOCK, wr * NA_KEY_COLS), axis=-1)
        p = p.reshape(s.shape).astype(v.dtype)
        o = jnp.einsum('bhjqwk,bwjkhd->bjqhd', p, v_blk)
        return o.reshape(b, GRID_W, h * dh)

    out = lax.map(one_row, jnp.arange(rows))
    return jnp.transpose(out, (1, 0, 2, 3)).reshape(b, L, h * dh)


def mla_attention(cq, ckv, kr, cq_norm, ckv_norm, w_uq, w_ukv, q_norm, k_norm, cos, sin):
    b, L, _ = cq.shape
    q = (rms_norm(cq, cq_norm) @ w_uq).reshape(b, L, MLA_HEADS, MLA_QK)
    kv = (rms_norm(ckv, ckv_norm) @ w_ukv).reshape(b, L, MLA_HEADS, MLA_NOPE + MLA_V)
    k_nope, v = kv[..., :MLA_NOPE], kv[..., MLA_NOPE:]
    k = jnp.concatenate([k_nope, jnp.broadcast_to(kr[:, :, None, :], (b, L, MLA_HEADS, MLA_ROPE))], axis=-1)
    q = rms_norm(q, q_norm)
    k = rms_norm(k, k_norm)
    q = jnp.concatenate([q[..., :MLA_NOPE], apply_rope(q[..., MLA_NOPE:], cos, sin)], axis=-1)
    k = jnp.concatenate([k[..., :MLA_NOPE], apply_rope(k[..., MLA_NOPE:], cos, sin)], axis=-1)
    nblk = L // MLA_Q_BLOCK
    qb = jnp.transpose(q.reshape(b, nblk, MLA_Q_BLOCK, MLA_HEADS, MLA_QK), (1, 0, 2, 3, 4))
    scale = MLA_QK ** -0.5

    def one_block(qi):
        s = jnp.einsum('bqhd,bkhd->bhqk', qi, k, preferred_element_type=jnp.float32) * scale
        p = jax.nn.softmax(s, axis=-1).astype(v.dtype)
        return jnp.einsum('bhqk,bkhd->bqhd', p, v)

    o = lax.map(one_block, qb)
    return jnp.transpose(o, (1, 0, 2, 3, 4)).reshape(b, L, MLA_WIDTH)


def centred_shift(p):
    prev = jnp.pad(p[:, :-1], ((0, 0), (1, 0), (0, 0)))
    nxt = jnp.pad(p[:, 1:], ((0, 0), (0, 1), (0, 0)))
    return 0.5 * (prev + nxt)


def to_heads(t):
    return t.reshape(t.shape[:-1] + (RW_HEADS, RW_HEAD_DIM))


def rwkv7_scan(r, w, k, v, kk, a, reverse):
    b, L, h, n = r.shape

    def step(S, inp):
        r_t, w_t, k_t, v_t, kk_t, a_t = inp
        s_kk = jnp.einsum('bhvk,bhk->bhv', S, kk_t)
        S = S * w_t[:, :, None, :] - s_kk[..., None] * (kk_t * a_t)[:, :, None, :] + v_t[..., None] * k_t[:, :, None, :]
        return S, jnp.einsum('bhvk,bhk->bhv', S, r_t)

    xs = tuple(jnp.moveaxis(t, 1, 0) for t in (r, w, k, v, kk, a))
    s0 = jnp.zeros((b, h, n, n), jnp.float32)
    _, ys = lax.scan(step, s0, xs, reverse=reverse)
    return jnp.moveaxis(ys, 0, 1)


def rwkv7_mix(p, mu, w0, w_up, a0, a_up, g_up, k_k, k_a, r_k, ln_w, ln_b):
    f32 = jnp.float32
    b, L, _ = p.shape
    p = p.astype(f32)
    p = p + mu.astype(f32) * (centred_shift(p) - p)
    r, k, v, wd, ad, gd = jnp.split(p, RW_SPLITS, axis=-1)
    wd = jnp.tanh(wd).reshape(b, L, 2, RW_DECAY_RANK)
    ad = ad.reshape(b, L, 2, RW_A_RANK)
    w_raw = w0.astype(f32) + jnp.einsum('bldr,drc->bldc', wd, w_up.astype(f32))
    decay = jnp.exp(-jnp.exp(-jax.nn.softplus(-w_raw) - 0.5))
    a = jax.nn.sigmoid(a0.astype(f32) + jnp.einsum('bldr,drc->bldc', ad, a_up.astype(f32)))
    g = jax.nn.sigmoid(gd) @ g_up.astype(f32)
    kk = to_heads(k * k_k.astype(f32))
    kk = kk * lax.rsqrt(jnp.sum(kk * kk, axis=-1, keepdims=True) + 1e-12)
    kd = k[:, :, None, :] * (1.0 + (a - 1.0) * k_a.astype(f32))
    rh, vh = to_heads(r), to_heads(v)
    y = (rwkv7_scan(rh, to_heads(decay[:, :, 0]), to_heads(kd[:, :, 0]), vh, kk, to_heads(a[:, :, 0]), False)
         + rwkv7_scan(rh, to_heads(decay[:, :, 1]), to_heads(kd[:, :, 1]), vh, kk, to_heads(a[:, :, 1]), True))
    mean = jnp.mean(y, axis=-1, keepdims=True)
    var = jnp.mean(jnp.square(y - mean), axis=-1, keepdims=True)
    y = ((y - mean) * lax.rsqrt(var + RW_LN_EPS)).reshape(b, L, RW_WIDTH) * ln_w.astype(f32) + ln_b.astype(f32)
    bonus = jnp.sum(rh[:, :, None] * to_heads(kd) * r_k.astype(f32), axis=(2, -1))
    y = y + (bonus[..., None] * vh).reshape(b, L, RW_WIDTH)
    return y * g


def encoder_trunk(x, norm1_g, w_in, b_gate, na_q_norm, na_k_norm, na_rpb, na_proj,
                  mla_cq_norm, mla_ckv_norm, mla_w_uq, mla_w_ukv, mla_q_norm, mla_k_norm, mla_proj,
                  rw_mu, rw_w0, rw_w_up, rw_a0, rw_a_up, rw_g_up, rw_k_k, rw_k_a, rw_r_k, rw_ln_w, rw_ln_b, rw_proj,
                  w_out, norm2_g, ffn_w_gate, ffn_w_up, ffn_w_down):
    b, L, d = x.shape
    cos, sin = axial_rope(L)
    for l in range(DEPTH):
        h = rms_norm(x, norm1_g[l])
        proj = h @ w_in[l]
        qa, ka, va, cq, ckv, kr, rw_cols, gate_in = jnp.split(proj, IN_SPLITS, axis=-1)
        qa = rms_norm(qa.reshape(b, L, NA_HEADS, NA_HEAD_DIM), na_q_norm[l])
        ka = rms_norm(ka.reshape(b, L, NA_HEADS, NA_HEAD_DIM), na_k_norm[l])
        va = va.reshape(b, L, NA_HEADS, NA_HEAD_DIM)
        y_a = neighbourhood_attention(qa, ka, va, na_rpb[l]) @ na_proj[l]
        y_b = mla_attention(cq, ckv, kr, mla_cq_norm[l], mla_ckv_norm[l], mla_w_uq[l], mla_w_ukv[l],
                            mla_q_norm[l], mla_k_norm[l], cos, sin) @ mla_proj[l]
        y_c = rwkv7_mix(rw_cols, rw_mu[l], rw_w0[l], rw_w_up[l], rw_a0[l], rw_a_up[l], rw_g_up[l],
                        rw_k_k[l], rw_k_a[l], rw_r_k[l], rw_ln_w[l], rw_ln_b[l]).astype(x.dtype) @ rw_proj[l]
        gates = jax.nn.sigmoid((gate_in + b_gate[l]).astype(jnp.float32)).astype(x.dtype).reshape(b, L, N_BRANCH, d)
        mixed = gates[:, :, 0] * y_a + gates[:, :, 1] * y_b + gates[:, :, 2] * y_c
        x = x + mixed @ w_out[l]
        h2 = rms_norm(x, norm2_g[l])
        x = x + (jax.nn.silu(h2 @ ffn_w_gate[l]) * (h2 @ ffn_w_up[l])) @ ffn_w_down[l]
    return x


def setup_inputs(seed: int = 0) -> dict:
    key = jax.random.key(seed)
    ks = iter(jax.random.split(key, 48))

    def nrm(shape, scale):
        return scale * jax.random.normal(next(ks), shape, dtype=jnp.float32)

    def gain(shape):
        return 1.0 + nrm(shape, 0.05)

    return {
        'x_prompt': nrm((BATCH, SEQ, D_MODEL), 1.0),
        'x_sample': nrm((DEC_BATCH, DEC_SEQ, D_MODEL), 1.0),
        'norm1_g': gain((DEPTH, D_MODEL)),
        'w_in': nrm((DEPTH, D_MODEL, D_IN), D_MODEL ** -0.5),
        'b_gate': nrm((DEPTH, N_BRANCH * D_MODEL), 0.1),
        'na_q_norm': gain((DEPTH, NA_HEAD_DIM)),
        'na_k_norm': gain((DEPTH, NA_HEAD_DIM)),
        'na_rpb': nrm((DEPTH, NA_HEADS, NA_RPB_ROWS, NA_RPB_COLS), 0.5),
        'na_proj': nrm((DEPTH, NA_WIDTH, D_MODEL), NA_WIDTH ** -0.5),
        'mla_cq_norm': gain((DEPTH, MLA_Q_RANK)),
        'mla_ckv_norm': gain((DEPTH, MLA_KV_RANK)),
        'mla_w_uq': nrm((DEPTH, MLA_Q_RANK, MLA_HEADS * MLA_QK), MLA_Q_RANK ** -0.5),
        'mla_w_ukv': nrm((DEPTH, MLA_KV_RANK, MLA_HEADS * (MLA_NOPE + MLA_V)), MLA_KV_RANK ** -0.5),
        'mla_q_norm': gain((DEPTH, MLA_QK)),
        'mla_k_norm': gain((DEPTH, MLA_QK)),
        'mla_proj': nrm((DEPTH, MLA_WIDTH, D_MODEL), MLA_WIDTH ** -0.5),
        'rw_mu': jax.random.uniform(next(ks), (DEPTH, RW_IN), dtype=jnp.float32),
        'rw_w0': nrm((DEPTH, 2, RW_WIDTH), 1.0),
        'rw_w_up': nrm((DEPTH, 2, RW_DECAY_RANK, RW_WIDTH), 0.5 * RW_DECAY_RANK ** -0.5),
        'rw_a0': nrm((DEPTH, 2, RW_WIDTH), 0.5),
        'rw_a_up': nrm((DEPTH, 2, RW_A_RANK, RW_WIDTH), 0.5 * RW_A_RANK ** -0.5),
        'rw_g_up': nrm((DEPTH, RW_G_RANK, RW_WIDTH), RW_G_RANK ** -0.5),
        'rw_k_k': 0.85 + nrm((DEPTH, RW_WIDTH), 0.05),
        'rw_k_a': gain((DEPTH, RW_WIDTH)),
        'rw_r_k': nrm((DEPTH, RW_HEADS, RW_HEAD_DIM), 0.1),
        'rw_ln_w': gain((DEPTH, RW_WIDTH)),
        'rw_ln_b': nrm((DEPTH, RW_WIDTH), 0.02),
        'rw_proj': nrm((DEPTH, RW_WIDTH, D_MODEL), RW_WIDTH ** -0.5),
        'w_out': nrm((DEPTH, D_MODEL, D_MODEL), D_MODEL ** -0.5),
        'norm2_g': gain((DEPTH, D_MODEL)),
        'ffn_w_gate': nrm((DEPTH, D_MODEL, D_FF), D_MODEL ** -0.5),
        'ffn_w_up': nrm((DEPTH, D_MODEL, D_FF), D_MODEL ** -0.5),
        'ffn_w_down': nrm((DEPTH, D_FF, D_MODEL), D_FF ** -0.5),
    }


def reference(x_prompt, x_sample, norm1_g, w_in, b_gate, na_q_norm, na_k_norm, na_rpb, na_proj,
              mla_cq_norm, mla_ckv_norm, mla_w_uq, mla_w_ukv, mla_q_norm, mla_k_norm, mla_proj,
              rw_mu, rw_w0, rw_w_up, rw_a0, rw_a_up, rw_g_up, rw_k_k, rw_k_a, rw_r_k, rw_ln_w, rw_ln_b, rw_proj,
              w_out, norm2_g, ffn_w_gate, ffn_w_up, ffn_w_down):
    weights = (norm1_g, w_in, b_gate, na_q_norm, na_k_norm, na_rpb, na_proj,
               mla_cq_norm, mla_ckv_norm, mla_w_uq, mla_w_ukv, mla_q_norm, mla_k_norm, mla_proj,
               rw_mu, rw_w0, rw_w_up, rw_a0, rw_a_up, rw_g_up, rw_k_k, rw_k_a, rw_r_k, rw_ln_w, rw_ln_b, rw_proj,
               w_out, norm2_g, ffn_w_gate, ffn_w_up, ffn_w_down)
    y_prompt = encoder_trunk(x_prompt, *weights)
    y_sample = encoder_trunk(x_sample, *weights)
    return (y_prompt, y_sample)
```

```cpp
#include <hip/hip_runtime.h>
#include <hip/hip_cooperative_groups.h>
#include <cstdio>
#include <cstdint>
namespace cg = cooperative_groups;
namespace pg8 {
#define PG8_LAS __attribute__((address_space(3)))
typedef unsigned short bf16_t;
typedef short bf16x8 __attribute__((ext_vector_type(8)));
typedef float f32x4 __attribute__((ext_vector_type(4)));
typedef unsigned u32x4 __attribute__((ext_vector_type(4)));
constexpr int BM = 256, BK = 64, HALF = 128, HTB = HALF * BK * 2  , STAGE_BYTES = 8 * HTB, NXCD = 8, WGM = 8;

__host__ __device__ __forceinline__ int lds_byte(int r, int c) { const int st = (r >> 4) * 2 + (c >> 5), rr = r & 15, cc = c & 31, ob = rr * 64 + cc * 2; return st * 1024 + (ob ^ (((ob >> 9) & 1) << 5)); }
__host__ __device__ __forceinline__ void stage_rc(int b, int& R, int& C) { const int st = b / 1024, sb = b % 1024, swz = sb ^ (((sb >> 9) & 1) << 5); R = (st >> 1) * 16 + swz / 64; C = (st & 1) * 32 + (swz % 64) / 2; }
__host__ __device__ __forceinline__ int perm32(int rho) { const int n = rho >> 4, i = rho & 15; return 8 * (i >> 2) + 4 * n + (i & 3); }

struct Unit { int pm, pn; };
struct Gemm { const bf16_t* A; const bf16_t* Bt; int M, N, K; };

struct StaticOrder {
    int nM, nN, nwg, G, c;
    __host__ __device__ void init(int M, int N, int G_, int c_) { nM = M / BM; nN = N / BM; nwg = nM * nN; G = G_; c = c_; }
    __host__ __device__ bool next(int i, Unit& u) const {
        const long L = (long)i * G + c; if (L >= nwg) return false;
        int wgid = (int)L; { const int q = nwg / NXCD, r = nwg % NXCD, xcd = wgid % NXCD, off = wgid / NXCD; wgid = (xcd < r ? xcd * (q + 1) : r * (q + 1) + (xcd - r) * q) + off; }
        const int nig = WGM * nN, gid = wgid / nig, fm = gid * WGM, gsz = (nM - fm) < WGM ? (nM - fm) : WGM;
        u.pm = fm + ((wgid % nig) % gsz); u.pn = (wgid % nig) / gsz; return true;
    }
    __device__ __forceinline__ void a_ready(const Unit&) const {}
    __device__ __forceinline__ void done(const Unit&) const {}
};

__device__ __forceinline__ unsigned cvt_pk_bf16(float lo, float hi) { unsigned r; asm volatile("v_cvt_pk_bf16_f32 %0, %1, %2" : "=v"(r) : "v"(lo), "v"(hi)); return r; }
typedef float f32x2 __attribute__((ext_vector_type(2)));
}
namespace pg8 {
template <class Epi, class Sched, bool ALIGN_EPI = false, bool SP2 = false>
__device__ __forceinline__ void gemm_phase(PG8_LAS unsigned char* lds, const Gemm g, const Sched& S, const Epi& E) {
    int tid_l = threadIdx.x; asm volatile("" : "+v"(tid_l)); const int tid = tid_l, wid = __builtin_amdgcn_readfirstlane(tid >> 6), lane = tid & 63, wr = wid >> 2, wc = wid & 3, fr = lane & 15, fq = lane >> 4;
    const int K = g.K, nt = K / BK;
    unsigned voffA[2], voffB[2];
#pragma unroll
    for (int i = 0; i < 2; ++i) { int R, C; stage_rc(tid * 16 + i * 8192, R, C); const int Rb = Epi::PERM ? ((R & ~31) + perm32(R & 31)) : R;
        voffA[i] = (unsigned)(R * K + C) * 2u; voffB[i] = (unsigned)(Rb * K + C) * 2u; }
    const size_t kstep = (size_t)(BK * 2);
    const size_t hstep = (size_t)HALF * K * 2;
    const size_t tstep = 2 * hstep;
    const unsigned ldsw = (unsigned)wid * 1024u;
    const int aoff = lds_byte(wr * 64 + fr, fq * 8), boff = lds_byte(wc * 32 + fr, fq * 8);
#define PG8_SA(b, h) (((b) * 2 + (h)) * HTB)
#define PG8_SB(b, h) ((4 + (b) * 2 + (h)) * HTB)
#define PG8_STAGE(bufoff, gbase, voff) do { _Pragma("unroll") for (int _i = 0; _i < 2; ++_i) \
        __builtin_amdgcn_global_load_lds((const unsigned*)((const char*)(gbase) + (voff)[_i]), (PG8_LAS unsigned*)(lds + (bufoff) + ldsw + _i * 8192), 16, 0, 0); } while (0)
#define PG8_LDA(dst, b, h) do { _Pragma("unroll") for (int m = 0; m < 4; ++m) _Pragma("unroll") for (int k = 0; k < 2; ++k) dst[m][k] = *(const PG8_LAS bf16x8*)(lds + PG8_SA(b, h) + aoff + m * 2048 + k * 1024); } while (0)
#define PG8_LDB(dst, b, h) do { _Pragma("unroll") for (int n = 0; n < 2; ++n) _Pragma("unroll") for (int k = 0; k < 2; ++k) dst[n][k] = *(const PG8_LAS bf16x8*)(lds + PG8_SB(b, h) + boff + n * 2048 + k * 1024); } while (0)
#define PG8_MMA(ai, bj, At, Bt) do { __builtin_amdgcn_s_setprio(1); _Pragma("unroll") for (int m = 0; m < 4; ++m) _Pragma("unroll") for (int n = 0; n < 2; ++n) _Pragma("unroll") for (int k = 0; k < 2; ++k) \
        acc[ai][bj][m][n] = __builtin_amdgcn_mfma_f32_16x16x32_bf16(Bt[n][k], At[m][k], acc[ai][bj][m][n], 0, 0, 0); __builtin_amdgcn_s_setprio(0); } while (0)
#define PG8_WAIT_V(n) asm volatile("s_waitcnt vmcnt(" #n ")" ::: "memory")
#define PG8_WAIT_L(n) asm volatile("s_waitcnt lgkmcnt(" #n ")" ::: "memory")
#define PG8_BAR __builtin_amdgcn_s_barrier()
#define PG8_SCHED __builtin_amdgcn_sched_barrier(0)
    Unit cur, nxt; int ui = 0;
    if (!S.next(0, cur)) return;
    f32x4 acc[2][2][4][2];
#pragma unroll
    for (int a = 0; a < 2; ++a)
#pragma unroll
        for (int b = 0; b < 2; ++b)
#pragma unroll
            for (int m = 0; m < 4; ++m)
#pragma unroll
                for (int n = 0; n < 2; ++n) acc[a][b][m][n] = (f32x4){0.f, 0.f, 0.f, 0.f};
    bf16x8 At[4][2], B0[2][2], B1[2][2];
    const char* cA = (const char*)g.A + (size_t)cur.pm * tstep; const char* cB = (const char*)g.Bt + (size_t)cur.pn * tstep;
    S.a_ready(cur);
    if constexpr (SP2) {
        PG8_STAGE(PG8_SB(0, 0), cB, voffB); PG8_STAGE(PG8_SB(0, 1), cB + hstep, voffB); PG8_STAGE(PG8_SA(0, 0), cA, voffA); PG8_STAGE(PG8_SA(0, 1), cA + hstep, voffA);
        if (wr == 1) PG8_BAR;
        PG8_WAIT_V(2); PG8_BAR;
        PG8_STAGE(PG8_SB(1, 0), cB + kstep, voffB); PG8_STAGE(PG8_SA(1, 0), cA + kstep, voffA); PG8_STAGE(PG8_SB(1, 1), cB + hstep + kstep, voffB);
        PG8_WAIT_V(6); PG8_BAR;
    } else {
        PG8_STAGE(PG8_SB(0, 0), cB, voffB); PG8_STAGE(PG8_SA(0, 0), cA, voffA); PG8_STAGE(PG8_SB(0, 1), cB + hstep, voffB); PG8_STAGE(PG8_SA(0, 1), cA + hstep, voffA);
        if (wr == 1) PG8_BAR;
        PG8_WAIT_V(4); PG8_BAR;
        PG8_STAGE(PG8_SB(1, 0), cB + kstep, voffB); PG8_STAGE(PG8_SA(1, 0), cA + kstep, voffA); PG8_STAGE(PG8_SB(1, 1), cB + hstep + kstep, voffB);
        PG8_WAIT_V(6); PG8_BAR;
    }
    for (;;) {
        const bool has_next = S.next(ui + 1, nxt);
        const char* nA = has_next ? (const char*)g.A + (size_t)nxt.pm * tstep : cA; const char* nB = has_next ? (const char*)g.Bt + (size_t)nxt.pn * tstep : cB;
        for (int t = 0; t < nt; t += 2) {
            const bool last = (t == nt - 2);
            const char* a1 = cA + (size_t)(t + 1) * kstep;
            const char* a2 = last ? nA : cA + (size_t)(t + 2) * kstep; const char* b2 = last ? nB : cB + (size_t)(t + 2) * kstep;
            const char* a3 = a2 + kstep; const char* b3 = b2 + kstep;
            if (last && has_next) S.a_ready(nxt);
            if constexpr (SP2) {
            PG8_LDB(B0, 0, 0); PG8_LDB(B1, 0, 1); PG8_SCHED; PG8_LDA(At, 0, 0); PG8_STAGE(PG8_SA(1, 1), a1 + hstep, voffA);
            PG8_WAIT_V(8); PG8_WAIT_L(0); PG8_BAR; PG8_MMA(0, 0, At, B0); PG8_MMA(0, 1, At, B1); PG8_BAR; PG8_SCHED;
            PG8_LDA(At, 0, 1); PG8_STAGE(PG8_SB(0, 0), b2, voffB); PG8_STAGE(PG8_SB(0, 1), b2 + hstep, voffB); PG8_STAGE(PG8_SA(0, 0), a2, voffA);
            PG8_WAIT_V(8); PG8_WAIT_L(0); PG8_BAR; PG8_MMA(1, 0, At, B0); PG8_MMA(1, 1, At, B1); PG8_BAR; PG8_SCHED;
            PG8_LDB(B0, 1, 0); PG8_LDB(B1, 1, 1); PG8_SCHED; PG8_LDA(At, 1, 0); PG8_STAGE(PG8_SA(0, 1), a2 + hstep, voffA);
            PG8_WAIT_V(8); PG8_WAIT_L(0); PG8_BAR; PG8_MMA(0, 0, At, B0); PG8_MMA(0, 1, At, B1); PG8_BAR; PG8_SCHED;
            PG8_LDA(At, 1, 1); PG8_STAGE(PG8_SB(1, 0), b3, voffB); PG8_STAGE(PG8_SB(1, 1), b3 + hstep, voffB); PG8_STAGE(PG8_SA(1, 0), a3, voffA);
            PG8_WAIT_V(8); PG8_WAIT_L(0); PG8_BAR; PG8_MMA(1, 0, At, B0); PG8_MMA(1, 1, At, B1); PG8_BAR; PG8_SCHED;
            } else {
            PG8_LDB(B0, 0, 0); PG8_SCHED; PG8_LDA(At, 0, 0); PG8_STAGE(PG8_SA(1, 1), a1 + hstep, voffA);
            PG8_WAIT_L(8); PG8_BAR; PG8_WAIT_L(0); PG8_MMA(0, 0, At, B0); PG8_BAR; PG8_SCHED;
            PG8_LDB(B1, 0, 1); PG8_STAGE(PG8_SB(0, 0), b2, voffB);
            PG8_BAR; PG8_WAIT_L(0); PG8_MMA(0, 1, At, B1); PG8_BAR;
            PG8_LDA(At, 0, 1); PG8_STAGE(PG8_SA(0, 0), a2, voffA);
            PG8_BAR; PG8_WAIT_L(0); PG8_MMA(1, 0, At, B0); PG8_BAR; PG8_SCHED;
            PG8_STAGE(PG8_SB(0, 1), b2 + hstep, voffB);
            PG8_WAIT_V(6); PG8_BAR; PG8_MMA(1, 1, At, B1); PG8_BAR;
            PG8_LDB(B0, 1, 0); PG8_SCHED; PG8_LDA(At, 1, 0); PG8_STAGE(PG8_SA(0, 1), a2 + hstep, voffA);
            PG8_WAIT_L(8); PG8_BAR; PG8_WAIT_L(0); PG8_MMA(0, 0, At, B0); PG8_BAR; PG8_SCHED;
            PG8_LDB(B1, 1, 1); PG8_STAGE(PG8_SB(1, 0), b3, voffB);
            PG8_BAR; PG8_WAIT_L(0); PG8_MMA(0, 1, At, B1); PG8_BAR;
            PG8_LDA(At, 1, 1); PG8_STAGE(PG8_SA(1, 0), a3, voffA);
            PG8_BAR; PG8_WAIT_L(0); PG8_MMA(1, 0, At, B0); PG8_BAR; PG8_SCHED;
            PG8_STAGE(PG8_SB(1, 1), b3 + hstep, voffB);
            PG8_WAIT_V(6); PG8_BAR; PG8_MMA(1, 1, At, B1); PG8_BAR;
            }
        }
        if constexpr (ALIGN_EPI) { if (wr == 0) PG8_BAR; }
        if constexpr (!Epi::AFTER_DRAIN) { E(acc, cur, wr, wc, fr, fq); S.done(cur); }
        if (!has_next) break;
#pragma unroll
        for (int a = 0; a < 2; ++a)
#pragma unroll
            for (int b = 0; b < 2; ++b)
#pragma unroll
                for (int m = 0; m < 4; ++m)
#pragma unroll
                    for (int n = 0; n < 2; ++n) acc[a][b][m][n] = (f32x4){0.f, 0.f, 0.f, 0.f};
        cur = nxt; cA = nA; cB = nB; ++ui;
        if constexpr (ALIGN_EPI) { if (wr == 1) PG8_BAR; }
    }
    PG8_WAIT_V(0);
    if constexpr (!ALIGN_EPI) { if (wr == 0) PG8_BAR; }
    PG8_BAR;
    if constexpr (Epi::AFTER_DRAIN) { E.fused(acc, cur, wr, wc, fr, fq, lds, wid, lane); S.done(cur); }
#undef PG8_SA
#undef PG8_SB
#undef PG8_STAGE
#undef PG8_LDA
#undef PG8_LDB
#undef PG8_MMA
#undef PG8_WAIT_V
#undef PG8_WAIT_L
#undef PG8_BAR
#undef PG8_SCHED
}
}

#define LAS __attribute__((address_space(3)))
typedef unsigned short bf16;
typedef unsigned v4u __attribute__((ext_vector_type(4)));
typedef unsigned v2u __attribute__((ext_vector_type(2)));
typedef float f32x4 __attribute__((ext_vector_type(4)));
typedef float f32x16 __attribute__((ext_vector_type(16)));
typedef short bf16x8 __attribute__((ext_vector_type(8)));
typedef short s16x4 __attribute__((ext_vector_type(4)));
typedef _Float16 h8 __attribute__((ext_vector_type(8)));

__device__ __forceinline__ unsigned pk2(float lo, float hi) { return pg8::cvt_pk_bf16(lo, hi); }
__device__ __forceinline__ float bflo(unsigned u) { return __uint_as_float(u << 16); }
__device__ __forceinline__ float bfhi(unsigned u) { return __uint_as_float(u & 0xffff0000u); }
__device__ __forceinline__ float bf2f(bf16 b) { return __uint_as_float(((unsigned)b) << 16); }
__device__ __forceinline__ bf16 f2bf(float f) { return (bf16)(pk2(f, 0.f) & 0xffffu); }
#define UNPACK8(v, f) do { f[0] = bflo(v.x); f[1] = bfhi(v.x); f[2] = bflo(v.y); f[3] = bfhi(v.y); f[4] = bflo(v.z); f[5] = bfhi(v.z); f[6] = bflo(v.w); f[7] = bfhi(v.w); } while (0)
#define PACK8(o, f) do { o.x = pk2(f[0], f[1]); o.y = pk2(f[2], f[3]); o.z = pk2(f[4], f[5]); o.w = pk2(f[6], f[7]); } while (0)
__device__ __forceinline__ int ltid() { int t = threadIdx.x; asm volatile("" : "+v"(t)); return t; }
__device__ __forceinline__ float sigmoidf_(float x) { return 1.f / (1.f + __expf(-x)); }
__device__ __forceinline__ float wave_sum(float v) {
#pragma unroll
    for (int o = 1; o < 64; o <<= 1) v += __shfl_xor(v, o);
    return v;
}
__device__ __forceinline__ float sum8(float v) { v += __shfl_xor(v, 1); v += __shfl_xor(v, 2); v += __shfl_xor(v, 4); return v; }
#define DPP_ADD(x, ctrl) ((x) + __builtin_bit_cast(float, __builtin_amdgcn_update_dpp(0, __builtin_bit_cast(int, (x)), (ctrl), 0xF, 0xF, true)))
__device__ __forceinline__ float red8(float x) { x = DPP_ADD(x, 0xB1); x = DPP_ADD(x, 0x4E); x = DPP_ADD(x, 0x141); return x; }

constexpr int DM = 1024, DIN = 6944, DPROJ = 4096, NMAIN = 3872, DGATE = 3072, DFF = 2816;
constexpr int NTOK = 131072, NPROMPT = 65536;
constexpr int C_KA = 512, C_VA = 1024, C_CQ = 1536, C_CKV = 1792, C_KR = 1920, C_RW = 1952;
constexpr float LOG2E = 1.4426950408889634f;
constexpr float NA_QS = 0.125f * LOG2E;
constexpr float MLA_QS = 0.10206207261596575f * LOG2E;
constexpr float NEPS = 1e-6f;

constexpr size_t MiB = 1u << 20;
constexpr size_t WS_CTL = 0, CTL_BYTES = 1 * MiB;
constexpr size_t W_OFF = 1 * MiB, W_STRIDE = 39 * MiB;
constexpr size_t WO_IN = 0, WO_G = 8 * MiB, WO_BR = 14 * MiB, WO_OUT = 17 * MiB, WO_GU = 19 * MiB, WO_DN = 30 * MiB, WO_MU = 35 * MiB + 512 * 1024, WO_RU = 37 * MiB;
constexpr size_t ACT_OFF = 80 * MiB;
constexpr size_t TOKB_H = 2048, TOKB_P = 8192, TOKB_M = 3584, TOKB_A = 1536, TOKB_S = 9216, TOKB_Y = 3072, TOKB_Z = 2048;
constexpr size_t TOKB = TOKB_H + TOKB_P + TOKB_M + TOKB_A + TOKB_S + TOKB_Y + TOKB_Z;
static_assert(WO_MU + 1792 * 384 * 2 <= WO_RU && WO_RU + 2560 * 384 * 2 <= W_STRIDE && WO_DN + 1024 * 2816 * 2 <= WO_MU && WO_GU + 5632 * 1024 * 2 <= WO_DN, "weight map");
constexpr int LDS_RING = 131072, LDS_BYTES = LDS_RING + 1024;

struct Params { const float* in[33]; float* out; unsigned char* ws; int G; int Tg; };
typedef const __attribute__((address_space(4))) Params* CP;

constexpr size_t WS_PARAMS = 512 * 1024;
struct Reg { unsigned char* ws; size_t Tg;
    __device__ __forceinline__ bf16* RH() const { return (bf16*)(ws + ACT_OFF); }
    __device__ __forceinline__ bf16* RP() const { return (bf16*)(ws + ACT_OFF + Tg * TOKB_H); }
    __device__ __forceinline__ bf16* RM() const { return (bf16*)(ws + ACT_OFF + Tg * (TOKB_H + TOKB_P)); }
    __device__ __forceinline__ bf16* RA() const { return (bf16*)(ws + ACT_OFF + Tg * (TOKB_H + TOKB_P + TOKB_M)); }
    __device__ __forceinline__ _Float16* RS() const { return (_Float16*)(ws + ACT_OFF + Tg * (TOKB_H + TOKB_P + TOKB_M + TOKB_A)); }
    __device__ __forceinline__ bf16* RY() const { return (bf16*)(ws + ACT_OFF + Tg * (TOKB_H + TOKB_P + TOKB_M + TOKB_A + TOKB_S)); }
    __device__ __forceinline__ bf16* RZ() const { return (bf16*)(ws + ACT_OFF + Tg * (TOKB_H + TOKB_P + TOKB_M + TOKB_A + TOKB_S + TOKB_Y)); }
};
enum { GM_IN = 0, GM_MU = 1, GM_RU = 2, GM_GATE = 3, GM_BR0 = 4, GM_BR1 = 5, GM_BR2 = 6, GM_OUT = 7, GM_GU = 8, GM_DN = 9 };
#define EPI_FENCE() asm volatile("" ::: "memory")
struct EpiUni {
    static constexpr bool PERM = true, AFTER_DRAIN = false;
    CP pp; int id, l, g;
    __device__ __forceinline__ void operator()(const pg8::f32x4 (&acc)[2][2][4][2], const pg8::Unit& u, int wr, int wc, int fr, int fq) const {
        CP q = pp; asm volatile("" : "+s"(q));
        const int Tg = q->Tg; const Reg R{q->ws, (size_t)Tg}; const size_t asz = (size_t)Tg * 512;
        const int row0 = u.pm * 256 + wr * 64 + fr, col0 = u.pn * 256 + wc * 32 + 8 * fq;
        switch (id) {
        case GM_IN: case GM_MU: {
            bf16* O = (id == GM_IN) ? R.RP() : R.RM(); const int ldc = (id == GM_IN) ? DPROJ : 1792;
#pragma unroll
            for (int ai = 0; ai < 2; ++ai)
#pragma unroll
                for (int m = 0; m < 4; ++m) { bf16* rp = O + (size_t)(row0 + ai * 128 + m * 16) * ldc + col0;
#pragma unroll
                    for (int bj = 0; bj < 2; ++bj) { const f32x4 v0 = acc[ai][bj][m][0], v1 = acc[ai][bj][m][1]; v4u w; w.x = pk2(v0[0], v0[1]); w.y = pk2(v0[2], v0[3]); w.z = pk2(v1[0], v1[1]); w.w = pk2(v1[2], v1[3]);
                        *(v4u*)(rp + bj * 128) = w; } }
        } break;
        case GM_GATE: {
            bf16* O = R.RP(); const float* bias = q->in[4] + l * DGATE + col0;
#pragma unroll
            for (int bj = 0; bj < 2; ++bj) { const f32x4 b0 = *(const f32x4*)(bias + bj * 128), b1 = *(const f32x4*)(bias + bj * 128 + 4);
#pragma unroll
                for (int ai = 0; ai < 2; ++ai)
#pragma unroll
                    for (int m = 0; m < 4; ++m) { const f32x4 v0 = acc[ai][bj][m][0] + b0, v1 = acc[ai][bj][m][1] + b1; float f[8];
#pragma unroll
                        for (int i = 0; i < 4; ++i) { f[i] = sigmoidf_(v0[i]); f[4 + i] = sigmoidf_(v1[i]); }
                        v4u w; PACK8(w, f); *(v4u*)(O + (size_t)(row0 + ai * 128 + m * 16) * DGATE + col0 + bj * 128) = w; }
                EPI_FENCE(); }
        } break;
        case GM_GU: {
            bf16* O = R.RP(); const int hc = u.pn * 128 + wc * 32 + 8 * fq;
#pragma unroll
            for (int ai = 0; ai < 2; ++ai)
#pragma unroll
                for (int m = 0; m < 4; ++m) { float f[8];
#pragma unroll
                    for (int n = 0; n < 2; ++n)
#pragma unroll
                        for (int i = 0; i < 4; ++i) { const float gt = acc[ai][0][m][n][i], up = acc[ai][1][m][n][i]; f[4 * n + i] = gt * sigmoidf_(gt) * up; }
                    v4u w; PACK8(w, f); *(v4u*)(O + (size_t)(row0 + ai * 128 + m * 16) * DFF + hc) = w; }
        } break;
        case GM_BR0: case GM_BR1: case GM_BR2: {
            bf16* O = R.RM(); const bf16* Gt = R.RP() + (id - GM_BR0) * 1024; const bool first = (id == GM_BR0);
#pragma unroll
            for (int ai = 0; ai < 2; ++ai)
#pragma unroll
                for (int m = 0; m < 4; ++m) { const size_t row = (size_t)(row0 + ai * 128 + m * 16);
#pragma unroll
                    for (int bj = 0; bj < 2; ++bj) { const int col = col0 + bj * 128; const v4u gv = *(const v4u*)(Gt + row * DGATE + col); float gg[8], f[8]; UNPACK8(gv, gg);
#pragma unroll
                        for (int i = 0; i < 4; ++i) { f[i] = gg[i] * acc[ai][bj][m][0][i]; f[4 + i] = gg[4 + i] * acc[ai][bj][m][1][i]; }
                        if (!first) { const v4u ov = *(const v4u*)(O + row * DM + col); float o[8]; UNPACK8(ov, o);
#pragma unroll
                            for (int i = 0; i < 8; ++i) f[i] += o[i]; }
                        v4u w; PACK8(w, f); *(v4u*)(O + row * DM + col) = w; }
                    EPI_FENCE(); }
        } break;
        case GM_OUT: case GM_DN: {
            const int t0 = g * Tg; float* xout = q->out + (size_t)t0 * DM;
            const float* xin = (id == GM_OUT && l == 0) ? ((t0 < NPROMPT) ? q->in[0] + (size_t)t0 * DM : q->in[1] + (size_t)(t0 - NPROMPT) * DM) : xout;
#pragma unroll
            for (int ai = 0; ai < 2; ++ai)
#pragma unroll
                for (int m = 0; m < 4; ++m) { const size_t off = (size_t)(row0 + ai * 128 + m * 16) * DM + col0;
#pragma unroll
                    for (int bj = 0; bj < 2; ++bj)
#pragma unroll
                        for (int n = 0; n < 2; ++n) { const f32x4 b = *(const f32x4*)(xin + off + bj * 128 + n * 4); *(f32x4*)(xout + off + bj * 128 + n * 4) = b + acc[ai][bj][m][n]; }
                    EPI_FENCE(); }
        } break;
        case GM_RU: {
            _Float16* rs = R.RS(); const _Float16* ktmp = (const _Float16*)R.RZ(); bf16* gout = R.RY() + 2 * asz;
            const int type = u.pn >> 1; const int cl0 = (u.pn & 1) * 256 + wc * 32 + 8 * fq;
            const float* w0 = q->in[17] + l * 1024; const float* a0 = q->in[19] + l * 1024; const float* ka = q->in[23] + l * 512;
#pragma unroll
            for (int ai = 0; ai < 2; ++ai)
#pragma unroll
                for (int m = 0; m < 4; ++m) { const size_t row = (size_t)(row0 + ai * 128 + m * 16);
#pragma unroll
                    for (int bj = 0; bj < 2; ++bj) { const int cl = cl0 + bj * 128; float f[8];
#pragma unroll
                        for (int i = 0; i < 4; ++i) { f[i] = acc[ai][bj][m][0][i]; f[4 + i] = acc[ai][bj][m][1][i]; }
                        if (type < 2) {
                            h8 o;
#pragma unroll
                            for (int i = 0; i < 8; ++i) o[i] = (_Float16)__expf(-0.6065306597126334f * sigmoidf_(f[i] + w0[type * 512 + cl + i]));
                            *(h8*)(rs + (size_t)(3 + type) * asz + row * 512 + cl) = o;
                        } else if (type < 4) {
                            const int d = type - 2; const h8 kv = *(const h8*)(ktmp + row * 512 + cl), kkv = *(const h8*)(rs + (size_t)2 * asz + row * 512 + cl); h8 o1, o2;
#pragma unroll
                            for (int i = 0; i < 8; ++i) { const float a = sigmoidf_(f[i] + a0[d * 512 + cl + i]); o1[i] = (_Float16)((float)kkv[i] * a); o2[i] = (_Float16)((float)kv[i] * (1.f + (a - 1.f) * ka[cl + i])); }
                            *(h8*)(rs + (size_t)(5 + d) * asz + row * 512 + cl) = o1; *(h8*)(rs + (size_t)(7 + d) * asz + row * 512 + cl) = o2;
                        } else { v4u w; PACK8(w, f); *(v4u*)(gout + row * 512 + cl) = w; }
                        EPI_FENCE(); } }
        } break;
        default: break;
        }
    }
};

__device__ __forceinline__ void transpose_item(const float* W, int ldw, int N, bf16* WT, int ldt, int koff, int row_off, int mode, LAS float* scr, int item, int lane) {
    const int nblk = N / 32, kb = item / nblk, nb = item % nblk, k0 = 64 * kb, n0 = 32 * nb;
#pragma unroll 8
    for (int i = 0; i < 32; ++i) { const int kk = 2 * i + (lane >> 5); scr[kk * 33 + (lane & 31)] = W[(size_t)(k0 + kk) * ldw + n0 + (lane & 31)]; }
    asm volatile("s_waitcnt lgkmcnt(0)" ::: "memory");
    const int c = lane & 7;
#pragma unroll
    for (int j = 0; j < 4; ++j) { const int n = (lane >> 3) + 8 * j; const LAS float* s = scr + (8 * c) * 33 + n;
        v4u o; o.x = pk2(s[0 * 33], s[1 * 33]); o.y = pk2(s[2 * 33], s[3 * 33]); o.z = pk2(s[4 * 33], s[5 * 33]); o.w = pk2(s[6 * 33], s[7 * 33]);
        const int nn = n0 + n; const int drow = mode ? ((nn >> 7) * 256 + row_off + (nn & 127)) : (row_off + nn);
        *(v4u*)(WT + (size_t)drow * ldt + koff + k0 + 8 * c) = o; }
    asm volatile("s_waitcnt lgkmcnt(0)" ::: "memory");
}
__device__ __forceinline__ void transpose_job(const float* W, int ldw, int K, int N, bf16* WT, int ldt, int koff, int row_off, int mode, LAS float* scr, int gw, int ngw, int lane) {
    const int nitems = (K / 64) * (N / 32);
    for (int it = gw; it < nitems; it += ngw) transpose_item(W, ldw, N, WT, ldt, koff, row_off, mode, scr, it, lane);
}
__device__ __forceinline__ void zero_bytes(unsigned char* p, size_t nbytes, size_t gtid, size_t ngt) {
    const v4u z = {0u, 0u, 0u, 0u};
    for (size_t i = gtid; i < nbytes / 16; i += ngt) ((v4u*)p)[i] = z;
}

__device__ __forceinline__ void phase_norm(const float* x, const float* g, bf16* hb, int Tg, int gw, int ngw, int lane) {
    for (int t = gw; t < Tg; t += ngw) {
        const f32x4* xr = (const f32x4*)(x + (size_t)t * DM) + lane; f32x4 v[4]; float s = 0.f;
#pragma unroll
        for (int j = 0; j < 4; ++j) { v[j] = xr[64 * j]; s += (v[j].x * v[j].x + v[j].y * v[j].y) + (v[j].z * v[j].z + v[j].w * v[j].w); }
        const float inv = rsqrtf(wave_sum(s) * (1.f / DM) + NEPS);
        v2u* o8 = (v2u*)(hb + (size_t)t * DM) + lane;
#pragma unroll
        for (int j = 0; j < 4; ++j) { const f32x4 gg = ((const f32x4*)g)[lane + 64 * j]; v2u o; o.x = pk2(v[j].x * inv * gg.x, v[j].y * inv * gg.y); o.y = pk2(v[j].z * inv * gg.z, v[j].w * inv * gg.w); o8[64 * j] = o; }
    }
}

__device__ __forceinline__ void phase_post_proj(CP pp, int l, bf16* proj, bf16* mla_a, bf16* rw_a, _Float16* rs, _Float16* ktmp, size_t asz, int Tg, int L, int gw, int ngw, int lane) {
    const float* gq = pp->in[5] + l * 64; const float* gk = pp->in[6] + l * 64;
    const float* gcq = pp->in[9] + l * 256; const float* gckv = pp->in[10] + l * 128;
    const float* mu = pp->in[16] + l * 1920; const float* kkw = pp->in[22] + l * 512;
    for (int t = gw; t < Tg; t += ngw) {
        bf16* row = proj + (size_t)t * DPROJ; const int tpos = t % L;
        {
            const int gi = 8 * (lane & 7);
            v4u qv = *(const v4u*)(row + 8 * lane); float f[8]; UNPACK8(qv, f); float ss = 0.f;
#pragma unroll
            for (int i = 0; i < 8; ++i) ss += f[i] * f[i];
            float inv = rsqrtf(sum8(ss) * (1.f / 64.f) + NEPS) * NA_QS;
#pragma unroll
            for (int i = 0; i < 8; ++i) f[i] = f[i] * inv * gq[gi + i];
            PACK8(qv, f); *(v4u*)(row + 8 * lane) = qv;
            v4u kv = *(const v4u*)(row + C_KA + 8 * lane); UNPACK8(kv, f); ss = 0.f;
#pragma unroll
            for (int i = 0; i < 8; ++i) ss += f[i] * f[i];
            inv = rsqrtf(sum8(ss) * (1.f / 64.f) + NEPS);
#pragma unroll
            for (int i = 0; i < 8; ++i) f[i] = f[i] * inv * gk[gi + i];
            PACK8(kv, f); *(v4u*)(row + C_KA + 8 * lane) = kv;
        }
        {
            const v2u cv = *(const v2u*)(row + C_CQ + 4 * lane); float a0 = bflo(cv.x), a1 = bfhi(cv.x), a2 = bflo(cv.y), a3 = bfhi(cv.y);
            float inv = rsqrtf(wave_sum(a0 * a0 + a1 * a1 + a2 * a2 + a3 * a3) * (1.f / 256.f) + NEPS);
            const f32x4 gg = *(const f32x4*)(gcq + 4 * lane); v2u o; o.x = pk2(a0 * inv * gg.x, a1 * inv * gg.y); o.y = pk2(a2 * inv * gg.z, a3 * inv * gg.w);
            *(v2u*)(mla_a + (size_t)t * 384 + 4 * lane) = o;
            const unsigned kvv = *(const unsigned*)(row + C_CKV + 2 * lane); a0 = bflo(kvv); a1 = bfhi(kvv);
            inv = rsqrtf(wave_sum(a0 * a0 + a1 * a1) * (1.f / 128.f) + NEPS);
            *(unsigned*)(mla_a + (size_t)t * 384 + 256 + 2 * lane) = pk2(a0 * inv * gckv[2 * lane], a1 * inv * gckv[2 * lane + 1]);
        }
        const bool hasp = tpos > 0, hasn = tpos < L - 1;
#pragma unroll
        for (int it = 0; it < 4; ++it) {
            const int c0 = (it * 64 + lane) * 8;
            if (it < 3 || lane < 48) {
                const bf16* src = row + C_RW + c0; float pc[8], pp[8], pn[8];
                { const v4u v = *(const v4u*)src; UNPACK8(v, pc); }
                if (hasp) { const v4u v = *(const v4u*)(src - DPROJ); UNPACK8(v, pp); } else {
#pragma unroll
                    for (int i = 0; i < 8; ++i) pp[i] = 0.f; }
                if (hasn) { const v4u v = *(const v4u*)(src + DPROJ); UNPACK8(v, pn); } else {
#pragma unroll
                    for (int i = 0; i < 8; ++i) pn[i] = 0.f; }
#pragma unroll
                for (int i = 0; i < 8; ++i) pc[i] = pc[i] + mu[c0 + i] * (0.5f * (pp[i] + pn[i]) - pc[i]);
                if (it == 0) { h8 o;
#pragma unroll
                    for (int i = 0; i < 8; ++i) o[i] = (_Float16)pc[i];
                    *(h8*)(rs + (size_t)t * 512 + c0) = o; }
                else if (it == 1) { const int c = c0 - 512; h8 o; float kk[8]; float ss = 0.f;
#pragma unroll
                    for (int i = 0; i < 8; ++i) { o[i] = (_Float16)pc[i]; kk[i] = pc[i] * kkw[c + i]; ss += kk[i] * kk[i]; }
                    *(h8*)(ktmp + (size_t)t * 512 + c) = o;
                    const float inv = rsqrtf(sum8(ss) + 1e-12f);
#pragma unroll
                    for (int i = 0; i < 8; ++i) o[i] = (_Float16)(kk[i] * inv);
                    *(h8*)(rs + 2 * asz + (size_t)t * 512 + c) = o; }
                else if (it == 2) { const int c = c0 - 1024; h8 o;
#pragma unroll
                    for (int i = 0; i < 8; ++i) o[i] = (_Float16)pc[i];
                    *(h8*)(rs + asz + (size_t)t * 512 + c) = o; }
                else { const int c = c0 - 1536; float f[8];
#pragma unroll
                    for (int i = 0; i < 8; ++i) { const float x = pc[i]; f[i] = (c < 128) ? (1.f - 2.f / (1.f + __expf(2.f * x))) : ((c < 256) ? x : sigmoidf_(x)); }
                    v4u w; PACK8(w, f); *(v4u*)(rw_a + (size_t)t * 384 + c) = w; }
            }
        }
    }
}

__device__ __forceinline__ void phase_mla_post(CP pp, int l, bf16* mraw, const bf16* proj, bf16* mk, int Tg, int L, int gw, int ngw, int lane) {
    const float* gq = pp->in[13] + l * 96; const float* gk = pp->in[14] + l * 96;
    const float gqn = gq[lane], gkn = gk[lane], gqr = lane < 32 ? gq[64 + lane] : 0.f, gkr = lane < 32 ? gk[64 + lane] : 0.f;
    const int fi = lane & 7; const float invf = __expf(-(float)fi * (9.210340371976184f / 8.f));
    for (int t = gw; t < Tg; t += ngw) {
        const int tpos = t % L; const float pos = (float)(((lane & 15) < 8) ? (tpos >> 6) : (tpos & 63));
        float rev = pos * invf * 0.15915494309189535f; rev -= floorf(rev);
        const float cs = __builtin_amdgcn_cosf(rev), sn = __builtin_amdgcn_sinf(rev);
        bf16* mrow = mraw + (size_t)t * 1792; bf16* krow = mk + (size_t)t * 768;
        const float krv = lane < 32 ? bf2f(proj[(size_t)t * DPROJ + C_KR + lane]) : 0.f;
#pragma unroll 2
        for (int h = 0; h < 8; ++h) {
            {   float qn = bf2f(mrow[h * 96 + lane]); float qr = lane < 32 ? bf2f(mrow[h * 96 + 64 + lane]) : 0.f;
                const float inv = rsqrtf(wave_sum(qn * qn + qr * qr) * (1.f / 96.f) + NEPS);
                qn = qn * inv * gqn; qr = qr * inv * gqr;
                const float pr = __shfl_xor(qr, 16);
                const float ro = (lane < 16) ? (qr * cs - pr * sn) : (pr * sn + qr * cs);
                mrow[h * 96 + lane] = f2bf(qn * MLA_QS); if (lane < 32) mrow[h * 96 + 64 + lane] = f2bf(ro * MLA_QS); }
            {   float kn = bf2f(mrow[768 + h * 128 + lane]); float kr = krv;
                const float inv = rsqrtf(wave_sum(kn * kn + kr * kr) * (1.f / 96.f) + NEPS);
                kn = kn * inv * gkn; kr = kr * inv * gkr;
                const float pr = __shfl_xor(kr, 16);
                const float ro = (lane < 16) ? (kr * cs - pr * sn) : (pr * sn + kr * cs);
                krow[h * 96 + lane] = f2bf(kn); if (lane < 32) krow[h * 96 + 64 + lane] = f2bf(ro); }
        }
    }
}

__device__ __forceinline__ void phase_rw_post(CP pp, int l, const _Float16* rs, size_t asz, const bf16* yfb, bf16* yc, int Tg, int gw, int ngw, int lane) {
    const float* lnw = pp->in[25] + l * 512 + 8 * lane; const float* lnb = pp->in[26] + l * 512 + 8 * lane; const float* rk = pp->in[24] + l * 512 + 8 * lane;
    for (int t = gw; t < Tg; t += ngw) {
        const size_t o = (size_t)t * 512 + 8 * lane; float y[8], f[8];
        { const v4u a = *(const v4u*)(yfb + o); const v4u b = *(const v4u*)(yfb + asz + o); UNPACK8(a, y); UNPACK8(b, f); }
        float s = 0.f;
#pragma unroll
        for (int i = 0; i < 8; ++i) { y[i] += f[i]; s += y[i]; }
        const float mean = sum8(s) * (1.f / 64.f); float q = 0.f;
#pragma unroll
        for (int i = 0; i < 8; ++i) { y[i] -= mean; q += y[i] * y[i]; }
        const float rstd = rsqrtf(sum8(q) * (1.f / 64.f) + 64e-5f);
        const h8 r = *(const h8*)(rs + o), v = *(const h8*)(rs + asz + o), kd0 = *(const h8*)(rs + 7 * asz + o), kd1 = *(const h8*)(rs + 8 * asz + o);
        float b = 0.f;
#pragma unroll
        for (int i = 0; i < 8; ++i) b += (float)r[i] * ((float)kd0[i] + (float)kd1[i]) * rk[i];
        b = sum8(b);
        const v4u gv = *(const v4u*)(yc + o); UNPACK8(gv, f);
#pragma unroll
        for (int i = 0; i < 8; ++i) f[i] = (y[i] * rstd * lnw[i] + lnb[i] + b * (float)v[i]) * f[i];
        v4u w; PACK8(w, f); *(v4u*)(yc + o) = w;
    }
}

__device__ __forceinline__ void scan_unit(int u, int L, const _Float16* rs, size_t asz, bf16* yfb) {
    const int tid = ltid(); const int lane = tid & 63, w = tid >> 6, vr = lane >> 3, ko = lane & 7;
    const int dir = u & 1, sh = u >> 1, h = sh & 7, s = sh >> 3;
    const size_t base = (size_t)s * L * 512 + h * 64;
    const long stp = dir ? -512 : 512; const size_t first = dir ? (size_t)(L - 1) * 512 : 0;
    const _Float16* pr = rs + base + first + 8 * ko;
    const _Float16* pv = rs + asz + base + first + 8 * w + vr;
    const _Float16* pkk = rs + 2 * asz + base + first + 8 * ko;
    const _Float16* pw = rs + (size_t)(3 + dir) * asz + base + first + 8 * ko;
    const _Float16* pka = rs + (size_t)(5 + dir) * asz + base + first + 8 * ko;
    const _Float16* pkd = rs + (size_t)(7 + dir) * asz + base + first + 8 * ko;
    bf16* py = yfb + (size_t)dir * asz + base + first + 8 * w + vr;
    float S[8];
#pragma unroll
    for (int i = 0; i < 8; ++i) S[i] = 0.f;
    h8 br[4], bkk[4], bw[4], bka[4], bkd[4]; _Float16 bv[4];
#pragma unroll
    for (int j = 0; j < 4; ++j) { const long o = stp * j; br[j] = *(const h8*)(pr + o); bkk[j] = *(const h8*)(pkk + o); bw[j] = *(const h8*)(pw + o); bka[j] = *(const h8*)(pka + o); bkd[j] = *(const h8*)(pkd + o); bv[j] = pv[o]; }
    for (int i0 = 0; i0 < L; i0 += 4) {
#pragma unroll
        for (int j = 0; j < 4; ++j) {
            const h8 r = br[j], kk = bkk[j], wv = bw[j], ka = bka[j], kd = bkd[j]; const float vv = (float)bv[j];
            { const int nx = i0 + 4 + j; const long o = stp * (long)(nx < L ? nx : L - 1);
              br[j] = *(const h8*)(pr + o); bkk[j] = *(const h8*)(pkk + o); bw[j] = *(const h8*)(pw + o); bka[j] = *(const h8*)(pka + o); bkd[j] = *(const h8*)(pkd + o); bv[j] = pv[o]; }
            float skk = 0.f;
#pragma unroll
            for (int i = 0; i < 8; ++i) skk += S[i] * (float)kk[i];
            skk = -red8(skk);
            float y = 0.f;
#pragma unroll
            for (int i = 0; i < 8; ++i) { float sn = S[i] * (float)wv[i]; sn += skk * (float)ka[i]; sn += vv * (float)kd[i]; S[i] = sn; y += sn * (float)r[i]; }
            y = red8(y);
            if (ko == 0) py[stp * (long)(i0 + j)] = f2bf(y);
        }
    }
}

constexpr int MKP = 208, MVP = 144, MBUF = 64 * MKP + 64 * MVP;
__device__ __forceinline__ void mla_unit(int u, int L, const bf16* mraw, const bf16* mk, bf16* yb, LAS unsigned char* lds) {
    const int tid = ltid(), lane = tid & 63, w = tid >> 6, q32 = lane & 31, hi = lane >> 5;
    const int nqb = L >> 8, qb = u % nqb, sh = u / nqb, h = sh & 7, s = sh >> 3;
    const size_t base = (size_t)s * L; const int NT = L >> 6;
    const size_t qtok = base + qb * 256 + w * 32 + q32;
    bf16x8 qf[6];
#pragma unroll
    for (int ks = 0; ks < 6; ++ks) qf[ks] = *(const bf16x8*)(mraw + qtok * 1792 + h * 96 + ks * 16 + hi * 8);
    const int kkey0 = tid / 12, kch0 = tid % 12, kkey1 = (tid + 512) / 12, kch1 = (tid + 512) % 12; const bool k2 = tid < 256;
    const bf16* ks0 = mk + (base + kkey0) * 768 + h * 96 + kch0 * 8; const bf16* ks1 = mk + (base + kkey1) * 768 + h * 96 + kch1 * 8;
    const int vkey = tid >> 3, vch = tid & 7;
    const bf16* vs = mraw + (base + vkey) * 1792 + 768 + h * 128 + 64 + vch * 8;
    const int kd0 = kkey0 * MKP + kch0 * 16, kd1 = kkey1 * MKP + kch1 * 16, vd = 64 * MKP + vkey * MVP + vch * 16;
    v4u rk0, rk1 = {0u, 0u, 0u, 0u}, rv;
    rk0 = *(const v4u*)ks0; if (k2) rk1 = *(const v4u*)ks1; rv = *(const v4u*)vs;
    *(LAS v4u*)(lds + kd0) = rk0; if (k2) *(LAS v4u*)(lds + kd1) = rk1; *(LAS v4u*)(lds + vd) = rv;
    __syncthreads();
    const int kmap = 16 * (q32 >> 4) + 8 * ((q32 >> 2) & 1) + (q32 & 3) + 4 * ((q32 >> 3) & 1);
    const int koff = kmap * MKP + hi * 16;
    const int voff = 64 * MKP + (8 * hi + ((lane & 15) >> 2)) * MVP + (16 * ((lane >> 4) & 1) + 4 * (lane & 3)) * 2;
    f32x16 o0 = {}, o1 = {}; float m = -1e30f, lsum = 0.f;
    for (int kt = 0; kt < NT; ++kt) {
        const int cur = (kt & 1) * MBUF, nxt = MBUF - cur;
        if (kt + 1 < NT) { const size_t adv = (size_t)(kt + 1) * 64; rk0 = *(const v4u*)(ks0 + adv * 768); if (k2) rk1 = *(const v4u*)(ks1 + adv * 768); rv = *(const v4u*)(vs + adv * 1792); }
        f32x16 s0 = {}, s1 = {};
#pragma unroll
        for (int ks = 0; ks < 6; ++ks) {
            const bf16x8 a0 = *(const LAS bf16x8*)(lds + cur + koff + ks * 32), a1 = *(const LAS bf16x8*)(lds + cur + koff + 32 * MKP + ks * 32);
            s0 = __builtin_amdgcn_mfma_f32_32x32x16_bf16(a0, qf[ks], s0, 0, 0, 0); s1 = __builtin_amdgcn_mfma_f32_32x32x16_bf16(a1, qf[ks], s1, 0, 0, 0);
        }
        float mt = fmaxf(s0[0], s1[0]);
#pragma unroll
        for (int r = 1; r < 16; ++r) mt = fmaxf(mt, fmaxf(s0[r], s1[r]));
        mt = fmaxf(mt, __shfl_xor(mt, 32));
        const float mn = fmaxf(m, mt), alpha = __builtin_amdgcn_exp2f(m - mn); m = mn;
        float ps = 0.f;
#pragma unroll
        for (int r = 0; r < 16; ++r) { s0[r] = __builtin_amdgcn_exp2f(s0[r] - mn); s1[r] = __builtin_amdgcn_exp2f(s1[r] - mn); ps += s0[r] + s1[r]; }
        lsum = lsum * alpha + ps;
#pragma unroll
        for (int r = 0; r < 16; ++r) { o0[r] *= alpha; o1[r] *= alpha; }
#pragma unroll
        for (int kb = 0; kb < 2; ++kb)
#pragma unroll
            for (int g = 0; g < 2; ++g) {
                v4u pw;
                if (kb == 0) { pw.x = pk2(s0[8 * g + 0], s0[8 * g + 1]); pw.y = pk2(s0[8 * g + 2], s0[8 * g + 3]); pw.z = pk2(s0[8 * g + 4], s0[8 * g + 5]); pw.w = pk2(s0[8 * g + 6], s0[8 * g + 7]); }
                else         { pw.x = pk2(s1[8 * g + 0], s1[8 * g + 1]); pw.y = pk2(s1[8 * g + 2], s1[8 * g + 3]); pw.z = pk2(s1[8 * g + 4], s1[8 * g + 5]); pw.w = pk2(s1[8 * g + 6], s1[8 * g + 7]); }
                const bf16x8 pf = __builtin_bit_cast(bf16x8, pw);
                const int vb = cur + voff + (kb * 32 + 16 * g) * MVP;
                const s16x4 a00 = __builtin_amdgcn_ds_read_tr16_b64_v4i16((LAS s16x4*)(lds + vb)), a01 = __builtin_amdgcn_ds_read_tr16_b64_v4i16((LAS s16x4*)(lds + vb + 4 * MVP));
                const s16x4 a10 = __builtin_amdgcn_ds_read_tr16_b64_v4i16((LAS s16x4*)(lds + vb + 64)), a11 = __builtin_amdgcn_ds_read_tr16_b64_v4i16((LAS s16x4*)(lds + vb + 64 + 4 * MVP));
                const bf16x8 v0 = {a00[0], a00[1], a00[2], a00[3], a01[0], a01[1], a01[2], a01[3]}, v1 = {a10[0], a10[1], a10[2], a10[3], a11[0], a11[1], a11[2], a11[3]};
                o0 = __builtin_amdgcn_mfma_f32_32x32x16_bf16(v0, pf, o0, 0, 0, 0); o1 = __builtin_amdgcn_mfma_f32_32x32x16_bf16(v1, pf, o1, 0, 0, 0);
            }
        if (kt + 1 < NT) { *(LAS v4u*)(lds + nxt + kd0) = rk0; if (k2) *(LAS v4u*)(lds + nxt + kd1) = rk1; *(LAS v4u*)(lds + nxt + vd) = rv; }
        __syncthreads();
    }
    lsum += __shfl_xor(lsum, 32);
    const float inv = 1.f / lsum;
    bf16* orow = yb + qtok * 512 + h * 64 + 4 * hi;
#pragma unroll
    for (int rq = 0; rq < 4; ++rq) {
        v2u a, b; a.x = pk2(o0[4 * rq] * inv, o0[4 * rq + 1] * inv); a.y = pk2(o0[4 * rq + 2] * inv, o0[4 * rq + 3] * inv);
        b.x = pk2(o1[4 * rq] * inv, o1[4 * rq + 1] * inv); b.y = pk2(o1[4 * rq + 2] * inv, o1[4 * rq + 3] * inv);
        *(v2u*)(orow + 8 * rq) = a; *(v2u*)(orow + 32 + 8 * rq) = b;
    }
}

constexpr int NVP = 144;
__device__ __forceinline__ void na_unit(int u, int L, int l, const float* rpb_all, const bf16* proj, bf16* ya, LAS unsigned char* lds) {
    const int tid = ltid(); const int lane = tid & 63, w = tid >> 6, i16 = lane & 15, quad = lane >> 4;
    const int rows = L >> 6; const int hq = u & 3, sr = u >> 2, r = sr % rows, s = sr / rows;
    const int h = 2 * hq + (w >> 2), j = w & 3;
    const int rs = min(max(r - 4, 0), rows - 8), kc0 = min(max(16 * j - 8, 0), 32);
    const size_t base = (size_t)s * L;
    const size_t qtok = base + r * 64 + 16 * j + i16;
    bf16x8 qf[2];
    qf[0] = *(const bf16x8*)(proj + qtok * DPROJ + h * 64 + quad * 8); qf[1] = *(const bf16x8*)(proj + qtok * DPROJ + h * 64 + 32 + quad * 8);
    const int cA = (i16 >> 2) * 8 + (i16 & 3);
    f32x4 sa[8], sb[8];
#pragma unroll
    for (int wr = 0; wr < 8; ++wr) {
        const bf16* kp = proj + (base + (size_t)(rs + wr) * 64 + kc0 + cA) * DPROJ + C_KA + h * 64 + quad * 8;
        const bf16x8 ka0 = *(const bf16x8*)kp, ka1 = *(const bf16x8*)(kp + 32), kb0 = *(const bf16x8*)(kp + 4 * DPROJ), kb1 = *(const bf16x8*)(kp + 4 * DPROJ + 32);
        f32x4 a = {0.f, 0.f, 0.f, 0.f}, b = {0.f, 0.f, 0.f, 0.f};
        a = __builtin_amdgcn_mfma_f32_16x16x32_bf16(ka0, qf[0], a, 0, 0, 0); a = __builtin_amdgcn_mfma_f32_16x16x32_bf16(ka1, qf[1], a, 0, 0, 0);
        b = __builtin_amdgcn_mfma_f32_16x16x32_bf16(kb0, qf[0], b, 0, 0, 0); b = __builtin_amdgcn_mfma_f32_16x16x32_bf16(kb1, qf[1], b, 0, 0, 0);
        sa[wr] = a; sb[wr] = b;
    }
    const int qc = 16 * j + i16, wst = min(max(qc - 8, 0), 48);
    const float* rpb = rpb_all + (size_t)(l * 8 + h) * 15 * 31;
    float mx = -1e30f;
#pragma unroll
    for (int wr = 0; wr < 8; ++wr) { const float* rb = rpb + (rs + wr - r + 7) * 31;
#pragma unroll
        for (int jj = 0; jj < 4; ++jj) {
            { const int kc = kc0 + quad * 8 + jj; const bool ok = (kc >= wst) && (kc < wst + 16); const int dc = min(max(kc - qc + 15, 0), 30);
              const float v = ok ? (sa[wr][jj] + rb[dc] * LOG2E) : -1e30f; sa[wr][jj] = v; mx = fmaxf(mx, v); }
            { const int kc = kc0 + quad * 8 + 4 + jj; const bool ok = (kc >= wst) && (kc < wst + 16); const int dc = min(max(kc - qc + 15, 0), 30);
              const float v = ok ? (sb[wr][jj] + rb[dc] * LOG2E) : -1e30f; sb[wr][jj] = v; mx = fmaxf(mx, v); }
        } }
    mx = fmaxf(mx, __shfl_xor(mx, 16)); mx = fmaxf(mx, __shfl_xor(mx, 32));
    float ls = 0.f;
#pragma unroll
    for (int wr = 0; wr < 8; ++wr)
#pragma unroll
        for (int jj = 0; jj < 4; ++jj) { sa[wr][jj] = __builtin_amdgcn_exp2f(sa[wr][jj] - mx); sb[wr][jj] = __builtin_amdgcn_exp2f(sb[wr][jj] - mx); ls += sa[wr][jj] + sb[wr][jj]; }
    ls += __shfl_xor(ls, 16); ls += __shfl_xor(ls, 32);
    LAS unsigned char* vw = lds + w * (64 * NVP);
    f32x4 oc[4];
#pragma unroll
    for (int db = 0; db < 4; ++db) oc[db] = (f32x4){0.f, 0.f, 0.f, 0.f};
    const int toff = (quad * 8 + (i16 >> 2)) * NVP + (4 * (lane & 3)) * 2;
#pragma unroll
    for (int ck = 0; ck < 4; ++ck) {
        v4u tmp[8];
#pragma unroll
        for (int it = 0; it < 8; ++it) { const int idx = it * 64 + lane, key = idx >> 3, ch = idx & 7;
            tmp[it] = *(const v4u*)(proj + (base + (size_t)(rs + 2 * ck + (key >> 5)) * 64 + kc0 + (key & 31)) * DPROJ + C_VA + h * 64 + ch * 8); }
        asm volatile("s_waitcnt lgkmcnt(0)" ::: "memory");
#pragma unroll
        for (int it = 0; it < 8; ++it) { const int idx = it * 64 + lane, key = idx >> 3, ch = idx & 7; *(LAS v4u*)(vw + key * NVP + ch * 16) = tmp[it]; }
        asm volatile("s_waitcnt lgkmcnt(0)" ::: "memory");
#pragma unroll
        for (int wl = 0; wl < 2; ++wl) { const int wr = 2 * ck + wl;
            v4u pw; pw.x = pk2(sa[wr][0], sa[wr][1]); pw.y = pk2(sa[wr][2], sa[wr][3]); pw.z = pk2(sb[wr][0], sb[wr][1]); pw.w = pk2(sb[wr][2], sb[wr][3]);
            const bf16x8 pf = __builtin_bit_cast(bf16x8, pw);
#pragma unroll
            for (int db = 0; db < 4; ++db) { const int vb = toff + wl * 32 * NVP + db * 32;
                const s16x4 t0 = __builtin_amdgcn_ds_read_tr16_b64_v4i16((LAS s16x4*)(vw + vb)), t1 = __builtin_amdgcn_ds_read_tr16_b64_v4i16((LAS s16x4*)(vw + vb + 4 * NVP));
                const bf16x8 vf = {t0[0], t0[1], t0[2], t0[3], t1[0], t1[1], t1[2], t1[3]};
                oc[db] = __builtin_amdgcn_mfma_f32_16x16x32_bf16(vf, pf, oc[db], 0, 0, 0); }
        }
    }
    const float inv = 1.f / ls;
    bf16* orow = ya + qtok * 512 + h * 64 + quad * 4;
#pragma unroll
    for (int db = 0; db < 4; ++db) { v2u o; o.x = pk2(oc[db][0] * inv, oc[db][1] * inv); o.y = pk2(oc[db][2] * inv, oc[db][3] * inv); *(v2u*)(orow + db * 16) = o; }
}

constexpr int NPH = 13;
__device__ __forceinline__ void run_phase(CP pp, int st, LAS unsigned char* lds) {
    volatile LAS unsigned* lctl = (volatile LAS unsigned*)(lds + LDS_RING);
    const int tid = ltid(), lane = tid & 63, wave = __builtin_amdgcn_readfirstlane(tid >> 6);
    int bid_ = blockIdx.x; asm volatile("" : "+s"(bid_));
    const int NB = gridDim.x, gw = bid_ * 8 + wave, ngw = NB * 8;
    const int ph = st % NPH, gl = st / NPH, l = gl & 1, g = gl >> 1;
    unsigned char* ws = pp->ws; const int Tg = pp->Tg;
    const Reg R{ws, (size_t)Tg};
    const size_t asz = (size_t)Tg * 512;
    const int t0 = g * Tg; const int L = (t0 < NPROMPT) ? 8192 : 4096;
    float* xout = pp->out + (size_t)t0 * DM;
    int gid0 = 0, gidn = 0;
    switch (ph) {
    case 0: {
        const float* xin = (l == 0) ? ((t0 < NPROMPT) ? pp->in[0] + (size_t)t0 * DM : pp->in[1] + (size_t)(t0 - NPROMPT) * DM) : xout;
        phase_norm(xin, pp->in[2] + l * DM, R.RH(), Tg, gw, ngw, lane);
    } break;
    case 1: gid0 = GM_IN; gidn = 1; break;
    case 2: {
        phase_post_proj(pp, l, R.RP(), R.RA(), R.RA() + (size_t)Tg * 384, R.RS(), (_Float16*)R.RZ(), asz, Tg, L, gw, ngw, lane);
    } break;
    case 3: gid0 = GM_MU; gidn = 2; break;
    case 4: {
        phase_mla_post(pp, l, R.RM(), R.RP(), R.RA(), Tg, L, gw, ngw, lane);
    } break;
    case 5: {
        unsigned* qctr = (unsigned*)(ws + WS_CTL) + 64 * gl; const int nseq = Tg / L;
        const int NS = nseq * 16, NM = nseq * 8 * (L >> 8), NN = nseq * (L >> 6) * 4, NTOT = NS + NM + NN;
        for (;;) {
            __syncthreads();
            if (tid == 0) lctl[0] = atomicAdd(qctr, 1u);
            __syncthreads();
            const int u = (int)lctl[0];
            if (u >= NTOT) break;
            if (u < NS) scan_unit(u, L, R.RS(), asz, R.RZ());
            else if (u < NS + NM) mla_unit(u - NS, L, R.RM(), R.RA(), R.RY() + asz, lds);
            else na_unit(u - NS - NM, L, l, pp->in[7], R.RP(), R.RY(), lds);
        }
    } break;
    case 6: {
        phase_rw_post(pp, l, R.RS(), asz, R.RZ(), R.RY() + 2 * asz, Tg, gw, ngw, lane);
    } break;
    case 7: gid0 = GM_GATE; gidn = 1; break;
    case 8: gid0 = GM_BR0; gidn = 3; break;
    case 9: gid0 = GM_OUT; gidn = 1; break;
    case 10: {
        phase_norm(xout, pp->in[29] + l * DM, R.RH(), Tg, gw, ngw, lane);
    } break;
    case 11: gid0 = GM_GU; gidn = 1; break;
    case 12: gid0 = GM_DN; gidn = 1; break;
    default: break;
    }
#pragma unroll 1
    for (int id = gid0; id < gid0 + gidn; ++id) {
        const unsigned char* wb = ws + W_OFF + (size_t)l * W_STRIDE;
        const bf16* A; const bf16* Bt; int N, K;
        switch (id) {
        case GM_IN:   A = R.RH(); Bt = (const bf16*)(wb + WO_IN); N = DPROJ; K = 1024; break;
        case GM_MU:   A = R.RA(); Bt = (const bf16*)(wb + WO_MU); N = 1792; K = 384; break;
        case GM_RU:   A = R.RA() + (size_t)Tg * 384; Bt = (const bf16*)(wb + WO_RU); N = 2560; K = 384; break;
        case GM_GATE: A = R.RH(); Bt = (const bf16*)(wb + WO_G); N = DGATE; K = 1024; break;
        case GM_BR0: case GM_BR1: case GM_BR2: A = R.RY() + (size_t)(id - GM_BR0) * asz; Bt = (const bf16*)(wb + WO_BR + (size_t)(id - GM_BR0) * MiB); N = DM; K = 512; break;
        case GM_OUT:  A = R.RM(); Bt = (const bf16*)(wb + WO_OUT); N = DM; K = 1024; break;
        case GM_GU:   A = R.RH(); Bt = (const bf16*)(wb + WO_GU); N = 2 * DFF; K = 1024; break;
        default:      A = R.RP(); Bt = (const bf16*)(wb + WO_DN); N = DM; K = DFF; break;
        }
        pg8::Gemm gm{A, Bt, Tg, N, K}; pg8::StaticOrder S; S.init(Tg, N, NB, bid_);
        EpiUni E{pp, id, l, g}; pg8::gemm_phase<EpiUni, pg8::StaticOrder, true, true>(lds, gm, S, E);
    }
}

__device__ __forceinline__ void run_phase0(CP pp, int part, LAS unsigned char* lds) {
    const int tid = ltid(), lane = tid & 63, wave = __builtin_amdgcn_readfirstlane(tid >> 6);
    const int NB = gridDim.x, gw = blockIdx.x * 8 + wave, ngw = NB * 8;
    const size_t gtid = (size_t)blockIdx.x * 512 + tid, ngt = (size_t)NB * 512;
    unsigned char* ws = pp->ws;
    if (part == 0) {
        for (int l = 0; l < 2; ++l) { unsigned char* wb = ws + W_OFF + (size_t)l * W_STRIDE;
            zero_bytes(wb + WO_IN + (size_t)NMAIN * 2048, (size_t)(DPROJ - NMAIN) * 2048, gtid, ngt);
            zero_bytes(wb + WO_MU, (size_t)1792 * 384 * 2, gtid, ngt);
            zero_bytes(wb + WO_RU, (size_t)2560 * 384 * 2, gtid, ngt); }
    } else {
        LAS float* scr = (LAS float*)(lds + wave * 16384);
#pragma unroll 1
        for (int l = 0; l < 2; ++l) { unsigned char* wb = ws + W_OFF + (size_t)l * W_STRIDE;
            const float* w_in = pp->in[3] + (size_t)l * DM * DIN;
            transpose_job(w_in, DIN, 1024, NMAIN, (bf16*)(wb + WO_IN), 1024, 0, 0, 0, scr, gw, ngw, lane);
            transpose_job(w_in + NMAIN, DIN, 1024, DGATE, (bf16*)(wb + WO_G), 1024, 0, 0, 0, scr, gw, ngw, lane);
            transpose_job(pp->in[8] + (size_t)l * 512 * 1024, 1024, 512, 1024, (bf16*)(wb + WO_BR), 512, 0, 0, 0, scr, gw, ngw, lane);
            transpose_job(pp->in[15] + (size_t)l * 512 * 1024, 1024, 512, 1024, (bf16*)(wb + WO_BR + 1 * MiB), 512, 0, 0, 0, scr, gw, ngw, lane);
            transpose_job(pp->in[27] + (size_t)l * 512 * 1024, 1024, 512, 1024, (bf16*)(wb + WO_BR + 2 * MiB), 512, 0, 0, 0, scr, gw, ngw, lane);
            transpose_job(pp->in[28] + (size_t)l * 1024 * 1024, 1024, 1024, 1024, (bf16*)(wb + WO_OUT), 1024, 0, 0, 0, scr, gw, ngw, lane);
            transpose_job(pp->in[30] + (size_t)l * 1024 * DFF, DFF, 1024, DFF, (bf16*)(wb + WO_GU), 1024, 0, 0, 1, scr, gw, ngw, lane);
            transpose_job(pp->in[31] + (size_t)l * 1024 * DFF, DFF, 1024, DFF, (bf16*)(wb + WO_GU), 1024, 0, 128, 1, scr, gw, ngw, lane);
            transpose_job(pp->in[32] + (size_t)l * DFF * 1024, 1024, DFF, 1024, (bf16*)(wb + WO_DN), DFF, 0, 0, 0, scr, gw, ngw, lane);
            transpose_job(pp->in[11] + (size_t)l * 256 * 768, 768, 256, 768, (bf16*)(wb + WO_MU), 384, 0, 0, 0, scr, gw, ngw, lane);
            transpose_job(pp->in[12] + (size_t)l * 128 * 1024, 1024, 128, 1024, (bf16*)(wb + WO_MU), 384, 256, 768, 0, scr, gw, ngw, lane);
#pragma unroll 1
            for (int d = 0; d < 2; ++d) {
                transpose_job(pp->in[18] + (size_t)(l * 2 + d) * 64 * 512, 512, 64, 512, (bf16*)(wb + WO_RU), 384, 64 * d, 512 * d, 0, scr, gw, ngw, lane);
                transpose_job(pp->in[20] + (size_t)(l * 2 + d) * 64 * 512, 512, 64, 512, (bf16*)(wb + WO_RU), 384, 128 + 64 * d, 1024 + 512 * d, 0, scr, gw, ngw, lane); }
            transpose_job(pp->in[21] + (size_t)l * 128 * 512, 512, 128, 512, (bf16*)(wb + WO_RU), 384, 256, 2048, 0, scr, gw, ngw, lane);
        }
    }
}

__global__ void __launch_bounds__(512, 2) mega(Params p) {
    extern __shared__ __attribute__((aligned(16))) unsigned char lds_raw[];
    LAS unsigned char* lds = (LAS unsigned char*)lds_raw;
    cg::grid_group grid = cg::this_grid();
    if (blockIdx.x == 0 && threadIdx.x == 0) { Params* d = (Params*)(p.ws + WS_PARAMS); *d = p; }
    const int nsteps = p.G * 2 * NPH;
    grid.sync();
#pragma unroll 1
    for (int st = -2; st < nsteps; ++st) {
        int s2 = st; asm volatile("" : "+s"(s2));
        CP pp = (CP)(p.ws + WS_PARAMS); asm volatile("" : "+s"(pp));
        if (s2 < 0) run_phase0(pp, s2 + 2, lds); else run_phase(pp, s2, lds);
        grid.sync();
    }
}

extern "C" void kernel_launch(void* const* d_in, const int* in_sizes, int n_in, void* d_out, int out_size, void* d_ws, size_t ws_size, hipStream_t stream) {
    static int grid = 0;
    if (grid == 0) {
        int dev = 0, cus = 0, per_cu = 0;
        hipGetDevice(&dev); hipDeviceGetAttribute(&cus, hipDeviceAttributeMultiprocessorCount, dev);
        hipFuncSetAttribute((const void*)mega, hipFuncAttributeMaxDynamicSharedMemorySize, LDS_BYTES);
        hipOccupancyMaxActiveBlocksPerMultiprocessor(&per_cu, (const void*)mega, 512, LDS_BYTES);
        (void)hipGetLastError();
        if (per_cu < 1) per_cu = 1;
        grid = cus * per_cu;
    }
    int G = 2;
    while (G < 16 && ACT_OFF + (size_t)(NTOK / G) * TOKB > ws_size) G *= 2;
    if (hipMemsetAsync((char*)d_ws + WS_CTL, 0, CTL_BYTES, stream) != hipSuccess) { fprintf(stderr, "kernel_launch: memset failed\n"); return; }
    Params p{};
    for (int i = 0; i < 33; ++i) p.in[i] = (const float*)d_in[i];
    p.out = (float*)d_out; p.ws = (unsigned char*)d_ws; p.G = G; p.Tg = NTOK / G;
    void* args[] = {&p};
    hipError_t e = hipLaunchCooperativeKernel((const void*)mega, dim3(grid), dim3(512), args, LDS_BYTES, stream);
    if (e != hipSuccess) fprintf(stderr, "cooperative launch failed: %s (grid %d)\n", hipGetErrorString(e), grid);
}
```

```cpp
#include <hip/hip_runtime.h>
#include <hip/hip_cooperative_groups.h>
#include <cstdio>
#include <cstdint>
namespace cg = cooperative_groups;
namespace pg8 {
#define PG8_LAS __attribute__((address_space(3)))
typedef unsigned short bf16_t;
typedef short bf16x8 __attribute__((ext_vector_type(8)));
typedef float f32x4 __attribute__((ext_vector_type(4)));
typedef unsigned u32x4 __attribute__((ext_vector_type(4)));
constexpr int BM = 256, BK = 64, HALF = 128, HTB = HALF * BK * 2  , STAGE_BYTES = 8 * HTB, NXCD = 8, WGM = 8;

__host__ __device__ __forceinline__ int lds_byte(int r, int c) { const int st = (r >> 4) * 2 + (c >> 5), rr = r & 15, cc = c & 31, ob = rr * 64 + cc * 2; return st * 1024 + (ob ^ (((ob >> 9) & 1) << 5)); }
__host__ __device__ __forceinline__ void stage_rc(int b, int& R, int& C) { const int st = b / 1024, sb = b % 1024, swz = sb ^ (((sb >> 9) & 1) << 5); R = (st >> 1) * 16 + swz / 64; C = (st & 1) * 32 + (swz % 64) / 2; }
__host__ __device__ __forceinline__ int perm32(int rho) { const int n = rho >> 4, i = rho & 15; return 8 * (i >> 2) + 4 * n + (i & 3); }

struct Unit { int pm, pn; };
struct Gemm { const bf16_t* A; const bf16_t* Bt; int M, N, K; };

struct StaticOrder {
    int nM, nN, nwg, G, c;
    __host__ __device__ void init(int M, int N, int G_, int c_) { nM = M / BM; nN = N / BM; nwg = nM * nN; G = G_; c = c_; }
    __host__ __device__ bool next(int i, Unit& u) const {
        const long L = (long)i * G + c; if (L >= nwg) return false;
        int wgid = (int)L; { const int q = nwg / NXCD, r = nwg % NXCD, xcd = wgid % NXCD, off = wgid / NXCD; wgid = (xcd < r ? xcd * (q + 1) : r * (q + 1) + (xcd - r) * q) + off; }
        const int nig = WGM * nN, gid = wgid / nig, fm = gid * WGM, gsz = (nM - fm) < WGM ? (nM - fm) : WGM;
        u.pm = fm + ((wgid % nig) % gsz); u.pn = (wgid % nig) / gsz; return true;
    }
    __device__ __forceinline__ void a_ready(const Unit&) const {}
    __device__ __forceinline__ void done(const Unit&) const {}
};

__device__ __forceinline__ unsigned cvt_pk_bf16(float lo, float hi) { unsigned r; asm volatile("v_cvt_pk_bf16_f32 %0, %1, %2" : "=v"(r) : "v"(lo), "v"(hi)); return r; }
typedef float f32x2 __attribute__((ext_vector_type(2)));
}
namespace pg8 {
template <class Epi, class Sched, bool ALIGN_EPI = false, bool SP2 = false>
__device__ __forceinline__ void gemm_phase(PG8_LAS unsigned char* lds, const Gemm g, const Sched& S, const Epi& E) {
    int tid_l = threadIdx.x; asm volatile("" : "+v"(tid_l)); const int tid = tid_l, wid = __builtin_amdgcn_readfirstlane(tid >> 6), lane = tid & 63, wr = wid >> 2, wc = wid & 3, fr = lane & 15, fq = lane >> 4;
    const int K = g.K, nt = K / BK;
    unsigned voffA[2], voffB[2];
#pragma unroll
    for (int i = 0; i < 2; ++i) { int R, C; stage_rc(tid * 16 + i * 8192, R, C); const int Rb = Epi::PERM ? ((R & ~31) + perm32(R & 31)) : R;
        voffA[i] = (unsigned)(R * K + C) * 2u; voffB[i] = (unsigned)(Rb * K + C) * 2u; }
    const size_t kstep = (size_t)(BK * 2);
    const size_t hstep = (size_t)HALF * K * 2;
    const size_t tstep = 2 * hstep;
    const unsigned ldsw = (unsigned)wid * 1024u;
    const int aoff = lds_byte(wr * 64 + fr, fq * 8), boff = lds_byte(wc * 32 + fr, fq * 8);
#define PG8_SA(b, h) (((b) * 2 + (h)) * HTB)
#define PG8_SB(b, h) ((4 + (b) * 2 + (h)) * HTB)
#define PG8_STAGE(bufoff, gbase, voff) do { _Pragma("unroll") for (int _i = 0; _i < 2; ++_i) \
        __builtin_amdgcn_global_load_lds((const unsigned*)((const char*)(gbase) + (voff)[_i]), (PG8_LAS unsigned*)(lds + (bufoff) + ldsw + _i * 8192), 16, 0, 0); } while (0)
#define PG8_LDA(dst, b, h) do { _Pragma("unroll") for (int m = 0; m < 4; ++m) _Pragma("unroll") for (int k = 0; k < 2; ++k) dst[m][k] = *(const PG8_LAS bf16x8*)(lds + PG8_SA(b, h) + aoff + m * 2048 + k * 1024); } while (0)
#define PG8_LDB(dst, b, h) do { _Pragma("unroll") for (int n = 0; n < 2; ++n) _Pragma("unroll") for (int k = 0; k < 2; ++k) dst[n][k] = *(const PG8_LAS bf16x8*)(lds + PG8_SB(b, h) + boff + n * 2048 + k * 1024); } while (0)
#define PG8_MMA(ai, bj, At, Bt) do { __builtin_amdgcn_s_setprio(1); _Pragma("unroll") for (int m = 0; m < 4; ++m) _Pragma("unroll") for (int n = 0; n < 2; ++n) _Pragma("unroll") for (int k = 0; k < 2; ++k) \
        acc[ai][bj][m][n] = __builtin_amdgcn_mfma_f32_16x16x32_bf16(Bt[n][k], At[m][k], acc[ai][bj][m][n], 0, 0, 0); __builtin_amdgcn_s_setprio(0); } while (0)
#define PG8_WAIT_V(n) asm volatile("s_waitcnt vmcnt(" #n ")" ::: "memory")
#define PG8_WAIT_L(n) asm volatile("s_waitcnt lgkmcnt(" #n ")" ::: "memory")
#define PG8_BAR __builtin_amdgcn_s_barrier()
#define PG8_SCHED __builtin_amdgcn_sched_barrier(0)
    Unit cur, nxt; int ui = 0;
    if (!S.next(0, cur)) return;
    f32x4 acc[2][2][4][2];
#pragma unroll
    for (int a = 0; a < 2; ++a)
#pragma unroll
        for (int b = 0; b < 2; ++b)
#pragma unroll
            for (int m = 0; m < 4; ++m)
#pragma unroll
                for (int n = 0; n < 2; ++n) acc[a][b][m][n] = (f32x4){0.f, 0.f, 0.f, 0.f};
    bf16x8 At[4][2], B0[2][2], B1[2][2];
    const char* cA = (const char*)g.A + (size_t)cur.pm * tstep; const char* cB = (const char*)g.Bt + (size_t)cur.pn * tstep;
    S.a_ready(cur);
    if constexpr (SP2) {
        PG8_STAGE(PG8_SB(0, 0), cB, voffB); PG8_STAGE(PG8_SB(0, 1), cB + hstep, voffB); PG8_STAGE(PG8_SA(0, 0), cA, voffA); PG8_STAGE(PG8_SA(0, 1), cA + hstep, voffA);
        if (wr == 1) PG8_BAR;
        PG8_WAIT_V(2); PG8_BAR;
        PG8_STAGE(PG8_SB(1, 0), cB + kstep, voffB); PG8_STAGE(PG8_SA(1, 0), cA + kstep, voffA); PG8_STAGE(PG8_SB(1, 1), cB + hstep + kstep, voffB);
        PG8_WAIT_V(6); PG8_BAR;
    } else {
        PG8_STAGE(PG8_SB(0, 0), cB, voffB); PG8_STAGE(PG8_SA(0, 0), cA, voffA); PG8_STAGE(PG8_SB(0, 1), cB + hstep, voffB); PG8_STAGE(PG8_SA(0, 1), cA + hstep, voffA);
        if (wr == 1) PG8_BAR;
        PG8_WAIT_V(4); PG8_BAR;
        PG8_STAGE(PG8_SB(1, 0), cB + kstep, voffB); PG8_STAGE(PG8_SA(1, 0), cA + kstep, voffA); PG8_STAGE(PG8_SB(1, 1), cB + hstep + kstep, voffB);
        PG8_WAIT_V(6); PG8_BAR;
    }
    for (;;) {
        const bool has_next = S.next(ui + 1, nxt);
        const char* nA = has_next ? (const char*)g.A + (size_t)nxt.pm * tstep : cA; const char* nB = has_next ? (const char*)g.Bt + (size_t)nxt.pn * tstep : cB;
        for (int t = 0; t < nt; t += 2) {
            const bool last = (t == nt - 2);
            const char* a1 = cA + (size_t)(t + 1) * kstep;
            const char* a2 = last ? nA : cA + (size_t)(t + 2) * kstep; const char* b2 = last ? nB : cB + (size_t)(t + 2) * kstep;
            const char* a3 = a2 + kstep; const char* b3 = b2 + kstep;
            if (last && has_next) S.a_ready(nxt);
            if constexpr (SP2) {
            PG8_LDB(B0, 0, 0); PG8_LDB(B1, 0, 1); PG8_SCHED; PG8_LDA(At, 0, 0); PG8_STAGE(PG8_SA(1, 1), a1 + hstep, voffA);
            PG8_WAIT_V(8); PG8_WAIT_L(0); PG8_BAR; PG8_MMA(0, 0, At, B0); PG8_MMA(0, 1, At, B1); PG8_BAR; PG8_SCHED;
            PG8_LDA(At, 0, 1); PG8_STAGE(PG8_SB(0, 0), b2, voffB); PG8_STAGE(PG8_SB(0, 1), b2 + hstep, voffB); PG8_STAGE(PG8_SA(0, 0), a2, voffA);
            PG8_WAIT_V(8); PG8_WAIT_L(0); PG8_BAR; PG8_MMA(1, 0, At, B0); PG8_MMA(1, 1, At, B1); PG8_BAR; PG8_SCHED;
            PG8_LDB(B0, 1, 0); PG8_LDB(B1, 1, 1); PG8_SCHED; PG8_LDA(At, 1, 0); PG8_STAGE(PG8_SA(0, 1), a2 + hstep, voffA);
            PG8_WAIT_V(8); PG8_WAIT_L(0); PG8_BAR; PG8_MMA(0, 0, At, B0); PG8_MMA(0, 1, At, B1); PG8_BAR; PG8_SCHED;
            PG8_LDA(At, 1, 1); PG8_STAGE(PG8_SB(1, 0), b3, voffB); PG8_STAGE(PG8_SB(1, 1), b3 + hstep, voffB); PG8_STAGE(PG8_SA(1, 0), a3, voffA);
            PG8_WAIT_V(8); PG8_WAIT_L(0); PG8_BAR; PG8_MMA(1, 0, At, B0); PG8_MMA(1, 1, At, B1); PG8_BAR; PG8_SCHED;
            } else {
            PG8_LDB(B0, 0, 0); PG8_SCHED; PG8_LDA(At, 0, 0); PG8_STAGE(PG8_SA(1, 1), a1 + hstep, voffA);
            PG8_WAIT_L(8); PG8_BAR; PG8_WAIT_L(0); PG8_MMA(0, 0, At, B0); PG8_BAR; PG8_SCHED;
            PG8_LDB(B1, 0, 1); PG8_STAGE(PG8_SB(0, 0), b2, voffB);
            PG8_BAR; PG8_WAIT_L(0); PG8_MMA(0, 1, At, B1); PG8_BAR;
            PG8_LDA(At, 0, 1); PG8_STAGE(PG8_SA(0, 0), a2, voffA);
            PG8_BAR; PG8_WAIT_L(0); PG8_MMA(1, 0, At, B0); PG8_BAR; PG8_SCHED;
            PG8_STAGE(PG8_SB(0, 1), b2 + hstep, voffB);
            PG8_WAIT_V(6); PG8_BAR; PG8_MMA(1, 1, At, B1); PG8_BAR;
            PG8_LDB(B0, 1, 0); PG8_SCHED; PG8_LDA(At, 1, 0); PG8_STAGE(PG8_SA(0, 1), a2 + hstep, voffA);
            PG8_WAIT_L(8); PG8_BAR; PG8_WAIT_L(0); PG8_MMA(0, 0, At, B0); PG8_BAR; PG8_SCHED;
            PG8_LDB(B1, 1, 1); PG8_STAGE(PG8_SB(1, 0), b3, voffB);
            PG8_BAR; PG8_WAIT_L(0); PG8_MMA(0, 1, At, B1); PG8_BAR;
            PG8_LDA(At, 1, 1); PG8_STAGE(PG8_SA(1, 0), a3, voffA);
            PG8_BAR; PG8_WAIT_L(0); PG8_MMA(1, 0, At, B0); PG8_BAR; PG8_SCHED;
            PG8_STAGE(PG8_SB(1, 1), b3 + hstep, voffB);
            PG8_WAIT_V(6); PG8_BAR; PG8_MMA(1, 1, At, B1); PG8_BAR;
            }
        }
        if constexpr (ALIGN_EPI) { if (wr == 0) PG8_BAR; }
        if constexpr (!Epi::AFTER_DRAIN) { E(acc, cur, wr, wc, fr, fq); S.done(cur); }
        if (!has_next) break;
#pragma unroll
        for (int a = 0; a < 2; ++a)
#pragma unroll
            for (int b = 0; b < 2; ++b)
#pragma unroll
                for (int m = 0; m < 4; ++m)
#pragma unroll
                    for (int n = 0; n < 2; ++n) acc[a][b][m][n] = (f32x4){0.f, 0.f, 0.f, 0.f};
        cur = nxt; cA = nA; cB = nB; ++ui;
        if constexpr (ALIGN_EPI) { if (wr == 1) PG8_BAR; }
    }
    PG8_WAIT_V(0);
    if constexpr (!ALIGN_EPI) { if (wr == 0) PG8_BAR; }
    PG8_BAR;
    if constexpr (Epi::AFTER_DRAIN) { E.fused(acc, cur, wr, wc, fr, fq, lds, wid, lane); S.done(cur); }
#undef PG8_SA
#undef PG8_SB
#undef PG8_STAGE
#undef PG8_LDA
#undef PG8_LDB
#undef PG8_MMA
#undef PG8_WAIT_V
#undef PG8_WAIT_L
#undef PG8_BAR
#undef PG8_SCHED
}
}

#define LAS __attribute__((address_space(3)))
typedef unsigned short bf16;
typedef unsigned v4u __attribute__((ext_vector_type(4)));
typedef unsigned v2u __attribute__((ext_vector_type(2)));
typedef float f32x4 __attribute__((ext_vector_type(4)));
typedef float f32x16 __attribute__((ext_vector_type(16)));
typedef short bf16x8 __attribute__((ext_vector_type(8)));
typedef short s16x4 __attribute__((ext_vector_type(4)));
typedef _Float16 h8 __attribute__((ext_vector_type(8)));

__device__ __forceinline__ unsigned pk2(float lo, float hi) { return pg8::cvt_pk_bf16(lo, hi); }
__device__ __forceinline__ float bflo(unsigned u) { return __uint_as_float(u << 16); }
__device__ __forceinline__ float bfhi(unsigned u) { return __uint_as_float(u & 0xffff0000u); }
__device__ __forceinline__ float bf2f(bf16 b) { return __uint_as_float(((unsigned)b) << 16); }
__device__ __forceinline__ bf16 f2bf(float f) { return (bf16)(pk2(f, 0.f) & 0xffffu); }
#define UNPACK8(v, f) do { f[0] = bflo(v.x); f[1] = bfhi(v.x); f[2] = bflo(v.y); f[3] = bfhi(v.y); f[4] = bflo(v.z); f[5] = bfhi(v.z); f[6] = bflo(v.w); f[7] = bfhi(v.w); } while (0)
#define PACK8(o, f) do { o.x = pk2(f[0], f[1]); o.y = pk2(f[2], f[3]); o.z = pk2(f[4], f[5]); o.w = pk2(f[6], f[7]); } while (0)
__device__ __forceinline__ int ltid() { int t = threadIdx.x; asm volatile("" : "+v"(t)); return t; }
__device__ __forceinline__ float sigmoidf_(float x) { return 1.f / (1.f + __expf(-x)); }
__device__ __forceinline__ float wave_sum(float v) {
#pragma unroll
    for (int o = 1; o < 64; o <<= 1) v += __shfl_xor(v, o);
    return v;
}
__device__ __forceinline__ float sum8(float v) { v += __shfl_xor(v, 1); v += __shfl_xor(v, 2); v += __shfl_xor(v, 4); return v; }

constexpr int DM = 1024, DIN = 6944, DPROJ = 4096, NMAIN = 3872, DGATE = 3072, DFF = 2816;
constexpr int NTOK = 131072, NPROMPT = 65536;
constexpr int C_KA = 512, C_VA = 1024, C_CQ = 1536, C_CKV = 1792, C_KR = 1920, C_RW = 1952;
constexpr float LOG2E = 1.4426950408889634f;
constexpr float NA_QS = 0.125f * LOG2E;
constexpr float MLA_QS = 0.10206207261596575f * LOG2E;
constexpr float NEPS = 1e-6f;

constexpr size_t MiB = 1u << 20;
constexpr size_t WS_CTL = 0, CTL_BYTES = 1 * MiB;
constexpr size_t W_OFF = 1 * MiB, W_STRIDE = 39 * MiB;
constexpr size_t WO_IN = 0, WO_G = 8 * MiB, WO_BR = 14 * MiB, WO_OUT = 17 * MiB, WO_GU = 19 * MiB, WO_DN = 30 * MiB, WO_MU = 35 * MiB + 512 * 1024, WO_RU = 37 * MiB;
constexpr size_t ACT_OFF = 80 * MiB;
constexpr size_t TOKB_H = 2048, TOKB_P = 8192, TOKB_M = 3584, TOKB_A = 1536, TOKB_S = 9216, TOKB_Y = 3072, TOKB_Z = 2048;
constexpr size_t TOKB = TOKB_H + TOKB_P + TOKB_M + TOKB_A + TOKB_S + TOKB_Y + TOKB_Z;
static_assert(WO_MU + 1792 * 384 * 2 <= WO_RU && WO_RU + 2560 * 384 * 2 <= W_STRIDE && WO_DN + 1024 * 2816 * 2 <= WO_MU && WO_GU + 5632 * 1024 * 2 <= WO_DN, "weight map");
constexpr int LDS_RING = 131072, LDS_BYTES = LDS_RING + 1024;

struct Params { const float* in[33]; float* out; unsigned char* ws; int G; int Tg; };
typedef const __attribute__((address_space(4))) Params* CP;

constexpr size_t WS_PARAMS = 512 * 1024;
struct Reg { unsigned char* ws; size_t Tg;
    __device__ __forceinline__ bf16* RH() const { return (bf16*)(ws + ACT_OFF); }
    __device__ __forceinline__ bf16* RP() const { return (bf16*)(ws + ACT_OFF + Tg * TOKB_H); }
    __device__ __forceinline__ bf16* RM() const { return (bf16*)(ws + ACT_OFF + Tg * (TOKB_H + TOKB_P)); }
    __device__ __forceinline__ bf16* RA() const { return (bf16*)(ws + ACT_OFF + Tg * (TOKB_H + TOKB_P + TOKB_M)); }
    __device__ __forceinline__ _Float16* RS() const { return (_Float16*)(ws + ACT_OFF + Tg * (TOKB_H + TOKB_P + TOKB_M + TOKB_A)); }
    __device__ __forceinline__ bf16* RY() const { return (bf16*)(ws + ACT_OFF + Tg * (TOKB_H + TOKB_P + TOKB_M + TOKB_A + TOKB_S)); }
    __device__ __forceinline__ bf16* RZ() const { return (bf16*)(ws + ACT_OFF + Tg * (TOKB_H + TOKB_P + TOKB_M + TOKB_A + TOKB_S + TOKB_Y)); }
};
enum { GM_IN = 0, GM_MU = 1, GM_RU = 2, GM_GATE = 3, GM_BR0 = 4, GM_BR1 = 5, GM_BR2 = 6, GM_OUT = 7, GM_GU = 8, GM_DN = 9 };
#define EPI_FENCE() asm volatile("" ::: "memory")
struct EpiUni {
    static constexpr bool PERM = true, AFTER_DRAIN = false;
    CP pp; int id, l, g;
    __device__ __forceinline__ void operator()(const pg8::f32x4 (&acc)[2][2][4][2], const pg8::Unit& u, int wr, int wc, int fr, int fq) const {
        CP q = pp; asm volatile("" : "+s"(q));
        const int Tg = q->Tg; const Reg R{q->ws, (size_t)Tg}; const size_t asz = (size_t)Tg * 512;
        const int row0 = u.pm * 256 + wr * 64 + fr, col0 = u.pn * 256 + wc * 32 + 8 * fq;
        switch (id) {
        case GM_IN: case GM_MU: {
            bf16* O = (id == GM_IN) ? R.RP() : R.RM(); const int ldc = (id == GM_IN) ? DPROJ : 1792;
#pragma unroll
            for (int ai = 0; ai < 2; ++ai)
#pragma unroll
                for (int m = 0; m < 4; ++m) { bf16* rp = O + (size_t)(row0 + ai * 128 + m * 16) * ldc + col0;
#pragma unroll
                    for (int bj = 0; bj < 2; ++bj) { const f32x4 v0 = acc[ai][bj][m][0], v1 = acc[ai][bj][m][1]; v4u w; w.x = pk2(v0[0], v0[1]); w.y = pk2(v0[2], v0[3]); w.z = pk2(v1[0], v1[1]); w.w = pk2(v1[2], v1[3]);
                        *(v4u*)(rp + bj * 128) = w; } }
        } break;
        case GM_GATE: {
            bf16* O = R.RP(); const float* bias = q->in[4] + l * DGATE + col0;
#pragma unroll
            for (int bj = 0; bj < 2; ++bj) { const f32x4 b0 = *(const f32x4*)(bias + bj * 128), b1 = *(const f32x4*)(bias + bj * 128 + 4);
#pragma unroll
                for (int ai = 0; ai < 2; ++ai)
#pragma unroll
                    for (int m = 0; m < 4; ++m) { const f32x4 v0 = acc[ai][bj][m][0] + b0, v1 = acc[ai][bj][m][1] + b1; float f[8];
#pragma unroll
                        for (int i = 0; i < 4; ++i) { f[i] = sigmoidf_(v0[i]); f[4 + i] = sigmoidf_(v1[i]); }
                        v4u w; PACK8(w, f); *(v4u*)(O + (size_t)(row0 + ai * 128 + m * 16) * DGATE + col0 + bj * 128) = w; }
                EPI_FENCE(); }
        } break;
        case GM_GU: {
            bf16* O = R.RP(); const int hc = u.pn * 128 + wc * 32 + 8 * fq;
#pragma unroll
            for (int ai = 0; ai < 2; ++ai)
#pragma unroll
                for (int m = 0; m < 4; ++m) { float f[8];
#pragma unroll
                    for (int n = 0; n < 2; ++n)
#pragma unroll
                        for (int i = 0; i < 4; ++i) { const float gt = acc[ai][0][m][n][i], up = acc[ai][1][m][n][i]; f[4 * n + i] = gt * sigmoidf_(gt) * up; }
                    v4u w; PACK8(w, f); *(v4u*)(O + (size_t)(row0 + ai * 128 + m * 16) * DFF + hc) = w; }
        } break;
        case GM_BR0: case GM_BR1: case GM_BR2: {
            bf16* O = R.RM(); const bf16* Gt = R.RP() + (id - GM_BR0) * 1024; const bool first = (id == GM_BR0);
#pragma unroll
            for (int ai = 0; ai < 2; ++ai)
#pragma unroll
                for (int m = 0; m < 4; ++m) { const size_t row = (size_t)(row0 + ai * 128 + m * 16);
#pragma unroll
                    for (int bj = 0; bj < 2; ++bj) { const int col = col0 + bj * 128; const v4u gv = *(const v4u*)(Gt + row * DGATE + col); float gg[8], f[8]; UNPACK8(gv, gg);
#pragma unroll
                        for (int i = 0; i < 4; ++i) { f[i] = gg[i] * acc[ai][bj][m][0][i]; f[4 + i] = gg[4 + i] * acc[ai][bj][m][1][i]; }
                        if (!first) { const v4u ov = *(const v4u*)(O + row * DM + col); float o[8]; UNPACK8(ov, o);
#pragma unroll
                            for (int i = 0; i < 8; ++i) f[i] += o[i]; }
                        v4u w; PACK8(w, f); *(v4u*)(O + row * DM + col) = w; }
                    EPI_FENCE(); }
        } break;
        case GM_OUT: case GM_DN: {
            const int t0 = g * Tg; float* xout = q->out + (size_t)t0 * DM;
            const float* xin = (id == GM_OUT && l == 0) ? ((t0 < NPROMPT) ? q->in[0] + (size_t)t0 * DM : q->in[1] + (size_t)(t0 - NPROMPT) * DM) : xout;
#pragma unroll
            for (int ai = 0; ai < 2; ++ai)
#pragma unroll
                for (int m = 0; m < 4; ++m) { const size_t off = (size_t)(row0 + ai * 128 + m * 16) * DM + col0;
#pragma unroll
                    for (int bj = 0; bj < 2; ++bj)
#pragma unroll
                        for (int n = 0; n < 2; ++n) { const f32x4 b = *(const f32x4*)(xin + off + bj * 128 + n * 4); *(f32x4*)(xout + off + bj * 128 + n * 4) = b + acc[ai][bj][m][n]; }
                    EPI_FENCE(); }
        } break;
        case GM_RU: {
            _Float16* rs = R.RS(); const _Float16* ktmp = (const _Float16*)R.RZ(); bf16* gout = R.RY() + 2 * asz;
            const int type = u.pn >> 1; const int cl0 = (u.pn & 1) * 256 + wc * 32 + 8 * fq;
            const float* w0 = q->in[17] + l * 1024; const float* a0 = q->in[19] + l * 1024; const float* ka = q->in[23] + l * 512;
#pragma unroll
            for (int ai = 0; ai < 2; ++ai)
#pragma unroll
                for (int m = 0; m < 4; ++m) { const size_t row = (size_t)(row0 + ai * 128 + m * 16);
#pragma unroll
                    for (int bj = 0; bj < 2; ++bj) { const int cl = cl0 + bj * 128; float f[8];
#pragma unroll
                        for (int i = 0; i < 4; ++i) { f[i] = acc[ai][bj][m][0][i]; f[4 + i] = acc[ai][bj][m][1][i]; }
                        if (type < 2) {
                            h8 o;
#pragma unroll
                            for (int i = 0; i < 8; ++i) o[i] = (_Float16)__expf(-0.6065306597126334f * sigmoidf_(f[i] + w0[type * 512 + cl + i]));
                            *(h8*)(rs + (size_t)(3 + type) * asz + row * 512 + cl) = o;
                        } else if (type < 4) {
                            const int d = type - 2; const h8 kv = *(const h8*)(ktmp + row * 512 + cl), kkv = *(const h8*)(rs + (size_t)2 * asz + row * 512 + cl); h8 o1, o2;
#pragma unroll
                            for (int i = 0; i < 8; ++i) { const float a = sigmoidf_(f[i] + a0[d * 512 + cl + i]); o1[i] = (_Float16)((float)kkv[i] * a); o2[i] = (_Float16)((float)kv[i] * (1.f + (a - 1.f) * ka[cl + i])); }
                            *(h8*)(rs + (size_t)(5 + d) * asz + row * 512 + cl) = o1; *(h8*)(rs + (size_t)(7 + d) * asz + row * 512 + cl) = o2;
                        } else { v4u w; PACK8(w, f); *(v4u*)(gout + row * 512 + cl) = w; }
                        EPI_FENCE(); } }
        } break;
        default: break;
        }
    }
};

__device__ __forceinline__ void transpose_item(const float* W, int ldw, int N, bf16* WT, int ldt, int koff, int row_off, int mode, LAS float* scr, int item, int lane) {
    const int nblk = N / 32, kb = item / nblk, nb = item % nblk, k0 = 64 * kb, n0 = 32 * nb;
#pragma unroll 8
    for (int i = 0; i < 32; ++i) { const int kk = 2 * i + (lane >> 5); scr[kk * 33 + (lane & 31)] = W[(size_t)(k0 + kk) * ldw + n0 + (lane & 31)]; }
    asm volatile("s_waitcnt lgkmcnt(0)" ::: "memory");
    const int c = lane & 7;
#pragma unroll
    for (int j = 0; j < 4; ++j) { const int n = (lane >> 3) + 8 * j; const LAS float* s = scr + (8 * c) * 33 + n;
        v4u o; o.x = pk2(s[0 * 33], s[1 * 33]); o.y = pk2(s[2 * 33], s[3 * 33]); o.z = pk2(s[4 * 33], s[5 * 33]); o.w = pk2(s[6 * 33], s[7 * 33]);
        const int nn = n0 + n; const int drow = mode ? ((nn >> 7) * 256 + row_off + (nn & 127)) : (row_off + nn);
        *(v4u*)(WT + (size_t)drow * ldt + koff + k0 + 8 * c) = o; }
    asm volatile("s_waitcnt lgkmcnt(0)" ::: "memory");
}
__device__ __forceinline__ void transpose_job(const float* W, int ldw, int K, int N, bf16* WT, int ldt, int koff, int row_off, int mode, LAS float* scr, int gw, int ngw, int lane) {
    const int nitems = (K / 64) * (N / 32);
    for (int it = gw; it < nitems; it += ngw) transpose_item(W, ldw, N, WT, ldt, koff, row_off, mode, scr, it, lane);
}
__device__ __forceinline__ void zero_bytes(unsigned char* p, size_t nbytes, size_t gtid, size_t ngt) {
    const v4u z = {0u, 0u, 0u, 0u};
    for (size_t i = gtid; i < nbytes / 16; i += ngt) ((v4u*)p)[i] = z;
}

__device__ __forceinline__ void phase_norm(const float* x, const float* g, bf16* hb, int Tg, int gw, int ngw, int lane) {
    for (int t = gw; t < Tg; t += ngw) {
        const f32x4* xr = (const f32x4*)(x + (size_t)t * DM) + lane; f32x4 v[4]; float s = 0.f;
#pragma unroll
        for (int j = 0; j < 4; ++j) { v[j] = xr[64 * j]; s += (v[j].x * v[j].x + v[j].y * v[j].y) + (v[j].z * v[j].z + v[j].w * v[j].w); }
        const float inv = rsqrtf(wave_sum(s) * (1.f / DM) + NEPS);
        v2u* o8 = (v2u*)(hb + (size_t)t * DM) + lane;
#pragma unroll
        for (int j = 0; j < 4; ++j) { const f32x4 gg = ((const f32x4*)g)[lane + 64 * j]; v2u o; o.x = pk2(v[j].x * inv * gg.x, v[j].y * inv * gg.y); o.y = pk2(v[j].z * inv * gg.z, v[j].w * inv * gg.w); o8[64 * j] = o; }
    }
}

__device__ __forceinline__ void phase_post_proj(CP pp, int l, bf16* proj, bf16* mla_a, bf16* rw_a, _Float16* rs, _Float16* ktmp, size_t asz, int Tg, int L, int gw, int ngw, int lane) {
    const float* gq = pp->in[5] + l * 64; const float* gk = pp->in[6] + l * 64;
    const float* gcq = pp->in[9] + l * 256; const float* gckv = pp->in[10] + l * 128;
    const float* mu = pp->in[16] + l * 1920; const float* kkw = pp->in[22] + l * 512;
    for (int t = gw; t < Tg; t += ngw) {
        bf16* row = proj + (size_t)t * DPROJ; const int tpos = t % L;
        {
            const int gi = 8 * (lane & 7);
            v4u qv = *(const v4u*)(row + 8 * lane); float f[8]; UNPACK8(qv, f); float ss = 0.f;
#pragma unroll
            for (int i = 0; i < 8; ++i) ss += f[i] * f[i];
            float inv = rsqrtf(sum8(ss) * (1.f / 64.f) + NEPS) * NA_QS;
#pragma unroll
            for (int i = 0; i < 8; ++i) f[i] = f[i] * inv * gq[gi + i];
            PACK8(qv, f); *(v4u*)(row + 8 * lane) = qv;
            v4u kv = *(const v4u*)(row + C_KA + 8 * lane); UNPACK8(kv, f); ss = 0.f;
#pragma unroll
            for (int i = 0; i < 8; ++i) ss += f[i] * f[i];
            inv = rsqrtf(sum8(ss) * (1.f / 64.f) + NEPS);
#pragma unroll
            for (int i = 0; i < 8; ++i) f[i] = f[i] * inv * gk[gi + i];
            PACK8(kv, f); *(v4u*)(row + C_KA + 8 * lane) = kv;
        }
        {
            const v2u cv = *(const v2u*)(row + C_CQ + 4 * lane); float a0 = bflo(cv.x), a1 = bfhi(cv.x), a2 = bflo(cv.y), a3 = bfhi(cv.y);
            float inv = rsqrtf(wave_sum(a0 * a0 + a1 * a1 + a2 * a2 + a3 * a3) * (1.f / 256.f) + NEPS);
            const f32x4 gg = *(const f32x4*)(gcq + 4 * lane); v2u o; o.x = pk2(a0 * inv * gg.x, a1 * inv * gg.y); o.y = pk2(a2 * inv * gg.z, a3 * inv * gg.w);
            *(v2u*)(mla_a + (size_t)t * 384 + 4 * lane) = o;
            const unsigned kvv = *(const unsigned*)(row + C_CKV + 2 * lane); a0 = bflo(kvv); a1 = bfhi(kvv);
            inv = rsqrtf(wave_sum(a0 * a0 + a1 * a1) * (1.f / 128.f) + NEPS);
            *(unsigned*)(mla_a + (size_t)t * 384 + 256 + 2 * lane) = pk2(a0 * inv * gckv[2 * lane], a1 * inv * gckv[2 * lane + 1]);
        }
        const bool hasp = tpos > 0, hasn = tpos < L - 1;
#pragma unroll
        for (int it = 0; it < 4; ++it) {
            const int c0 = (it * 64 + lane) * 8;
            if (it < 3 || lane < 48) {
                const bf16* src = row + C_RW + c0; float pc[8], pp[8], pn[8];
                { const v4u v = *(const v4u*)src; UNPACK8(v, pc); }
                if (hasp) { const v4u v = *(const v4u*)(src - DPROJ); UNPACK8(v, pp); } else {
#pragma unroll
                    for (int i = 0; i < 8; ++i) pp[i] = 0.f; }
                if (hasn) { const v4u v = *(const v4u*)(src + DPROJ); UNPACK8(v, pn); } else {
#pragma unroll
                    for (int i = 0; i < 8; ++i) pn[i] = 0.f; }
#pragma unroll
                for (int i = 0; i < 8; ++i) pc[i] = pc[i] + mu[c0 + i] * (0.5f * (pp[i] + pn[i]) - pc[i]);
                if (it == 0) { h8 o;
#pragma unroll
                    for (int i = 0; i < 8; ++i) o[i] = (_Float16)pc[i];
                    *(h8*)(rs + (size_t)t * 512 + c0) = o; }
                else if (it == 1) { const int c = c0 - 512; h8 o; float kk[8]; float ss = 0.f;
#pragma unroll
                    for (int i = 0; i < 8; ++i) { o[i] = (_Float16)pc[i]; kk[i] = pc[i] * kkw[c + i]; ss += kk[i] * kk[i]; }
                    *(h8*)(ktmp + (size_t)t * 512 + c) = o;
                    const float inv = rsqrtf(sum8(ss) + 1e-12f);
#pragma unroll
                    for (int i = 0; i < 8; ++i) o[i] = (_Float16)(kk[i] * inv);
                    *(h8*)(rs + 2 * asz + (size_t)t * 512 + c) = o; }
                else if (it == 2) { const int c = c0 - 1024; h8 o;
#pragma unroll
                    for (int i = 0; i < 8; ++i) o[i] = (_Float16)pc[i];
                    *(h8*)(rs + asz + (size_t)t * 512 + c) = o; }
                else { const int c = c0 - 1536; float f[8];
#pragma unroll
                    for (int i = 0; i < 8; ++i) { const float x = pc[i]; f[i] = (c < 128) ? (1.f - 2.f / (1.f + __expf(2.f * x))) : ((c < 256) ? x : sigmoidf_(x)); }
                    v4u w; PACK8(w, f); *(v4u*)(rw_a + (size_t)t * 384 + c) = w; }
            }
        }
    }
}

__device__ __forceinline__ void phase_mla_post(CP pp, int l, bf16* mraw, const bf16* proj, bf16* mk, int Tg, int L, int gw, int ngw, int lane) {
    const float* gq = pp->in[13] + l * 96; const float* gk = pp->in[14] + l * 96;
    const float gqn = gq[lane], gkn = gk[lane], gqr = lane < 32 ? gq[64 + lane] : 0.f, gkr = lane < 32 ? gk[64 + lane] : 0.f;
    const int fi = lane & 7; const float invf = __expf(-(float)fi * (9.210340371976184f / 8.f));
    for (int t = gw; t < Tg; t += ngw) {
        const int tpos = t % L; const float pos = (float)(((lane & 15) < 8) ? (tpos >> 6) : (tpos & 63));
        float rev = pos * invf * 0.15915494309189535f; rev -= floorf(rev);
        const float cs = __builtin_amdgcn_cosf(rev), sn = __builtin_amdgcn_sinf(rev);
        bf16* mrow = mraw + (size_t)t * 1792; bf16* krow = mk + (size_t)t * 768;
        const float krv = lane < 32 ? bf2f(proj[(size_t)t * DPROJ + C_KR + lane]) : 0.f;
#pragma unroll 2
        for (int h = 0; h < 8; ++h) {
            {   float qn = bf2f(mrow[h * 96 + lane]); float qr = lane < 32 ? bf2f(mrow[h * 96 + 64 + lane]) : 0.f;
                const float inv = rsqrtf(wave_sum(qn * qn + qr * qr) * (1.f / 96.f) + NEPS);
                qn = qn * inv * gqn; qr = qr * inv * gqr;
                const float pr = __shfl_xor(qr, 16);
                const float ro = (lane < 16) ? (qr * cs - pr * sn) : (pr * sn + qr * cs);
                mrow[h * 96 + lane] = f2bf(qn * MLA_QS); if (lane < 32) mrow[h * 96 + 64 + lane] = f2bf(ro * MLA_QS); }
            {   float kn = bf2f(mrow[768 + h * 128 + lane]); float kr = krv;
                const float inv = rsqrtf(wave_sum(kn * kn + kr * kr) * (1.f / 96.f) + NEPS);
                kn = kn * inv * gkn; kr = kr * inv * gkr;
                const float pr = __shfl_xor(kr, 16);
                const float ro = (lane < 16) ? (kr * cs - pr * sn) : (pr * sn + kr * cs);
                krow[h * 96 + lane] = f2bf(kn); if (lane < 32) krow[h * 96 + 64 + lane] = f2bf(ro); }
        }
    }
}

__device__ __forceinline__ void phase_rw_post(CP pp, int l, const _Float16* rs, size_t asz, const bf16* yfb, bf16* yc, int Tg, int gw, int ngw, int lane) {
    const float* lnw = pp->in[25] + l * 512 + 8 * lane; const float* lnb = pp->in[26] + l * 512 + 8 * lane; const float* rk = pp->in[24] + l * 512 + 8 * lane;
    for (int t = gw; t < Tg; t += ngw) {
        const size_t o = (size_t)t * 512 + 8 * lane; float y[8], f[8];
        { const v4u a = *(const v4u*)(yfb + o); const v4u b = *(const v4u*)(yfb + asz + o); UNPACK8(a, y); UNPACK8(b, f); }
        float s = 0.f;
#pragma unroll
        for (int i = 0; i < 8; ++i) { y[i] += f[i]; s += y[i]; }
        const float mean = sum8(s) * (1.f / 64.f); float q = 0.f;
#pragma unroll
        for (int i = 0; i < 8; ++i) { y[i] -= mean; q += y[i] * y[i]; }
        const float rstd = rsqrtf(sum8(q) * (1.f / 64.f) + 64e-5f);
        const h8 r = *(const h8*)(rs + o), v = *(const h8*)(rs + asz + o), kd0 = *(const h8*)(rs + 7 * asz + o), kd1 = *(const h8*)(rs + 8 * asz + o);
        float b = 0.f;
#pragma unroll
        for (int i = 0; i < 8; ++i) b += (float)r[i] * ((float)kd0[i] + (float)kd1[i]) * rk[i];
        b = sum8(b);
        const v4u gv = *(const v4u*)(yc + o); UNPACK8(gv, f);
#pragma unroll
        for (int i = 0; i < 8; ++i) f[i] = (y[i] * rstd * lnw[i] + lnb[i] + b * (float)v[i]) * f[i];
        v4u w; PACK8(w, f); *(v4u*)(yc + o) = w;
    }
}

#define GAS __attribute__((address_space(1)))
typedef float f2 __attribute__((ext_vector_type(2)));
__device__ __forceinline__ float red8(float x) {
    asm("s_nop 1\n\tv_add_f32_dpp %0, %0, %0 quad_perm:[1,0,3,2] row_mask:0xf bank_mask:0xf bound_ctrl:1\n\ts_nop 1\n\t"
        "v_add_f32_dpp %0, %0, %0 quad_perm:[2,3,0,1] row_mask:0xf bank_mask:0xf bound_ctrl:1\n\ts_nop 1\n\t"
        "v_add_f32_dpp %0, %0, %0 row_half_mirror row_mask:0xf bank_mask:0xf bound_ctrl:1\n\ts_nop 1" : "+v"(x));
    return x;
}
constexpr int SCH = 32, SBUF = 6 * SCH * 256;
__device__ __forceinline__ void scan_unit(int u, int L, const _Float16* rs, size_t asz, bf16* yfb, LAS unsigned char* lds) {
    const int tid = ltid(); const int lane = tid & 63, w = tid >> 6, vr = lane >> 3, ko = lane & 7;
    const int dir = u & 1, sh = u >> 1, h = sh & 7, s = sh >> 3;
    const int kA = tid >> 8, lj = (tid >> 3) & 31, lp = tid & 7;
    const size_t tok0 = (size_t)s * L + (dir ? (L - 1 - lj) : lj);
    const long tstep = dir ? -(long)SCH * 512 : (long)SCH * 512;
    const size_t eoff = tok0 * 512 + h * 64 + lp * 8;
    const GAS _Float16* g0 = (const GAS _Float16*)(rs + (size_t)(kA ? 2 : 0) * asz + eoff);
    const GAS _Float16* g1 = (const GAS _Float16*)(rs + (size_t)(kA ? 5 + dir : 3 + dir) * asz + eoff);
    const GAS _Float16* g2 = (const GAS _Float16*)(rs + (size_t)(kA ? 1 : 7 + dir) * asz + eoff);
    const int ld0 = (((0 + kA) * SCH + lj) * 64 + lp * 8) * 4, ld1 = (((2 + kA) * SCH + lj) * 64 + lp * 8) * 4, ld2 = (((4 + kA) * SCH + lj) * 64 + lp * 8) * 4;
    GAS bf16* py = (GAS bf16*)(yfb + (size_t)dir * asz + ((size_t)s * L + (dir ? L - 1 : 0)) * 512 + h * 64 + 8 * w + vr);
    const long ystep = dir ? -512 : 512;
    const int rd = ko * 32, rdv = (5 * SCH * 64 + 8 * w + vr) * 4;
    f2 S[4];
#pragma unroll
    for (int i = 0; i < 4; ++i) S[i] = (f2){0.f, 0.f};
    h8 p0 = *(const GAS h8*)g0, p1 = *(const GAS h8*)g1, p2 = *(const GAS h8*)g2;
#define SCAN_PUT(bufo) do { f32x4 a, b; \
        a = (f32x4){(float)p0[0], (float)p0[1], (float)p0[2], (float)p0[3]}; b = (f32x4){(float)p0[4], (float)p0[5], (float)p0[6], (float)p0[7]}; *(LAS f32x4*)(lds + (bufo) + ld0) = a; *(LAS f32x4*)(lds + (bufo) + ld0 + 16) = b; \
        a = (f32x4){(float)p1[0], (float)p1[1], (float)p1[2], (float)p1[3]}; b = (f32x4){(float)p1[4], (float)p1[5], (float)p1[6], (float)p1[7]}; *(LAS f32x4*)(lds + (bufo) + ld1) = a; *(LAS f32x4*)(lds + (bufo) + ld1 + 16) = b; \
        a = (f32x4){(float)p2[0], (float)p2[1], (float)p2[2], (float)p2[3]}; b = (f32x4){(float)p2[4], (float)p2[5], (float)p2[6], (float)p2[7]}; *(LAS f32x4*)(lds + (bufo) + ld2) = a; *(LAS f32x4*)(lds + (bufo) + ld2 + 16) = b; } while (0)
    SCAN_PUT(0);
    __syncthreads();
    const int NC = L / SCH;
#pragma unroll 1
    for (int c = 0; c < NC; ++c) {
        const int cur = (c & 1) * SBUF;
        if (c + 1 < NC) { const long o = tstep * (long)(c + 1); p0 = *(const GAS h8*)(g0 + o); p1 = *(const GAS h8*)(g1 + o); p2 = *(const GAS h8*)(g2 + o); }
        LAS unsigned char* bp = lds + cur + rd;
        GAS bf16* pyc = py + ystep * (long)(c * SCH);
#pragma unroll 1
        for (int j0 = 0; j0 < SCH; j0 += 4) { float yv[4];
#pragma unroll
        for (int jj = 0; jj < 4; ++jj) { const int j = j0 + jj;
            const LAS unsigned char* q = bp + j * 256;
            const f32x4 r0 = *(const LAS f32x4*)(q), r1 = *(const LAS f32x4*)(q + 16);
            const f32x4 k0 = *(const LAS f32x4*)(q + SCH * 256), k1 = *(const LAS f32x4*)(q + SCH * 256 + 16);
            const f32x4 w0 = *(const LAS f32x4*)(q + 2 * SCH * 256), w1 = *(const LAS f32x4*)(q + 2 * SCH * 256 + 16);
            const f32x4 a0 = *(const LAS f32x4*)(q + 3 * SCH * 256), a1 = *(const LAS f32x4*)(q + 3 * SCH * 256 + 16);
            const f32x4 d0 = *(const LAS f32x4*)(q + 4 * SCH * 256), d1 = *(const LAS f32x4*)(q + 4 * SCH * 256 + 16);
            const float vv = *(const LAS float*)(lds + cur + rdv + j * 256);
            f2 pd = S[0] * k0.xy; pd = S[1] * k0.zw + pd; pd = S[2] * k1.xy + pd; pd = S[3] * k1.zw + pd;
            const float nskk = -red8(pd.x + pd.y);
            const f2 vv2 = (f2){vv, vv}, ns2 = (f2){nskk, nskk};
            f2 t;
            t = d0.xy * vv2; t = a0.xy * ns2 + t; S[0] = S[0] * w0.xy + t;
            t = d0.zw * vv2; t = a0.zw * ns2 + t; S[1] = S[1] * w0.zw + t;
            t = d1.xy * vv2; t = a1.xy * ns2 + t; S[2] = S[2] * w1.xy + t;
            t = d1.zw * vv2; t = a1.zw * ns2 + t; S[3] = S[3] * w1.zw + t;
            f2 qd = S[0] * r0.xy; qd = S[1] * r0.zw + qd; qd = S[2] * r1.xy + qd; qd = S[3] * r1.zw + qd;
            yv[jj] = red8(qd.x + qd.y);
        }
            if (ko == 0) {
#pragma unroll
                for (int jj = 0; jj < 4; ++jj) pyc[ystep * (j0 + jj)] = f2bf(yv[jj]); }
        }
        if (c + 1 < NC) SCAN_PUT(SBUF - cur);
        __syncthreads();
    }
#undef SCAN_PUT
}

constexpr int MKP = 208, MVP = 144, MBUF = 64 * MKP + 64 * MVP;
__device__ __forceinline__ void mla_unit(int u, int L, const bf16* mraw, const bf16* mk, bf16* yb, LAS unsigned char* lds) {
    const int tid = ltid(), lane = tid & 63, w = tid >> 6, q32 = lane & 31, hi = lane >> 5;
    const int nqb = L >> 8, qb = u % nqb, sh = u / nqb, h = sh & 7, s = sh >> 3;
    const size_t base = (size_t)s * L; const int NT = L >> 6;
    const size_t qtok = base + qb * 256 + w * 32 + q32;
    bf16x8 qf[6];
#pragma unroll
    for (int ks = 0; ks < 6; ++ks) qf[ks] = *(const bf16x8*)(mraw + qtok * 1792 + h * 96 + ks * 16 + hi * 8);
    const int kkey0 = tid / 12, kch0 = tid % 12, kkey1 = (tid + 512) / 12, kch1 = (tid + 512) % 12; const bool k2 = tid < 256;
    const bf16* ks0 = mk + (base + kkey0) * 768 + h * 96 + kch0 * 8; const bf16* ks1 = mk + (base + kkey1) * 768 + h * 96 + kch1 * 8;
    const int vkey = tid >> 3, vch = tid & 7;
    const bf16* vs = mraw + (base + vkey) * 1792 + 768 + h * 128 + 64 + vch * 8;
    const int kd0 = kkey0 * MKP + kch0 * 16, kd1 = kkey1 * MKP + kch1 * 16, vd = 64 * MKP + vkey * MVP + vch * 16;
    v4u rk0, rk1 = {0u, 0u, 0u, 0u}, rv;
    rk0 = *(const v4u*)ks0; if (k2) rk1 = *(const v4u*)ks1; rv = *(const v4u*)vs;
    *(LAS v4u*)(lds + kd0) = rk0; if (k2) *(LAS v4u*)(lds + kd1) = rk1; *(LAS v4u*)(lds + vd) = rv;
    __syncthreads();
    const int kmap = 16 * (q32 >> 4) + 8 * ((q32 >> 2) & 1) + (q32 & 3) + 4 * ((q32 >> 3) & 1);
    const int koff = kmap * MKP + hi * 16;
    const int voff = 64 * MKP + (8 * hi + ((lane & 15) >> 2)) * MVP + (16 * ((lane >> 4) & 1) + 4 * (lane & 3)) * 2;
    f32x16 o0 = {}, o1 = {}; float m = -1e30f, lsum = 0.f;
    for (int kt = 0; kt < NT; ++kt) {
        const int cur = (kt & 1) * MBUF, nxt = MBUF - cur;
        if (kt + 1 < NT) { const size_t adv = (size_t)(kt + 1) * 64; rk0 = *(const v4u*)(ks0 + adv * 768); if (k2) rk1 = *(const v4u*)(ks1 + adv * 768); rv = *(const v4u*)(vs + adv * 1792); }
        f32x16 s0 = {}, s1 = {};
#pragma unroll
        for (int ks = 0; ks < 6; ++ks) {
            const bf16x8 a0 = *(const LAS bf16x8*)(lds + cur + koff + ks * 32), a1 = *(const LAS bf16x8*)(lds + cur + koff + 32 * MKP + ks * 32);
            s0 = __builtin_amdgcn_mfma_f32_32x32x16_bf16(a0, qf[ks], s0, 0, 0, 0); s1 = __builtin_amdgcn_mfma_f32_32x32x16_bf16(a1, qf[ks], s1, 0, 0, 0);
        }
        float mt = fmaxf(s0[0], s1[0]);
#pragma unroll
        for (int r = 1; r < 16; ++r) mt = fmaxf(mt, fmaxf(s0[r], s1[r]));
        mt = fmaxf(mt, __shfl_xor(mt, 32));
        const float mn = fmaxf(m, mt), alpha = __builtin_amdgcn_exp2f(m - mn); m = mn;
        float ps = 0.f;
#pragma unroll
        for (int r = 0; r < 16; ++r) { s0[r] = __builtin_amdgcn_exp2f(s0[r] - mn); s1[r] = __builtin_amdgcn_exp2f(s1[r] - mn); ps += s0[r] + s1[r]; }
        lsum = lsum * alpha + ps;
#pragma unroll
        for (int r = 0; r < 16; ++r) { o0[r] *= alpha; o1[r] *= alpha; }
#pragma unroll
        for (int kb = 0; kb < 2; ++kb)
#pragma unroll
            for (int g = 0; g < 2; ++g) {
                v4u pw;
                if (kb == 0) { pw.x = pk2(s0[8 * g + 0], s0[8 * g + 1]); pw.y = pk2(s0[8 * g + 2], s0[8 * g + 3]); pw.z = pk2(s0[8 * g + 4], s0[8 * g + 5]); pw.w = pk2(s0[8 * g + 6], s0[8 * g + 7]); }
                else         { pw.x = pk2(s1[8 * g + 0], s1[8 * g + 1]); pw.y = pk2(s1[8 * g + 2], s1[8 * g + 3]); pw.z = pk2(s1[8 * g + 4], s1[8 * g + 5]); pw.w = pk2(s1[8 * g + 6], s1[8 * g + 7]); }
                const bf16x8 pf = __builtin_bit_cast(bf16x8, pw);
                const int vb = cur + voff + (kb * 32 + 16 * g) * MVP;
                const s16x4 a00 = __builtin_amdgcn_ds_read_tr16_b64_v4i16((LAS s16x4*)(lds + vb)), a01 = __builtin_amdgcn_ds_read_tr16_b64_v4i16((LAS s16x4*)(lds + vb + 4 * MVP));
                const s16x4 a10 = __builtin_amdgcn_ds_read_tr16_b64_v4i16((LAS s16x4*)(lds + vb + 64)), a11 = __builtin_amdgcn_ds_read_tr16_b64_v4i16((LAS s16x4*)(lds + vb + 64 + 4 * MVP));
                const bf16x8 v0 = {a00[0], a00[1], a00[2], a00[3], a01[0], a01[1], a01[2], a01[3]}, v1 = {a10[0], a10[1], a10[2], a10[3], a11[0], a11[1], a11[2], a11[3]};
                o0 = __builtin_amdgcn_mfma_f32_32x32x16_bf16(v0, pf, o0, 0, 0, 0); o1 = __builtin_amdgcn_mfma_f32_32x32x16_bf16(v1, pf, o1, 0, 0, 0);
            }
        if (kt + 1 < NT) { *(LAS v4u*)(lds + nxt + kd0) = rk0; if (k2) *(LAS v4u*)(lds + nxt + kd1) = rk1; *(LAS v4u*)(lds + nxt + vd) = rv; }
        __syncthreads();
    }
    lsum += __shfl_xor(lsum, 32);
    const float inv = 1.f / lsum;
    bf16* orow = yb + qtok * 512 + h * 64 + 4 * hi;
#pragma unroll
    for (int rq = 0; rq < 4; ++rq) {
        v2u a, b; a.x = pk2(o0[4 * rq] * inv, o0[4 * rq + 1] * inv); a.y = pk2(o0[4 * rq + 2] * inv, o0[4 * rq + 3] * inv);
        b.x = pk2(o1[4 * rq] * inv, o1[4 * rq + 1] * inv); b.y = pk2(o1[4 * rq + 2] * inv, o1[4 * rq + 3] * inv);
        *(v2u*)(orow + 8 * rq) = a; *(v2u*)(orow + 32 + 8 * rq) = b;
    }
}

constexpr int NVP = 144;
__device__ __forceinline__ void na_unit(int u, int L, int l, const float* rpb_all, const bf16* proj, bf16* ya, LAS unsigned char* lds) {
    const int tid = ltid(); const int lane = tid & 63, w = tid >> 6, i16 = lane & 15, quad = lane >> 4;
    const int rows = L >> 6; const int hq = u & 3, sr = u >> 2, r = sr % rows, s = sr / rows;
    const int h = 2 * hq + (w >> 2), j = w & 3;
    const int rs = min(max(r - 4, 0), rows - 8), kc0 = min(max(16 * j - 8, 0), 32);
    const size_t base = (size_t)s * L;
    const size_t qtok = base + r * 64 + 16 * j + i16;
    bf16x8 qf[2];
    qf[0] = *(const bf16x8*)(proj + qtok * DPROJ + h * 64 + quad * 8); qf[1] = *(const bf16x8*)(proj + qtok * DPROJ + h * 64 + 32 + quad * 8);
    const int cA = (i16 >> 2) * 8 + (i16 & 3);
    f32x4 sa[8], sb[8];
#pragma unroll
    for (int wr = 0; wr < 8; ++wr) {
        const bf16* kp = proj + (base + (size_t)(rs + wr) * 64 + kc0 + cA) * DPROJ + C_KA + h * 64 + quad * 8;
        const bf16x8 ka0 = *(const bf16x8*)kp, ka1 = *(const bf16x8*)(kp + 32), kb0 = *(const bf16x8*)(kp + 4 * DPROJ), kb1 = *(const bf16x8*)(kp + 4 * DPROJ + 32);
        f32x4 a = {0.f, 0.f, 0.f, 0.f}, b = {0.f, 0.f, 0.f, 0.f};
        a = __builtin_amdgcn_mfma_f32_16x16x32_bf16(ka0, qf[0], a, 0, 0, 0); a = __builtin_amdgcn_mfma_f32_16x16x32_bf16(ka1, qf[1], a, 0, 0, 0);
        b = __builtin_amdgcn_mfma_f32_16x16x32_bf16(kb0, qf[0], b, 0, 0, 0); b = __builtin_amdgcn_mfma_f32_16x16x32_bf16(kb1, qf[1], b, 0, 0, 0);
        sa[wr] = a; sb[wr] = b;
    }
    const int qc = 16 * j + i16, wst = min(max(qc - 8, 0), 48);
    const float* rpb = rpb_all + (size_t)(l * 8 + h) * 15 * 31;
    float mx = -1e30f;
#pragma unroll
    for (int wr = 0; wr < 8; ++wr) { const float* rb = rpb + (rs + wr - r + 7) * 31;
#pragma unroll
        for (int jj = 0; jj < 4; ++jj) {
            { const int kc = kc0 + quad * 8 + jj; const bool ok = (kc >= wst) && (kc < wst + 16); const int dc = min(max(kc - qc + 15, 0), 30);
              const float v = ok ? (sa[wr][jj] + rb[dc] * LOG2E) : -1e30f; sa[wr][jj] = v; mx = fmaxf(mx, v); }
            { const int kc = kc0 + quad * 8 + 4 + jj; const bool ok = (kc >= wst) && (kc < wst + 16); const int dc = min(max(kc - qc + 15, 0), 30);
              const float v = ok ? (sb[wr][jj] + rb[dc] * LOG2E) : -1e30f; sb[wr][jj] = v; mx = fmaxf(mx, v); }
        } }
    mx = fmaxf(mx, __shfl_xor(mx, 16)); mx = fmaxf(mx, __shfl_xor(mx, 32));
    float ls = 0.f;
#pragma unroll
    for (int wr = 0; wr < 8; ++wr)
#pragma unroll
        for (int jj = 0; jj < 4; ++jj) { sa[wr][jj] = __builtin_amdgcn_exp2f(sa[wr][jj] - mx); sb[wr][jj] = __builtin_amdgcn_exp2f(sb[wr][jj] - mx); ls += sa[wr][jj] + sb[wr][jj]; }
    ls += __shfl_xor(ls, 16); ls += __shfl_xor(ls, 32);
    LAS unsigned char* vw = lds + w * (64 * NVP);
    f32x4 oc[4];
#pragma unroll
    for (int db = 0; db < 4; ++db) oc[db] = (f32x4){0.f, 0.f, 0.f, 0.f};
    const int toff = (quad * 8 + (i16 >> 2)) * NVP + (4 * (lane & 3)) * 2;
#pragma unroll
    for (int ck = 0; ck < 4; ++ck) {
        v4u tmp[8];
#pragma unroll
        for (int it = 0; it < 8; ++it) { const int idx = it * 64 + lane, key = idx >> 3, ch = idx & 7;
            tmp[it] = *(const v4u*)(proj + (base + (size_t)(rs + 2 * ck + (key >> 5)) * 64 + kc0 + (key & 31)) * DPROJ + C_VA + h * 64 + ch * 8); }
        asm volatile("s_waitcnt lgkmcnt(0)" ::: "memory");
#pragma unroll
        for (int it = 0; it < 8; ++it) { const int idx = it * 64 + lane, key = idx >> 3, ch = idx & 7; *(LAS v4u*)(vw + key * NVP + ch * 16) = tmp[it]; }
        asm volatile("s_waitcnt lgkmcnt(0)" ::: "memory");
#pragma unroll
        for (int wl = 0; wl < 2; ++wl) { const int wr = 2 * ck + wl;
            v4u pw; pw.x = pk2(sa[wr][0], sa[wr][1]); pw.y = pk2(sa[wr][2], sa[wr][3]); pw.z = pk2(sb[wr][0], sb[wr][1]); pw.w = pk2(sb[wr][2], sb[wr][3]);
            const bf16x8 pf = __builtin_bit_cast(bf16x8, pw);
#pragma unroll
            for (int db = 0; db < 4; ++db) { const int vb = toff + wl * 32 * NVP + db * 32;
                const s16x4 t0 = __builtin_amdgcn_ds_read_tr16_b64_v4i16((LAS s16x4*)(vw + vb)), t1 = __builtin_amdgcn_ds_read_tr16_b64_v4i16((LAS s16x4*)(vw + vb + 4 * NVP));
                const bf16x8 vf = {t0[0], t0[1], t0[2], t0[3], t1[0], t1[1], t1[2], t1[3]};
                oc[db] = __builtin_amdgcn_mfma_f32_16x16x32_bf16(vf, pf, oc[db], 0, 0, 0); }
        }
    }
    const float inv = 1.f / ls;
    bf16* orow = ya + qtok * 512 + h * 64 + quad * 4;
#pragma unroll
    for (int db = 0; db < 4; ++db) { v2u o; o.x = pk2(oc[db][0] * inv, oc[db][1] * inv); o.y = pk2(oc[db][2] * inv, oc[db][3] * inv); *(v2u*)(orow + db * 16) = o; }
}

constexpr int NPH = 13;
__device__ __forceinline__ void run_phase(CP pp, int st, LAS unsigned char* lds) {
    volatile LAS unsigned* lctl = (volatile LAS unsigned*)(lds + LDS_RING);
    const int tid = ltid(), lane = tid & 63, wave = __builtin_amdgcn_readfirstlane(tid >> 6);
    int bid_ = blockIdx.x; asm volatile("" : "+s"(bid_));
    const int NB = gridDim.x, gw = bid_ * 8 + wave, ngw = NB * 8;
    const int ph = st % NPH, gl = st / NPH, l = gl & 1, g = gl >> 1;
    unsigned char* ws = pp->ws; const int Tg = pp->Tg;
    const Reg R{ws, (size_t)Tg};
    const size_t asz = (size_t)Tg * 512;
    const int t0 = g * Tg; const int L = (t0 < NPROMPT) ? 8192 : 4096;
    float* xout = pp->out + (size_t)t0 * DM;
    int gid0 = 0, gidn = 0;
    switch (ph) {
    case 0: {
        const float* xin = (l == 0) ? ((t0 < NPROMPT) ? pp->in[0] + (size_t)t0 * DM : pp->in[1] + (size_t)(t0 - NPROMPT) * DM) : xout;
        phase_norm(xin, pp->in[2] + l * DM, R.RH(), Tg, gw, ngw, lane);
    } break;
    case 1: gid0 = GM_IN; gidn = 1; break;
    case 2: {
        phase_post_proj(pp, l, R.RP(), R.RA(), R.RA() + (size_t)Tg * 384, R.RS(), (_Float16*)R.RZ(), asz, Tg, L, gw, ngw, lane);
    } break;
    case 3: gid0 = GM_MU; gidn = 2; break;
    case 4: {
        phase_mla_post(pp, l, R.RM(), R.RP(), R.RA(), Tg, L, gw, ngw, lane);
    } break;
    case 5: {
        unsigned* qctr = (unsigned*)(ws + WS_CTL) + 64 * gl; const int nseq = Tg / L;
        const int NS = nseq * 16, NM = nseq * 8 * (L >> 8), NN = nseq * (L >> 6) * 4, NTOT = NS + NM + NN;
        for (;;) {
            __syncthreads();
            if (tid == 0) lctl[0] = atomicAdd(qctr, 1u);
            __syncthreads();
            const int u = __builtin_amdgcn_readfirstlane((int)lctl[0]);
            if (u >= NTOT) break;
            if (u < NS) scan_unit(u, L, R.RS(), asz, R.RZ(), lds);
            else if (u < NS + NM) mla_unit(u - NS, L, R.RM(), R.RA(), R.RY() + asz, lds);
            else na_unit(u - NS - NM, L, l, pp->in[7], R.RP(), R.RY(), lds);
        }
    } break;
    case 6: {
        phase_rw_post(pp, l, R.RS(), asz, R.RZ(), R.RY() + 2 * asz, Tg, gw, ngw, lane);
    } break;
    case 7: gid0 = GM_GATE; gidn = 1; break;
    case 8: gid0 = GM_BR0; gidn = 3; break;
    case 9: gid0 = GM_OUT; gidn = 1; break;
    case 10: {
        phase_norm(xout, pp->in[29] + l * DM, R.RH(), Tg, gw, ngw, lane);
    } break;
    case 11: gid0 = GM_GU; gidn = 1; break;
    case 12: gid0 = GM_DN; gidn = 1; break;
    default: break;
    }
#pragma unroll 1
    for (int id = gid0; id < gid0 + gidn; ++id) {
        const unsigned char* wb = ws + W_OFF + (size_t)l * W_STRIDE;
        const bf16* A; const bf16* Bt; int N, K;
        switch (id) {
        case GM_IN:   A = R.RH(); Bt = (const bf16*)(wb + WO_IN); N = DPROJ; K = 1024; break;
        case GM_MU:   A = R.RA(); Bt = (const bf16*)(wb + WO_MU); N = 1792; K = 384; break;
        case GM_RU:   A = R.RA() + (size_t)Tg * 384; Bt = (const bf16*)(wb + WO_RU); N = 2560; K = 384; break;
        case GM_GATE: A = R.RH(); Bt = (const bf16*)(wb + WO_G); N = DGATE; K = 1024; break;
        case GM_BR0: case GM_BR1: case GM_BR2: A = R.RY() + (size_t)(id - GM_BR0) * asz; Bt = (const bf16*)(wb + WO_BR + (size_t)(id - GM_BR0) * MiB); N = DM; K = 512; break;
        case GM_OUT:  A = R.RM(); Bt = (const bf16*)(wb + WO_OUT); N = DM; K = 1024; break;
        case GM_GU:   A = R.RH(); Bt = (const bf16*)(wb + WO_GU); N = 2 * DFF; K = 1024; break;
        default:      A = R.RP(); Bt = (const bf16*)(wb + WO_DN); N = DM; K = DFF; break;
        }
        pg8::Gemm gm{A, Bt, Tg, N, K}; pg8::StaticOrder S; S.init(Tg, N, NB, bid_);
        EpiUni E{pp, id, l, g}; pg8::gemm_phase<EpiUni, pg8::StaticOrder, true, true>(lds, gm, S, E);
    }
}

__device__ __forceinline__ void run_phase0(CP pp, int part, LAS unsigned char* lds) {
    const int tid = ltid(), lane = tid & 63, wave = __builtin_amdgcn_readfirstlane(tid >> 6);
    const int NB = gridDim.x, gw = blockIdx.x * 8 + wave, ngw = NB * 8;
    const size_t gtid = (size_t)blockIdx.x * 512 + tid, ngt = (size_t)NB * 512;
    unsigned char* ws = pp->ws;
    if (part == 0) {
        for (int l = 0; l < 2; ++l) { unsigned char* wb = ws + W_OFF + (size_t)l * W_STRIDE;
            zero_bytes(wb + WO_IN + (size_t)NMAIN * 2048, (size_t)(DPROJ - NMAIN) * 2048, gtid, ngt);
            zero_bytes(wb + WO_MU, (size_t)1792 * 384 * 2, gtid, ngt);
            zero_bytes(wb + WO_RU, (size_t)2560 * 384 * 2, gtid, ngt); }
    } else {
        LAS float* scr = (LAS float*)(lds + wave * 16384);
#pragma unroll 1
        for (int l = 0; l < 2; ++l) { unsigned char* wb = ws + W_OFF + (size_t)l * W_STRIDE;
            const float* w_in = pp->in[3] + (size_t)l * DM * DIN;
            transpose_job(w_in, DIN, 1024, NMAIN, (bf16*)(wb + WO_IN), 1024, 0, 0, 0, scr, gw, ngw, lane);
            transpose_job(w_in + NMAIN, DIN, 1024, DGATE, (bf16*)(wb + WO_G), 1024, 0, 0, 0, scr, gw, ngw, lane);
            transpose_job(pp->in[8] + (size_t)l * 512 * 1024, 1024, 512, 1024, (bf16*)(wb + WO_BR), 512, 0, 0, 0, scr, gw, ngw, lane);
            transpose_job(pp->in[15] + (size_t)l * 512 * 1024, 1024, 512, 1024, (bf16*)(wb + WO_BR + 1 * MiB), 512, 0, 0, 0, scr, gw, ngw, lane);
            transpose_job(pp->in[27] + (size_t)l * 512 * 1024, 1024, 512, 1024, (bf16*)(wb + WO_BR + 2 * MiB), 512, 0, 0, 0, scr, gw, ngw, lane);
            transpose_job(pp->in[28] + (size_t)l * 1024 * 1024, 1024, 1024, 1024, (bf16*)(wb + WO_OUT), 1024, 0, 0, 0, scr, gw, ngw, lane);
            transpose_job(pp->in[30] + (size_t)l * 1024 * DFF, DFF, 1024, DFF, (bf16*)(wb + WO_GU), 1024, 0, 0, 1, scr, gw, ngw, lane);
            transpose_job(pp->in[31] + (size_t)l * 1024 * DFF, DFF, 1024, DFF, (bf16*)(wb + WO_GU), 1024, 0, 128, 1, scr, gw, ngw, lane);
            transpose_job(pp->in[32] + (size_t)l * DFF * 1024, 1024, DFF, 1024, (bf16*)(wb + WO_DN), DFF, 0, 0, 0, scr, gw, ngw, lane);
            transpose_job(pp->in[11] + (size_t)l * 256 * 768, 768, 256, 768, (bf16*)(wb + WO_MU), 384, 0, 0, 0, scr, gw, ngw, lane);
            transpose_job(pp->in[12] + (size_t)l * 128 * 1024, 1024, 128, 1024, (bf16*)(wb + WO_MU), 384, 256, 768, 0, scr, gw, ngw, lane);
#pragma unroll 1
            for (int d = 0; d < 2; ++d) {
                transpose_job(pp->in[18] + (size_t)(l * 2 + d) * 64 * 512, 512, 64, 512, (bf16*)(wb + WO_RU), 384, 64 * d, 512 * d, 0, scr, gw, ngw, lane);
                transpose_job(pp->in[20] + (size_t)(l * 2 + d) * 64 * 512, 512, 64, 512, (bf16*)(wb + WO_RU), 384, 128 + 64 * d, 1024 + 512 * d, 0, scr, gw, ngw, lane); }
            transpose_job(pp->in[21] + (size_t)l * 128 * 512, 512, 128, 512, (bf16*)(wb + WO_RU), 384, 256, 2048, 0, scr, gw, ngw, lane);
        }
    }
}

__global__ void __launch_bounds__(512, 2) mega(Params p) {
    extern __shared__ __attribute__((aligned(16))) unsigned char lds_raw[];
    LAS unsigned char* lds = (LAS unsigned char*)lds_raw;
    cg::grid_group grid = cg::this_grid();
    if (blockIdx.x == 0 && threadIdx.x == 0) { Params* d = (Params*)(p.ws + WS_PARAMS); *d = p; }
    const int nsteps = p.G * 2 * NPH;
    grid.sync();
#pragma unroll 1
    for (int st = -2; st < nsteps; ++st) {
        int s2 = st; asm volatile("" : "+s"(s2));
        CP pp = (CP)(p.ws + WS_PARAMS); asm volatile("" : "+s"(pp));
        if (s2 < 0) run_phase0(pp, s2 + 2, lds); else run_phase(pp, s2, lds);
        grid.sync();
    }
}

extern "C" void kernel_launch(void* const* d_in, const int* in_sizes, int n_in, void* d_out, int out_size, void* d_ws, size_t ws_size, hipStream_t stream) {
    static int grid = 0;
    if (grid == 0) {
        int dev = 0, cus = 0, per_cu = 0;
        hipGetDevice(&dev); hipDeviceGetAttribute(&cus, hipDeviceAttributeMultiprocessorCount, dev);
        hipFuncSetAttribute((const void*)mega, hipFuncAttributeMaxDynamicSharedMemorySize, LDS_BYTES);
        hipOccupancyMaxActiveBlocksPerMultiprocessor(&per_cu, (const void*)mega, 512, LDS_BYTES);
        (void)hipGetLastError();
        if (per_cu < 1) per_cu = 1;
        grid = cus * per_cu;
    }
    int G = 2;
    while (G < 16 && ACT_OFF + (size_t)(NTOK / G) * TOKB > ws_size) G *= 2;
    if (hipMemsetAsync((char*)d_ws + WS_CTL, 0, CTL_BYTES, stream) != hipSuccess) { fprintf(stderr, "kernel_launch: memset failed\n"); return; }
    Params p{};
    for (int i = 0; i < 33; ++i) p.in[i] = (const float*)d_in[i];
    p.out = (float*)d_out; p.ws = (unsigned char*)d_ws; p.G = G; p.Tg = NTOK / G;
    void* args[] = {&p};
    hipError_t e = hipLaunchCooperativeKernel((const void*)mega, dim3(grid), dim3(512), args, LDS_BYTES, stream);
    if (e != hipSuccess) fprintf(stderr, "cooperative launch failed: %s (grid %d)\n", hipGetErrorString(e), grid);
}
```

```cpp
#include <hip/hip_runtime.h>
#include <hip/hip_cooperative_groups.h>
#include <cstdio>
#include <cstdint>
namespace cg = cooperative_groups;
namespace pg8 {
#define PG8_LAS __attribute__((address_space(3)))
typedef unsigned short bf16_t;
typedef short bf16x8 __attribute__((ext_vector_type(8)));
typedef float f32x4 __attribute__((ext_vector_type(4)));
typedef unsigned u32x4 __attribute__((ext_vector_type(4)));
constexpr int BM = 256, BK = 64, HALF = 128, HTB = HALF * BK * 2  , STAGE_BYTES = 8 * HTB, NXCD = 8, WGM = 8;

__host__ __device__ __forceinline__ int lds_byte(int r, int c) { const int st = (r >> 4) * 2 + (c >> 5), rr = r & 15, cc = c & 31, ob = rr * 64 + cc * 2; return st * 1024 + (ob ^ (((ob >> 9) & 1) << 5)); }
__host__ __device__ __forceinline__ void stage_rc(int b, int& R, int& C) { const int st = b / 1024, sb = b % 1024, swz = sb ^ (((sb >> 9) & 1) << 5); R = (st >> 1) * 16 + swz / 64; C = (st & 1) * 32 + (swz % 64) / 2; }
__host__ __device__ __forceinline__ int perm32(int rho) { const int n = rho >> 4, i = rho & 15; return 8 * (i >> 2) + 4 * n + (i & 3); }

struct Unit { int pm, pn; };
struct Gemm { const bf16_t* A; const bf16_t* Bt; int M, N, K; };

struct StaticOrder {
    int nM, nN, nwg, G, c;
    __host__ __device__ void init(int M, int N, int G_, int c_) { nM = M / BM; nN = N / BM; nwg = nM * nN; G = G_; c = c_; }
    __host__ __device__ bool next(int i, Unit& u) const {
        const long L = (long)i * G + c; if (L >= nwg) return false;
        int wgid = (int)L; { const int q = nwg / NXCD, r = nwg % NXCD, xcd = wgid % NXCD, off = wgid / NXCD; wgid = (xcd < r ? xcd * (q + 1) : r * (q + 1) + (xcd - r) * q) + off; }
        const int nig = WGM * nN, gid = wgid / nig, fm = gid * WGM, gsz = (nM - fm) < WGM ? (nM - fm) : WGM;
        u.pm = fm + ((wgid % nig) % gsz); u.pn = (wgid % nig) / gsz; return true;
    }
    __device__ __forceinline__ void a_ready(const Unit&) const {}
    __device__ __forceinline__ void done(const Unit&) const {}
};

__device__ __forceinline__ unsigned cvt_pk_bf16(float lo, float hi) { unsigned r; asm volatile("v_cvt_pk_bf16_f32 %0, %1, %2" : "=v"(r) : "v"(lo), "v"(hi)); return r; }
typedef float f32x2 __attribute__((ext_vector_type(2)));
}
namespace pg8 {
template <class Epi, class Sched, bool ALIGN_EPI = false, bool SP2 = false>
__device__ __forceinline__ void gemm_phase(PG8_LAS unsigned char* lds, const Gemm g, const Sched& S, const Epi& E) {
    int tid_l = threadIdx.x; asm volatile("" : "+v"(tid_l)); const int tid = tid_l, wid = __builtin_amdgcn_readfirstlane(tid >> 6), lane = tid & 63, wr = wid >> 2, wc = wid & 3, fr = lane & 15, fq = lane >> 4;
    const int K = g.K, nt = K / BK;
    unsigned voffA[2], voffB[2];
#pragma unroll
    for (int i = 0; i < 2; ++i) { int R, C; stage_rc(tid * 16 + i * 8192, R, C); const int Rb = Epi::PERM ? ((R & ~31) + perm32(R & 31)) : R;
        voffA[i] = (unsigned)(R * K + C) * 2u; voffB[i] = (unsigned)(Rb * K + C) * 2u; }
    const size_t kstep = (size_t)(BK * 2);
    const size_t hstep = (size_t)HALF * K * 2;
    const size_t tstep = 2 * hstep;
    const unsigned ldsw = (unsigned)wid * 1024u;
    const int aoff = lds_byte(wr * 64 + fr, fq * 8), boff = lds_byte(wc * 32 + fr, fq * 8);
#define PG8_SA(b, h) (((b) * 2 + (h)) * HTB)
#define PG8_SB(b, h) ((4 + (b) * 2 + (h)) * HTB)
#define PG8_STAGE(bufoff, gbase, voff) do { _Pragma("unroll") for (int _i = 0; _i < 2; ++_i) \
        __builtin_amdgcn_global_load_lds((const unsigned*)((const char*)(gbase) + (voff)[_i]), (PG8_LAS unsigned*)(lds + (bufoff) + ldsw + _i * 8192), 16, 0, 0); } while (0)
#define PG8_LDA(dst, b, h) do { _Pragma("unroll") for (int m = 0; m < 4; ++m) _Pragma("unroll") for (int k = 0; k < 2; ++k) dst[m][k] = *(const PG8_LAS bf16x8*)(lds + PG8_SA(b, h) + aoff + m * 2048 + k * 1024); } while (0)
#define PG8_LDB(dst, b, h) do { _Pragma("unroll") for (int n = 0; n < 2; ++n) _Pragma("unroll") for (int k = 0; k < 2; ++k) dst[n][k] = *(const PG8_LAS bf16x8*)(lds + PG8_SB(b, h) + boff + n * 2048 + k * 1024); } while (0)
#define PG8_MMA(ai, bj, At, Bt) do { __builtin_amdgcn_s_setprio(1); _Pragma("unroll") for (int m = 0; m < 4; ++m) _Pragma("unroll") for (int n = 0; n < 2; ++n) _Pragma("unroll") for (int k = 0; k < 2; ++k) \
        acc[ai][bj][m][n] = __builtin_amdgcn_mfma_f32_16x16x32_bf16(Bt[n][k], At[m][k], acc[ai][bj][m][n], 0, 0, 0); __builtin_amdgcn_s_setprio(0); } while (0)
#define PG8_WAIT_V(n) asm volatile("s_waitcnt vmcnt(" #n ")" ::: "memory")
#define PG8_WAIT_L(n) asm volatile("s_waitcnt lgkmcnt(" #n ")" ::: "memory")
#define PG8_BAR __builtin_amdgcn_s_barrier()
#define PG8_SCHED __builtin_amdgcn_sched_barrier(0)
    Unit cur, nxt; int ui = 0;
    if (!S.next(0, cur)) return;
    f32x4 acc[2][2][4][2];
#pragma unroll
    for (int a = 0; a < 2; ++a)
#pragma unroll
        for (int b = 0; b < 2; ++b)
#pragma unroll
            for (int m = 0; m < 4; ++m)
#pragma unroll
                for (int n = 0; n < 2; ++n) acc[a][b][m][n] = (f32x4){0.f, 0.f, 0.f, 0.f};
    bf16x8 At[4][2], B0[2][2], B1[2][2];
    const char* cA = (const char*)g.A + (size_t)cur.pm * tstep; const char* cB = (const char*)g.Bt + (size_t)cur.pn * tstep;
    S.a_ready(cur);
    if constexpr (SP2) {
        PG8_STAGE(PG8_SB(0, 0), cB, voffB); PG8_STAGE(PG8_SB(0, 1), cB + hstep, voffB); PG8_STAGE(PG8_SA(0, 0), cA, voffA); PG8_STAGE(PG8_SA(0, 1), cA + hstep, voffA);
        if (wr == 1) PG8_BAR;
        PG8_WAIT_V(2); PG8_BAR;
        PG8_STAGE(PG8_SB(1, 0), cB + kstep, voffB); PG8_STAGE(PG8_SA(1, 0), cA + kstep, voffA); PG8_STAGE(PG8_SB(1, 1), cB + hstep + kstep, voffB);
        PG8_WAIT_V(6); PG8_BAR;
    } else {
        PG8_STAGE(PG8_SB(0, 0), cB, voffB); PG8_STAGE(PG8_SA(0, 0), cA, voffA); PG8_STAGE(PG8_SB(0, 1), cB + hstep, voffB); PG8_STAGE(PG8_SA(0, 1), cA + hstep, voffA);
        if (wr == 1) PG8_BAR;
        PG8_WAIT_V(4); PG8_BAR;
        PG8_STAGE(PG8_SB(1, 0), cB + kstep, voffB); PG8_STAGE(PG8_SA(1, 0), cA + kstep, voffA); PG8_STAGE(PG8_SB(1, 1), cB + hstep + kstep, voffB);
        PG8_WAIT_V(6); PG8_BAR;
    }
    for (;;) {
        const bool has_next = S.next(ui + 1, nxt);
        const char* nA = has_next ? (const char*)g.A + (size_t)nxt.pm * tstep : cA; const char* nB = has_next ? (const char*)g.Bt + (size_t)nxt.pn * tstep : cB;
        for (int t = 0; t < nt; t += 2) {
            const bool last = (t == nt - 2);
            const char* a1 = cA + (size_t)(t + 1) * kstep;
            const char* a2 = last ? nA : cA + (size_t)(t + 2) * kstep; const char* b2 = last ? nB : cB + (size_t)(t + 2) * kstep;
            const char* a3 = a2 + kstep; const char* b3 = b2 + kstep;
            if (last && has_next) S.a_ready(nxt);
            if constexpr (SP2) {
            PG8_LDB(B0, 0, 0); PG8_LDB(B1, 0, 1); PG8_SCHED; PG8_LDA(At, 0, 0); PG8_STAGE(PG8_SA(1, 1), a1 + hstep, voffA);
            PG8_WAIT_V(8); PG8_WAIT_L(0); PG8_BAR; PG8_MMA(0, 0, At, B0); PG8_MMA(0, 1, At, B1); PG8_BAR; PG8_SCHED;
            PG8_LDA(At, 0, 1); PG8_STAGE(PG8_SB(0, 0), b2, voffB); PG8_STAGE(PG8_SB(0, 1), b2 + hstep, voffB); PG8_STAGE(PG8_SA(0, 0), a2, voffA);
            PG8_WAIT_V(8); PG8_WAIT_L(0); PG8_BAR; PG8_MMA(1, 0, At, B0); PG8_MMA(1, 1, At, B1); PG8_BAR; PG8_SCHED;
            PG8_LDB(B0, 1, 0); PG8_LDB(B1, 1, 1); PG8_SCHED; PG8_LDA(At, 1, 0); PG8_STAGE(PG8_SA(0, 1), a2 + hstep, voffA);
            PG8_WAIT_V(8); PG8_WAIT_L(0); PG8_BAR; PG8_MMA(0, 0, At, B0); PG8_MMA(0, 1, At, B1); PG8_BAR; PG8_SCHED;
            PG8_LDA(At, 1, 1); PG8_STAGE(PG8_SB(1, 0), b3, voffB); PG8_STAGE(PG8_SB(1, 1), b3 + hstep, voffB); PG8_STAGE(PG8_SA(1, 0), a3, voffA);
            PG8_WAIT_V(8); PG8_WAIT_L(0); PG8_BAR; PG8_MMA(1, 0, At, B0); PG8_MMA(1, 1, At, B1); PG8_BAR; PG8_SCHED;
            } else {
            PG8_LDB(B0, 0, 0); PG8_SCHED; PG8_LDA(At, 0, 0); PG8_STAGE(PG8_SA(1, 1), a1 + hstep, voffA);
            PG8_WAIT_L(8); PG8_BAR; PG8_WAIT_L(0); PG8_MMA(0, 0, At, B0); PG8_BAR; PG8_SCHED;
            PG8_LDB(B1, 0, 1); PG8_STAGE(PG8_SB(0, 0), b2, voffB);
            PG8_BAR; PG8_WAIT_L(0); PG8_MMA(0, 1, At, B1); PG8_BAR;
            PG8_LDA(At, 0, 1); PG8_STAGE(PG8_SA(0, 0), a2, voffA);
            PG8_BAR; PG8_WAIT_L(0); PG8_MMA(1, 0, At, B0); PG8_BAR; PG8_SCHED;
            PG8_STAGE(PG8_SB(0, 1), b2 + hstep, voffB);
            PG8_WAIT_V(6); PG8_BAR; PG8_MMA(1, 1, At, B1); PG8_BAR;
            PG8_LDB(B0, 1, 0); PG8_SCHED; PG8_LDA(At, 1, 0); PG8_STAGE(PG8_SA(0, 1), a2 + hstep, voffA);
            PG8_WAIT_L(8); PG8_BAR; PG8_WAIT_L(0); PG8_MMA(0, 0, At, B0); PG8_BAR; PG8_SCHED;
            PG8_LDB(B1, 1, 1); PG8_STAGE(PG8_SB(1, 0), b3, voffB);
            PG8_BAR; PG8_WAIT_L(0); PG8_MMA(0, 1, At, B1); PG8_BAR;
            PG8_LDA(At, 1, 1); PG8_STAGE(PG8_SA(1, 0), a3, voffA);
            PG8_BAR; PG8_WAIT_L(0); PG8_MMA(1, 0, At, B0); PG8_BAR; PG8_SCHED;
            PG8_STAGE(PG8_SB(1, 1), b3 + hstep, voffB);
            PG8_WAIT_V(6); PG8_BAR; PG8_MMA(1, 1, At, B1); PG8_BAR;
            }
        }
        if constexpr (ALIGN_EPI) { if (wr == 0) PG8_BAR; }
        if constexpr (!Epi::AFTER_DRAIN) { E(acc, cur, wr, wc, fr, fq); S.done(cur); }
        if (!has_next) break;
#pragma unroll
        for (int a = 0; a < 2; ++a)
#pragma unroll
            for (int b = 0; b < 2; ++b)
#pragma unroll
                for (int m = 0; m < 4; ++m)
#pragma unroll
                    for (int n = 0; n < 2; ++n) acc[a][b][m][n] = (f32x4){0.f, 0.f, 0.f, 0.f};
        cur = nxt; cA = nA; cB = nB; ++ui;
        if constexpr (ALIGN_EPI) { if (wr == 1) PG8_BAR; }
    }
    PG8_WAIT_V(0);
    if constexpr (!ALIGN_EPI) { if (wr == 0) PG8_BAR; }
    PG8_BAR;
    if constexpr (Epi::AFTER_DRAIN) { E.fused(acc, cur, wr, wc, fr, fq, lds, wid, lane); S.done(cur); }
#undef PG8_SA
#undef PG8_SB
#undef PG8_STAGE
#undef PG8_LDA
#undef PG8_LDB
#undef PG8_MMA
#undef PG8_WAIT_V
#undef PG8_WAIT_L
#undef PG8_BAR
#undef PG8_SCHED
}
}

#define LAS __attribute__((address_space(3)))
typedef unsigned short bf16;
typedef unsigned v4u __attribute__((ext_vector_type(4)));
typedef unsigned v2u __attribute__((ext_vector_type(2)));
typedef float f32x4 __attribute__((ext_vector_type(4)));
typedef float f32x16 __attribute__((ext_vector_type(16)));
typedef short bf16x8 __attribute__((ext_vector_type(8)));
typedef short s16x4 __attribute__((ext_vector_type(4)));
typedef _Float16 h8 __attribute__((ext_vector_type(8)));

__device__ __forceinline__ unsigned pk2(float lo, float hi) { return pg8::cvt_pk_bf16(lo, hi); }
__device__ __forceinline__ float bflo(unsigned u) { return __uint_as_float(u << 16); }
__device__ __forceinline__ float bfhi(unsigned u) { return __uint_as_float(u & 0xffff0000u); }
__device__ __forceinline__ float bf2f(bf16 b) { return __uint_as_float(((unsigned)b) << 16); }
__device__ __forceinline__ bf16 f2bf(float f) { return (bf16)(pk2(f, 0.f) & 0xffffu); }
#define UNPACK8(v, f) do { f[0] = bflo(v.x); f[1] = bfhi(v.x); f[2] = bflo(v.y); f[3] = bfhi(v.y); f[4] = bflo(v.z); f[5] = bfhi(v.z); f[6] = bflo(v.w); f[7] = bfhi(v.w); } while (0)
#define PACK8(o, f) do { o.x = pk2(f[0], f[1]); o.y = pk2(f[2], f[3]); o.z = pk2(f[4], f[5]); o.w = pk2(f[6], f[7]); } while (0)
__device__ __forceinline__ int ltid() { int t = threadIdx.x; asm volatile("" : "+v"(t)); return t; }
__device__ __forceinline__ float sigmoidf_(float x) { return 1.f / (1.f + __expf(-x)); }
__device__ __forceinline__ float wave_sum(float v) {
#pragma unroll
    for (int o = 1; o < 64; o <<= 1) v += __shfl_xor(v, o);
    return v;
}
__device__ __forceinline__ float sum8(float v) { v += __shfl_xor(v, 1); v += __shfl_xor(v, 2); v += __shfl_xor(v, 4); return v; }

constexpr int DM = 1024, DIN = 6944, DPROJ = 4096, NMAIN = 3872, DGATE = 3072, DFF = 2816;
constexpr int NTOK = 131072, NPROMPT = 65536;
constexpr int C_KA = 512, C_VA = 1024, C_CQ = 1536, C_CKV = 1792, C_KR = 1920, C_RW = 1952;
constexpr float LOG2E = 1.4426950408889634f;
constexpr float NA_QS = 0.125f * LOG2E;
constexpr float MLA_QS = 0.10206207261596575f * LOG2E;
constexpr float NEPS = 1e-6f;

constexpr size_t MiB = 1u << 20;
constexpr size_t WS_CTL = 0, CTL_BYTES = 1 * MiB;
constexpr size_t W_OFF = 1 * MiB, W_STRIDE = 39 * MiB;
constexpr size_t WO_IN = 0, WO_G = 8 * MiB, WO_BR = 14 * MiB, WO_OUT = 17 * MiB, WO_GU = 19 * MiB, WO_DN = 30 * MiB, WO_MU = 35 * MiB + 512 * 1024, WO_RU = 37 * MiB;
constexpr size_t ACT_OFF = 80 * MiB;
constexpr size_t TOKB_H = 2048, TOKB_P = 8192, TOKB_M = 3584, TOKB_A = 1536, TOKB_S = 9216, TOKB_Y = 3072, TOKB_Z = 2048;
constexpr size_t TOKB = TOKB_H + TOKB_P + TOKB_M + TOKB_A + TOKB_S + TOKB_Y + TOKB_Z;
static_assert(WO_MU + 1792 * 384 * 2 <= WO_RU && WO_RU + 2560 * 384 * 2 <= W_STRIDE && WO_DN + 1024 * 2816 * 2 <= WO_MU && WO_GU + 5632 * 1024 * 2 <= WO_DN, "weight map");
constexpr int LDS_RING = 131072, LDS_BYTES = LDS_RING + 1024;

struct Params { const float* in[33]; float* out; unsigned char* ws; int G; int Tg; };
typedef const __attribute__((address_space(4))) Params* CP;

constexpr size_t WS_PARAMS = 512 * 1024;
struct Reg { unsigned char* ws; size_t Tg;
    __device__ __forceinline__ bf16* RH() const { return (bf16*)(ws + ACT_OFF); }
    __device__ __forceinline__ bf16* RP() const { return (bf16*)(ws + ACT_OFF + Tg * TOKB_H); }
    __device__ __forceinline__ bf16* RM() const { return (bf16*)(ws + ACT_OFF + Tg * (TOKB_H + TOKB_P)); }
    __device__ __forceinline__ bf16* RA() const { return (bf16*)(ws + ACT_OFF + Tg * (TOKB_H + TOKB_P + TOKB_M)); }
    __device__ __forceinline__ _Float16* RS() const { return (_Float16*)(ws + ACT_OFF + Tg * (TOKB_H + TOKB_P + TOKB_M + TOKB_A)); }
    __device__ __forceinline__ bf16* RY() const { return (bf16*)(ws + ACT_OFF + Tg * (TOKB_H + TOKB_P + TOKB_M + TOKB_A + TOKB_S)); }
    __device__ __forceinline__ bf16* RZ() const { return (bf16*)(ws + ACT_OFF + Tg * (TOKB_H + TOKB_P + TOKB_M + TOKB_A + TOKB_S + TOKB_Y)); }
};
enum { GM_IN = 0, GM_MU = 1, GM_RU = 2, GM_GATE = 3, GM_BR0 = 4, GM_BR1 = 5, GM_BR2 = 6, GM_OUT = 7, GM_GU = 8, GM_DN = 9 };
#define EPI_FENCE() asm volatile("" ::: "memory")
struct EpiUni {
    static constexpr bool PERM = true, AFTER_DRAIN = false;
    CP pp; int id, l, g;
    __device__ __forceinline__ void operator()(const pg8::f32x4 (&acc)[2][2][4][2], const pg8::Unit& u, int wr, int wc, int fr, int fq) const {
        CP q = pp; asm volatile("" : "+s"(q));
        const int Tg = q->Tg; const Reg R{q->ws, (size_t)Tg}; const size_t asz = (size_t)Tg * 512;
        const int row0 = u.pm * 256 + wr * 64 + fr, col0 = u.pn * 256 + wc * 32 + 8 * fq;
        switch (id) {
        case GM_IN: case GM_MU: {
            bf16* O = (id == GM_IN) ? R.RP() : R.RM(); const int ldc = (id == GM_IN) ? DPROJ : 1792;
#pragma unroll
            for (int ai = 0; ai < 2; ++ai)
#pragma unroll
                for (int m = 0; m < 4; ++m) { bf16* rp = O + (size_t)(row0 + ai * 128 + m * 16) * ldc + col0;
#pragma unroll
                    for (int bj = 0; bj < 2; ++bj) { const f32x4 v0 = acc[ai][bj][m][0], v1 = acc[ai][bj][m][1]; v4u w; w.x = pk2(v0[0], v0[1]); w.y = pk2(v0[2], v0[3]); w.z = pk2(v1[0], v1[1]); w.w = pk2(v1[2], v1[3]);
                        *(v4u*)(rp + bj * 128) = w; } }
        } break;
        case GM_GATE: {
            bf16* O = R.RP(); const float* bias = q->in[4] + l * DGATE + col0;
#pragma unroll
            for (int bj = 0; bj < 2; ++bj) { const f32x4 b0 = *(const f32x4*)(bias + bj * 128), b1 = *(const f32x4*)(bias + bj * 128 + 4);
#pragma unroll
                for (int ai = 0; ai < 2; ++ai)
#pragma unroll
                    for (int m = 0; m < 4; ++m) { const f32x4 v0 = acc[ai][bj][m][0] + b0, v1 = acc[ai][bj][m][1] + b1; float f[8];
#pragma unroll
                        for (int i = 0; i < 4; ++i) { f[i] = sigmoidf_(v0[i]); f[4 + i] = sigmoidf_(v1[i]); }
                        v4u w; PACK8(w, f); *(v4u*)(O + (size_t)(row0 + ai * 128 + m * 16) * DGATE + col0 + bj * 128) = w; }
                EPI_FENCE(); }
        } break;
        case GM_GU: {
            bf16* O = R.RP(); const int hc = u.pn * 128 + wc * 32 + 8 * fq;
#pragma unroll
            for (int ai = 0; ai < 2; ++ai)
#pragma unroll
                for (int m = 0; m < 4; ++m) { float f[8];
#pragma unroll
                    for (int n = 0; n < 2; ++n)
#pragma unroll
                        for (int i = 0; i < 4; ++i) { const float gt = acc[ai][0][m][n][i], up = acc[ai][1][m][n][i]; f[4 * n + i] = gt * sigmoidf_(gt) * up; }
                    v4u w; PACK8(w, f); *(v4u*)(O + (size_t)(row0 + ai * 128 + m * 16) * DFF + hc) = w; }
        } break;
        case GM_BR0: case GM_BR1: case GM_BR2: {
            bf16* O = R.RM(); const bf16* Gt = R.RP() + (id - GM_BR0) * 1024; const bool first = (id == GM_BR0);
#pragma unroll
            for (int ai = 0; ai < 2; ++ai)
#pragma unroll
                for (int m = 0; m < 4; ++m) { const size_t row = (size_t)(row0 + ai * 128 + m * 16);
#pragma unroll
                    for (int bj = 0; bj < 2; ++bj) { const int col = col0 + bj * 128; const v4u gv = *(const v4u*)(Gt + row * DGATE + col); float gg[8], f[8]; UNPACK8(gv, gg);
#pragma unroll
                        for (int i = 0; i < 4; ++i) { f[i] = gg[i] * acc[ai][bj][m][0][i]; f[4 + i] = gg[4 + i] * acc[ai][bj][m][1][i]; }
                        if (!first) { const v4u ov = *(const v4u*)(O + row * DM + col); float o[8]; UNPACK8(ov, o);
#pragma unroll
                            for (int i = 0; i < 8; ++i) f[i] += o[i]; }
                        v4u w; PACK8(w, f); *(v4u*)(O + row * DM + col) = w; }
                    EPI_FENCE(); }
        } break;
        case GM_OUT: case GM_DN: {
            const int t0 = g * Tg; float* xout = q->out + (size_t)t0 * DM;
            const float* xin = (id == GM_OUT && l == 0) ? ((t0 < NPROMPT) ? q->in[0] + (size_t)t0 * DM : q->in[1] + (size_t)(t0 - NPROMPT) * DM) : xout;
#pragma unroll
            for (int ai = 0; ai < 2; ++ai)
#pragma unroll
                for (int m = 0; m < 4; ++m) { const size_t off = (size_t)(row0 + ai * 128 + m * 16) * DM + col0;
#pragma unroll
                    for (int bj = 0; bj < 2; ++bj)
#pragma unroll
                        for (int n = 0; n < 2; ++n) { const f32x4 b = *(const f32x4*)(xin + off + bj * 128 + n * 4); *(f32x4*)(xout + off + bj * 128 + n * 4) = b + acc[ai][bj][m][n]; }
                    EPI_FENCE(); }
        } break;
        case GM_RU: {
            _Float16* rs = R.RS(); const _Float16* ktmp = (const _Float16*)R.RZ(); bf16* gout = R.RY() + 2 * asz;
            const int type = u.pn >> 1; const int cl0 = (u.pn & 1) * 256 + wc * 32 + 8 * fq;
            const float* w0 = q->in[17] + l * 1024; const float* a0 = q->in[19] + l * 1024; const float* ka = q->in[23] + l * 512;
#pragma unroll
            for (int ai = 0; ai < 2; ++ai)
#pragma unroll
                for (int m = 0; m < 4; ++m) { const size_t row = (size_t)(row0 + ai * 128 + m * 16);
#pragma unroll
                    for (int bj = 0; bj < 2; ++bj) { const int cl = cl0 + bj * 128; float f[8];
#pragma unroll
                        for (int i = 0; i < 4; ++i) { f[i] = acc[ai][bj][m][0][i]; f[4 + i] = acc[ai][bj][m][1][i]; }
                        if (type < 2) {
                            h8 o;
#pragma unroll
                            for (int i = 0; i < 8; ++i) o[i] = (_Float16)__expf(-0.6065306597126334f * sigmoidf_(f[i] + w0[type * 512 + cl + i]));
                            *(h8*)(rs + (size_t)(3 + type) * asz + row * 512 + cl) = o;
                        } else if (type < 4) {
                            const int d = type - 2; const h8 kv = *(const h8*)(ktmp + row * 512 + cl), kkv = *(const h8*)(rs + (size_t)2 * asz + row * 512 + cl); h8 o1, o2;
#pragma unroll
                            for (int i = 0; i < 8; ++i) { const float a = sigmoidf_(f[i] + a0[d * 512 + cl + i]); o1[i] = (_Float16)((float)kkv[i] * a); o2[i] = (_Float16)((float)kv[i] * (1.f + (a - 1.f) * ka[cl + i])); }
                            *(h8*)(rs + (size_t)(5 + d) * asz + row * 512 + cl) = o1; *(h8*)(rs + (size_t)(7 + d) * asz + row * 512 + cl) = o2;
                        } else { v4u w; PACK8(w, f); *(v4u*)(gout + row * 512 + cl) = w; }
                        EPI_FENCE(); } }
        } break;
        default: break;
        }
    }
};

__device__ __forceinline__ void transpose_item(const float* W, int ldw, int N, bf16* WT, int ldt, int koff, int row_off, int mode, LAS float* scr, int item, int lane) {
    const int nblk = N / 32, kb = item / nblk, nb = item % nblk, k0 = 64 * kb, n0 = 32 * nb;
#pragma unroll 8
    for (int i = 0; i < 32; ++i) { const int kk = 2 * i + (lane >> 5); scr[kk * 33 + (lane & 31)] = W[(size_t)(k0 + kk) * ldw + n0 + (lane & 31)]; }
    asm volatile("s_waitcnt lgkmcnt(0)" ::: "memory");
    const int c = lane & 7;
#pragma unroll
    for (int j = 0; j < 4; ++j) { const int n = (lane >> 3) + 8 * j; const LAS float* s = scr + (8 * c) * 33 + n;
        v4u o; o.x = pk2(s[0 * 33], s[1 * 33]); o.y = pk2(s[2 * 33], s[3 * 33]); o.z = pk2(s[4 * 33], s[5 * 33]); o.w = pk2(s[6 * 33], s[7 * 33]);
        const int nn = n0 + n; const int drow = mode ? ((nn >> 7) * 256 + row_off + (nn & 127)) : (row_off + nn);
        *(v4u*)(WT + (size_t)drow * ldt + koff + k0 + 8 * c) = o; }
    asm volatile("s_waitcnt lgkmcnt(0)" ::: "memory");
}
__device__ __forceinline__ void transpose_job(const float* W, int ldw, int K, int N, bf16* WT, int ldt, int koff, int row_off, int mode, LAS float* scr, int gw, int ngw, int lane) {
    const int nitems = (K / 64) * (N / 32);
    for (int it = gw; it < nitems; it += ngw) transpose_item(W, ldw, N, WT, ldt, koff, row_off, mode, scr, it, lane);
}
__device__ __forceinline__ void zero_bytes(unsigned char* p, size_t nbytes, size_t gtid, size_t ngt) {
    const v4u z = {0u, 0u, 0u, 0u};
    for (size_t i = gtid; i < nbytes / 16; i += ngt) ((v4u*)p)[i] = z;
}

__device__ __forceinline__ void phase_norm(const float* x, const float* g, bf16* hb, int Tg, int gw, int ngw, int lane) {
    for (int t = gw; t < Tg; t += 2 * ngw) {
        const int t2 = (t + ngw < Tg) ? t + ngw : t;
        const f32x4* xa = (const f32x4*)(x + (size_t)t * DM) + lane; const f32x4* xb = (const f32x4*)(x + (size_t)t2 * DM) + lane; f32x4 va[4], vb[4]; float sa = 0.f, sb = 0.f;
#pragma unroll
        for (int j = 0; j < 4; ++j) { va[j] = xa[64 * j]; vb[j] = xb[64 * j]; }
#pragma unroll
        for (int j = 0; j < 4; ++j) { sa += (va[j].x * va[j].x + va[j].y * va[j].y) + (va[j].z * va[j].z + va[j].w * va[j].w); sb += (vb[j].x * vb[j].x + vb[j].y * vb[j].y) + (vb[j].z * vb[j].z + vb[j].w * vb[j].w); }
        const float ia = rsqrtf(wave_sum(sa) * (1.f / DM) + NEPS), ib = rsqrtf(wave_sum(sb) * (1.f / DM) + NEPS);
        v2u* oa = (v2u*)(hb + (size_t)t * DM) + lane; v2u* ob = (v2u*)(hb + (size_t)t2 * DM) + lane;
#pragma unroll
        for (int j = 0; j < 4; ++j) { const f32x4 gg = ((const f32x4*)g)[lane + 64 * j]; v2u o;
            o.x = pk2(va[j].x * ia * gg.x, va[j].y * ia * gg.y); o.y = pk2(va[j].z * ia * gg.z, va[j].w * ia * gg.w); oa[64 * j] = o;
            o.x = pk2(vb[j].x * ib * gg.x, vb[j].y * ib * gg.y); o.y = pk2(vb[j].z * ib * gg.z, vb[j].w * ib * gg.w); ob[64 * j] = o; }
    }
}

__device__ __forceinline__ void phase_post_proj(CP pp, int l, bf16* proj, bf16* mla_a, bf16* rw_a, _Float16* rs, _Float16* ktmp, size_t asz, int Tg, int L, int gw, int ngw, int lane) {
    const float* gq = pp->in[5] + l * 64; const float* gk = pp->in[6] + l * 64;
    const float* gcq = pp->in[9] + l * 256; const float* gckv = pp->in[10] + l * 128;
    const float* mu = pp->in[16] + l * 1920; const float* kkw = pp->in[22] + l * 512;
    for (int t = gw; t < Tg; t += ngw) {
        bf16* row = proj + (size_t)t * DPROJ; const int tpos = t % L;
        const bool hasp = tpos > 0, hasn = tpos < L - 1;
        v4u qv = *(const v4u*)(row + 8 * lane), kv = *(const v4u*)(row + C_KA + 8 * lane); const v2u cv = *(const v2u*)(row + C_CQ + 4 * lane); const unsigned kvv = *(const unsigned*)(row + C_CKV + 2 * lane);
        v4u rwc[4], rwp[4], rwn[4];
#pragma unroll
        for (int it = 0; it < 4; ++it) { const int c0 = (it * 64 + lane) * 8; const v4u z = {0u, 0u, 0u, 0u}; rwc[it] = z; rwp[it] = z; rwn[it] = z;
            if (it < 3 || lane < 48) { const bf16* src = row + C_RW + c0; rwc[it] = *(const v4u*)src; if (hasp) rwp[it] = *(const v4u*)(src - DPROJ); if (hasn) rwn[it] = *(const v4u*)(src + DPROJ); } }
        {
            const int gi = 8 * (lane & 7);
            float f[8]; UNPACK8(qv, f); float ss = 0.f;
#pragma unroll
            for (int i = 0; i < 8; ++i) ss += f[i] * f[i];
            float inv = rsqrtf(sum8(ss) * (1.f / 64.f) + NEPS) * NA_QS;
#pragma unroll
            for (int i = 0; i < 8; ++i) f[i] = f[i] * inv * gq[gi + i];
            PACK8(qv, f); *(v4u*)(row + 8 * lane) = qv;
            UNPACK8(kv, f); ss = 0.f;
#pragma unroll
            for (int i = 0; i < 8; ++i) ss += f[i] * f[i];
            inv = rsqrtf(sum8(ss) * (1.f / 64.f) + NEPS);
#pragma unroll
            for (int i = 0; i < 8; ++i) f[i] = f[i] * inv * gk[gi + i];
            PACK8(kv, f); *(v4u*)(row + C_KA + 8 * lane) = kv;
        }
        {
            float a0 = bflo(cv.x), a1 = bfhi(cv.x), a2 = bflo(cv.y), a3 = bfhi(cv.y);
            float inv = rsqrtf(wave_sum(a0 * a0 + a1 * a1 + a2 * a2 + a3 * a3) * (1.f / 256.f) + NEPS);
            const f32x4 gg = *(const f32x4*)(gcq + 4 * lane); v2u o; o.x = pk2(a0 * inv * gg.x, a1 * inv * gg.y); o.y = pk2(a2 * inv * gg.z, a3 * inv * gg.w);
            *(v2u*)(mla_a + (size_t)t * 384 + 4 * lane) = o;
            a0 = bflo(kvv); a1 = bfhi(kvv);
            inv = rsqrtf(wave_sum(a0 * a0 + a1 * a1) * (1.f / 128.f) + NEPS);
            *(unsigned*)(mla_a + (size_t)t * 384 + 256 + 2 * lane) = pk2(a0 * inv * gckv[2 * lane], a1 * inv * gckv[2 * lane + 1]);
        }
#pragma unroll
        for (int it = 0; it < 4; ++it) {
            const int c0 = (it * 64 + lane) * 8;
            if (it < 3 || lane < 48) {
                float pc[8], pp[8], pn[8]; UNPACK8(rwc[it], pc); UNPACK8(rwp[it], pp); UNPACK8(rwn[it], pn);
#pragma unroll
                for (int i = 0; i < 8; ++i) pc[i] = pc[i] + mu[c0 + i] * (0.5f * (pp[i] + pn[i]) - pc[i]);
                if (it == 0) { h8 o;
#pragma unroll
                    for (int i = 0; i < 8; ++i) o[i] = (_Float16)pc[i];
                    *(h8*)(rs + (size_t)t * 512 + c0) = o; }
                else if (it == 1) { const int c = c0 - 512; h8 o; float kk[8]; float ss = 0.f;
#pragma unroll
                    for (int i = 0; i < 8; ++i) { o[i] = (_Float16)pc[i]; kk[i] = pc[i] * kkw[c + i]; ss += kk[i] * kk[i]; }
                    *(h8*)(ktmp + (size_t)t * 512 + c) = o;
                    const float inv = rsqrtf(sum8(ss) + 1e-12f);
#pragma unroll
                    for (int i = 0; i < 8; ++i) o[i] = (_Float16)(kk[i] * inv);
                    *(h8*)(rs + 2 * asz + (size_t)t * 512 + c) = o; }
                else if (it == 2) { const int c = c0 - 1024; h8 o;
#pragma unroll
                    for (int i = 0; i < 8; ++i) o[i] = (_Float16)pc[i];
                    *(h8*)(rs + asz + (size_t)t * 512 + c) = o; }
                else { const int c = c0 - 1536; float f[8];
#pragma unroll
                    for (int i = 0; i < 8; ++i) { const float x = pc[i]; f[i] = (c < 128) ? (1.f - 2.f / (1.f + __expf(2.f * x))) : ((c < 256) ? x : sigmoidf_(x)); }
                    v4u w; PACK8(w, f); *(v4u*)(rw_a + (size_t)t * 384 + c) = w; }
            }
        }
    }
}

__device__ __forceinline__ void phase_mla_post(CP pp, int l, bf16* mraw, const bf16* proj, bf16* mk, int Tg, int L, int gw, int ngw, int lane) {
    const float* gq = pp->in[13] + l * 96; const float* gk = pp->in[14] + l * 96;
    const float gqn = gq[lane], gkn = gk[lane], gqr = lane < 32 ? gq[64 + lane] : 0.f, gkr = lane < 32 ? gk[64 + lane] : 0.f;
    const int fi = lane & 7; const float invf = __expf(-(float)fi * (9.210340371976184f / 8.f));
    for (int t = gw; t < Tg; t += ngw) {
        const int tpos = t % L; const float pos = (float)(((lane & 15) < 8) ? (tpos >> 6) : (tpos & 63));
        float rev = pos * invf * 0.15915494309189535f; rev -= floorf(rev);
        const float cs = __builtin_amdgcn_cosf(rev), sn = __builtin_amdgcn_sinf(rev);
        bf16* mrow = mraw + (size_t)t * 1792; bf16* krow = mk + (size_t)t * 768;
        const float krv = lane < 32 ? bf2f(proj[(size_t)t * DPROJ + C_KR + lane]) : 0.f;
        bf16 lqn[8], lqr[8], lkn[8];
#pragma unroll
        for (int h = 0; h < 8; ++h) { lqn[h] = mrow[h * 96 + lane]; lqr[h] = mrow[h * 96 + 64 + (lane & 31)]; lkn[h] = mrow[768 + h * 128 + lane]; }
#pragma unroll
        for (int h = 0; h < 8; ++h) {
            {   float qn = bf2f(lqn[h]); float qr = lane < 32 ? bf2f(lqr[h]) : 0.f;
                const float inv = rsqrtf(wave_sum(qn * qn + qr * qr) * (1.f / 96.f) + NEPS);
                qn = qn * inv * gqn; qr = qr * inv * gqr;
                const float pr = __shfl_xor(qr, 16);
                const float ro = (lane < 16) ? (qr * cs - pr * sn) : (pr * sn + qr * cs);
                mrow[h * 96 + lane] = f2bf(qn * MLA_QS); if (lane < 32) mrow[h * 96 + 64 + lane] = f2bf(ro * MLA_QS); }
            {   float kn = bf2f(lkn[h]); float kr = krv;
                const float inv = rsqrtf(wave_sum(kn * kn + kr * kr) * (1.f / 96.f) + NEPS);
                kn = kn * inv * gkn; kr = kr * inv * gkr;
                const float pr = __shfl_xor(kr, 16);
                const float ro = (lane < 16) ? (kr * cs - pr * sn) : (pr * sn + kr * cs);
                krow[h * 96 + lane] = f2bf(kn); if (lane < 32) krow[h * 96 + 64 + lane] = f2bf(ro); }
        }
    }
}

__device__ __forceinline__ void phase_rw_post(CP pp, int l, const _Float16* rs, size_t asz, const bf16* yfb, bf16* yc, int Tg, int gw, int ngw, int lane) {
    const float* lnw = pp->in[25] + l * 512 + 8 * lane; const float* lnb = pp->in[26] + l * 512 + 8 * lane; const float* rk = pp->in[24] + l * 512 + 8 * lane;
    for (int t = gw; t < Tg; t += ngw) {
        const size_t o = (size_t)t * 512 + 8 * lane; float y[8], f[8];
        { const v4u a = *(const v4u*)(yfb + o); const v4u b = *(const v4u*)(yfb + asz + o); UNPACK8(a, y); UNPACK8(b, f); }
        float s = 0.f;
#pragma unroll
        for (int i = 0; i < 8; ++i) { y[i] += f[i]; s += y[i]; }
        const float mean = sum8(s) * (1.f / 64.f); float q = 0.f;
#pragma unroll
        for (int i = 0; i < 8; ++i) { y[i] -= mean; q += y[i] * y[i]; }
        const float rstd = rsqrtf(sum8(q) * (1.f / 64.f) + 64e-5f);
        const h8 r = *(const h8*)(rs + o), v = *(const h8*)(rs + asz + o), kd0 = *(const h8*)(rs + 7 * asz + o), kd1 = *(const h8*)(rs + 8 * asz + o);
        float b = 0.f;
#pragma unroll
        for (int i = 0; i < 8; ++i) b += (float)r[i] * ((float)kd0[i] + (float)kd1[i]) * rk[i];
        b = sum8(b);
        const v4u gv = *(const v4u*)(yc + o); UNPACK8(gv, f);
#pragma unroll
        for (int i = 0; i < 8; ++i) f[i] = (y[i] * rstd * lnw[i] + lnb[i] + b * (float)v[i]) * f[i];
        v4u w; PACK8(w, f); *(v4u*)(yc + o) = w;
    }
}

#define GAS __attribute__((address_space(1)))
typedef float f2 __attribute__((ext_vector_type(2)));
__device__ __forceinline__ float red8(float x) {
    asm("s_nop 1\n\tv_add_f32_dpp %0, %0, %0 quad_perm:[1,0,3,2] row_mask:0xf bank_mask:0xf bound_ctrl:1\n\ts_nop 1\n\t"
        "v_add_f32_dpp %0, %0, %0 quad_perm:[2,3,0,1] row_mask:0xf bank_mask:0xf bound_ctrl:1\n\ts_nop 1\n\t"
        "v_add_f32_dpp %0, %0, %0 row_half_mirror row_mask:0xf bank_mask:0xf bound_ctrl:1\n\ts_nop 1" : "+v"(x));
    return x;
}
constexpr int SCH = 32, SBUF = 6 * SCH * 256;
__device__ __forceinline__ void scan_unit(int u, int L, const _Float16* rs, size_t asz, bf16* yfb, LAS unsigned char* lds) {
    const int tid = ltid(); const int lane = tid & 63, w = tid >> 6, vr = lane >> 3, ko = lane & 7;
    const int dir = u & 1, sh = u >> 1, h = sh & 7, s = sh >> 3;
    const int kA = tid >> 8, lj = (tid >> 3) & 31, lp = tid & 7;
    const size_t tok0 = (size_t)s * L + (dir ? (L - 1 - lj) : lj);
    const long tstep = dir ? -(long)SCH * 512 : (long)SCH * 512;
    const size_t eoff = tok0 * 512 + h * 64 + lp * 8;
    const GAS _Float16* g0 = (const GAS _Float16*)(rs + (size_t)(kA ? 2 : 0) * asz + eoff);
    const GAS _Float16* g1 = (const GAS _Float16*)(rs + (size_t)(kA ? 5 + dir : 3 + dir) * asz + eoff);
    const GAS _Float16* g2 = (const GAS _Float16*)(rs + (size_t)(kA ? 1 : 7 + dir) * asz + eoff);
    const int ld0 = (((0 + kA) * SCH + lj) * 64 + lp * 8) * 4, ld1 = (((2 + kA) * SCH + lj) * 64 + lp * 8) * 4, ld2 = (((4 + kA) * SCH + lj) * 64 + lp * 8) * 4;
    GAS bf16* py = (GAS bf16*)(yfb + (size_t)dir * asz + ((size_t)s * L + (dir ? L - 1 : 0)) * 512 + h * 64 + 8 * w + vr);
    const long ystep = dir ? -512 : 512;
    const int rd = ko * 32, rdv = (5 * SCH * 64 + 8 * w + vr) * 4;
    f2 S[4];
#pragma unroll
    for (int i = 0; i < 4; ++i) S[i] = (f2){0.f, 0.f};
    h8 p0 = *(const GAS h8*)g0, p1 = *(const GAS h8*)g1, p2 = *(const GAS h8*)g2;
#define SCAN_PUT(bufo) do { f32x4 a, b; \
        a = (f32x4){(float)p0[0], (float)p0[1], (float)p0[2], (float)p0[3]}; b = (f32x4){(float)p0[4], (float)p0[5], (float)p0[6], (float)p0[7]}; *(LAS f32x4*)(lds + (bufo) + ld0) = a; *(LAS f32x4*)(lds + (bufo) + ld0 + 16) = b; \
        a = (f32x4){(float)p1[0], (float)p1[1], (float)p1[2], (float)p1[3]}; b = (f32x4){(float)p1[4], (float)p1[5], (float)p1[6], (float)p1[7]}; *(LAS f32x4*)(lds + (bufo) + ld1) = a; *(LAS f32x4*)(lds + (bufo) + ld1 + 16) = b; \
        a = (f32x4){(float)p2[0], (float)p2[1], (float)p2[2], (float)p2[3]}; b = (f32x4){(float)p2[4], (float)p2[5], (float)p2[6], (float)p2[7]}; *(LAS f32x4*)(lds + (bufo) + ld2) = a; *(LAS f32x4*)(lds + (bufo) + ld2 + 16) = b; } while (0)
    SCAN_PUT(0);
    __syncthreads();
    const int NC = L / SCH;
#pragma unroll 1
    for (int c = 0; c < NC; ++c) {
        const int cur = (c & 1) * SBUF;
        if (c + 1 < NC) { const long o = tstep * (long)(c + 1); p0 = *(const GAS h8*)(g0 + o); p1 = *(const GAS h8*)(g1 + o); p2 = *(const GAS h8*)(g2 + o); }
        LAS unsigned char* bp = lds + cur + rd;
        GAS bf16* pyc = py + ystep * (long)(c * SCH);
#pragma unroll 1
        for (int j0 = 0; j0 < SCH; j0 += 4) { float yv[4];
#pragma unroll
        for (int jj = 0; jj < 4; ++jj) { const int j = j0 + jj;
            const LAS unsigned char* q = bp + j * 256;
            const f32x4 r0 = *(const LAS f32x4*)(q), r1 = *(const LAS f32x4*)(q + 16);
            const f32x4 k0 = *(const LAS f32x4*)(q + SCH * 256), k1 = *(const LAS f32x4*)(q + SCH * 256 + 16);
            const f32x4 w0 = *(const LAS f32x4*)(q + 2 * SCH * 256), w1 = *(const LAS f32x4*)(q + 2 * SCH * 256 + 16);
            const f32x4 a0 = *(const LAS f32x4*)(q + 3 * SCH * 256), a1 = *(const LAS f32x4*)(q + 3 * SCH * 256 + 16);
            const f32x4 d0 = *(const LAS f32x4*)(q + 4 * SCH * 256), d1 = *(const LAS f32x4*)(q + 4 * SCH * 256 + 16);
            const float vv = *(const LAS float*)(lds + cur + rdv + j * 256);
            f2 pd = S[0] * k0.xy; pd = S[1] * k0.zw + pd; pd = S[2] * k1.xy + pd; pd = S[3] * k1.zw + pd;
            const float nskk = -red8(pd.x + pd.y);
            const f2 vv2 = (f2){vv, vv}, ns2 = (f2){nskk, nskk};
            f2 t;
            t = d0.xy * vv2; t = a0.xy * ns2 + t; S[0] = S[0] * w0.xy + t;
            t = d0.zw * vv2; t = a0.zw * ns2 + t; S[1] = S[1] * w0.zw + t;
            t = d1.xy * vv2; t = a1.xy * ns2 + t; S[2] = S[2] * w1.xy + t;
            t = d1.zw * vv2; t = a1.zw * ns2 + t; S[3] = S[3] * w1.zw + t;
            f2 qd = S[0] * r0.xy; qd = S[1] * r0.zw + qd; qd = S[2] * r1.xy + qd; qd = S[3] * r1.zw + qd;
            yv[jj] = red8(qd.x + qd.y);
        }
            if (ko == 0) {
#pragma unroll
                for (int jj = 0; jj < 4; ++jj) pyc[ystep * (j0 + jj)] = f2bf(yv[jj]); }
        }
        if (c + 1 < NC) SCAN_PUT(SBUF - cur);
        __syncthreads();
    }
#undef SCAN_PUT
}

constexpr int MKP = 208, MVP = 144, MBUF = 64 * MKP + 64 * MVP;
#define MLA_THR 6.0f
__device__ __forceinline__ float max3f(float a, float b, float c) { return fmaxf(fmaxf(a, b), c); }
__device__ __forceinline__ void mla_unit(int u, int L, const bf16* mraw, const bf16* mk, bf16* yb, LAS unsigned char* lds) {
    const int tid = ltid(), lane = tid & 63, w = tid >> 6, q32 = lane & 31, hi = lane >> 5;
    const int nqb = L >> 8, qb = u % nqb, sh = u / nqb, h = sh & 7, s = sh >> 3;
    const size_t base = (size_t)s * L; const int NT = L >> 6;
    const size_t qtok = base + qb * 256 + w * 32 + q32;
    bf16x8 qf[6];
#pragma unroll
    for (int ks = 0; ks < 6; ++ks) qf[ks] = *(const bf16x8*)(mraw + qtok * 1792 + h * 96 + ks * 16 + hi * 8);
    const int kkey0 = tid / 12, kch0 = tid % 12, kkey1 = (tid + 512) / 12, kch1 = (tid + 512) % 12; const bool k2 = tid < 256;
    const bf16* ks0 = mk + (base + kkey0) * 768 + h * 96 + kch0 * 8; const bf16* ks1 = mk + (base + kkey1) * 768 + h * 96 + kch1 * 8;
    const int vkey = tid >> 3, vch = tid & 7;
    const bf16* vs = mraw + (base + vkey) * 1792 + 768 + h * 128 + 64 + vch * 8;
    const int kd0 = kkey0 * MKP + kch0 * 16, kd1 = kkey1 * MKP + kch1 * 16, vd = 64 * MKP + vkey * MVP + vch * 16;
    v4u rk0, rk1 = {0u, 0u, 0u, 0u}, rv;
#define MLA_LOAD(t) do { const size_t adv_ = (size_t)(t) * 64; rk0 = *(const v4u*)(ks0 + adv_ * 768); if (k2) rk1 = *(const v4u*)(ks1 + adv_ * 768); rv = *(const v4u*)(vs + adv_ * 1792); } while (0)
#define MLA_PUT(bo) do { *(LAS v4u*)(lds + (bo) + kd0) = rk0; if (k2) *(LAS v4u*)(lds + (bo) + kd1) = rk1; *(LAS v4u*)(lds + (bo) + vd) = rv; } while (0)
    MLA_LOAD(0); MLA_PUT(0); MLA_LOAD(1); MLA_PUT(MBUF);
    __syncthreads();
    const int kmap = 16 * (q32 >> 4) + 8 * ((q32 >> 2) & 1) + (q32 & 3) + 4 * ((q32 >> 3) & 1);
    const int koff = kmap * MKP + hi * 16;
    const int voff = 64 * MKP + (8 * hi + ((lane & 15) >> 2)) * MVP + (16 * ((lane >> 4) & 1) + 4 * (lane & 3)) * 2;
    f32x16 o0 = {}, o1 = {}, negm = {}, pA0, pA1, pB0, pB1; float lsum = 0.f; v4u pw0, pw1, pw2, pw3;
    int b_prev = 0, b_cur = MBUF, b_next = 2 * MBUF;
#define MLA_KA(bo, ks) (*(const LAS bf16x8*)(lds + (bo) + koff + (ks) * 32))
#define MLA_KB(bo, ks) (*(const LAS bf16x8*)(lds + (bo) + koff + 32 * MKP + (ks) * 32))
#define MLA_QK2(C0, C1, bo, ks) do { C0 = __builtin_amdgcn_mfma_f32_32x32x16_bf16(MLA_KA(bo, ks), qf[ks], C0, 0, 0, 0); C1 = __builtin_amdgcn_mfma_f32_32x32x16_bf16(MLA_KB(bo, ks), qf[ks], C1, 0, 0, 0); } while (0)
#define MLA_FIN8(P, g, PW) do { float e0 = __builtin_amdgcn_exp2f(P[8 * g + 0]), e1 = __builtin_amdgcn_exp2f(P[8 * g + 1]), e2 = __builtin_amdgcn_exp2f(P[8 * g + 2]), e3 = __builtin_amdgcn_exp2f(P[8 * g + 3]), \
        e4 = __builtin_amdgcn_exp2f(P[8 * g + 4]), e5 = __builtin_amdgcn_exp2f(P[8 * g + 5]), e6 = __builtin_amdgcn_exp2f(P[8 * g + 6]), e7 = __builtin_amdgcn_exp2f(P[8 * g + 7]); \
        lsum += ((e0 + e1) + (e2 + e3)) + ((e4 + e5) + (e6 + e7)); PW.x = pk2(e0, e1); PW.y = pk2(e2, e3); PW.z = pk2(e4, e5); PW.w = pk2(e6, e7); } while (0)
#define MLA_VT(bo, kg, db) ({ const int vb_ = (bo) + voff + (kg) * 16 * MVP + (db) * 64; \
        const s16x4 t0_ = __builtin_amdgcn_ds_read_tr16_b64_v4i16((LAS s16x4*)(lds + vb_)), t1_ = __builtin_amdgcn_ds_read_tr16_b64_v4i16((LAS s16x4*)(lds + vb_ + 4 * MVP)); \
        (bf16x8){t0_[0], t0_[1], t0_[2], t0_[3], t1_[0], t1_[1], t1_[2], t1_[3]}; })
#define MLA_PV(bo, kg, PW) do { const bf16x8 pf_ = __builtin_bit_cast(bf16x8, PW); o0 = __builtin_amdgcn_mfma_f32_32x32x16_bf16(MLA_VT(bo, kg, 0), pf_, o0, 0, 0, 0); o1 = __builtin_amdgcn_mfma_f32_32x32x16_bf16(MLA_VT(bo, kg, 1), pf_, o1, 0, 0, 0); } while (0)
#define MLA_ROWMAX(C0, C1) ({ float a_ = max3f(C0[0], C0[1], C1[0]), b_ = max3f(C0[2], C0[3], C1[1]); a_ = max3f(a_, C1[2], C1[3]); \
        _Pragma("unroll") for (int r_ = 4; r_ < 16; r_ += 4) { a_ = max3f(a_, C0[r_], C0[r_ + 1]); b_ = max3f(b_, C0[r_ + 2], C0[r_ + 3]); a_ = max3f(a_, C1[r_], C1[r_ + 1]); b_ = max3f(b_, C1[r_ + 2], C1[r_ + 3]); } \
        const float m_ = fmaxf(a_, b_); fmaxf(m_, __shfl_xor(m_, 32)); })
#define MLA_STEP(P0, P1, C0, C1, j, HASNEXT) do { \
        if (HASNEXT) MLA_LOAD((j) + 1); \
        C0 = negm; C1 = negm; \
        MLA_QK2(C0, C1, b_cur, 0); MLA_QK2(C0, C1, b_cur, 1); MLA_FIN8(P0, 0, pw0); \
        MLA_QK2(C0, C1, b_cur, 2); MLA_FIN8(P0, 1, pw1); \
        MLA_QK2(C0, C1, b_cur, 3); MLA_FIN8(P1, 0, pw2); \
        MLA_QK2(C0, C1, b_cur, 4); MLA_FIN8(P1, 1, pw3); \
        MLA_QK2(C0, C1, b_cur, 5); \
        MLA_PV(b_prev, 0, pw0); MLA_PV(b_prev, 1, pw1); \
        const float mt_ = MLA_ROWMAX(C0, C1); \
        MLA_PV(b_prev, 2, pw2); MLA_PV(b_prev, 3, pw3); \
        if (__any(mt_ > MLA_THR)) { const float dl_ = fmaxf(mt_, 0.f); const float fs_ = __builtin_amdgcn_exp2f(-dl_); lsum *= fs_; \
            _Pragma("unroll") for (int r_ = 0; r_ < 16; ++r_) { C0[r_] -= dl_; C1[r_] -= dl_; negm[r_] -= dl_; o0[r_] *= fs_; o1[r_] *= fs_; } } \
        if (HASNEXT) MLA_PUT(b_next); \
        __syncthreads(); \
        { const int t_ = b_prev; b_prev = b_cur; b_cur = b_next; b_next = t_; } \
    } while (0)
    pA0 = negm; pA1 = negm;
#pragma unroll
    for (int ks = 0; ks < 6; ++ks) MLA_QK2(pA0, pA1, 0, ks);
    { const float m0 = MLA_ROWMAX(pA0, pA1);
#pragma unroll
      for (int r = 0; r < 16; ++r) { pA0[r] -= m0; pA1[r] -= m0; negm[r] = -m0; } }
    int jt = 1;
#pragma unroll 1
    for (; jt + 1 < NT; jt += 2) {
        MLA_STEP(pA0, pA1, pB0, pB1, jt, true);
        MLA_STEP(pB0, pB1, pA0, pA1, jt + 1, ((jt + 2) < NT));
    }
    if (jt < NT) { MLA_STEP(pA0, pA1, pB0, pB1, jt, false); pA0 = pB0; pA1 = pB1; }
    MLA_FIN8(pA0, 0, pw0); MLA_FIN8(pA0, 1, pw1); MLA_FIN8(pA1, 0, pw2); MLA_FIN8(pA1, 1, pw3);
    MLA_PV(b_prev, 0, pw0); MLA_PV(b_prev, 1, pw1); MLA_PV(b_prev, 2, pw2); MLA_PV(b_prev, 3, pw3);
    lsum += __shfl_xor(lsum, 32);
    const float inv = 1.f / lsum;
    bf16* orow = yb + qtok * 512 + h * 64 + 4 * hi;
#pragma unroll
    for (int rq = 0; rq < 4; ++rq) {
        v2u a, b; a.x = pk2(o0[4 * rq] * inv, o0[4 * rq + 1] * inv); a.y = pk2(o0[4 * rq + 2] * inv, o0[4 * rq + 3] * inv);
        b.x = pk2(o1[4 * rq] * inv, o1[4 * rq + 1] * inv); b.y = pk2(o1[4 * rq + 2] * inv, o1[4 * rq + 3] * inv);
        *(v2u*)(orow + 8 * rq) = a; *(v2u*)(orow + 32 + 8 * rq) = b;
    }
    __syncthreads();
#undef MLA_LOAD
#undef MLA_PUT
#undef MLA_KA
#undef MLA_KB
#undef MLA_QK2
#undef MLA_FIN8
#undef MLA_VT
#undef MLA_PV
#undef MLA_ROWMAX
#undef MLA_STEP
}

constexpr int NVP = 144;
__device__ __forceinline__ void na_unit(int u, int L, int l, const float* rpb_all, const bf16* proj, bf16* ya, LAS unsigned char* lds) {
    const int tid = ltid(); const int lane = tid & 63, w = tid >> 6, i16 = lane & 15, quad = lane >> 4;
    const int rows = L >> 6; const int hq = u & 3, sr = u >> 2, r = sr % rows, s = sr / rows;
    const int h = 2 * hq + (w >> 2), j = w & 3;
    const int rs = min(max(r - 4, 0), rows - 8), kc0 = min(max(16 * j - 8, 0), 32);
    const size_t base = (size_t)s * L;
    const size_t qtok = base + r * 64 + 16 * j + i16;
    bf16x8 qf[2];
    qf[0] = *(const bf16x8*)(proj + qtok * DPROJ + h * 64 + quad * 8); qf[1] = *(const bf16x8*)(proj + qtok * DPROJ + h * 64 + 32 + quad * 8);
    const int cA = (i16 >> 2) * 8 + (i16 & 3);
    f32x4 sa[8], sb[8];
#pragma unroll
    for (int wr = 0; wr < 8; ++wr) {
        const bf16* kp = proj + (base + (size_t)(rs + wr) * 64 + kc0 + cA) * DPROJ + C_KA + h * 64 + quad * 8;
        const bf16x8 ka0 = *(const bf16x8*)kp, ka1 = *(const bf16x8*)(kp + 32), kb0 = *(const bf16x8*)(kp + 4 * DPROJ), kb1 = *(const bf16x8*)(kp + 4 * DPROJ + 32);
        f32x4 a = {0.f, 0.f, 0.f, 0.f}, b = {0.f, 0.f, 0.f, 0.f};
        a = __builtin_amdgcn_mfma_f32_16x16x32_bf16(ka0, qf[0], a, 0, 0, 0); a = __builtin_amdgcn_mfma_f32_16x16x32_bf16(ka1, qf[1], a, 0, 0, 0);
        b = __builtin_amdgcn_mfma_f32_16x16x32_bf16(kb0, qf[0], b, 0, 0, 0); b = __builtin_amdgcn_mfma_f32_16x16x32_bf16(kb1, qf[1], b, 0, 0, 0);
        sa[wr] = a; sb[wr] = b;
    }
    const int qc = 16 * j + i16, wst = min(max(qc - 8, 0), 48);
    const float* rpb = rpb_all + (size_t)(l * 8 + h) * 15 * 31;
    float mx = -1e30f;
#pragma unroll
    for (int wr = 0; wr < 8; ++wr) { const float* rb = rpb + (rs + wr - r + 7) * 31;
#pragma unroll
        for (int jj = 0; jj < 4; ++jj) {
            { const int kc = kc0 + quad * 8 + jj; const bool ok = (kc >= wst) && (kc < wst + 16); const int dc = min(max(kc - qc + 15, 0), 30);
              const float v = ok ? (sa[wr][jj] + rb[dc] * LOG2E) : -1e30f; sa[wr][jj] = v; mx = fmaxf(mx, v); }
            { const int kc = kc0 + quad * 8 + 4 + jj; const bool ok = (kc >= wst) && (kc < wst + 16); const int dc = min(max(kc - qc + 15, 0), 30);
              const float v = ok ? (sb[wr][jj] + rb[dc] * LOG2E) : -1e30f; sb[wr][jj] = v; mx = fmaxf(mx, v); }
        } }
    mx = fmaxf(mx, __shfl_xor(mx, 16)); mx = fmaxf(mx, __shfl_xor(mx, 32));
    float ls = 0.f;
#pragma unroll
    for (int wr = 0; wr < 8; ++wr)
#pragma unroll
        for (int jj = 0; jj < 4; ++jj) { sa[wr][jj] = __builtin_amdgcn_exp2f(sa[wr][jj] - mx); sb[wr][jj] = __builtin_amdgcn_exp2f(sb[wr][jj] - mx); ls += sa[wr][jj] + sb[wr][jj]; }
    ls += __shfl_xor(ls, 16); ls += __shfl_xor(ls, 32);
    LAS unsigned char* vw = lds + w * (64 * NVP);
    f32x4 oc[4];
#pragma unroll
    for (int db = 0; db < 4; ++db) oc[db] = (f32x4){0.f, 0.f, 0.f, 0.f};
    const int toff = (quad * 8 + (i16 >> 2)) * NVP + (4 * (lane & 3)) * 2;
#pragma unroll
    for (int ck = 0; ck < 4; ++ck) {
        v4u tmp[8];
#pragma unroll
        for (int it = 0; it < 8; ++it) { const int idx = it * 64 + lane, key = idx >> 3, ch = idx & 7;
            tmp[it] = *(const v4u*)(proj + (base + (size_t)(rs + 2 * ck + (key >> 5)) * 64 + kc0 + (key & 31)) * DPROJ + C_VA + h * 64 + ch * 8); }
        asm volatile("s_waitcnt lgkmcnt(0)" ::: "memory");
#pragma unroll
        for (int it = 0; it < 8; ++it) { const int idx = it * 64 + lane, key = idx >> 3, ch = idx & 7; *(LAS v4u*)(vw + key * NVP + ch * 16) = tmp[it]; }
        asm volatile("s_waitcnt lgkmcnt(0)" ::: "memory");
#pragma unroll
        for (int wl = 0; wl < 2; ++wl) { const int wr = 2 * ck + wl;
            v4u pw; pw.x = pk2(sa[wr][0], sa[wr][1]); pw.y = pk2(sa[wr][2], sa[wr][3]); pw.z = pk2(sb[wr][0], sb[wr][1]); pw.w = pk2(sb[wr][2], sb[wr][3]);
            const bf16x8 pf = __builtin_bit_cast(bf16x8, pw);
#pragma unroll
            for (int db = 0; db < 4; ++db) { const int vb = toff + wl * 32 * NVP + db * 32;
                const s16x4 t0 = __builtin_amdgcn_ds_read_tr16_b64_v4i16((LAS s16x4*)(vw + vb)), t1 = __builtin_amdgcn_ds_read_tr16_b64_v4i16((LAS s16x4*)(vw + vb + 4 * NVP));
                const bf16x8 vf = {t0[0], t0[1], t0[2], t0[3], t1[0], t1[1], t1[2], t1[3]};
                oc[db] = __builtin_amdgcn_mfma_f32_16x16x32_bf16(vf, pf, oc[db], 0, 0, 0); }
        }
    }
    const float inv = 1.f / ls;
    bf16* orow = ya + qtok * 512 + h * 64 + quad * 4;
#pragma unroll
    for (int db = 0; db < 4; ++db) { v2u o; o.x = pk2(oc[db][0] * inv, oc[db][1] * inv); o.y = pk2(oc[db][2] * inv, oc[db][3] * inv); *(v2u*)(orow + db * 16) = o; }
}

#define XB_TMO      128
#define XB_XCNT(j)  (256  + 64 * (j))
#define XB_XSUB(j)  (1280 + 64 * (j))
#define XB_XGEN(j)  (2304 + 64 * (j))
#define XB_TOP      3328
#define XB_TOPGEN   3392
#define XCD_BAR_WORDS 3456
#define XB_SPIN_CAP (1u << 18)

__device__ __forceinline__ unsigned xb_ld(unsigned* p)              { return __hip_atomic_load(p, __ATOMIC_RELAXED, __HIP_MEMORY_SCOPE_AGENT); }
__device__ __forceinline__ unsigned xb_add(unsigned* p, unsigned v) { return __hip_atomic_fetch_add(p, v, __ATOMIC_RELAXED, __HIP_MEMORY_SCOPE_AGENT); }
__device__ __forceinline__ unsigned xb_xcc_id() { return (unsigned)__builtin_amdgcn_s_getreg((3 << 11) | 20) & 0xFu; }
#define XB_SPIN(cond, bar) do { unsigned _sp = 0; while (cond) { __builtin_amdgcn_s_sleep(1); \
    if ((++_sp & 255u) == 0u) { if (xb_ld(&(bar)[XB_TMO])) break; if (_sp > XB_SPIN_CAP) { atomicAdd(&(bar)[XB_TMO], 1u); break; } } } } while (0)

struct XcdBarrier {
    unsigned* bar; unsigned x;
    volatile LAS unsigned* st;
};

__device__ __forceinline__ XcdBarrier xcd_barrier_post(unsigned* bar, volatile LAS unsigned* st) {
    XcdBarrier b; b.bar = bar; b.x = xb_xcc_id(); b.st = st;
    if (threadIdx.x == 0) (void)xb_add(&bar[XB_XCNT(b.x)], 1u);
    return b;
}
__device__ __forceinline__ void xcd_barrier_complete(unsigned* bar, unsigned x, unsigned& nloc, unsigned& nx) {
    const unsigned G = gridDim.x * gridDim.y * gridDim.z;
    unsigned sum, cnt, mine, sp = 0u;
    for (;;) {
        sum = 0u; cnt = 0u; mine = 0u;
#pragma unroll
        for (unsigned j = 0; j < 16; ++j) { const unsigned c = xb_ld(&bar[XB_XCNT(j)]); sum += c; cnt += (c > 0u) ? 1u : 0u; mine = (j == x) ? c : mine; }
        if (sum == G) break;
        __builtin_amdgcn_s_sleep(1);
        if ((++sp & 255u) == 0u) { if (xb_ld(&bar[XB_TMO])) break; if (sp > XB_SPIN_CAP) { atomicAdd(&bar[XB_TMO], 1u); break; } }
    }
    nloc = mine > 0u ? mine : 1u; nx = cnt > 0u ? cnt : 1u;
}

__device__ __forceinline__ void xcd_barrier(const XcdBarrier& b) {
    asm volatile("s_waitcnt vmcnt(0)" ::: "memory");
    __syncthreads();
    if (threadIdx.x == 0) {
        unsigned* bar = b.bar;
        __builtin_amdgcn_s_waitcnt(0);
        unsigned nloc = b.st[0], nx = b.st[1];
        if (nloc == 0u) { xcd_barrier_complete(bar, b.x, nloc, nx); b.st[0] = nloc; b.st[1] = nx; }
        const unsigned old = xb_add(&bar[XB_XSUB(b.x)], 1u);
        const unsigned gen = old / nloc;
        if (old + 1u == (gen + 1u) * nloc) {
            __builtin_amdgcn_fence(__ATOMIC_RELEASE, "agent");
            asm volatile("s_waitcnt vmcnt(0)" ::: "memory");
            const unsigned og = xb_add(&bar[XB_TOP], 1u);
            const unsigned tg = og / nx;
            if (og + 1u == (tg + 1u) * nx) xb_add(&bar[XB_TOPGEN], 1u);
            else XB_SPIN(xb_ld(&bar[XB_TOPGEN]) == tg, bar);
            __builtin_amdgcn_fence(__ATOMIC_ACQUIRE, "agent");
            xb_add(&bar[XB_XGEN(b.x)], 1u);
            asm volatile("s_waitcnt vmcnt(0)" ::: "memory");
        } else {
            XB_SPIN(xb_ld(&bar[XB_XGEN(b.x)]) == gen, bar);
            __builtin_amdgcn_fence(__ATOMIC_ACQUIRE, "agent");
            asm volatile("s_waitcnt vmcnt(0)" ::: "memory");
        }
    }
    __syncthreads();
}

constexpr int NPH = 13;
__device__ __forceinline__ void run_phase(CP pp, int st, LAS unsigned char* lds) {
    volatile LAS unsigned* lctl = (volatile LAS unsigned*)(lds + LDS_RING);
    const int tid = ltid(), lane = tid & 63, wave = __builtin_amdgcn_readfirstlane(tid >> 6);
    int bid_ = blockIdx.x; asm volatile("" : "+s"(bid_));
    const int NB = gridDim.x, gw = bid_ * 8 + wave, ngw = NB * 8;
    const int ph = st % NPH, gl = st / NPH, l = gl & 1, g = gl >> 1;
    unsigned char* ws = pp->ws; const int Tg = pp->Tg;
    const Reg R{ws, (size_t)Tg};
    const size_t asz = (size_t)Tg * 512;
    const int t0 = g * Tg; const int L = (t0 < NPROMPT) ? 8192 : 4096;
    float* xout = pp->out + (size_t)t0 * DM;
    int gid0 = 0, gidn = 0;
    switch (ph) {
    case 0: {
        const float* xin = (l == 0) ? ((t0 < NPROMPT) ? pp->in[0] + (size_t)t0 * DM : pp->in[1] + (size_t)(t0 - NPROMPT) * DM) : xout;
        phase_norm(xin, pp->in[2] + l * DM, R.RH(), Tg, gw, ngw, lane);
    } break;
    case 1: gid0 = GM_IN; gidn = 1; break;
    case 2: {
        phase_post_proj(pp, l, R.RP(), R.RA(), R.RA() + (size_t)Tg * 384, R.RS(), (_Float16*)R.RZ(), asz, Tg, L, gw, ngw, lane);
    } break;
    case 3: gid0 = GM_MU; gidn = 2; break;
    case 4: {
        phase_mla_post(pp, l, R.RM(), R.RP(), R.RA(), Tg, L, gw, ngw, lane);
    } break;
    case 5: {
        unsigned* qctr = (unsigned*)(ws + WS_CTL) + 64 * gl; const int nseq = Tg / L;
        const int NS = nseq * 16, NM = nseq * 8 * (L >> 8), NN = nseq * (L >> 6) * 4, NTOT = NS + NM + NN;
        for (;;) {
            __syncthreads();
            if (tid == 0) lctl[0] = atomicAdd(qctr, 1u);
            __syncthreads();
            const int u = __builtin_amdgcn_readfirstlane((int)lctl[0]);
            if (u >= NTOT) break;
            if (u < NS) scan_unit(u, L, R.RS(), asz, R.RZ(), lds);
            else if (u < NS + NM) mla_unit(u - NS, L, R.RM(), R.RA(), R.RY() + asz, lds);
            else na_unit(u - NS - NM, L, l, pp->in[7], R.RP(), R.RY(), lds);
        }
    } break;
    case 6: {
        phase_rw_post(pp, l, R.RS(), asz, R.RZ(), R.RY() + 2 * asz, Tg, gw, ngw, lane);
    } break;
    case 7: gid0 = GM_GATE; gidn = 1; break;
    case 8: gid0 = GM_BR0; gidn = 3; break;
    case 9: gid0 = GM_OUT; gidn = 1; break;
    case 10: {
        phase_norm(xout, pp->in[29] + l * DM, R.RH(), Tg, gw, ngw, lane);
    } break;
    case 11: gid0 = GM_GU; gidn = 1; break;
    case 12: gid0 = GM_DN; gidn = 1; break;
    default: break;
    }
#pragma unroll 1
    for (int id = gid0; id < gid0 + gidn; ++id) {
        const unsigned char* wb = ws + W_OFF + (size_t)l * W_STRIDE;
        const bf16* A; const bf16* Bt; int N, K;
        switch (id) {
        case GM_IN:   A = R.RH(); Bt = (const bf16*)(wb + WO_IN); N = DPROJ; K = 1024; break;
        case GM_MU:   A = R.RA(); Bt = (const bf16*)(wb + WO_MU); N = 1792; K = 384; break;
        case GM_RU:   A = R.RA() + (size_t)Tg * 384; Bt = (const bf16*)(wb + WO_RU); N = 2560; K = 384; break;
        case GM_GATE: A = R.RH(); Bt = (const bf16*)(wb + WO_G); N = DGATE; K = 1024; break;
        case GM_BR0: case GM_BR1: case GM_BR2: A = R.RY() + (size_t)(id - GM_BR0) * asz; Bt = (const bf16*)(wb + WO_BR + (size_t)(id - GM_BR0) * MiB); N = DM; K = 512; break;
        case GM_OUT:  A = R.RM(); Bt = (const bf16*)(wb + WO_OUT); N = DM; K = 1024; break;
        case GM_GU:   A = R.RH(); Bt = (const bf16*)(wb + WO_GU); N = 2 * DFF; K = 1024; break;
        default:      A = R.RP(); Bt = (const bf16*)(wb + WO_DN); N = DM; K = DFF; break;
        }
        pg8::Gemm gm{A, Bt, Tg, N, K}; pg8::StaticOrder S; S.init(Tg, N, NB, bid_);
        EpiUni E{pp, id, l, g}; pg8::gemm_phase<EpiUni, pg8::StaticOrder, true, true>(lds, gm, S, E);
    }
}

__device__ __forceinline__ void run_phase0(CP pp, int part, LAS unsigned char* lds) {
    const int tid = ltid(), lane = tid & 63, wave = __builtin_amdgcn_readfirstlane(tid >> 6);
    const int NB = gridDim.x, gw = blockIdx.x * 8 + wave, ngw = NB * 8;
    const size_t gtid = (size_t)blockIdx.x * 512 + tid, ngt = (size_t)NB * 512;
    unsigned char* ws = pp->ws;
    if (part == 0) {
        for (int l = 0; l < 2; ++l) { unsigned char* wb = ws + W_OFF + (size_t)l * W_STRIDE;
            zero_bytes(wb + WO_IN + (size_t)NMAIN * 2048, (size_t)(DPROJ - NMAIN) * 2048, gtid, ngt);
            zero_bytes(wb + WO_MU, (size_t)1792 * 384 * 2, gtid, ngt);
            zero_bytes(wb + WO_RU, (size_t)2560 * 384 * 2, gtid, ngt); }
    } else {
        LAS float* scr = (LAS float*)(lds + wave * 16384);
#pragma unroll 1
        for (int l = 0; l < 2; ++l) { unsigned char* wb = ws + W_OFF + (size_t)l * W_STRIDE;
            const float* w_in = pp->in[3] + (size_t)l * DM * DIN;
            transpose_job(w_in, DIN, 1024, NMAIN, (bf16*)(wb + WO_IN), 1024, 0, 0, 0, scr, gw, ngw, lane);
            transpose_job(w_in + NMAIN, DIN, 1024, DGATE, (bf16*)(wb + WO_G), 1024, 0, 0, 0, scr, gw, ngw, lane);
            transpose_job(pp->in[8] + (size_t)l * 512 * 1024, 1024, 512, 1024, (bf16*)(wb + WO_BR), 512, 0, 0, 0, scr, gw, ngw, lane);
            transpose_job(pp->in[15] + (size_t)l * 512 * 1024, 1024, 512, 1024, (bf16*)(wb + WO_BR + 1 * MiB), 512, 0, 0, 0, scr, gw, ngw, lane);
            transpose_job(pp->in[27] + (size_t)l * 512 * 1024, 1024, 512, 1024, (bf16*)(wb + WO_BR + 2 * MiB), 512, 0, 0, 0, scr, gw, ngw, lane);
            transpose_job(pp->in[28] + (size_t)l * 1024 * 1024, 1024, 1024, 1024, (bf16*)(wb + WO_OUT), 1024, 0, 0, 0, scr, gw, ngw, lane);
            transpose_job(pp->in[30] + (size_t)l * 1024 * DFF, DFF, 1024, DFF, (bf16*)(wb + WO_GU), 1024, 0, 0, 1, scr, gw, ngw, lane);
            transpose_job(pp->in[31] + (size_t)l * 1024 * DFF, DFF, 1024, DFF, (bf16*)(wb + WO_GU), 1024, 0, 128, 1, scr, gw, ngw, lane);
            transpose_job(pp->in[32] + (size_t)l * DFF * 1024, 1024, DFF, 1024, (bf16*)(wb + WO_DN), DFF, 0, 0, 0, scr, gw, ngw, lane);
            transpose_job(pp->in[11] + (size_t)l * 256 * 768, 768, 256, 768, (bf16*)(wb + WO_MU), 384, 0, 0, 0, scr, gw, ngw, lane);
            transpose_job(pp->in[12] + (size_t)l * 128 * 1024, 1024, 128, 1024, (bf16*)(wb + WO_MU), 384, 256, 768, 0, scr, gw, ngw, lane);
#pragma unroll 1
            for (int d = 0; d < 2; ++d) {
                transpose_job(pp->in[18] + (size_t)(l * 2 + d) * 64 * 512, 512, 64, 512, (bf16*)(wb + WO_RU), 384, 64 * d, 512 * d, 0, scr, gw, ngw, lane);
                transpose_job(pp->in[20] + (size_t)(l * 2 + d) * 64 * 512, 512, 64, 512, (bf16*)(wb + WO_RU), 384, 128 + 64 * d, 1024 + 512 * d, 0, scr, gw, ngw, lane); }
            transpose_job(pp->in[21] + (size_t)l * 128 * 512, 512, 128, 512, (bf16*)(wb + WO_RU), 384, 256, 2048, 0, scr, gw, ngw, lane);
        }
    }
}

__global__ void __launch_bounds__(512, 2) mega(Params p) {
    extern __shared__ __attribute__((aligned(16))) unsigned char lds_raw[];
    LAS unsigned char* lds = (LAS unsigned char*)lds_raw;
    cg::grid_group grid = cg::this_grid();
    if (blockIdx.x == 0 && threadIdx.x == 0) { Params* d = (Params*)(p.ws + WS_PARAMS); *d = p; }
    const int nsteps = p.G * 2 * NPH;
    volatile LAS unsigned* bst = (volatile LAS unsigned*)(lds + LDS_RING + 32);
    if (threadIdx.x == 0) { bst[0] = 0u; bst[1] = 0u; }
    __syncthreads();
    const XcdBarrier bar = xcd_barrier_post((unsigned*)(p.ws + WS_CTL) + 4096, bst);
    grid.sync();
#pragma unroll 1
    for (int st = -2; st < nsteps; ++st) {
        int s2 = st; asm volatile("" : "+s"(s2));
        CP pp = (CP)(p.ws + WS_PARAMS); asm volatile("" : "+s"(pp));
        if (s2 < 0) run_phase0(pp, s2 + 2, lds); else run_phase(pp, s2, lds);
        xcd_barrier(bar);
    }
}

extern "C" void kernel_launch(void* const* d_in, const int* in_sizes, int n_in, void* d_out, int out_size, void* d_ws, size_t ws_size, hipStream_t stream) {
    static int grid = 0;
    if (grid == 0) {
        int dev = 0, cus = 0, per_cu = 0;
        hipGetDevice(&dev); hipDeviceGetAttribute(&cus, hipDeviceAttributeMultiprocessorCount, dev);
        hipFuncSetAttribute((const void*)mega, hipFuncAttributeMaxDynamicSharedMemorySize, LDS_BYTES);
        hipOccupancyMaxActiveBlocksPerMultiprocessor(&per_cu, (const void*)mega, 512, LDS_BYTES);
        (void)hipGetLastError();
        if (per_cu < 1) per_cu = 1;
        grid = cus * per_cu;
    }
    int G = 2;
    while (G < 16 && ACT_OFF + (size_t)(NTOK / G) * TOKB > ws_size) G *= 2;
    if (hipMemsetAsync((char*)d_ws + WS_CTL, 0, CTL_BYTES, stream) != hipSuccess) { fprintf(stderr, "kernel_launch: memset failed\n"); return; }
    Params p{};
    for (int i = 0; i < 33; ++i) p.in[i] = (const float*)d_in[i];
    p.out = (float*)d_out; p.ws = (unsigned char*)d_ws; p.G = G; p.Tg = NTOK / G;
    void* args[] = {&p};
    hipError_t e = hipLaunchCooperativeKernel((const void*)mega, dim3(grid), dim3(512), args, LDS_BYTES, stream);
    if (e != hipSuccess) fprintf(stderr, "cooperative launch failed: %s (grid %d)\n", hipGetErrorString(e), grid);
}
```

```cpp
#include <hip/hip_runtime.h>
#include <hip/hip_cooperative_groups.h>
#include <cstdio>
#include <cstdint>
namespace cg = cooperative_groups;
namespace pg8 {
#define PG8_LAS __attribute__((address_space(3)))
typedef unsigned short bf16_t;
typedef short bf16x8 __attribute__((ext_vector_type(8)));
typedef float f32x4 __attribute__((ext_vector_type(4)));
typedef unsigned u32x4 __attribute__((ext_vector_type(4)));
constexpr int BM = 256, BK = 64, HALF = 128, HTB = HALF * BK * 2  , STAGE_BYTES = 8 * HTB, NXCD = 8, WGM = 8;

__host__ __device__ __forceinline__ int lds_byte(int r, int c) { const int st = (r >> 4) * 2 + (c >> 5), rr = r & 15, cc = c & 31, ob = rr * 64 + cc * 2; return st * 1024 + (ob ^ (((ob >> 9) & 1) << 5)); }
__host__ __device__ __forceinline__ void stage_rc(int b, int& R, int& C) { const int st = b / 1024, sb = b % 1024, swz = sb ^ (((sb >> 9) & 1) << 5); R = (st >> 1) * 16 + swz / 64; C = (st & 1) * 32 + (swz % 64) / 2; }
__host__ __device__ __forceinline__ int perm32(int rho) { const int n = rho >> 4, i = rho & 15; return 8 * (i >> 2) + 4 * n + (i & 3); }

struct Unit { int pm, pn; };
struct Gemm { const bf16_t* A; const bf16_t* Bt; int M, N, K; int kmode; };
__device__ __forceinline__ void krange(int kmode, int pn, int K, int& kof, int& nt) {
    kof = 0; nt = K / BK;
    if (kmode == 1) { if (pn < 3) { nt = 4; } else { kof = 256; nt = 2; } }
    else if (kmode == 2) { kof = (pn < 4) ? 0 : ((pn < 8) ? 128 : 256); nt = 2; }
}

struct StaticOrder {
    int nM, nN, nwg, G, c;
    __host__ __device__ void init(int M, int N, int G_, int c_) { nM = M / BM; nN = N / BM; nwg = nM * nN; G = G_; c = c_; }
    __host__ __device__ bool next(int i, Unit& u) const {
        const long L = (long)i * G + c; if (L >= nwg) return false;
        int wgid = (int)L; { const int q = nwg / NXCD, r = nwg % NXCD, xcd = wgid % NXCD, off = wgid / NXCD; wgid = (xcd < r ? xcd * (q + 1) : r * (q + 1) + (xcd - r) * q) + off; }
        const int nig = WGM * nN, gid = wgid / nig, fm = gid * WGM, gsz = (nM - fm) < WGM ? (nM - fm) : WGM;
        u.pm = fm + ((wgid % nig) % gsz); u.pn = (wgid % nig) / gsz; return true;
    }
    __device__ __forceinline__ void a_ready(const Unit&) const {}
    __device__ __forceinline__ void done(const Unit&) const {}
};

__device__ __forceinline__ unsigned cvt_pk_bf16(float lo, float hi) { unsigned r; asm volatile("v_cvt_pk_bf16_f32 %0, %1, %2" : "=v"(r) : "v"(lo), "v"(hi)); return r; }
typedef float f32x2 __attribute__((ext_vector_type(2)));
}
namespace pg8 {
template <class Epi, class Sched, bool ALIGN_EPI = false, bool SP2 = false>
__device__ __forceinline__ void gemm_phase(PG8_LAS unsigned char* lds, const Gemm g, const Sched& S, const Epi& E) {
    int tid_l = threadIdx.x; asm volatile("" : "+v"(tid_l)); const int tid = tid_l, wid = __builtin_amdgcn_readfirstlane(tid >> 6), lane = tid & 63, wr = wid >> 2, wc = wid & 3, fr = lane & 15, fq = lane >> 4;
    const int K = g.K; int nt = K / BK;
    unsigned voffA[2], voffB[2];
#pragma unroll
    for (int i = 0; i < 2; ++i) { int R, C; stage_rc(tid * 16 + i * 8192, R, C); const int Rb = Epi::PERM ? ((R & ~31) + perm32(R & 31)) : R;
        voffA[i] = (unsigned)(R * K + C) * 2u; voffB[i] = (unsigned)(Rb * K + C) * 2u; }
    const size_t kstep = (size_t)(BK * 2);
    const size_t hstep = (size_t)HALF * K * 2;
    const size_t tstep = 2 * hstep;
    const unsigned ldsw = (unsigned)wid * 1024u;
    const int aoff = lds_byte(wr * 64 + fr, fq * 8), boff = lds_byte(wc * 32 + fr, fq * 8);
#define PG8_SA(b, h) (((b) * 2 + (h)) * HTB)
#define PG8_SB(b, h) ((4 + (b) * 2 + (h)) * HTB)
#define PG8_STAGE(bufoff, gbase, voff) do { _Pragma("unroll") for (int _i = 0; _i < 2; ++_i) \
        __builtin_amdgcn_global_load_lds((const unsigned*)((const char*)(gbase) + (voff)[_i]), (PG8_LAS unsigned*)(lds + (bufoff) + ldsw + _i * 8192), 16, 0, 0); } while (0)
#define PG8_LDA(dst, b, h) do { _Pragma("unroll") for (int m = 0; m < 4; ++m) _Pragma("unroll") for (int k = 0; k < 2; ++k) dst[m][k] = *(const PG8_LAS bf16x8*)(lds + PG8_SA(b, h) + aoff + m * 2048 + k * 1024); } while (0)
#define PG8_LDB(dst, b, h) do { _Pragma("unroll") for (int n = 0; n < 2; ++n) _Pragma("unroll") for (int k = 0; k < 2; ++k) dst[n][k] = *(const PG8_LAS bf16x8*)(lds + PG8_SB(b, h) + boff + n * 2048 + k * 1024); } while (0)
#define PG8_MMA(ai, bj, At, Bt) do { __builtin_amdgcn_s_setprio(1); _Pragma("unroll") for (int m = 0; m < 4; ++m) _Pragma("unroll") for (int n = 0; n < 2; ++n) _Pragma("unroll") for (int k = 0; k < 2; ++k) \
        acc[ai][bj][m][n] = __builtin_amdgcn_mfma_f32_16x16x32_bf16(Bt[n][k], At[m][k], acc[ai][bj][m][n], 0, 0, 0); __builtin_amdgcn_s_setprio(0); } while (0)
#define PG8_WAIT_V(n) asm volatile("s_waitcnt vmcnt(" #n ")" ::: "memory")
#define PG8_WAIT_L(n) asm volatile("s_waitcnt lgkmcnt(" #n ")" ::: "memory")
#define PG8_BAR __builtin_amdgcn_s_barrier()
#define PG8_SCHED __builtin_amdgcn_sched_barrier(0)
    Unit cur, nxt; int ui = 0;
    if (!S.next(0, cur)) return;
    f32x4 acc[2][2][4][2];
#pragma unroll
    for (int a = 0; a < 2; ++a)
#pragma unroll
        for (int b = 0; b < 2; ++b)
#pragma unroll
            for (int m = 0; m < 4; ++m)
#pragma unroll
                for (int n = 0; n < 2; ++n) acc[a][b][m][n] = (f32x4){0.f, 0.f, 0.f, 0.f};
    bf16x8 At[4][2], B0[2][2], B1[2][2];
    int kofc_; krange(g.kmode, cur.pn, K, kofc_, nt);
    const char* cA = (const char*)g.A + (size_t)cur.pm * tstep + (size_t)kofc_ * 2; const char* cB = (const char*)g.Bt + (size_t)cur.pn * tstep + (size_t)kofc_ * 2;
    S.a_ready(cur);
    if constexpr (SP2) {
        PG8_STAGE(PG8_SB(0, 0), cB, voffB); PG8_STAGE(PG8_SB(0, 1), cB + hstep, voffB); PG8_STAGE(PG8_SA(0, 0), cA, voffA); PG8_STAGE(PG8_SA(0, 1), cA + hstep, voffA);
        if (wr == 1) PG8_BAR;
        PG8_WAIT_V(2); PG8_BAR;
        PG8_STAGE(PG8_SB(1, 0), cB + kstep, voffB); PG8_STAGE(PG8_SA(1, 0), cA + kstep, voffA); PG8_STAGE(PG8_SB(1, 1), cB + hstep + kstep, voffB);
        PG8_WAIT_V(6); PG8_BAR;
    } else {
        PG8_STAGE(PG8_SB(0, 0), cB, voffB); PG8_STAGE(PG8_SA(0, 0), cA, voffA); PG8_STAGE(PG8_SB(0, 1), cB + hstep, voffB); PG8_STAGE(PG8_SA(0, 1), cA + hstep, voffA);
        if (wr == 1) PG8_BAR;
        PG8_WAIT_V(4); PG8_BAR;
        PG8_STAGE(PG8_SB(1, 0), cB + kstep, voffB); PG8_STAGE(PG8_SA(1, 0), cA + kstep, voffA); PG8_STAGE(PG8_SB(1, 1), cB + hstep + kstep, voffB);
        PG8_WAIT_V(6); PG8_BAR;
    }
    for (;;) {
        const bool has_next = S.next(ui + 1, nxt);
        int kofn_ = 0, ntn_ = nt; if (has_next) krange(g.kmode, nxt.pn, K, kofn_, ntn_);
        const char* nA = has_next ? (const char*)g.A + (size_t)nxt.pm * tstep + (size_t)kofn_ * 2 : cA; const char* nB = has_next ? (const char*)g.Bt + (size_t)nxt.pn * tstep + (size_t)kofn_ * 2 : cB;
        for (int t = 0; t < nt; t += 2) {
            const bool last = (t == nt - 2);
            const char* a1 = cA + (size_t)(t + 1) * kstep;
            const char* a2 = last ? nA : cA + (size_t)(t + 2) * kstep; const char* b2 = last ? nB : cB + (size_t)(t + 2) * kstep;
            const char* a3 = a2 + kstep; const char* b3 = b2 + kstep;
            if (last && has_next) S.a_ready(nxt);
            if constexpr (SP2) {
            PG8_LDB(B0, 0, 0); PG8_LDB(B1, 0, 1); PG8_SCHED; PG8_LDA(At, 0, 0); PG8_STAGE(PG8_SA(1, 1), a1 + hstep, voffA);
            PG8_WAIT_V(8); PG8_WAIT_L(0); PG8_BAR; PG8_MMA(0, 0, At, B0); PG8_MMA(0, 1, At, B1); PG8_BAR; PG8_SCHED;
            PG8_LDA(At, 0, 1); PG8_STAGE(PG8_SB(0, 0), b2, voffB); PG8_STAGE(PG8_SB(0, 1), b2 + hstep, voffB); PG8_STAGE(PG8_SA(0, 0), a2, voffA);
            PG8_WAIT_V(8); PG8_WAIT_L(0); PG8_BAR; PG8_MMA(1, 0, At, B0); PG8_MMA(1, 1, At, B1); PG8_BAR; PG8_SCHED;
            PG8_LDB(B0, 1, 0); PG8_LDB(B1, 1, 1); PG8_SCHED; PG8_LDA(At, 1, 0); PG8_STAGE(PG8_SA(0, 1), a2 + hstep, voffA);
            PG8_WAIT_V(8); PG8_WAIT_L(0); PG8_BAR; PG8_MMA(0, 0, At, B0); PG8_MMA(0, 1, At, B1); PG8_BAR; PG8_SCHED;
            PG8_LDA(At, 1, 1); PG8_STAGE(PG8_SB(1, 0), b3, voffB); PG8_STAGE(PG8_SB(1, 1), b3 + hstep, voffB); PG8_STAGE(PG8_SA(1, 0), a3, voffA);
            PG8_WAIT_V(8); PG8_WAIT_L(0); PG8_BAR; PG8_MMA(1, 0, At, B0); PG8_MMA(1, 1, At, B1); PG8_BAR; PG8_SCHED;
            } else {
            PG8_LDB(B0, 0, 0); PG8_SCHED; PG8_LDA(At, 0, 0); PG8_STAGE(PG8_SA(1, 1), a1 + hstep, voffA);
            PG8_WAIT_L(8); PG8_BAR; PG8_WAIT_L(0); PG8_MMA(0, 0, At, B0); PG8_BAR; PG8_SCHED;
            PG8_LDB(B1, 0, 1); PG8_STAGE(PG8_SB(0, 0), b2, voffB);
            PG8_BAR; PG8_WAIT_L(0); PG8_MMA(0, 1, At, B1); PG8_BAR;
            PG8_LDA(At, 0, 1); PG8_STAGE(PG8_SA(0, 0), a2, voffA);
            PG8_BAR; PG8_WAIT_L(0); PG8_MMA(1, 0, At, B0); PG8_BAR; PG8_SCHED;
            PG8_STAGE(PG8_SB(0, 1), b2 + hstep, voffB);
            PG8_WAIT_V(6); PG8_BAR; PG8_MMA(1, 1, At, B1); PG8_BAR;
            PG8_LDB(B0, 1, 0); PG8_SCHED; PG8_LDA(At, 1, 0); PG8_STAGE(PG8_SA(0, 1), a2 + hstep, voffA);
            PG8_WAIT_L(8); PG8_BAR; PG8_WAIT_L(0); PG8_MMA(0, 0, At, B0); PG8_BAR; PG8_SCHED;
            PG8_LDB(B1, 1, 1); PG8_STAGE(PG8_SB(1, 0), b3, voffB);
            PG8_BAR; PG8_WAIT_L(0); PG8_MMA(0, 1, At, B1); PG8_BAR;
            PG8_LDA(At, 1, 1); PG8_STAGE(PG8_SA(1, 0), a3, voffA);
            PG8_BAR; PG8_WAIT_L(0); PG8_MMA(1, 0, At, B0); PG8_BAR; PG8_SCHED;
            PG8_STAGE(PG8_SB(1, 1), b3 + hstep, voffB);
            PG8_WAIT_V(6); PG8_BAR; PG8_MMA(1, 1, At, B1); PG8_BAR;
            }
        }
        if constexpr (ALIGN_EPI) { if (wr == 0) PG8_BAR; }
        if constexpr (!Epi::AFTER_DRAIN) { E(acc, cur, wr, wc, fr, fq); S.done(cur); }
        if (!has_next) break;
#pragma unroll
        for (int a = 0; a < 2; ++a)
#pragma unroll
            for (int b = 0; b < 2; ++b)
#pragma unroll
                for (int m = 0; m < 4; ++m)
#pragma unroll
                    for (int n = 0; n < 2; ++n) acc[a][b][m][n] = (f32x4){0.f, 0.f, 0.f, 0.f};
        cur = nxt; cA = nA; cB = nB; nt = ntn_; ++ui;
        if constexpr (ALIGN_EPI) { if (wr == 1) PG8_BAR; }
    }
    PG8_WAIT_V(0);
    if constexpr (!ALIGN_EPI) { if (wr == 0) PG8_BAR; }
    PG8_BAR;
    if constexpr (Epi::AFTER_DRAIN) { E.fused(acc, cur, wr, wc, fr, fq, lds, wid, lane); S.done(cur); }
#undef PG8_SA
#undef PG8_SB
#undef PG8_STAGE
#undef PG8_LDA
#undef PG8_LDB
#undef PG8_MMA
#undef PG8_WAIT_V
#undef PG8_WAIT_L
#undef PG8_BAR
#undef PG8_SCHED
}
}

#define LAS __attribute__((address_space(3)))
typedef unsigned short bf16;
typedef unsigned v4u __attribute__((ext_vector_type(4)));
typedef unsigned v2u __attribute__((ext_vector_type(2)));
typedef float f32x4 __attribute__((ext_vector_type(4)));
typedef float f32x16 __attribute__((ext_vector_type(16)));
typedef short bf16x8 __attribute__((ext_vector_type(8)));
typedef short s16x4 __attribute__((ext_vector_type(4)));
typedef _Float16 h8 __attribute__((ext_vector_type(8)));

__device__ __forceinline__ unsigned pk2(float lo, float hi) { return pg8::cvt_pk_bf16(lo, hi); }
__device__ __forceinline__ float bflo(unsigned u) { return __uint_as_float(u << 16); }
__device__ __forceinline__ float bfhi(unsigned u) { return __uint_as_float(u & 0xffff0000u); }
__device__ __forceinline__ float bf2f(bf16 b) { return __uint_as_float(((unsigned)b) << 16); }
__device__ __forceinline__ bf16 f2bf(float f) { return (bf16)(pk2(f, 0.f) & 0xffffu); }
#define UNPACK8(v, f) do { f[0] = bflo(v.x); f[1] = bfhi(v.x); f[2] = bflo(v.y); f[3] = bfhi(v.y); f[4] = bflo(v.z); f[5] = bfhi(v.z); f[6] = bflo(v.w); f[7] = bfhi(v.w); } while (0)
#define PACK8(o, f) do { o.x = pk2(f[0], f[1]); o.y = pk2(f[2], f[3]); o.z = pk2(f[4], f[5]); o.w = pk2(f[6], f[7]); } while (0)
__device__ __forceinline__ int ltid() { int t = threadIdx.x; asm volatile("" : "+v"(t)); return t; }
__device__ __forceinline__ float sigmoidf_(float x) { return 1.f / (1.f + __expf(-x)); }
__device__ __forceinline__ float wave_sum(float v) {
#pragma unroll
    for (int o = 1; o < 64; o <<= 1) v += __shfl_xor(v, o);
    return v;
}
__device__ __forceinline__ float sum8(float v) { v += __shfl_xor(v, 1); v += __shfl_xor(v, 2); v += __shfl_xor(v, 4); return v; }

constexpr int DM = 1024, DIN = 6944, DPROJ = 4096, NMAIN = 3872, DGATE = 3072, DFF = 2816;
constexpr int NTOK = 131072, NPROMPT = 65536;
constexpr int C_KA = 512, C_VA = 1024, C_CQ = 1536, C_CKV = 1792, C_KR = 1920, C_RW = 1952;
constexpr float LOG2E = 1.4426950408889634f;
constexpr float NA_QS = 0.125f * LOG2E;
constexpr float MLA_QS = 0.10206207261596575f * LOG2E;
constexpr float NEPS = 1e-6f;

constexpr size_t MiB = 1u << 20;
constexpr size_t WS_CTL = 0, CTL_BYTES = 1 * MiB;
constexpr size_t W_OFF = 1 * MiB, W_STRIDE = 39 * MiB;
constexpr size_t WO_IN = 0, WO_G = 8 * MiB, WO_BR = 14 * MiB, WO_OUT = 17 * MiB, WO_GU = 19 * MiB, WO_DN = 30 * MiB, WO_MU = 35 * MiB + 512 * 1024, WO_RU = 37 * MiB;
constexpr size_t ACT_OFF = 80 * MiB;
constexpr size_t TOKB_H = 2048, TOKB_P = 8192, TOKB_M = 3584, TOKB_A = 1536, TOKB_S = 9216, TOKB_Y = 3072, TOKB_Z = 2048;
constexpr size_t TOKB = TOKB_H + TOKB_P + TOKB_M + TOKB_A + TOKB_S + TOKB_Y + TOKB_Z;
static_assert(WO_MU + 1792 * 384 * 2 <= WO_RU && WO_RU + 2560 * 384 * 2 <= W_STRIDE && WO_DN + 1024 * 2816 * 2 <= WO_MU && WO_GU + 5632 * 1024 * 2 <= WO_DN, "weight map");
constexpr int LDS_RING = 131072, LDS_BYTES = LDS_RING + 1024;

struct Params { const float* in[33]; float* out; unsigned char* ws; int G; int Tg; };
typedef const __attribute__((address_space(4))) Params* CP;

constexpr size_t WS_PARAMS = 512 * 1024;
struct Reg { unsigned char* ws; size_t Tg;
    __device__ __forceinline__ bf16* RH() const { return (bf16*)(ws + ACT_OFF); }
    __device__ __forceinline__ bf16* RP() const { return (bf16*)(ws + ACT_OFF + Tg * TOKB_H); }
    __device__ __forceinline__ bf16* RM() const { return (bf16*)(ws + ACT_OFF + Tg * (TOKB_H + TOKB_P)); }
    __device__ __forceinline__ bf16* RA() const { return (bf16*)(ws + ACT_OFF + Tg * (TOKB_H + TOKB_P + TOKB_M)); }
    __device__ __forceinline__ _Float16* RS() const { return (_Float16*)(ws + ACT_OFF + Tg * (TOKB_H + TOKB_P + TOKB_M + TOKB_A)); }
    __device__ __forceinline__ bf16* RY() const { return (bf16*)(ws + ACT_OFF + Tg * (TOKB_H + TOKB_P + TOKB_M + TOKB_A + TOKB_S)); }
    __device__ __forceinline__ bf16* RZ() const { return (bf16*)(ws + ACT_OFF + Tg * (TOKB_H + TOKB_P + TOKB_M + TOKB_A + TOKB_S + TOKB_Y)); }
};
enum { GM_IN = 0, GM_MU = 1, GM_RU = 2, GM_GATE = 3, GM_BR0 = 4, GM_BR1 = 5, GM_BR2 = 6, GM_OUT = 7, GM_GU = 8, GM_DN = 9 };
#define EPI_FENCE() asm volatile("" ::: "memory")
struct EpiUni {
    static constexpr bool PERM = true, AFTER_DRAIN = false;
    CP pp; int id, l, g;
    __device__ __forceinline__ void operator()(const pg8::f32x4 (&acc)[2][2][4][2], const pg8::Unit& u, int wr, int wc, int fr, int fq) const {
        CP q = pp; asm volatile("" : "+s"(q));
        const int Tg = q->Tg; const Reg R{q->ws, (size_t)Tg}; const size_t asz = (size_t)Tg * 512;
        const int row0 = u.pm * 256 + wr * 64 + fr, col0 = u.pn * 256 + wc * 32 + 8 * fq;
        switch (id) {
        case GM_IN: case GM_MU: {
            bf16* O = (id == GM_IN) ? R.RP() : R.RM(); const int ldc = (id == GM_IN) ? DPROJ : 1792;
#pragma unroll
            for (int ai = 0; ai < 2; ++ai)
#pragma unroll
                for (int m = 0; m < 4; ++m) { bf16* rp = O + (size_t)(row0 + ai * 128 + m * 16) * ldc + col0;
#pragma unroll
                    for (int bj = 0; bj < 2; ++bj) { const f32x4 v0 = acc[ai][bj][m][0], v1 = acc[ai][bj][m][1]; v4u w; w.x = pk2(v0[0], v0[1]); w.y = pk2(v0[2], v0[3]); w.z = pk2(v1[0], v1[1]); w.w = pk2(v1[2], v1[3]);
                        *(v4u*)(rp + bj * 128) = w; } }
        } break;
        case GM_GATE: {
            bf16* O = R.RP(); const float* bias = q->in[4] + l * DGATE + col0;
#pragma unroll
            for (int bj = 0; bj < 2; ++bj) { const f32x4 b0 = *(const f32x4*)(bias + bj * 128), b1 = *(const f32x4*)(bias + bj * 128 + 4);
#pragma unroll
                for (int ai = 0; ai < 2; ++ai)
#pragma unroll
                    for (int m = 0; m < 4; ++m) { const f32x4 v0 = acc[ai][bj][m][0] + b0, v1 = acc[ai][bj][m][1] + b1; float f[8];
#pragma unroll
                        for (int i = 0; i < 4; ++i) { f[i] = sigmoidf_(v0[i]); f[4 + i] = sigmoidf_(v1[i]); }
                        v4u w; PACK8(w, f); *(v4u*)(O + (size_t)(row0 + ai * 128 + m * 16) * DGATE + col0 + bj * 128) = w; }
                EPI_FENCE(); }
        } break;
        case GM_GU: {
            bf16* O = R.RP(); const int hc = u.pn * 128 + wc * 32 + 8 * fq;
#pragma unroll
            for (int ai = 0; ai < 2; ++ai)
#pragma unroll
                for (int m = 0; m < 4; ++m) { float f[8];
#pragma unroll
                    for (int n = 0; n < 2; ++n)
#pragma unroll
                        for (int i = 0; i < 4; ++i) { const float gt = acc[ai][0][m][n][i], up = acc[ai][1][m][n][i]; f[4 * n + i] = gt * sigmoidf_(gt) * up; }
                    v4u w; PACK8(w, f); *(v4u*)(O + (size_t)(row0 + ai * 128 + m * 16) * DFF + hc) = w; }
        } break;
        case GM_BR0: case GM_BR1: case GM_BR2: {
            bf16* O = R.RM(); const bf16* Gt = R.RP() + (id - GM_BR0) * 1024; const bool first = (id == GM_BR0);
#pragma unroll
            for (int ai = 0; ai < 2; ++ai)
#pragma unroll
                for (int m = 0; m < 4; ++m) { const size_t row = (size_t)(row0 + ai * 128 + m * 16);
#pragma unroll
                    for (int bj = 0; bj < 2; ++bj) { const int col = col0 + bj * 128; const v4u gv = *(const v4u*)(Gt + row * DGATE + col); float gg[8], f[8]; UNPACK8(gv, gg);
#pragma unroll
                        for (int i = 0; i < 4; ++i) { f[i] = gg[i] * acc[ai][bj][m][0][i]; f[4 + i] = gg[4 + i] * acc[ai][bj][m][1][i]; }
                        if (!first) { const v4u ov = *(const v4u*)(O + row * DM + col); float o[8]; UNPACK8(ov, o);
#pragma unroll
                            for (int i = 0; i < 8; ++i) f[i] += o[i]; }
                        v4u w; PACK8(w, f); *(v4u*)(O + row * DM + col) = w; }
                    EPI_FENCE(); }
        } break;
        case GM_OUT: case GM_DN: {
            const int t0 = g * Tg; float* xout = q->out + (size_t)t0 * DM;
            const float* xin = (id == GM_OUT && l == 0) ? ((t0 < NPROMPT) ? q->in[0] + (size_t)t0 * DM : q->in[1] + (size_t)(t0 - NPROMPT) * DM) : xout;
#pragma unroll
            for (int ai = 0; ai < 2; ++ai)
#pragma unroll
                for (int m = 0; m < 4; ++m) { const size_t off = (size_t)(row0 + ai * 128 + m * 16) * DM + col0;
#pragma unroll
                    for (int bj = 0; bj < 2; ++bj)
#pragma unroll
                        for (int n = 0; n < 2; ++n) { const f32x4 b = *(const f32x4*)(xin + off + bj * 128 + n * 4); *(f32x4*)(xout + off + bj * 128 + n * 4) = b + acc[ai][bj][m][n]; }
                    EPI_FENCE(); }
        } break;
        case GM_RU: {
            _Float16* rs = R.RS(); const _Float16* ktmp = (const _Float16*)R.RZ(); bf16* gout = R.RY() + 2 * asz;
            const int type = u.pn >> 1; const int cl0 = (u.pn & 1) * 256 + wc * 32 + 8 * fq;
            const float* w0 = q->in[17] + l * 1024; const float* a0 = q->in[19] + l * 1024; const float* ka = q->in[23] + l * 512;
#pragma unroll
            for (int ai = 0; ai < 2; ++ai)
#pragma unroll
                for (int m = 0; m < 4; ++m) { const size_t row = (size_t)(row0 + ai * 128 + m * 16);
#pragma unroll
                    for (int bj = 0; bj < 2; ++bj) { const int cl = cl0 + bj * 128; float f[8];
#pragma unroll
                        for (int i = 0; i < 4; ++i) { f[i] = acc[ai][bj][m][0][i]; f[4 + i] = acc[ai][bj][m][1][i]; }
                        if (type < 2) {
                            h8 o;
#pragma unroll
                            for (int i = 0; i < 8; ++i) o[i] = (_Float16)__expf(-0.6065306597126334f * sigmoidf_(f[i] + w0[type * 512 + cl + i]));
                            *(h8*)(rs + (size_t)(3 + type) * asz + row * 512 + cl) = o;
                        } else if (type < 4) {
                            const int d = type - 2; const h8 kv = *(const h8*)(ktmp + row * 512 + cl), kkv = *(const h8*)(rs + (size_t)2 * asz + row * 512 + cl); h8 o1, o2;
#pragma unroll
                            for (int i = 0; i < 8; ++i) { const float a = sigmoidf_(f[i] + a0[d * 512 + cl + i]); o1[i] = (_Float16)((float)kkv[i] * a); o2[i] = (_Float16)((float)kv[i] * (1.f + (a - 1.f) * ka[cl + i])); }
                            *(h8*)(rs + (size_t)(5 + d) * asz + row * 512 + cl) = o1; *(h8*)(rs + (size_t)(7 + d) * asz + row * 512 + cl) = o2;
                        } else { v4u w; PACK8(w, f); *(v4u*)(gout + row * 512 + cl) = w; }
                        EPI_FENCE(); } }
        } break;
        default: break;
        }
    }
};

__device__ __forceinline__ void transpose_item(const float* W, int ldw, int N, bf16* WT, int ldt, int koff, int row_off, int mode, LAS float* scr, int item, int lane) {
    const int nblk = N / 32, kb = item / nblk, nb = item % nblk, k0 = 64 * kb, n0 = 32 * nb;
#pragma unroll 8
    for (int i = 0; i < 32; ++i) { const int kk = 2 * i + (lane >> 5); scr[kk * 33 + (lane & 31)] = W[(size_t)(k0 + kk) * ldw + n0 + (lane & 31)]; }
    asm volatile("s_waitcnt lgkmcnt(0)" ::: "memory");
    const int c = lane & 7;
#pragma unroll
    for (int j = 0; j < 4; ++j) { const int n = (lane >> 3) + 8 * j; const LAS float* s = scr + (8 * c) * 33 + n;
        v4u o; o.x = pk2(s[0 * 33], s[1 * 33]); o.y = pk2(s[2 * 33], s[3 * 33]); o.z = pk2(s[4 * 33], s[5 * 33]); o.w = pk2(s[6 * 33], s[7 * 33]);
        const int nn = n0 + n; const int drow = mode ? ((nn >> 7) * 256 + row_off + (nn & 127)) : (row_off + nn);
        *(v4u*)(WT + (size_t)drow * ldt + koff + k0 + 8 * c) = o; }
    asm volatile("s_waitcnt lgkmcnt(0)" ::: "memory");
}
__device__ __forceinline__ void transpose_job(const float* W, int ldw, int K, int N, bf16* WT, int ldt, int koff, int row_off, int mode, LAS float* scr, int gw, int ngw, int lane) {
    const int nitems = (K / 64) * (N / 32);
    for (int it = gw; it < nitems; it += ngw) transpose_item(W, ldw, N, WT, ldt, koff, row_off, mode, scr, it, lane);
}
__device__ __forceinline__ void zero_bytes(unsigned char* p, size_t nbytes, size_t gtid, size_t ngt) {
    const v4u z = {0u, 0u, 0u, 0u};
    for (size_t i = gtid; i < nbytes / 16; i += ngt) ((v4u*)p)[i] = z;
}

__device__ __forceinline__ void phase_norm(const float* x, const float* g, bf16* hb, int Tg, int gw, int ngw, int lane) {
    for (int t = gw; t < Tg; t += 2 * ngw) {
        const int t2 = (t + ngw < Tg) ? t + ngw : t;
        const f32x4* xa = (const f32x4*)(x + (size_t)t * DM) + lane; const f32x4* xb = (const f32x4*)(x + (size_t)t2 * DM) + lane; f32x4 va[4], vb[4]; float sa = 0.f, sb = 0.f;
#pragma unroll
        for (int j = 0; j < 4; ++j) { va[j] = xa[64 * j]; vb[j] = xb[64 * j]; }
#pragma unroll
        for (int j = 0; j < 4; ++j) { sa += (va[j].x * va[j].x + va[j].y * va[j].y) + (va[j].z * va[j].z + va[j].w * va[j].w); sb += (vb[j].x * vb[j].x + vb[j].y * vb[j].y) + (vb[j].z * vb[j].z + vb[j].w * vb[j].w); }
        const float ia = rsqrtf(wave_sum(sa) * (1.f / DM) + NEPS), ib = rsqrtf(wave_sum(sb) * (1.f / DM) + NEPS);
        v2u* oa = (v2u*)(hb + (size_t)t * DM) + lane; v2u* ob = (v2u*)(hb + (size_t)t2 * DM) + lane;
#pragma unroll
        for (int j = 0; j < 4; ++j) { const f32x4 gg = ((const f32x4*)g)[lane + 64 * j]; v2u o;
            o.x = pk2(va[j].x * ia * gg.x, va[j].y * ia * gg.y); o.y = pk2(va[j].z * ia * gg.z, va[j].w * ia * gg.w); oa[64 * j] = o;
            o.x = pk2(vb[j].x * ib * gg.x, vb[j].y * ib * gg.y); o.y = pk2(vb[j].z * ib * gg.z, vb[j].w * ib * gg.w); ob[64 * j] = o; }
    }
}

__device__ __forceinline__ void phase_post_proj(CP pp, int l, bf16* proj, bf16* mla_a, bf16* rw_a, _Float16* rs, _Float16* ktmp, size_t asz, int Tg, int L, int gw, int ngw, int lane) {
    const float* gq = pp->in[5] + l * 64; const float* gk = pp->in[6] + l * 64;
    const float* gcq = pp->in[9] + l * 256; const float* gckv = pp->in[10] + l * 128;
    const float* mu = pp->in[16] + l * 1920; const float* kkw = pp->in[22] + l * 512;
    for (int t = gw; t < Tg; t += ngw) {
        bf16* row = proj + (size_t)t * DPROJ; const int tpos = t % L;
        const bool hasp = tpos > 0, hasn = tpos < L - 1;
        v4u qv = *(const v4u*)(row + 8 * lane), kv = *(const v4u*)(row + C_KA + 8 * lane); const v2u cv = *(const v2u*)(row + C_CQ + 4 * lane); const unsigned kvv = *(const unsigned*)(row + C_CKV + 2 * lane);
        v4u rwc[4], rwp[4], rwn[4];
#pragma unroll
        for (int it = 0; it < 4; ++it) { const int c0 = (it * 64 + lane) * 8; const v4u z = {0u, 0u, 0u, 0u}; rwc[it] = z; rwp[it] = z; rwn[it] = z;
            if (it < 3 || lane < 48) { const bf16* src = row + C_RW + c0; rwc[it] = *(const v4u*)src; if (hasp) rwp[it] = *(const v4u*)(src - DPROJ); if (hasn) rwn[it] = *(const v4u*)(src + DPROJ); } }
        {
            const int gi = 8 * (lane & 7);
            float f[8]; UNPACK8(qv, f); float ss = 0.f;
#pragma unroll
            for (int i = 0; i < 8; ++i) ss += f[i] * f[i];
            float inv = rsqrtf(sum8(ss) * (1.f / 64.f) + NEPS) * NA_QS;
#pragma unroll
            for (int i = 0; i < 8; ++i) f[i] = f[i] * inv * gq[gi + i];
            PACK8(qv, f); *(v4u*)(row + 8 * lane) = qv;
            UNPACK8(kv, f); ss = 0.f;
#pragma unroll
            for (int i = 0; i < 8; ++i) ss += f[i] * f[i];
            inv = rsqrtf(sum8(ss) * (1.f / 64.f) + NEPS);
#pragma unroll
            for (int i = 0; i < 8; ++i) f[i] = f[i] * inv * gk[gi + i];
            PACK8(kv, f); *(v4u*)(row + C_KA + 8 * lane) = kv;
        }
        {
            float a0 = bflo(cv.x), a1 = bfhi(cv.x), a2 = bflo(cv.y), a3 = bfhi(cv.y);
            float inv = rsqrtf(wave_sum(a0 * a0 + a1 * a1 + a2 * a2 + a3 * a3) * (1.f / 256.f) + NEPS);
            const f32x4 gg = *(const f32x4*)(gcq + 4 * lane); v2u o; o.x = pk2(a0 * inv * gg.x, a1 * inv * gg.y); o.y = pk2(a2 * inv * gg.z, a3 * inv * gg.w);
            *(v2u*)(mla_a + (size_t)t * 384 + 4 * lane) = o;
            a0 = bflo(kvv); a1 = bfhi(kvv);
            inv = rsqrtf(wave_sum(a0 * a0 + a1 * a1) * (1.f / 128.f) + NEPS);
            *(unsigned*)(mla_a + (size_t)t * 384 + 256 + 2 * lane) = pk2(a0 * inv * gckv[2 * lane], a1 * inv * gckv[2 * lane + 1]);
        }
#pragma unroll
        for (int it = 0; it < 4; ++it) {
            const int c0 = (it * 64 + lane) * 8;
            if (it < 3 || lane < 48) {
                float pc[8], pp[8], pn[8]; UNPACK8(rwc[it], pc); UNPACK8(rwp[it], pp); UNPACK8(rwn[it], pn);
#pragma unroll
                for (int i = 0; i < 8; ++i) pc[i] = pc[i] + mu[c0 + i] * (0.5f * (pp[i] + pn[i]) - pc[i]);
                if (it == 0) { h8 o;
#pragma unroll
                    for (int i = 0; i < 8; ++i) o[i] = (_Float16)pc[i];
                    *(h8*)(rs + (size_t)t * 512 + c0) = o; }
                else if (it == 1) { const int c = c0 - 512; h8 o; float kk[8]; float ss = 0.f;
#pragma unroll
                    for (int i = 0; i < 8; ++i) { o[i] = (_Float16)pc[i]; kk[i] = pc[i] * kkw[c + i]; ss += kk[i] * kk[i]; }
                    *(h8*)(ktmp + (size_t)t * 512 + c) = o;
                    const float inv = rsqrtf(sum8(ss) + 1e-12f);
#pragma unroll
                    for (int i = 0; i < 8; ++i) o[i] = (_Float16)(kk[i] * inv);
                    *(h8*)(rs + 2 * asz + (size_t)t * 512 + c) = o; }
                else if (it == 2) { const int c = c0 - 1024; h8 o;
#pragma unroll
                    for (int i = 0; i < 8; ++i) o[i] = (_Float16)pc[i];
                    *(h8*)(rs + asz + (size_t)t * 512 + c) = o; }
                else { const int c = c0 - 1536; float f[8];
#pragma unroll
                    for (int i = 0; i < 8; ++i) { const float x = pc[i]; f[i] = (c < 128) ? (1.f - 2.f / (1.f + __expf(2.f * x))) : ((c < 256) ? x : sigmoidf_(x)); }
                    v4u w; PACK8(w, f); *(v4u*)(rw_a + (size_t)t * 384 + c) = w; }
            }
        }
    }
}

__device__ __forceinline__ void phase_mla_post(CP pp, int l, bf16* mraw, const bf16* proj, bf16* mk, int Tg, int L, int gw, int ngw, int lane) {
    const float* gq = pp->in[13] + l * 96; const float* gk = pp->in[14] + l * 96;
    const float gqn = gq[lane], gkn = gk[lane], gqr = lane < 32 ? gq[64 + lane] : 0.f, gkr = lane < 32 ? gk[64 + lane] : 0.f;
    const int fi = lane & 7; const float invf = __expf(-(float)fi * (9.210340371976184f / 8.f));
    for (int t = gw; t < Tg; t += ngw) {
        const int tpos = t % L; const float pos = (float)(((lane & 15) < 8) ? (tpos >> 6) : (tpos & 63));
        float rev = pos * invf * 0.15915494309189535f; rev -= floorf(rev);
        const float cs = __builtin_amdgcn_cosf(rev), sn = __builtin_amdgcn_sinf(rev);
        bf16* mrow = mraw + (size_t)t * 1792; bf16* krow = mk + (size_t)t * 768;
        const float krv = lane < 32 ? bf2f(proj[(size_t)t * DPROJ + C_KR + lane]) : 0.f;
        bf16 lqn[8], lqr[8], lkn[8];
#pragma unroll
        for (int h = 0; h < 8; ++h) { lqn[h] = mrow[h * 96 + lane]; lqr[h] = mrow[h * 96 + 64 + (lane & 31)]; lkn[h] = mrow[768 + h * 128 + lane]; }
#pragma unroll
        for (int h = 0; h < 8; ++h) {
            {   float qn = bf2f(lqn[h]); float qr = lane < 32 ? bf2f(lqr[h]) : 0.f;
                const float inv = rsqrtf(wave_sum(qn * qn + qr * qr) * (1.f / 96.f) + NEPS);
                qn = qn * inv * gqn; qr = qr * inv * gqr;
                const float pr = __shfl_xor(qr, 16);
                const float ro = (lane < 16) ? (qr * cs - pr * sn) : (pr * sn + qr * cs);
                mrow[h * 96 + lane] = f2bf(qn * MLA_QS); if (lane < 32) mrow[h * 96 + 64 + lane] = f2bf(ro * MLA_QS); }
            {   float kn = bf2f(lkn[h]); float kr = krv;
                const float inv = rsqrtf(wave_sum(kn * kn + kr * kr) * (1.f / 96.f) + NEPS);
                kn = kn * inv * gkn; kr = kr * inv * gkr;
                const float pr = __shfl_xor(kr, 16);
                const float ro = (lane < 16) ? (kr * cs - pr * sn) : (pr * sn + kr * cs);
                krow[h * 96 + lane] = f2bf(kn); if (lane < 32) krow[h * 96 + 64 + lane] = f2bf(ro); }
        }
    }
}

__device__ __forceinline__ void phase_rw_post(CP pp, int l, const _Float16* rs, size_t asz, const bf16* yfb, bf16* yc, int Tg, int gw, int ngw, int lane) {
    const float* lnw = pp->in[25] + l * 512 + 8 * lane; const float* lnb = pp->in[26] + l * 512 + 8 * lane; const float* rk = pp->in[24] + l * 512 + 8 * lane;
    for (int t = gw; t < Tg; t += ngw) {
        const size_t o = (size_t)t * 512 + 8 * lane; float y[8], f[8];
        { const v4u a = *(const v4u*)(yfb + o); const v4u b = *(const v4u*)(yfb + asz + o); UNPACK8(a, y); UNPACK8(b, f); }
        float s = 0.f;
#pragma unroll
        for (int i = 0; i < 8; ++i) { y[i] += f[i]; s += y[i]; }
        const float mean = sum8(s) * (1.f / 64.f); float q = 0.f;
#pragma unroll
        for (int i = 0; i < 8; ++i) { y[i] -= mean; q += y[i] * y[i]; }
        const float rstd = rsqrtf(sum8(q) * (1.f / 64.f) + 64e-5f);
        const h8 r = *(const h8*)(rs + o), v = *(const h8*)(rs + asz + o), kd0 = *(const h8*)(rs + 7 * asz + o), kd1 = *(const h8*)(rs + 8 * asz + o);
        float b = 0.f;
#pragma unroll
        for (int i = 0; i < 8; ++i) b += (float)r[i] * ((float)kd0[i] + (float)kd1[i]) * rk[i];
        b = sum8(b);
        const v4u gv = *(const v4u*)(yc + o); UNPACK8(gv, f);
#pragma unroll
        for (int i = 0; i < 8; ++i) f[i] = (y[i] * rstd * lnw[i] + lnb[i] + b * (float)v[i]) * f[i];
        v4u w; PACK8(w, f); *(v4u*)(yc + o) = w;
    }
}

#define GAS __attribute__((address_space(1)))
typedef float f2 __attribute__((ext_vector_type(2)));
#define DPP_ADD(x, ctrl) ((x) + __builtin_bit_cast(float, __builtin_amdgcn_update_dpp(0, __builtin_bit_cast(int, (x)), (ctrl), 0xF, 0xF, true)))
__device__ __forceinline__ float red8(float x) { x = DPP_ADD(x, 0xB1); x = DPP_ADD(x, 0x4E); x = DPP_ADD(x, 0x141); return x; }
constexpr int SCH = 32, SBUF = 6 * SCH * 256;
__device__ __forceinline__ void scan_unit(int u, int L, const _Float16* rs, size_t asz, bf16* yfb, LAS unsigned char* lds) {
    const int tid = ltid(); const int lane = tid & 63, w = tid >> 6, vr = lane >> 3, ko = lane & 7;
    const int dir = u & 1, sh = u >> 1, h = sh & 7, s = sh >> 3;
    const int kA = tid >> 8, lj = (tid >> 3) & 31, lp = tid & 7;
    const size_t tok0 = (size_t)s * L + (dir ? (L - 1 - lj) : lj);
    const long tstep = dir ? -(long)SCH * 512 : (long)SCH * 512;
    const size_t eoff = tok0 * 512 + h * 64 + lp * 8;
    const GAS _Float16* g0 = (const GAS _Float16*)(rs + (size_t)(kA ? 2 : 0) * asz + eoff);
    const GAS _Float16* g1 = (const GAS _Float16*)(rs + (size_t)(kA ? 5 + dir : 3 + dir) * asz + eoff);
    const GAS _Float16* g2 = (const GAS _Float16*)(rs + (size_t)(kA ? 1 : 7 + dir) * asz + eoff);
    const int ld0 = (((0 + kA) * SCH + lj) * 64 + lp * 8) * 4, ld1 = (((2 + kA) * SCH + lj) * 64 + lp * 8) * 4, ld2 = (((4 + kA) * SCH + lj) * 64 + lp * 8) * 4;
    GAS bf16* py = (GAS bf16*)(yfb + (size_t)dir * asz + ((size_t)s * L + (dir ? L - 1 : 0)) * 512 + h * 64 + 8 * w + vr);
    const long ystep = dir ? -512 : 512;
    const int rd = ko * 32, rdv = (5 * SCH * 64 + 8 * w + vr) * 4;
    f2 S[4];
#pragma unroll
    for (int i = 0; i < 4; ++i) S[i] = (f2){0.f, 0.f};
    h8 p0 = *(const GAS h8*)g0, p1 = *(const GAS h8*)g1, p2 = *(const GAS h8*)g2;
#define SCAN_PUT(bufo) do { f32x4 a, b; \
        a = (f32x4){(float)p0[0], (float)p0[1], (float)p0[2], (float)p0[3]}; b = (f32x4){(float)p0[4], (float)p0[5], (float)p0[6], (float)p0[7]}; *(LAS f32x4*)(lds + (bufo) + ld0) = a; *(LAS f32x4*)(lds + (bufo) + ld0 + 16) = b; \
        a = (f32x4){(float)p1[0], (float)p1[1], (float)p1[2], (float)p1[3]}; b = (f32x4){(float)p1[4], (float)p1[5], (float)p1[6], (float)p1[7]}; *(LAS f32x4*)(lds + (bufo) + ld1) = a; *(LAS f32x4*)(lds + (bufo) + ld1 + 16) = b; \
        a = (f32x4){(float)p2[0], (float)p2[1], (float)p2[2], (float)p2[3]}; b = (f32x4){(float)p2[4], (float)p2[5], (float)p2[6], (float)p2[7]}; *(LAS f32x4*)(lds + (bufo) + ld2) = a; *(LAS f32x4*)(lds + (bufo) + ld2 + 16) = b; } while (0)
    SCAN_PUT(0);
    __syncthreads();
    const int NC = L / SCH;
#pragma unroll 1
    for (int c = 0; c < NC; ++c) {
        const int cur = (c & 1) * SBUF;
        if (c + 1 < NC) { const long o = tstep * (long)(c + 1); p0 = *(const GAS h8*)(g0 + o); p1 = *(const GAS h8*)(g1 + o); p2 = *(const GAS h8*)(g2 + o); }
        LAS unsigned char* bp = lds + cur + rd;
        GAS bf16* pyc = py + ystep * (long)(c * SCH);
#pragma unroll 1
        for (int j0 = 0; j0 < SCH; j0 += 4) { float yv[4];
#pragma unroll
        for (int jj = 0; jj < 4; ++jj) { const int j = j0 + jj;
            const LAS unsigned char* q = bp + j * 256;
            const f32x4 r0 = *(const LAS f32x4*)(q), r1 = *(const LAS f32x4*)(q + 16);
            const f32x4 k0 = *(const LAS f32x4*)(q + SCH * 256), k1 = *(const LAS f32x4*)(q + SCH * 256 + 16);
            const f32x4 w0 = *(const LAS f32x4*)(q + 2 * SCH * 256), w1 = *(const LAS f32x4*)(q + 2 * SCH * 256 + 16);
            const f32x4 a0 = *(const LAS f32x4*)(q + 3 * SCH * 256), a1 = *(const LAS f32x4*)(q + 3 * SCH * 256 + 16);
            const f32x4 d0 = *(const LAS f32x4*)(q + 4 * SCH * 256), d1 = *(const LAS f32x4*)(q + 4 * SCH * 256 + 16);
            const float vv = *(const LAS float*)(lds + cur + rdv + j * 256);
            const f2 vv2 = (f2){vv, vv};
            f2 e0 = S[0] * w0.xy, e1 = S[1] * w0.zw, e2 = S[2] * w1.xy, e3 = S[3] * w1.zw;
            f2 pa = S[0] * k0.xy, pb = S[1] * k0.zw; pa = S[2] * k1.xy + pa; pb = S[3] * k1.zw + pb;
            e0 = d0.xy * vv2 + e0; e1 = d0.zw * vv2 + e1; e2 = d1.xy * vv2 + e2; e3 = d1.zw * vv2 + e3;
            const f2 pd = pa + pb;
            const float nskk = -red8(pd.x + pd.y);
            const f2 ns2 = (f2){nskk, nskk};
            S[0] = a0.xy * ns2 + e0; S[1] = a0.zw * ns2 + e1; S[2] = a1.xy * ns2 + e2; S[3] = a1.zw * ns2 + e3;
            f2 qa = S[0] * r0.xy, qb = S[1] * r0.zw; qa = S[2] * r1.xy + qa; qb = S[3] * r1.zw + qb;
            const f2 qd = qa + qb;
            yv[jj] = red8(qd.x + qd.y);
        }
            if (ko == 0) {
#pragma unroll
                for (int jj = 0; jj < 4; ++jj) pyc[ystep * (j0 + jj)] = f2bf(yv[jj]); }
        }
        if (c + 1 < NC) SCAN_PUT(SBUF - cur);
        __syncthreads();
    }
#undef SCAN_PUT
}

constexpr int MKP = 208, MVP = 144, MBUF = 64 * MKP + 64 * MVP;
#define MLA_THR 6.0f
__device__ __forceinline__ float max3f(float a, float b, float c) { return fmaxf(fmaxf(a, b), c); }
__device__ __forceinline__ void mla_unit(int u, int L, const bf16* mraw, const bf16* mk, bf16* yb, LAS unsigned char* lds) {
    const int tid = ltid(), lane = tid & 63, w = tid >> 6, q32 = lane & 31, hi = lane >> 5;
    const int nqb = L >> 8, qb = u % nqb, sh = u / nqb, h = sh & 7, s = sh >> 3;
    const size_t base = (size_t)s * L; const int NT = L >> 6;
    const size_t qtok = base + qb * 256 + w * 32 + q32;
    bf16x8 qf[6];
#pragma unroll
    for (int ks = 0; ks < 6; ++ks) qf[ks] = *(const bf16x8*)(mraw + qtok * 1792 + h * 96 + ks * 16 + hi * 8);
    const int kkey0 = tid / 12, kch0 = tid % 12, kkey1 = (tid + 512) / 12, kch1 = (tid + 512) % 12; const bool k2 = tid < 256;
    const bf16* ks0 = mk + (base + kkey0) * 768 + h * 96 + kch0 * 8; const bf16* ks1 = mk + (base + kkey1) * 768 + h * 96 + kch1 * 8;
    const int vkey = tid >> 3, vch = tid & 7;
    const bf16* vs = mraw + (base + vkey) * 1792 + 768 + h * 128 + 64 + vch * 8;
    const int kd0 = kkey0 * MKP + kch0 * 16, kd1 = kkey1 * MKP + kch1 * 16, vd = 64 * MKP + vkey * MVP + vch * 16;
    v4u rk0, rk1 = {0u, 0u, 0u, 0u}, rv, sk0, sk1 = {0u, 0u, 0u, 0u}, sv;
#define MLA_LOAD(t) do { const size_t adv_ = (size_t)(t) * 64; rk0 = *(const v4u*)(ks0 + adv_ * 768); if (k2) rk1 = *(const v4u*)(ks1 + adv_ * 768); rv = *(const v4u*)(vs + adv_ * 1792); } while (0)
#define MLA_PUT(bo) do { *(LAS v4u*)(lds + (bo) + kd0) = rk0; if (k2) *(LAS v4u*)(lds + (bo) + kd1) = rk1; *(LAS v4u*)(lds + (bo) + vd) = rv; } while (0)
#define MLA_LOADB(t) do { const size_t adv_ = (size_t)(t) * 64; sk0 = *(const v4u*)(ks0 + adv_ * 768); if (k2) sk1 = *(const v4u*)(ks1 + adv_ * 768); sv = *(const v4u*)(vs + adv_ * 1792); } while (0)
#define MLA_PUTB(bo) do { *(LAS v4u*)(lds + (bo) + kd0) = sk0; if (k2) *(LAS v4u*)(lds + (bo) + kd1) = sk1; *(LAS v4u*)(lds + (bo) + vd) = sv; } while (0)
    MLA_LOAD(0); MLA_PUT(0); MLA_LOAD(1); MLA_PUT(MBUF);
    __syncthreads();
    const int kmap = 16 * (q32 >> 4) + 8 * ((q32 >> 2) & 1) + (q32 & 3) + 4 * ((q32 >> 3) & 1);
    const int koff = kmap * MKP + hi * 16;
    const int voff = 64 * MKP + (8 * hi + ((lane & 15) >> 2)) * MVP + (16 * ((lane >> 4) & 1) + 4 * (lane & 3)) * 2;
    f32x16 o0 = {}, o1 = {}, negm = {}, pA0, pA1, pB0, pB1; float lsum = 0.f; v4u pw0, pw1, pw2, pw3;
    int b_prev = 0, b_cur = MBUF, b_next = 2 * MBUF;
#define MLA_KA(bo, ks) (*(const LAS bf16x8*)(lds + (bo) + koff + (ks) * 32))
#define MLA_KB(bo, ks) (*(const LAS bf16x8*)(lds + (bo) + koff + 32 * MKP + (ks) * 32))
#define MLA_QK2(C0, C1, bo, ks) do { C0 = __builtin_amdgcn_mfma_f32_32x32x16_bf16(MLA_KA(bo, ks), qf[ks], C0, 0, 0, 0); C1 = __builtin_amdgcn_mfma_f32_32x32x16_bf16(MLA_KB(bo, ks), qf[ks], C1, 0, 0, 0); } while (0)
#define MLA_FIN8(P, g, PW) do { float e0 = __builtin_amdgcn_exp2f(P[8 * g + 0]), e1 = __builtin_amdgcn_exp2f(P[8 * g + 1]), e2 = __builtin_amdgcn_exp2f(P[8 * g + 2]), e3 = __builtin_amdgcn_exp2f(P[8 * g + 3]), \
        e4 = __builtin_amdgcn_exp2f(P[8 * g + 4]), e5 = __builtin_amdgcn_exp2f(P[8 * g + 5]), e6 = __builtin_amdgcn_exp2f(P[8 * g + 6]), e7 = __builtin_amdgcn_exp2f(P[8 * g + 7]); \
        lsum += ((e0 + e1) + (e2 + e3)) + ((e4 + e5) + (e6 + e7)); PW.x = pk2(e0, e1); PW.y = pk2(e2, e3); PW.z = pk2(e4, e5); PW.w = pk2(e6, e7); } while (0)
#define MLA_VT(bo, kg, db) ({ const int vb_ = (bo) + voff + (kg) * 16 * MVP + (db) * 64; \
        const s16x4 t0_ = __builtin_amdgcn_ds_read_tr16_b64_v4i16((LAS s16x4*)(lds + vb_)), t1_ = __builtin_amdgcn_ds_read_tr16_b64_v4i16((LAS s16x4*)(lds + vb_ + 4 * MVP)); \
        (bf16x8){t0_[0], t0_[1], t0_[2], t0_[3], t1_[0], t1_[1], t1_[2], t1_[3]}; })
#define MLA_PV(bo, kg, PW) do { const bf16x8 pf_ = __builtin_bit_cast(bf16x8, PW); o0 = __builtin_amdgcn_mfma_f32_32x32x16_bf16(MLA_VT(bo, kg, 0), pf_, o0, 0, 0, 0); o1 = __builtin_amdgcn_mfma_f32_32x32x16_bf16(MLA_VT(bo, kg, 1), pf_, o1, 0, 0, 0); } while (0)
#define MLA_ROWMAX(C0, C1) ({ float a_ = max3f(C0[0], C0[1], C1[0]), b_ = max3f(C0[2], C0[3], C1[1]); a_ = max3f(a_, C1[2], C1[3]); \
        _Pragma("unroll") for (int r_ = 4; r_ < 16; r_ += 4) { a_ = max3f(a_, C0[r_], C0[r_ + 1]); b_ = max3f(b_, C0[r_ + 2], C0[r_ + 3]); a_ = max3f(a_, C1[r_], C1[r_ + 1]); b_ = max3f(b_, C1[r_ + 2], C1[r_ + 3]); } \
        const float m_ = fmaxf(a_, b_); fmaxf(m_, __shfl_xor(m_, 32)); })
#define MLA_STEP(P0, P1, C0, C1, j, LOADX, PUTX) do { \
        if ((j) + 2 < NT) LOADX((j) + 2); \
        C0 = negm; C1 = negm; \
        MLA_QK2(C0, C1, b_cur, 0); MLA_QK2(C0, C1, b_cur, 1); MLA_FIN8(P0, 0, pw0); \
        MLA_QK2(C0, C1, b_cur, 2); MLA_FIN8(P0, 1, pw1); \
        MLA_QK2(C0, C1, b_cur, 3); MLA_FIN8(P1, 0, pw2); \
        MLA_QK2(C0, C1, b_cur, 4); MLA_FIN8(P1, 1, pw3); \
        MLA_QK2(C0, C1, b_cur, 5); \
        MLA_PV(b_prev, 0, pw0); MLA_PV(b_prev, 1, pw1); \
        const float mt_ = MLA_ROWMAX(C0, C1); \
        MLA_PV(b_prev, 2, pw2); MLA_PV(b_prev, 3, pw3); \
        if (__any(mt_ > MLA_THR)) { const float dl_ = fmaxf(mt_, 0.f); const float fs_ = __builtin_amdgcn_exp2f(-dl_); lsum *= fs_; \
            _Pragma("unroll") for (int r_ = 0; r_ < 16; ++r_) { C0[r_] -= dl_; C1[r_] -= dl_; negm[r_] -= dl_; o0[r_] *= fs_; o1[r_] *= fs_; } } \
        if ((j) + 1 < NT) PUTX(b_next); \
        __syncthreads(); \
        { const int t_ = b_prev; b_prev = b_cur; b_cur = b_next; b_next = t_; } \
    } while (0)
    pA0 = negm; pA1 = negm;
#pragma unroll
    for (int ks = 0; ks < 6; ++ks) MLA_QK2(pA0, pA1, 0, ks);
    { const float m0 = MLA_ROWMAX(pA0, pA1);
#pragma unroll
      for (int r = 0; r < 16; ++r) { pA0[r] -= m0; pA1[r] -= m0; negm[r] = -m0; } }
    MLA_LOADB(2);
    int jt = 1;
#pragma unroll 1
    for (; jt + 1 < NT; jt += 2) {
        MLA_STEP(pA0, pA1, pB0, pB1, jt, MLA_LOAD, MLA_PUTB);
        MLA_STEP(pB0, pB1, pA0, pA1, jt + 1, MLA_LOADB, MLA_PUT);
    }
    if (jt < NT) { MLA_STEP(pA0, pA1, pB0, pB1, jt, MLA_LOAD, MLA_PUTB); pA0 = pB0; pA1 = pB1; }
    MLA_FIN8(pA0, 0, pw0); MLA_FIN8(pA0, 1, pw1); MLA_FIN8(pA1, 0, pw2); MLA_FIN8(pA1, 1, pw3);
    MLA_PV(b_prev, 0, pw0); MLA_PV(b_prev, 1, pw1); MLA_PV(b_prev, 2, pw2); MLA_PV(b_prev, 3, pw3);
    lsum += __shfl_xor(lsum, 32);
    const float inv = 1.f / lsum;
    bf16* orow = yb + qtok * 512 + h * 64 + 4 * hi;
#pragma unroll
    for (int rq = 0; rq < 4; ++rq) {
        v2u a, b; a.x = pk2(o0[4 * rq] * inv, o0[4 * rq + 1] * inv); a.y = pk2(o0[4 * rq + 2] * inv, o0[4 * rq + 3] * inv);
        b.x = pk2(o1[4 * rq] * inv, o1[4 * rq + 1] * inv); b.y = pk2(o1[4 * rq + 2] * inv, o1[4 * rq + 3] * inv);
        *(v2u*)(orow + 8 * rq) = a; *(v2u*)(orow + 32 + 8 * rq) = b;
    }
    __syncthreads();
#undef MLA_LOAD
#undef MLA_PUT
#undef MLA_LOADB
#undef MLA_PUTB
#undef MLA_KA
#undef MLA_KB
#undef MLA_QK2
#undef MLA_FIN8
#undef MLA_VT
#undef MLA_PV
#undef MLA_ROWMAX
#undef MLA_STEP
}

constexpr int NVP = 144;
__device__ __forceinline__ void na_unit(int u, int L, int l, const float* rpb_all, const bf16* proj, bf16* ya, LAS unsigned char* lds) {
    const int tid = ltid(); const int lane = tid & 63, w = tid >> 6, i16 = lane & 15, quad = lane >> 4;
    const int rows = L >> 6; const int hq = u & 3, sr = u >> 2, r = sr % rows, s = sr / rows;
    const int h = 2 * hq + (w >> 2), j = w & 3;
    const int rs = min(max(r - 4, 0), rows - 8), kc0 = min(max(16 * j - 8, 0), 32);
    const size_t base = (size_t)s * L;
    const size_t qtok = base + r * 64 + 16 * j + i16;
    bf16x8 qf[2];
    qf[0] = *(const bf16x8*)(proj + qtok * DPROJ + h * 64 + quad * 8); qf[1] = *(const bf16x8*)(proj + qtok * DPROJ + h * 64 + 32 + quad * 8);
    const int cA = (i16 >> 2) * 8 + (i16 & 3);
    f32x4 sa[8], sb[8];
#pragma unroll
    for (int wr = 0; wr < 8; ++wr) {
        const bf16* kp = proj + (base + (size_t)(rs + wr) * 64 + kc0 + cA) * DPROJ + C_KA + h * 64 + quad * 8;
        const bf16x8 ka0 = *(const bf16x8*)kp, ka1 = *(const bf16x8*)(kp + 32), kb0 = *(const bf16x8*)(kp + 4 * DPROJ), kb1 = *(const bf16x8*)(kp + 4 * DPROJ + 32);
        f32x4 a = {0.f, 0.f, 0.f, 0.f}, b = {0.f, 0.f, 0.f, 0.f};
        a = __builtin_amdgcn_mfma_f32_16x16x32_bf16(ka0, qf[0], a, 0, 0, 0); a = __builtin_amdgcn_mfma_f32_16x16x32_bf16(ka1, qf[1], a, 0, 0, 0);
        b = __builtin_amdgcn_mfma_f32_16x16x32_bf16(kb0, qf[0], b, 0, 0, 0); b = __builtin_amdgcn_mfma_f32_16x16x32_bf16(kb1, qf[1], b, 0, 0, 0);
        sa[wr] = a; sb[wr] = b;
    }
    const int qc = 16 * j + i16, wst = min(max(qc - 8, 0), 48);
    const float* rpb = rpb_all + (size_t)(l * 8 + h) * 15 * 31;
    float mx = -1e30f;
#pragma unroll
    for (int wr = 0; wr < 8; ++wr) { const float* rb = rpb + (rs + wr - r + 7) * 31;
#pragma unroll
        for (int jj = 0; jj < 4; ++jj) {
            { const int kc = kc0 + quad * 8 + jj; const bool ok = (kc >= wst) && (kc < wst + 16); const int dc = min(max(kc - qc + 15, 0), 30);
              const float v = ok ? (sa[wr][jj] + rb[dc] * LOG2E) : -1e30f; sa[wr][jj] = v; mx = fmaxf(mx, v); }
            { const int kc = kc0 + quad * 8 + 4 + jj; const bool ok = (kc >= wst) && (kc < wst + 16); const int dc = min(max(kc - qc + 15, 0), 30);
              const float v = ok ? (sb[wr][jj] + rb[dc] * LOG2E) : -1e30f; sb[wr][jj] = v; mx = fmaxf(mx, v); }
        } }
    mx = fmaxf(mx, __shfl_xor(mx, 16)); mx = fmaxf(mx, __shfl_xor(mx, 32));
    float ls = 0.f;
#pragma unroll
    for (int wr = 0; wr < 8; ++wr)
#pragma unroll
        for (int jj = 0; jj < 4; ++jj) { sa[wr][jj] = __builtin_amdgcn_exp2f(sa[wr][jj] - mx); sb[wr][jj] = __builtin_amdgcn_exp2f(sb[wr][jj] - mx); ls += sa[wr][jj] + sb[wr][jj]; }
    ls += __shfl_xor(ls, 16); ls += __shfl_xor(ls, 32);
    LAS unsigned char* vw = lds + w * (64 * NVP);
    f32x4 oc[4];
#pragma unroll
    for (int db = 0; db < 4; ++db) oc[db] = (f32x4){0.f, 0.f, 0.f, 0.f};
    const int toff = (quad * 8 + (i16 >> 2)) * NVP + (4 * (lane & 3)) * 2;
#pragma unroll
    for (int ck = 0; ck < 4; ++ck) {
        v4u tmp[8];
#pragma unroll
        for (int it = 0; it < 8; ++it) { const int idx = it * 64 + lane, key = idx >> 3, ch = idx & 7;
            tmp[it] = *(const v4u*)(proj + (base + (size_t)(rs + 2 * ck + (key >> 5)) * 64 + kc0 + (key & 31)) * DPROJ + C_VA + h * 64 + ch * 8); }
        asm volatile("s_waitcnt lgkmcnt(0)" ::: "memory");
#pragma unroll
        for (int it = 0; it < 8; ++it) { const int idx = it * 64 + lane, key = idx >> 3, ch = idx & 7; *(LAS v4u*)(vw + key * NVP + ch * 16) = tmp[it]; }
        asm volatile("s_waitcnt lgkmcnt(0)" ::: "memory");
#pragma unroll
        for (int wl = 0; wl < 2; ++wl) { const int wr = 2 * ck + wl;
            v4u pw; pw.x = pk2(sa[wr][0], sa[wr][1]); pw.y = pk2(sa[wr][2], sa[wr][3]); pw.z = pk2(sb[wr][0], sb[wr][1]); pw.w = pk2(sb[wr][2], sb[wr][3]);
            const bf16x8 pf = __builtin_bit_cast(bf16x8, pw);
#pragma unroll
            for (int db = 0; db < 4; ++db) { const int vb = toff + wl * 32 * NVP + db * 32;
                const s16x4 t0 = __builtin_amdgcn_ds_read_tr16_b64_v4i16((LAS s16x4*)(vw + vb)), t1 = __builtin_amdgcn_ds_read_tr16_b64_v4i16((LAS s16x4*)(vw + vb + 4 * NVP));
                const bf16x8 vf = {t0[0], t0[1], t0[2], t0[3], t1[0], t1[1], t1[2], t1[3]};
                oc[db] = __builtin_amdgcn_mfma_f32_16x16x32_bf16(vf, pf, oc[db], 0, 0, 0); }
        }
    }
    const float inv = 1.f / ls;
    bf16* orow = ya + qtok * 512 + h * 64 + quad * 4;
#pragma unroll
    for (int db = 0; db < 4; ++db) { v2u o; o.x = pk2(oc[db][0] * inv, oc[db][1] * inv); o.y = pk2(oc[db][2] * inv, oc[db][3] * inv); *(v2u*)(orow + db * 16) = o; }
}

#define XB_TMO      128
#define XB_XCNT(j)  (256  + 64 * (j))
#define XB_XSUB(j)  (1280 + 64 * (j))
#define XB_XGEN(j)  (2304 + 64 * (j))
#define XB_TOP      3328
#define XB_TOPGEN   3392
#define XCD_BAR_WORDS 3456
#define XB_SPIN_CAP (1u << 18)

__device__ __forceinline__ unsigned xb_ld(unsigned* p)              { return __hip_atomic_load(p, __ATOMIC_RELAXED, __HIP_MEMORY_SCOPE_AGENT); }
__device__ __forceinline__ unsigned xb_add(unsigned* p, unsigned v) { return __hip_atomic_fetch_add(p, v, __ATOMIC_RELAXED, __HIP_MEMORY_SCOPE_AGENT); }
__device__ __forceinline__ unsigned xb_xcc_id() { return (unsigned)__builtin_amdgcn_s_getreg((3 << 11) | 20) & 0xFu; }
#define XB_SPIN(cond, bar) do { unsigned _sp = 0; while (cond) { __builtin_amdgcn_s_sleep(1); \
    if ((++_sp & 255u) == 0u) { if (xb_ld(&(bar)[XB_TMO])) break; if (_sp > XB_SPIN_CAP) { atomicAdd(&(bar)[XB_TMO], 1u); break; } } } } while (0)

struct XcdBarrier {
    unsigned* bar; unsigned x;
    volatile LAS unsigned* st;
};

__device__ __forceinline__ XcdBarrier xcd_barrier_post(unsigned* bar, volatile LAS unsigned* st) {
    XcdBarrier b; b.bar = bar; b.x = xb_xcc_id(); b.st = st;
    if (threadIdx.x == 0) (void)xb_add(&bar[XB_XCNT(b.x)], 1u);
    return b;
}
__device__ __forceinline__ void xcd_barrier_complete(unsigned* bar, unsigned x, unsigned& nloc, unsigned& nx) {
    const unsigned G = gridDim.x * gridDim.y * gridDim.z;
    unsigned sum, cnt, mine, sp = 0u;
    for (;;) {
        sum = 0u; cnt = 0u; mine = 0u;
#pragma unroll
        for (unsigned j = 0; j < 16; ++j) { const unsigned c = xb_ld(&bar[XB_XCNT(j)]); sum += c; cnt += (c > 0u) ? 1u : 0u; mine = (j == x) ? c : mine; }
        if (sum == G) break;
        __builtin_amdgcn_s_sleep(1);
        if ((++sp & 255u) == 0u) { if (xb_ld(&bar[XB_TMO])) break; if (sp > XB_SPIN_CAP) { atomicAdd(&bar[XB_TMO], 1u); break; } }
    }
    nloc = mine > 0u ? mine : 1u; nx = cnt > 0u ? cnt : 1u;
}

__device__ __forceinline__ void xcd_barrier(const XcdBarrier& b) {
    asm volatile("s_waitcnt vmcnt(0)" ::: "memory");
    __syncthreads();
    if (threadIdx.x == 0) {
        unsigned* bar = b.bar;
        __builtin_amdgcn_s_waitcnt(0);
        unsigned nloc = b.st[0], nx = b.st[1];
        if (nloc == 0u) { xcd_barrier_complete(bar, b.x, nloc, nx); b.st[0] = nloc; b.st[1] = nx; }
        const unsigned old = xb_add(&bar[XB_XSUB(b.x)], 1u);
        const unsigned gen = old / nloc;
        if (old + 1u == (gen + 1u) * nloc) {
            __builtin_amdgcn_fence(__ATOMIC_RELEASE, "agent");
            asm volatile("s_waitcnt vmcnt(0)" ::: "memory");
            const unsigned og = xb_add(&bar[XB_TOP], 1u);
            const unsigned tg = og / nx;
            if (og + 1u == (tg + 1u) * nx) xb_add(&bar[XB_TOPGEN], 1u);
            else XB_SPIN(xb_ld(&bar[XB_TOPGEN]) == tg, bar);
            __builtin_amdgcn_fence(__ATOMIC_ACQUIRE, "agent");
            xb_add(&bar[XB_XGEN(b.x)], 1u);
            asm volatile("s_waitcnt vmcnt(0)" ::: "memory");
        } else {
            XB_SPIN(xb_ld(&bar[XB_XGEN(b.x)]) == gen, bar);
            __builtin_amdgcn_fence(__ATOMIC_ACQUIRE, "agent");
            asm volatile("s_waitcnt vmcnt(0)" ::: "memory");
        }
    }
    __syncthreads();
}

constexpr int NPH = 13;
__device__ __forceinline__ void run_phase(CP pp, int st, LAS unsigned char* lds) {
    volatile LAS unsigned* lctl = (volatile LAS unsigned*)(lds + LDS_RING);
    const int tid = ltid(), lane = tid & 63, wave = __builtin_amdgcn_readfirstlane(tid >> 6);
    int bid_ = blockIdx.x; asm volatile("" : "+s"(bid_));
    const int NB = gridDim.x, gw = bid_ * 8 + wave, ngw = NB * 8;
    const int ph = st % NPH, gl = st / NPH, l = gl & 1, g = gl >> 1;
    unsigned char* ws = pp->ws; const int Tg = pp->Tg;
    const Reg R{ws, (size_t)Tg};
    const size_t asz = (size_t)Tg * 512;
    const int t0 = g * Tg; const int L = (t0 < NPROMPT) ? 8192 : 4096;
    float* xout = pp->out + (size_t)t0 * DM;
    int gid0 = 0, gidn = 0;
    switch (ph) {
    case 0: {
        const float* xin = (l == 0) ? ((t0 < NPROMPT) ? pp->in[0] + (size_t)t0 * DM : pp->in[1] + (size_t)(t0 - NPROMPT) * DM) : xout;
        phase_norm(xin, pp->in[2] + l * DM, R.RH(), Tg, gw, ngw, lane);
    } break;
    case 1: gid0 = GM_IN; gidn = 1; break;
    case 2: {
        phase_post_proj(pp, l, R.RP(), R.RA(), R.RA() + (size_t)Tg * 384, R.RS(), (_Float16*)R.RZ(), asz, Tg, L, gw, ngw, lane);
    } break;
    case 3: gid0 = GM_MU; gidn = 2; break;
    case 4: {
        phase_mla_post(pp, l, R.RM(), R.RP(), R.RA(), Tg, L, gw, ngw, lane);
    } break;
    case 5: {
        unsigned* qctr = (unsigned*)(ws + WS_CTL) + 64 * gl; const int nseq = Tg / L;
        const int NS = nseq * 16, NM = nseq * 8 * (L >> 8), NN = nseq * (L >> 6) * 4, NTOT = NS + NM + NN;
        for (;;) {
            __syncthreads();
            if (tid == 0) lctl[0] = atomicAdd(qctr, 1u);
            __syncthreads();
            const int u = __builtin_amdgcn_readfirstlane((int)lctl[0]);
            if (u >= NTOT) break;
            if (u < NS) scan_unit(u, L, R.RS(), asz, R.RZ(), lds);
            else if (u < NS + NM) mla_unit(u - NS, L, R.RM(), R.RA(), R.RY() + asz, lds);
            else na_unit(u - NS - NM, L, l, pp->in[7], R.RP(), R.RY(), lds);
        }
    } break;
    case 6: {
        phase_rw_post(pp, l, R.RS(), asz, R.RZ(), R.RY() + 2 * asz, Tg, gw, ngw, lane);
    } break;
    case 7: gid0 = GM_GATE; gidn = 1; break;
    case 8: gid0 = GM_BR0; gidn = 3; break;
    case 9: gid0 = GM_OUT; gidn = 1; break;
    case 10: {
        phase_norm(xout, pp->in[29] + l * DM, R.RH(), Tg, gw, ngw, lane);
    } break;
    case 11: gid0 = GM_GU; gidn = 1; break;
    case 12: gid0 = GM_DN; gidn = 1; break;
    default: break;
    }
#pragma unroll 1
    for (int id = gid0; id < gid0 + gidn; ++id) {
        const unsigned char* wb = ws + W_OFF + (size_t)l * W_STRIDE;
        const bf16* A; const bf16* Bt; int N, K;
        switch (id) {
        case GM_IN:   A = R.RH(); Bt = (const bf16*)(wb + WO_IN); N = DPROJ; K = 1024; break;
        case GM_MU:   A = R.RA(); Bt = (const bf16*)(wb + WO_MU); N = 1792; K = 384; break;
        case GM_RU:   A = R.RA() + (size_t)Tg * 384; Bt = (const bf16*)(wb + WO_RU); N = 2560; K = 384; break;
        case GM_GATE: A = R.RH(); Bt = (const bf16*)(wb + WO_G); N = DGATE; K = 1024; break;
        case GM_BR0: case GM_BR1: case GM_BR2: A = R.RY() + (size_t)(id - GM_BR0) * asz; Bt = (const bf16*)(wb + WO_BR + (size_t)(id - GM_BR0) * MiB); N = DM; K = 512; break;
        case GM_OUT:  A = R.RM(); Bt = (const bf16*)(wb + WO_OUT); N = DM; K = 1024; break;
        case GM_GU:   A = R.RH(); Bt = (const bf16*)(wb + WO_GU); N = 2 * DFF; K = 1024; break;
        default:      A = R.RP(); Bt = (const bf16*)(wb + WO_DN); N = DM; K = DFF; break;
        }
        pg8::Gemm gm{A, Bt, Tg, N, K, (id == GM_MU) ? 1 : ((id == GM_RU) ? 2 : 0)}; pg8::StaticOrder S; S.init(Tg, N, NB, bid_);
        EpiUni E{pp, id, l, g}; pg8::gemm_phase<EpiUni, pg8::StaticOrder, true, true>(lds, gm, S, E);
    }
}

__device__ __forceinline__ void run_phase0(CP pp, int part, LAS unsigned char* lds) {
    const int tid = ltid(), lane = tid & 63, wave = __builtin_amdgcn_readfirstlane(tid >> 6);
    const int NB = gridDim.x, gw = blockIdx.x * 8 + wave, ngw = NB * 8;
    const size_t gtid = (size_t)blockIdx.x * 512 + tid, ngt = (size_t)NB * 512;
    unsigned char* ws = pp->ws;
    if (part == 0) {
        for (int l = 0; l < 2; ++l) { unsigned char* wb = ws + W_OFF + (size_t)l * W_STRIDE;
            zero_bytes(wb + WO_IN + (size_t)NMAIN * 2048, (size_t)(DPROJ - NMAIN) * 2048, gtid, ngt);
            zero_bytes(wb + WO_MU, (size_t)1792 * 384 * 2, gtid, ngt);
            zero_bytes(wb + WO_RU, (size_t)2560 * 384 * 2, gtid, ngt); }
    } else {
        LAS float* scr = (LAS float*)(lds + wave * 16384);
#pragma unroll 1
        for (int l = 0; l < 2; ++l) { unsigned char* wb = ws + W_OFF + (size_t)l * W_STRIDE;
            const float* w_in = pp->in[3] + (size_t)l * DM * DIN;
            transpose_job(w_in, DIN, 1024, NMAIN, (bf16*)(wb + WO_IN), 1024, 0, 0, 0, scr, gw, ngw, lane);
            transpose_job(w_in + NMAIN, DIN, 1024, DGATE, (bf16*)(wb + WO_G), 1024, 0, 0, 0, scr, gw, ngw, lane);
            transpose_job(pp->in[8] + (size_t)l * 512 * 1024, 1024, 512, 1024, (bf16*)(wb + WO_BR), 512, 0, 0, 0, scr, gw, ngw, lane);
            transpose_job(pp->in[15] + (size_t)l * 512 * 1024, 1024, 512, 1024, (bf16*)(wb + WO_BR + 1 * MiB), 512, 0, 0, 0, scr, gw, ngw, lane);
            transpose_job(pp->in[27] + (size_t)l * 512 * 1024, 1024, 512, 1024, (bf16*)(wb + WO_BR + 2 * MiB), 512, 0, 0, 0, scr, gw, ngw, lane);
            transpose_job(pp->in[28] + (size_t)l * 1024 * 1024, 1024, 1024, 1024, (bf16*)(wb + WO_OUT), 1024, 0, 0, 0, scr, gw, ngw, lane);
            transpose_job(pp->in[30] + (size_t)l * 1024 * DFF, DFF, 1024, DFF, (bf16*)(wb + WO_GU), 1024, 0, 0, 1, scr, gw, ngw, lane);
            transpose_job(pp->in[31] + (size_t)l * 1024 * DFF, DFF, 1024, DFF, (bf16*)(wb + WO_GU), 1024, 0, 128, 1, scr, gw, ngw, lane);
            transpose_job(pp->in[32] + (size_t)l * DFF * 1024, 1024, DFF, 1024, (bf16*)(wb + WO_DN), DFF, 0, 0, 0, scr, gw, ngw, lane);
            transpose_job(pp->in[11] + (size_t)l * 256 * 768, 768, 256, 768, (bf16*)(wb + WO_MU), 384, 0, 0, 0, scr, gw, ngw, lane);
            transpose_job(pp->in[12] + (size_t)l * 128 * 1024, 1024, 128, 1024, (bf16*)(wb + WO_MU), 384, 256, 768, 0, scr, gw, ngw, lane);
#pragma unroll 1
            for (int d = 0; d < 2; ++d) {
                transpose_job(pp->in[18] + (size_t)(l * 2 + d) * 64 * 512, 512, 64, 512, (bf16*)(wb + WO_RU), 384, 64 * d, 512 * d, 0, scr, gw, ngw, lane);
                transpose_job(pp->in[20] + (size_t)(l * 2 + d) * 64 * 512, 512, 64, 512, (bf16*)(wb + WO_RU), 384, 128 + 64 * d, 1024 + 512 * d, 0, scr, gw, ngw, lane); }
            transpose_job(pp->in[21] + (size_t)l * 128 * 512, 512, 128, 512, (bf16*)(wb + WO_RU), 384, 256, 2048, 0, scr, gw, ngw, lane);
        }
    }
}

__global__ void __launch_bounds__(512, 2) mega(Params p) {
    extern __shared__ __attribute__((aligned(16))) unsigned char lds_raw[];
    LAS unsigned char* lds = (LAS unsigned char*)lds_raw;
    cg::grid_group grid = cg::this_grid();
    if (blockIdx.x == 0 && threadIdx.x == 0) { Params* d = (Params*)(p.ws + WS_PARAMS); *d = p; }
    const int nsteps = p.G * 2 * NPH;
    volatile LAS unsigned* bst = (volatile LAS unsigned*)(lds + LDS_RING + 32);
    if (threadIdx.x == 0) { bst[0] = 0u; bst[1] = 0u; }
    __syncthreads();
    const XcdBarrier bar = xcd_barrier_post((unsigned*)(p.ws + WS_CTL) + 4096, bst);
    grid.sync();
#pragma unroll 1
    for (int st = -2; st < nsteps; ++st) {
        int s2 = st; asm volatile("" : "+s"(s2));
        CP pp = (CP)(p.ws + WS_PARAMS); asm volatile("" : "+s"(pp));
        if (s2 < 0) run_phase0(pp, s2 + 2, lds); else run_phase(pp, s2, lds);
        xcd_barrier(bar);
    }
}

extern "C" void kernel_launch(void* const* d_in, const int* in_sizes, int n_in, void* d_out, int out_size, void* d_ws, size_t ws_size, hipStream_t stream) {
    static int grid = 0;
    if (grid == 0) {
        int dev = 0, cus = 0, per_cu = 0;
        hipGetDevice(&dev); hipDeviceGetAttribute(&cus, hipDeviceAttributeMultiprocessorCount, dev);
        hipFuncSetAttribute((const void*)mega, hipFuncAttributeMaxDynamicSharedMemorySize, LDS_BYTES);
        hipOccupancyMaxActiveBlocksPerMultiprocessor(&per_cu, (const void*)mega, 512, LDS_BYTES);
        (void)hipGetLastError();
        if (per_cu < 1) per_cu = 1;
        grid = cus * per_cu;
    }
    int G = 2;
    while (G < 16 && ACT_OFF + (size_t)(NTOK / G) * TOKB > ws_size) G *= 2;
    if (hipMemsetAsync((char*)d_ws + WS_CTL, 0, CTL_BYTES, stream) != hipSuccess) { fprintf(stderr, "kernel_launch: memset failed\n"); return; }
    Params p{};
    for (int i = 0; i < 33; ++i) p.in[i] = (const float*)d_in[i];
    p.out = (float*)d_out; p.ws = (unsigned char*)d_ws; p.G = G; p.Tg = NTOK / G;
    void* args[] = {&p};
    hipError_t e = hipLaunchCooperativeKernel((const void*)mega, dim3(grid), dim3(512), args, LDS_BYTES, stream);
    if (e != hipSuccess) fprintf(stderr, "cooperative launch failed: %s (grid %d)\n", hipGetErrorString(e), grid);
}
```

```cpp
#include <hip/hip_runtime.h>
#include <hip/hip_cooperative_groups.h>
#include <cstdio>
#include <cstdint>
namespace cg = cooperative_groups;
namespace pg8 {
#define PG8_LAS __attribute__((address_space(3)))
typedef unsigned short bf16_t;
typedef short bf16x8 __attribute__((ext_vector_type(8)));
typedef float f32x4 __attribute__((ext_vector_type(4)));
typedef unsigned u32x4 __attribute__((ext_vector_type(4)));
constexpr int BM = 256, BK = 64, HALF = 128, HTB = HALF * BK * 2  , STAGE_BYTES = 8 * HTB, NXCD = 8, WGM = 8;

__host__ __device__ __forceinline__ int lds_byte(int r, int c) { const int st = (r >> 4) * 2 + (c >> 5), rr = r & 15, cc = c & 31, ob = rr * 64 + cc * 2; return st * 1024 + (ob ^ (((ob >> 9) & 1) << 5)); }
__host__ __device__ __forceinline__ void stage_rc(int b, int& R, int& C) { const int st = b / 1024, sb = b % 1024, swz = sb ^ (((sb >> 9) & 1) << 5); R = (st >> 1) * 16 + swz / 64; C = (st & 1) * 32 + (swz % 64) / 2; }
__host__ __device__ __forceinline__ int perm32(int rho) { const int n = rho >> 4, i = rho & 15; return 8 * (i >> 2) + 4 * n + (i & 3); }

struct Unit { int pm, pn; };
struct Gemm { const bf16_t* A; const bf16_t* Bt; int M, N, K; int kmode; };
__device__ __forceinline__ void krange(int kmode, int pn, int K, int& kof, int& nt) {
    kof = 0; nt = K / BK;
    if (kmode == 1) { if (pn < 3) { nt = 4; } else { kof = 256; nt = 2; } }
    else if (kmode == 2) { kof = (pn < 4) ? 0 : ((pn < 8) ? 128 : 256); nt = 2; }
}

struct StaticOrder {
    int nM, nN, nwg, G, c;
    __host__ __device__ void init(int M, int N, int G_, int c_) { nM = M / BM; nN = N / BM; nwg = nM * nN; G = G_; c = c_; }
    __host__ __device__ bool next(int i, Unit& u) const {
        const long L = (long)i * G + c; if (L >= nwg) return false;
        int wgid = (int)L; { const int q = nwg / NXCD, r = nwg % NXCD, xcd = wgid % NXCD, off = wgid / NXCD; wgid = (xcd < r ? xcd * (q + 1) : r * (q + 1) + (xcd - r) * q) + off; }
        const int nig = WGM * nN, gid = wgid / nig, fm = gid * WGM, gsz = (nM - fm) < WGM ? (nM - fm) : WGM;
        u.pm = fm + ((wgid % nig) % gsz); u.pn = (wgid % nig) / gsz; return true;
    }
    __device__ __forceinline__ void a_ready(const Unit&) const {}
    __device__ __forceinline__ void done(const Unit&) const {}
};

__device__ __forceinline__ unsigned cvt_pk_bf16(float lo, float hi) { unsigned r; asm volatile("v_cvt_pk_bf16_f32 %0, %1, %2" : "=v"(r) : "v"(lo), "v"(hi)); return r; }
typedef float f32x2 __attribute__((ext_vector_type(2)));
}
namespace pg8 {
template <class Epi, class Sched, bool ALIGN_EPI = false, bool SP2 = false>
__device__ __forceinline__ void gemm_phase(PG8_LAS unsigned char* lds, const Gemm g, const Sched& S, const Epi& E) {
    int tid_l = threadIdx.x; asm volatile("" : "+v"(tid_l)); const int tid = tid_l, wid = __builtin_amdgcn_readfirstlane(tid >> 6), lane = tid & 63, wr = wid >> 2, wc = wid & 3, fr = lane & 15, fq = lane >> 4;
    const int K = g.K; int nt = K / BK;
    unsigned voffA[2], voffB[2];
#pragma unroll
    for (int i = 0; i < 2; ++i) { int R, C; stage_rc(tid * 16 + i * 8192, R, C); const int Rb = Epi::PERM ? ((R & ~31) + perm32(R & 31)) : R;
        voffA[i] = (unsigned)(R * K + C) * 2u; voffB[i] = (unsigned)(Rb * K + C) * 2u; }
    const size_t kstep = (size_t)(BK * 2);
    const size_t hstep = (size_t)HALF * K * 2;
    const size_t tstep = 2 * hstep;
    const unsigned ldsw = (unsigned)wid * 1024u;
    const int aoff = lds_byte(wr * 64 + fr, fq * 8), boff = lds_byte(wc * 32 + fr, fq * 8);
#define PG8_SA(b, h) (((b) * 2 + (h)) * HTB)
#define PG8_SB(b, h) ((4 + (b) * 2 + (h)) * HTB)
#define PG8_STAGE(bufoff, gbase, voff) do { _Pragma("unroll") for (int _i = 0; _i < 2; ++_i) \
        __builtin_amdgcn_global_load_lds((const unsigned*)((const char*)(gbase) + (voff)[_i]), (PG8_LAS unsigned*)(lds + (bufoff) + ldsw + _i * 8192), 16, 0, 0); } while (0)
#define PG8_LDA(dst, b, h) do { _Pragma("unroll") for (int m = 0; m < 4; ++m) _Pragma("unroll") for (int k = 0; k < 2; ++k) dst[m][k] = *(const PG8_LAS bf16x8*)(lds + PG8_SA(b, h) + aoff + m * 2048 + k * 1024); } while (0)
#define PG8_LDB(dst, b, h) do { _Pragma("unroll") for (int n = 0; n < 2; ++n) _Pragma("unroll") for (int k = 0; k < 2; ++k) dst[n][k] = *(const PG8_LAS bf16x8*)(lds + PG8_SB(b, h) + boff + n * 2048 + k * 1024); } while (0)
#define PG8_MMA(ai, bj, At, Bt) do { __builtin_amdgcn_s_setprio(1); _Pragma("unroll") for (int m = 0; m < 4; ++m) _Pragma("unroll") for (int n = 0; n < 2; ++n) _Pragma("unroll") for (int k = 0; k < 2; ++k) \
        acc[ai][bj][m][n] = __builtin_amdgcn_mfma_f32_16x16x32_bf16(Bt[n][k], At[m][k], acc[ai][bj][m][n], 0, 0, 0); __builtin_amdgcn_s_setprio(0); } while (0)
#define PG8_WAIT_V(n) asm volatile("s_waitcnt vmcnt(" #n ")" ::: "memory")
#define PG8_WAIT_L(n) asm volatile("s_waitcnt lgkmcnt(" #n ")" ::: "memory")
#define PG8_BAR __builtin_amdgcn_s_barrier()
#define PG8_SCHED __builtin_amdgcn_sched_barrier(0)
    Unit cur, nxt; int ui = 0;
    if (!S.next(0, cur)) return;
    f32x4 acc[2][2][4][2];
#pragma unroll
    for (int a = 0; a < 2; ++a)
#pragma unroll
        for (int b = 0; b < 2; ++b)
#pragma unroll
            for (int m = 0; m < 4; ++m)
#pragma unroll
                for (int n = 0; n < 2; ++n) acc[a][b][m][n] = (f32x4){0.f, 0.f, 0.f, 0.f};
    bf16x8 At[4][2], B0[2][2], B1[2][2];
    int kofc_; krange(g.kmode, cur.pn, K, kofc_, nt);
    const char* cA = (const char*)g.A + (size_t)cur.pm * tstep + (size_t)kofc_ * 2; const char* cB = (const char*)g.Bt + (size_t)cur.pn * tstep + (size_t)kofc_ * 2;
    S.a_ready(cur);
    if constexpr (SP2) {
        PG8_STAGE(PG8_SB(0, 0), cB, voffB); PG8_STAGE(PG8_SB(0, 1), cB + hstep, voffB); PG8_STAGE(PG8_SA(0, 0), cA, voffA); PG8_STAGE(PG8_SA(0, 1), cA + hstep, voffA);
        if (wr == 1) PG8_BAR;
        PG8_WAIT_V(2); PG8_BAR;
        PG8_STAGE(PG8_SB(1, 0), cB + kstep, voffB); PG8_STAGE(PG8_SA(1, 0), cA + kstep, voffA); PG8_STAGE(PG8_SB(1, 1), cB + hstep + kstep, voffB);
        PG8_WAIT_V(6); PG8_BAR;
    } else {
        PG8_STAGE(PG8_SB(0, 0), cB, voffB); PG8_STAGE(PG8_SA(0, 0), cA, voffA); PG8_STAGE(PG8_SB(0, 1), cB + hstep, voffB); PG8_STAGE(PG8_SA(0, 1), cA + hstep, voffA);
        if (wr == 1) PG8_BAR;
        PG8_WAIT_V(4); PG8_BAR;
        PG8_STAGE(PG8_SB(1, 0), cB + kstep, voffB); PG8_STAGE(PG8_SA(1, 0), cA + kstep, voffA); PG8_STAGE(PG8_SB(1, 1), cB + hstep + kstep, voffB);
        PG8_WAIT_V(6); PG8_BAR;
    }
    for (;;) {
        const bool has_next = S.next(ui + 1, nxt);
        int kofn_ = 0, ntn_ = nt; if (has_next) krange(g.kmode, nxt.pn, K, kofn_, ntn_);
        const char* nA = has_next ? (const char*)g.A + (size_t)nxt.pm * tstep + (size_t)kofn_ * 2 : cA; const char* nB = has_next ? (const char*)g.Bt + (size_t)nxt.pn * tstep + (size_t)kofn_ * 2 : cB;
        for (int t = 0; t < nt; t += 2) {
            const bool last = (t == nt - 2);
            const char* a1 = cA + (size_t)(t + 1) * kstep;
            const char* a2 = last ? nA : cA + (size_t)(t + 2) * kstep; const char* b2 = last ? nB : cB + (size_t)(t + 2) * kstep;
            const char* a3 = a2 + kstep; const char* b3 = b2 + kstep;
            if (last && has_next) S.a_ready(nxt);
            if constexpr (SP2) {
            PG8_LDB(B0, 0, 0); PG8_LDB(B1, 0, 1); PG8_SCHED; PG8_LDA(At, 0, 0); PG8_STAGE(PG8_SA(1, 1), a1 + hstep, voffA);
            PG8_WAIT_V(8); PG8_WAIT_L(0); PG8_BAR; PG8_MMA(0, 0, At, B0); PG8_MMA(0, 1, At, B1); PG8_BAR; PG8_SCHED;
            PG8_LDA(At, 0, 1); PG8_STAGE(PG8_SB(0, 0), b2, voffB); PG8_STAGE(PG8_SB(0, 1), b2 + hstep, voffB); PG8_STAGE(PG8_SA(0, 0), a2, voffA);
            PG8_WAIT_V(8); PG8_WAIT_L(0); PG8_BAR; PG8_MMA(1, 0, At, B0); PG8_MMA(1, 1, At, B1); PG8_BAR; PG8_SCHED;
            PG8_LDB(B0, 1, 0); PG8_LDB(B1, 1, 1); PG8_SCHED; PG8_LDA(At, 1, 0); PG8_STAGE(PG8_SA(0, 1), a2 + hstep, voffA);
            PG8_WAIT_V(8); PG8_WAIT_L(0); PG8_BAR; PG8_MMA(0, 0, At, B0); PG8_MMA(0, 1, At, B1); PG8_BAR; PG8_SCHED;
            PG8_LDA(At, 1, 1); PG8_STAGE(PG8_SB(1, 0), b3, voffB); PG8_STAGE(PG8_SB(1, 1), b3 + hstep, voffB); PG8_STAGE(PG8_SA(1, 0), a3, voffA);
            PG8_WAIT_V(8); PG8_WAIT_L(0); PG8_BAR; PG8_MMA(1, 0, At, B0); PG8_MMA(1, 1, At, B1); PG8_BAR; PG8_SCHED;
            } else {
            PG8_LDB(B0, 0, 0); PG8_SCHED; PG8_LDA(At, 0, 0); PG8_STAGE(PG8_SA(1, 1), a1 + hstep, voffA);
            PG8_WAIT_L(8); PG8_BAR; PG8_WAIT_L(0); PG8_MMA(0, 0, At, B0); PG8_BAR; PG8_SCHED;
            PG8_LDB(B1, 0, 1); PG8_STAGE(PG8_SB(0, 0), b2, voffB);
            PG8_BAR; PG8_WAIT_L(0); PG8_MMA(0, 1, At, B1); PG8_BAR;
            PG8_LDA(At, 0, 1); PG8_STAGE(PG8_SA(0, 0), a2, voffA);
            PG8_BAR; PG8_WAIT_L(0); PG8_MMA(1, 0, At, B0); PG8_BAR; PG8_SCHED;
            PG8_STAGE(PG8_SB(0, 1), b2 + hstep, voffB);
            PG8_WAIT_V(6); PG8_BAR; PG8_MMA(1, 1, At, B1); PG8_BAR;
            PG8_LDB(B0, 1, 0); PG8_SCHED; PG8_LDA(At, 1, 0); PG8_STAGE(PG8_SA(0, 1), a2 + hstep, voffA);
            PG8_WAIT_L(8); PG8_BAR; PG8_WAIT_L(0); PG8_MMA(0, 0, At, B0); PG8_BAR; PG8_SCHED;
            PG8_LDB(B1, 1, 1); PG8_STAGE(PG8_SB(1, 0), b3, voffB);
            PG8_BAR; PG8_WAIT_L(0); PG8_MMA(0, 1, At, B1); PG8_BAR;
            PG8_LDA(At, 1, 1); PG8_STAGE(PG8_SA(1, 0), a3, voffA);
            PG8_BAR; PG8_WAIT_L(0); PG8_MMA(1, 0, At, B0); PG8_BAR; PG8_SCHED;
            PG8_STAGE(PG8_SB(1, 1), b3 + hstep, voffB);
            PG8_WAIT_V(6); PG8_BAR; PG8_MMA(1, 1, At, B1); PG8_BAR;
            }
        }
        if constexpr (ALIGN_EPI) { if (wr == 0) PG8_BAR; }
        if constexpr (!Epi::AFTER_DRAIN) { E(acc, cur, wr, wc, fr, fq); S.done(cur); }
        if (!has_next) break;
#pragma unroll
        for (int a = 0; a < 2; ++a)
#pragma unroll
            for (int b = 0; b < 2; ++b)
#pragma unroll
                for (int m = 0; m < 4; ++m)
#pragma unroll
                    for (int n = 0; n < 2; ++n) acc[a][b][m][n] = (f32x4){0.f, 0.f, 0.f, 0.f};
        cur = nxt; cA = nA; cB = nB; nt = ntn_; ++ui;
        if constexpr (ALIGN_EPI) { if (wr == 1) PG8_BAR; }
    }
    PG8_WAIT_V(0);
    if constexpr (!ALIGN_EPI) { if (wr == 0) PG8_BAR; }
    PG8_BAR;
    if constexpr (Epi::AFTER_DRAIN) { E.fused(acc, cur, wr, wc, fr, fq, lds, wid, lane); S.done(cur); }
#undef PG8_SA
#undef PG8_SB
#undef PG8_STAGE
#undef PG8_LDA
#undef PG8_LDB
#undef PG8_MMA
#undef PG8_WAIT_V
#undef PG8_WAIT_L
#undef PG8_BAR
#undef PG8_SCHED
}
}

#define LAS __attribute__((address_space(3)))
typedef unsigned short bf16;
typedef unsigned v4u __attribute__((ext_vector_type(4)));
typedef unsigned v2u __attribute__((ext_vector_type(2)));
typedef float f32x4 __attribute__((ext_vector_type(4)));
typedef float f32x16 __attribute__((ext_vector_type(16)));
typedef short bf16x8 __attribute__((ext_vector_type(8)));
typedef short s16x4 __attribute__((ext_vector_type(4)));
typedef _Float16 h8 __attribute__((ext_vector_type(8)));

__device__ __forceinline__ unsigned pk2(float lo, float hi) { return pg8::cvt_pk_bf16(lo, hi); }
__device__ __forceinline__ float bflo(unsigned u) { return __uint_as_float(u << 16); }
__device__ __forceinline__ float bfhi(unsigned u) { return __uint_as_float(u & 0xffff0000u); }
__device__ __forceinline__ float bf2f(bf16 b) { return __uint_as_float(((unsigned)b) << 16); }
__device__ __forceinline__ bf16 f2bf(float f) { return (bf16)(pk2(f, 0.f) & 0xffffu); }
#define UNPACK8(v, f) do { f[0] = bflo(v.x); f[1] = bfhi(v.x); f[2] = bflo(v.y); f[3] = bfhi(v.y); f[4] = bflo(v.z); f[5] = bfhi(v.z); f[6] = bflo(v.w); f[7] = bfhi(v.w); } while (0)
#define PACK8(o, f) do { o.x = pk2(f[0], f[1]); o.y = pk2(f[2], f[3]); o.z = pk2(f[4], f[5]); o.w = pk2(f[6], f[7]); } while (0)
__device__ __forceinline__ int ltid() { int t = threadIdx.x; asm volatile("" : "+v"(t)); return t; }
__device__ __forceinline__ float sigmoidf_(float x) { return 1.f / (1.f + __expf(-x)); }
__device__ __forceinline__ float wave_sum(float v) {
#pragma unroll
    for (int o = 1; o < 64; o <<= 1) v += __shfl_xor(v, o);
    return v;
}
__device__ __forceinline__ float sum8(float v) { v += __shfl_xor(v, 1); v += __shfl_xor(v, 2); v += __shfl_xor(v, 4); return v; }

constexpr int DM = 1024, DIN = 6944, DPROJ = 4096, NMAIN = 3872, DGATE = 3072, DFF = 2816;
constexpr int NTOK = 131072, NPROMPT = 65536;
constexpr int C_KA = 512, C_VA = 1024, C_CQ = 1536, C_CKV = 1792, C_KR = 1920, C_RW = 1952;
constexpr float LOG2E = 1.4426950408889634f;
constexpr float NA_QS = 0.125f * LOG2E;
constexpr float MLA_QS = 0.10206207261596575f * LOG2E;
constexpr float NEPS = 1e-6f;

constexpr size_t MiB = 1u << 20;
constexpr size_t WS_CTL = 0, CTL_BYTES = 1 * MiB;
constexpr size_t W_OFF = 1 * MiB, W_STRIDE = 39 * MiB;
constexpr size_t WO_IN = 0, WO_G = 8 * MiB, WO_BR = 14 * MiB, WO_OUT = 17 * MiB, WO_GU = 19 * MiB, WO_DN = 30 * MiB, WO_MU = 35 * MiB + 512 * 1024, WO_RU = 37 * MiB;
constexpr size_t ACT_OFF = 80 * MiB;
constexpr size_t TOKB_H = 2048, TOKB_P = 8192, TOKB_M = 3584, TOKB_A = 1536, TOKB_S = 9216, TOKB_Y = 3072, TOKB_Z = 2048;
constexpr size_t TOKB = TOKB_H + TOKB_P + TOKB_M + TOKB_A + TOKB_S + TOKB_Y + TOKB_Z;
static_assert(WO_MU + 1792 * 384 * 2 <= WO_RU && WO_RU + 2560 * 384 * 2 <= W_STRIDE && WO_DN + 1024 * 2816 * 2 <= WO_MU && WO_GU + 5632 * 1024 * 2 <= WO_DN, "weight map");
constexpr int LDS_RING = 131072, LDS_BYTES = LDS_RING + 1024;

struct Params { const float* in[33]; float* out; unsigned char* ws; int G; int Tg; };
typedef const __attribute__((address_space(4))) Params* CP;

constexpr size_t WS_PARAMS = 512 * 1024;
struct Reg { unsigned char* ws; size_t Tg;
    __device__ __forceinline__ bf16* RH() const { return (bf16*)(ws + ACT_OFF); }
    __device__ __forceinline__ bf16* RP() const { return (bf16*)(ws + ACT_OFF + Tg * TOKB_H); }
    __device__ __forceinline__ bf16* RM() const { return (bf16*)(ws + ACT_OFF + Tg * (TOKB_H + TOKB_P)); }
    __device__ __forceinline__ bf16* RA() const { return (bf16*)(ws + ACT_OFF + Tg * (TOKB_H + TOKB_P + TOKB_M)); }
    __device__ __forceinline__ _Float16* RS() const { return (_Float16*)(ws + ACT_OFF + Tg * (TOKB_H + TOKB_P + TOKB_M + TOKB_A)); }
    __device__ __forceinline__ bf16* RY() const { return (bf16*)(ws + ACT_OFF + Tg * (TOKB_H + TOKB_P + TOKB_M + TOKB_A + TOKB_S)); }
    __device__ __forceinline__ bf16* RZ() const { return (bf16*)(ws + ACT_OFF + Tg * (TOKB_H + TOKB_P + TOKB_M + TOKB_A + TOKB_S + TOKB_Y)); }
};
enum { GM_IN = 0, GM_MU = 1, GM_RU = 2, GM_GATE = 3, GM_BR0 = 4, GM_BR1 = 5, GM_BR2 = 6, GM_OUT = 7, GM_GU = 8, GM_DN = 9 };
#define EPI_FENCE() asm volatile("" ::: "memory")
struct EpiUni {
    static constexpr bool PERM = true, AFTER_DRAIN = false;
    CP pp; int id, l, g;
    __device__ __forceinline__ void operator()(const pg8::f32x4 (&acc)[2][2][4][2], const pg8::Unit& u, int wr, int wc, int fr, int fq) const {
        CP q = pp; asm volatile("" : "+s"(q));
        const int Tg = q->Tg; const Reg R{q->ws, (size_t)Tg}; const size_t asz = (size_t)Tg * 512;
        const int row0 = u.pm * 256 + wr * 64 + fr, col0 = u.pn * 256 + wc * 32 + 8 * fq;
        switch (id) {
        case GM_IN: case GM_MU: {
            bf16* O = (id == GM_IN) ? R.RP() : R.RM(); const int ldc = (id == GM_IN) ? DPROJ : 1792;
#pragma unroll
            for (int ai = 0; ai < 2; ++ai)
#pragma unroll
                for (int m = 0; m < 4; ++m) { bf16* rp = O + (size_t)(row0 + ai * 128 + m * 16) * ldc + col0;
#pragma unroll
                    for (int bj = 0; bj < 2; ++bj) { const f32x4 v0 = acc[ai][bj][m][0], v1 = acc[ai][bj][m][1]; v4u w; w.x = pk2(v0[0], v0[1]); w.y = pk2(v0[2], v0[3]); w.z = pk2(v1[0], v1[1]); w.w = pk2(v1[2], v1[3]);
                        *(v4u*)(rp + bj * 128) = w; } }
        } break;
        case GM_GATE: {
            bf16* O = R.RP(); const float* bias = q->in[4] + l * DGATE + col0;
#pragma unroll
            for (int bj = 0; bj < 2; ++bj) { const f32x4 b0 = *(const f32x4*)(bias + bj * 128), b1 = *(const f32x4*)(bias + bj * 128 + 4);
#pragma unroll
                for (int ai = 0; ai < 2; ++ai)
#pragma unroll
                    for (int m = 0; m < 4; ++m) { const f32x4 v0 = acc[ai][bj][m][0] + b0, v1 = acc[ai][bj][m][1] + b1; float f[8];
#pragma unroll
                        for (int i = 0; i < 4; ++i) { f[i] = sigmoidf_(v0[i]); f[4 + i] = sigmoidf_(v1[i]); }
                        v4u w; PACK8(w, f); *(v4u*)(O + (size_t)(row0 + ai * 128 + m * 16) * DGATE + col0 + bj * 128) = w; }
                EPI_FENCE(); }
        } break;
        case GM_GU: {
            bf16* O = R.RP(); const int hc = u.pn * 128 + wc * 32 + 8 * fq;
#pragma unroll
            for (int ai = 0; ai < 2; ++ai)
#pragma unroll
                for (int m = 0; m < 4; ++m) { float f[8];
#pragma unroll
                    for (int n = 0; n < 2; ++n)
#pragma unroll
                        for (int i = 0; i < 4; ++i) { const float gt = acc[ai][0][m][n][i], up = acc[ai][1][m][n][i]; f[4 * n + i] = gt * sigmoidf_(gt) * up; }
                    v4u w; PACK8(w, f); *(v4u*)(O + (size_t)(row0 + ai * 128 + m * 16) * DFF + hc) = w; }
        } break;
        case GM_BR0: case GM_BR1: case GM_BR2: {
            bf16* O = R.RM(); const bf16* Gt = R.RP() + (id - GM_BR0) * 1024; const bool first = (id == GM_BR0);
#pragma unroll
            for (int ai = 0; ai < 2; ++ai)
#pragma unroll
                for (int m = 0; m < 4; ++m) { const size_t row = (size_t)(row0 + ai * 128 + m * 16);
#pragma unroll
                    for (int bj = 0; bj < 2; ++bj) { const int col = col0 + bj * 128; const v4u gv = *(const v4u*)(Gt + row * DGATE + col); float gg[8], f[8]; UNPACK8(gv, gg);
#pragma unroll
                        for (int i = 0; i < 4; ++i) { f[i] = gg[i] * acc[ai][bj][m][0][i]; f[4 + i] = gg[4 + i] * acc[ai][bj][m][1][i]; }
                        if (!first) { const v4u ov = *(const v4u*)(O + row * DM + col); float o[8]; UNPACK8(ov, o);
#pragma unroll
                            for (int i = 0; i < 8; ++i) f[i] += o[i]; }
                        v4u w; PACK8(w, f); *(v4u*)(O + row * DM + col) = w; }
                    EPI_FENCE(); }
        } break;
        case GM_OUT: case GM_DN: {
            const int t0 = g * Tg; float* xout = q->out + (size_t)t0 * DM;
            const float* xin = (id == GM_OUT && l == 0) ? ((t0 < NPROMPT) ? q->in[0] + (size_t)t0 * DM : q->in[1] + (size_t)(t0 - NPROMPT) * DM) : xout;
#pragma unroll
            for (int ai = 0; ai < 2; ++ai)
#pragma unroll
                for (int m = 0; m < 4; ++m) { const size_t off = (size_t)(row0 + ai * 128 + m * 16) * DM + col0;
#pragma unroll
                    for (int bj = 0; bj < 2; ++bj)
#pragma unroll
                        for (int n = 0; n < 2; ++n) { const f32x4 b = *(const f32x4*)(xin + off + bj * 128 + n * 4); *(f32x4*)(xout + off + bj * 128 + n * 4) = b + acc[ai][bj][m][n]; }
                    EPI_FENCE(); }
        } break;
        case GM_RU: {
            _Float16* rs = R.RS(); const _Float16* ktmp = (const _Float16*)R.RZ(); bf16* gout = R.RY() + 2 * asz;
            const int type = u.pn >> 1; const int cl0 = (u.pn & 1) * 256 + wc * 32 + 8 * fq;
            const float* w0 = q->in[17] + l * 1024; const float* a0 = q->in[19] + l * 1024; const float* ka = q->in[23] + l * 512;
#pragma unroll
            for (int ai = 0; ai < 2; ++ai)
#pragma unroll
                for (int m = 0; m < 4; ++m) { const size_t row = (size_t)(row0 + ai * 128 + m * 16);
#pragma unroll
                    for (int bj = 0; bj < 2; ++bj) { const int cl = cl0 + bj * 128; float f[8];
#pragma unroll
                        for (int i = 0; i < 4; ++i) { f[i] = acc[ai][bj][m][0][i]; f[4 + i] = acc[ai][bj][m][1][i]; }
                        if (type < 2) {
                            h8 o;
#pragma unroll
                            for (int i = 0; i < 8; ++i) o[i] = (_Float16)__expf(-0.6065306597126334f * sigmoidf_(f[i] + w0[type * 512 + cl + i]));
                            *(h8*)(rs + (size_t)(3 + type) * asz + row * 512 + cl) = o;
                        } else if (type < 4) {
                            const int d = type - 2; const h8 kv = *(const h8*)(ktmp + row * 512 + cl), kkv = *(const h8*)(rs + (size_t)2 * asz + row * 512 + cl); h8 o1, o2;
#pragma unroll
                            for (int i = 0; i < 8; ++i) { const float a = sigmoidf_(f[i] + a0[d * 512 + cl + i]); o1[i] = (_Float16)((float)kkv[i] * a); o2[i] = (_Float16)((float)kv[i] * (1.f + (a - 1.f) * ka[cl + i])); }
                            *(h8*)(rs + (size_t)(5 + d) * asz + row * 512 + cl) = o1; *(h8*)(rs + (size_t)(7 + d) * asz + row * 512 + cl) = o2;
                        } else { v4u w; PACK8(w, f); *(v4u*)(gout + row * 512 + cl) = w; }
                        EPI_FENCE(); } }
        } break;
        default: break;
        }
    }
};

__device__ __forceinline__ void transpose_item(const float* W, int ldw, int N, bf16* WT, int ldt, int koff, int row_off, int mode, LAS float* scr, int item, int lane) {
    const int nblk = N / 32, kb = item / nblk, nb = item % nblk, k0 = 64 * kb, n0 = 32 * nb;
#pragma unroll 8
    for (int i = 0; i < 32; ++i) { const int kk = 2 * i + (lane >> 5); scr[kk * 33 + (lane & 31)] = W[(size_t)(k0 + kk) * ldw + n0 + (lane & 31)]; }
    asm volatile("s_waitcnt lgkmcnt(0)" ::: "memory");
    const int c = lane & 7;
#pragma unroll
    for (int j = 0; j < 4; ++j) { const int n = (lane >> 3) + 8 * j; const LAS float* s = scr + (8 * c) * 33 + n;
        v4u o; o.x = pk2(s[0 * 33], s[1 * 33]); o.y = pk2(s[2 * 33], s[3 * 33]); o.z = pk2(s[4 * 33], s[5 * 33]); o.w = pk2(s[6 * 33], s[7 * 33]);
        const int nn = n0 + n; const int drow = mode ? ((nn >> 7) * 256 + row_off + (nn & 127)) : (row_off + nn);
        *(v4u*)(WT + (size_t)drow * ldt + koff + k0 + 8 * c) = o; }
    asm volatile("s_waitcnt lgkmcnt(0)" ::: "memory");
}
__device__ __forceinline__ void transpose_job(const float* W, int ldw, int K, int N, bf16* WT, int ldt, int koff, int row_off, int mode, LAS float* scr, int gw, int ngw, int lane) {
    const int nitems = (K / 64) * (N / 32);
    for (int it = gw; it < nitems; it += ngw) transpose_item(W, ldw, N, WT, ldt, koff, row_off, mode, scr, it, lane);
}
__device__ __forceinline__ void zero_bytes(unsigned char* p, size_t nbytes, size_t gtid, size_t ngt) {
    const v4u z = {0u, 0u, 0u, 0u};
    for (size_t i = gtid; i < nbytes / 16; i += ngt) ((v4u*)p)[i] = z;
}

__device__ __forceinline__ void phase_norm(const float* x, const float* g, bf16* hb, int Tg, int gw, int ngw, int lane) {
    for (int t = gw; t < Tg; t += 2 * ngw) {
        const int t2 = (t + ngw < Tg) ? t + ngw : t;
        const f32x4* xa = (const f32x4*)(x + (size_t)t * DM) + lane; const f32x4* xb = (const f32x4*)(x + (size_t)t2 * DM) + lane; f32x4 va[4], vb[4]; float sa = 0.f, sb = 0.f;
#pragma unroll
        for (int j = 0; j < 4; ++j) { va[j] = xa[64 * j]; vb[j] = xb[64 * j]; }
#pragma unroll
        for (int j = 0; j < 4; ++j) { sa += (va[j].x * va[j].x + va[j].y * va[j].y) + (va[j].z * va[j].z + va[j].w * va[j].w); sb += (vb[j].x * vb[j].x + vb[j].y * vb[j].y) + (vb[j].z * vb[j].z + vb[j].w * vb[j].w); }
        const float ia = rsqrtf(wave_sum(sa) * (1.f / DM) + NEPS), ib = rsqrtf(wave_sum(sb) * (1.f / DM) + NEPS);
        v2u* oa = (v2u*)(hb + (size_t)t * DM) + lane; v2u* ob = (v2u*)(hb + (size_t)t2 * DM) + lane;
#pragma unroll
        for (int j = 0; j < 4; ++j) { const f32x4 gg = ((const f32x4*)g)[lane + 64 * j]; v2u o;
            o.x = pk2(va[j].x * ia * gg.x, va[j].y * ia * gg.y); o.y = pk2(va[j].z * ia * gg.z, va[j].w * ia * gg.w); oa[64 * j] = o;
            o.x = pk2(vb[j].x * ib * gg.x, vb[j].y * ib * gg.y); o.y = pk2(vb[j].z * ib * gg.z, vb[j].w * ib * gg.w); ob[64 * j] = o; }
    }
}

__device__ __forceinline__ void phase_post_proj(CP pp, int l, bf16* proj, bf16* mla_a, bf16* rw_a, _Float16* rs, _Float16* ktmp, size_t asz, int Tg, int L, int gw, int ngw, int lane) {
    const float* gq = pp->in[5] + l * 64; const float* gk = pp->in[6] + l * 64;
    const float* gcq = pp->in[9] + l * 256; const float* gckv = pp->in[10] + l * 128;
    const float* mu = pp->in[16] + l * 1920; const float* kkw = pp->in[22] + l * 512;
    for (int t = gw; t < Tg; t += ngw) {
        bf16* row = proj + (size_t)t * DPROJ; const int tpos = t % L;
        const bool hasp = tpos > 0, hasn = tpos < L - 1;
        v4u qv = *(const v4u*)(row + 8 * lane), kv = *(const v4u*)(row + C_KA + 8 * lane); const v2u cv = *(const v2u*)(row + C_CQ + 4 * lane); const unsigned kvv = *(const unsigned*)(row + C_CKV + 2 * lane);
        v4u rwc[4], rwp[4], rwn[4];
#pragma unroll
        for (int it = 0; it < 4; ++it) { const int c0 = (it * 64 + lane) * 8; const v4u z = {0u, 0u, 0u, 0u}; rwc[it] = z; rwp[it] = z; rwn[it] = z;
            if (it < 3 || lane < 48) { const bf16* src = row + C_RW + c0; rwc[it] = *(const v4u*)src; if (hasp) rwp[it] = *(const v4u*)(src - DPROJ); if (hasn) rwn[it] = *(const v4u*)(src + DPROJ); } }
        {
            const int gi = 8 * (lane & 7);
            float f[8]; UNPACK8(qv, f); float ss = 0.f;
#pragma unroll
            for (int i = 0; i < 8; ++i) ss += f[i] * f[i];
            float inv = rsqrtf(sum8(ss) * (1.f / 64.f) + NEPS) * NA_QS;
#pragma unroll
            for (int i = 0; i < 8; ++i) f[i] = f[i] * inv * gq[gi + i];
            PACK8(qv, f); *(v4u*)(row + 8 * lane) = qv;
            UNPACK8(kv, f); ss = 0.f;
#pragma unroll
            for (int i = 0; i < 8; ++i) ss += f[i] * f[i];
            inv = rsqrtf(sum8(ss) * (1.f / 64.f) + NEPS);
#pragma unroll
            for (int i = 0; i < 8; ++i) f[i] = f[i] * inv * gk[gi + i];
            PACK8(kv, f); *(v4u*)(row + C_KA + 8 * lane) = kv;
        }
        {
            float a0 = bflo(cv.x), a1 = bfhi(cv.x), a2 = bflo(cv.y), a3 = bfhi(cv.y);
            float inv = rsqrtf(wave_sum(a0 * a0 + a1 * a1 + a2 * a2 + a3 * a3) * (1.f / 256.f) + NEPS);
            const f32x4 gg = *(const f32x4*)(gcq + 4 * lane); v2u o; o.x = pk2(a0 * inv * gg.x, a1 * inv * gg.y); o.y = pk2(a2 * inv * gg.z, a3 * inv * gg.w);
            *(v2u*)(mla_a + (size_t)t * 384 + 4 * lane) = o;
            a0 = bflo(kvv); a1 = bfhi(kvv);
            inv = rsqrtf(wave_sum(a0 * a0 + a1 * a1) * (1.f / 128.f) + NEPS);
            *(unsigned*)(mla_a + (size_t)t * 384 + 256 + 2 * lane) = pk2(a0 * inv * gckv[2 * lane], a1 * inv * gckv[2 * lane + 1]);
        }
#pragma unroll
        for (int it = 0; it < 4; ++it) {
            const int c0 = (it * 64 + lane) * 8;
            if (it < 3 || lane < 48) {
                float pc[8], pp[8], pn[8]; UNPACK8(rwc[it], pc); UNPACK8(rwp[it], pp); UNPACK8(rwn[it], pn);
#pragma unroll
                for (int i = 0; i < 8; ++i) pc[i] = pc[i] + mu[c0 + i] * (0.5f * (pp[i] + pn[i]) - pc[i]);
                if (it == 0) { h8 o;
#pragma unroll
                    for (int i = 0; i < 8; ++i) o[i] = (_Float16)pc[i];
                    *(h8*)(rs + (size_t)t * 512 + c0) = o; }
                else if (it == 1) { const int c = c0 - 512; h8 o; float kk[8]; float ss = 0.f;
#pragma unroll
                    for (int i = 0; i < 8; ++i) { o[i] = (_Float16)pc[i]; kk[i] = pc[i] * kkw[c + i]; ss += kk[i] * kk[i]; }
                    *(h8*)(ktmp + (size_t)t * 512 + c) = o;
                    const float inv = rsqrtf(sum8(ss) + 1e-12f);
#pragma unroll
                    for (int i = 0; i < 8; ++i) o[i] = (_Float16)(kk[i] * inv);
                    *(h8*)(rs + 2 * asz + (size_t)t * 512 + c) = o; }
                else if (it == 2) { const int c = c0 - 1024; h8 o;
#pragma unroll
                    for (int i = 0; i < 8; ++i) o[i] = (_Float16)pc[i];
                    *(h8*)(rs + asz + (size_t)t * 512 + c) = o; }
                else { const int c = c0 - 1536; float f[8];
#pragma unroll
                    for (int i = 0; i < 8; ++i) { const float x = pc[i]; f[i] = (c < 128) ? (1.f - 2.f / (1.f + __expf(2.f * x))) : ((c < 256) ? x : sigmoidf_(x)); }
                    v4u w; PACK8(w, f); *(v4u*)(rw_a + (size_t)t * 384 + c) = w; }
            }
        }
    }
}

__device__ __forceinline__ void phase_mla_post(CP pp, int l, bf16* mraw, const bf16* proj, bf16* mk, int Tg, int L, int gw, int ngw, int lane) {
    const float* gq = pp->in[13] + l * 96; const float* gk = pp->in[14] + l * 96;
    const float gqn = gq[lane], gkn = gk[lane], gqr = lane < 32 ? gq[64 + lane] : 0.f, gkr = lane < 32 ? gk[64 + lane] : 0.f;
    const int fi = lane & 7; const float invf = __expf(-(float)fi * (9.210340371976184f / 8.f));
    for (int t = gw; t < Tg; t += ngw) {
        const int tpos = t % L; const float pos = (float)(((lane & 15) < 8) ? (tpos >> 6) : (tpos & 63));
        float rev = pos * invf * 0.15915494309189535f; rev -= floorf(rev);
        const float cs = __builtin_amdgcn_cosf(rev), sn = __builtin_amdgcn_sinf(rev);
        bf16* mrow = mraw + (size_t)t * 1792; bf16* krow = mk + (size_t)t * 768;
        const float krv = lane < 32 ? bf2f(proj[(size_t)t * DPROJ + C_KR + lane]) : 0.f;
        bf16 lqn[8], lqr[8], lkn[8];
#pragma unroll
        for (int h = 0; h < 8; ++h) { lqn[h] = mrow[h * 96 + lane]; lqr[h] = mrow[h * 96 + 64 + (lane & 31)]; lkn[h] = mrow[768 + h * 128 + lane]; }
#pragma unroll
        for (int h = 0; h < 8; ++h) {
            {   float qn = bf2f(lqn[h]); float qr = lane < 32 ? bf2f(lqr[h]) : 0.f;
                const float inv = rsqrtf(wave_sum(qn * qn + qr * qr) * (1.f / 96.f) + NEPS);
                qn = qn * inv * gqn; qr = qr * inv * gqr;
                const float pr = __shfl_xor(qr, 16);
                const float ro = (lane < 16) ? (qr * cs - pr * sn) : (pr * sn + qr * cs);
                mrow[h * 96 + lane] = f2bf(qn * MLA_QS); if (lane < 32) mrow[h * 96 + 64 + lane] = f2bf(ro * MLA_QS); }
            {   float kn = bf2f(lkn[h]); float kr = krv;
                const float inv = rsqrtf(wave_sum(kn * kn + kr * kr) * (1.f / 96.f) + NEPS);
                kn = kn * inv * gkn; kr = kr * inv * gkr;
                const float pr = __shfl_xor(kr, 16);
                const float ro = (lane < 16) ? (kr * cs - pr * sn) : (pr * sn + kr * cs);
                krow[h * 96 + lane] = f2bf(kn); if (lane < 32) krow[h * 96 + 64 + lane] = f2bf(ro); }
        }
    }
}

__device__ __forceinline__ void phase_rw_post(CP pp, int l, const _Float16* rs, size_t asz, const bf16* yfb, bf16* yc, int Tg, int gw, int ngw, int lane) {
    const float* lnw = pp->in[25] + l * 512 + 8 * lane; const float* lnb = pp->in[26] + l * 512 + 8 * lane; const float* rk = pp->in[24] + l * 512 + 8 * lane;
    for (int t = gw; t < Tg; t += ngw) {
        const size_t o = (size_t)t * 512 + 8 * lane; float y[8], f[8];
        { const v4u a = *(const v4u*)(yfb + o); const v4u b = *(const v4u*)(yfb + asz + o); UNPACK8(a, y); UNPACK8(b, f); }
        float s = 0.f;
#pragma unroll
        for (int i = 0; i < 8; ++i) { y[i] += f[i]; s += y[i]; }
        const float mean = sum8(s) * (1.f / 64.f); float q = 0.f;
#pragma unroll
        for (int i = 0; i < 8; ++i) { y[i] -= mean; q += y[i] * y[i]; }
        const float rstd = rsqrtf(sum8(q) * (1.f / 64.f) + 64e-5f);
        const h8 r = *(const h8*)(rs + o), v = *(const h8*)(rs + asz + o), kd0 = *(const h8*)(rs + 7 * asz + o), kd1 = *(const h8*)(rs + 8 * asz + o);
        float b = 0.f;
#pragma unroll
        for (int i = 0; i < 8; ++i) b += (float)r[i] * ((float)kd0[i] + (float)kd1[i]) * rk[i];
        b = sum8(b);
        const v4u gv = *(const v4u*)(yc + o); UNPACK8(gv, f);
#pragma unroll
        for (int i = 0; i < 8; ++i) f[i] = (y[i] * rstd * lnw[i] + lnb[i] + b * (float)v[i]) * f[i];
        v4u w; PACK8(w, f); *(v4u*)(yc + o) = w;
    }
}

#define GAS __attribute__((address_space(1)))
typedef float f2 __attribute__((ext_vector_type(2)));
#define DPP_ADD(x, ctrl) ((x) + __builtin_bit_cast(float, __builtin_amdgcn_update_dpp(0, __builtin_bit_cast(int, (x)), (ctrl), 0xF, 0xF, true)))
__device__ __forceinline__ float red8(float x) { x = DPP_ADD(x, 0xB1); x = DPP_ADD(x, 0x4E); x = DPP_ADD(x, 0x141); return x; }
constexpr int SCH = 32, SBUF = 6 * SCH * 256;
__device__ __forceinline__ void scan_unit(int u, int L, const _Float16* rs, size_t asz, bf16* yfb, LAS unsigned char* lds) {
    const int tid = ltid(); const int lane = tid & 63, w = tid >> 6, vr = lane >> 3, ko = lane & 7;
    const int dir = u & 1, sh = u >> 1, h = sh & 7, s = sh >> 3;
    const int kA = tid >> 8, lj = (tid >> 3) & 31, lp = tid & 7;
    const size_t tok0 = (size_t)s * L + (dir ? (L - 1 - lj) : lj);
    const long tstep = dir ? -(long)SCH * 512 : (long)SCH * 512;
    const size_t eoff = tok0 * 512 + h * 64 + lp * 8;
    const GAS _Float16* g0 = (const GAS _Float16*)(rs + (size_t)(kA ? 2 : 0) * asz + eoff);
    const GAS _Float16* g1 = (const GAS _Float16*)(rs + (size_t)(kA ? 5 + dir : 3 + dir) * asz + eoff);
    const GAS _Float16* g2 = (const GAS _Float16*)(rs + (size_t)(kA ? 1 : 7 + dir) * asz + eoff);
    const int ld0 = (((0 + kA) * SCH + lj) * 64 + lp * 8) * 4, ld1 = (((2 + kA) * SCH + lj) * 64 + lp * 8) * 4, ld2 = (((4 + kA) * SCH + lj) * 64 + lp * 8) * 4;
    GAS bf16* py = (GAS bf16*)(yfb + (size_t)dir * asz + ((size_t)s * L + (dir ? L - 1 : 0)) * 512 + h * 64 + 8 * w + vr);
    const long ystep = dir ? -512 : 512;
    const int rd = ko * 32, rdv = (5 * SCH * 64 + 8 * w + vr) * 4;
    f2 S[4];
#pragma unroll
    for (int i = 0; i < 4; ++i) S[i] = (f2){0.f, 0.f};
    h8 p0 = *(const GAS h8*)g0, p1 = *(const GAS h8*)g1, p2 = *(const GAS h8*)g2;
#define SCAN_PUT(bufo) do { f32x4 a, b; \
        a = (f32x4){(float)p0[0], (float)p0[1], (float)p0[2], (float)p0[3]}; b = (f32x4){(float)p0[4], (float)p0[5], (float)p0[6], (float)p0[7]}; *(LAS f32x4*)(lds + (bufo) + ld0) = a; *(LAS f32x4*)(lds + (bufo) + ld0 + 16) = b; \
        a = (f32x4){(float)p1[0], (float)p1[1], (float)p1[2], (float)p1[3]}; b = (f32x4){(float)p1[4], (float)p1[5], (float)p1[6], (float)p1[7]}; *(LAS f32x4*)(lds + (bufo) + ld1) = a; *(LAS f32x4*)(lds + (bufo) + ld1 + 16) = b; \
        a = (f32x4){(float)p2[0], (float)p2[1], (float)p2[2], (float)p2[3]}; b = (f32x4){(float)p2[4], (float)p2[5], (float)p2[6], (float)p2[7]}; *(LAS f32x4*)(lds + (bufo) + ld2) = a; *(LAS f32x4*)(lds + (bufo) + ld2 + 16) = b; } while (0)
    SCAN_PUT(0);
    __syncthreads();
    const int NC = L / SCH;
#pragma unroll 1
    for (int c = 0; c < NC; ++c) {
        const int cur = (c & 1) * SBUF;
        if (c + 1 < NC) { const long o = tstep * (long)(c + 1); p0 = *(const GAS h8*)(g0 + o); p1 = *(const GAS h8*)(g1 + o); p2 = *(const GAS h8*)(g2 + o); }
        LAS unsigned char* bp = lds + cur + rd;
        GAS bf16* pyc = py + ystep * (long)(c * SCH);
#pragma unroll 1
        for (int j0 = 0; j0 < SCH; j0 += 4) { float yv[4];
#pragma unroll
        for (int jj = 0; jj < 4; ++jj) { const int j = j0 + jj;
            const LAS unsigned char* q = bp + j * 256;
            const f32x4 r0 = *(const LAS f32x4*)(q), r1 = *(const LAS f32x4*)(q + 16);
            const f32x4 k0 = *(const LAS f32x4*)(q + SCH * 256), k1 = *(const LAS f32x4*)(q + SCH * 256 + 16);
            const f32x4 w0 = *(const LAS f32x4*)(q + 2 * SCH * 256), w1 = *(const LAS f32x4*)(q + 2 * SCH * 256 + 16);
            const f32x4 a0 = *(const LAS f32x4*)(q + 3 * SCH * 256), a1 = *(const LAS f32x4*)(q + 3 * SCH * 256 + 16);
            const f32x4 d0 = *(const LAS f32x4*)(q + 4 * SCH * 256), d1 = *(const LAS f32x4*)(q + 4 * SCH * 256 + 16);
            const float vv = *(const LAS float*)(lds + cur + rdv + j * 256);
            const f2 vv2 = (f2){vv, vv};
            f2 e0 = S[0] * w0.xy, e1 = S[1] * w0.zw, e2 = S[2] * w1.xy, e3 = S[3] * w1.zw;
            f2 pa = S[0] * k0.xy, pb = S[1] * k0.zw; pa = S[2] * k1.xy + pa; pb = S[3] * k1.zw + pb;
            e0 = d0.xy * vv2 + e0; e1 = d0.zw * vv2 + e1; e2 = d1.xy * vv2 + e2; e3 = d1.zw * vv2 + e3;
            const f2 pd = pa + pb;
            const float nskk = -red8(pd.x + pd.y);
            const f2 ns2 = (f2){nskk, nskk};
            S[0] = a0.xy * ns2 + e0; S[1] = a0.zw * ns2 + e1; S[2] = a1.xy * ns2 + e2; S[3] = a1.zw * ns2 + e3;
            f2 qa = S[0] * r0.xy, qb = S[1] * r0.zw; qa = S[2] * r1.xy + qa; qb = S[3] * r1.zw + qb;
            const f2 qd = qa + qb;
            yv[jj] = red8(qd.x + qd.y);
        }
            if (ko == 0) {
#pragma unroll
                for (int jj = 0; jj < 4; ++jj) pyc[ystep * (j0 + jj)] = f2bf(yv[jj]); }
        }
        if (c + 1 < NC) SCAN_PUT(SBUF - cur);
        __syncthreads();
    }
#undef SCAN_PUT
}

constexpr int MKP = 208, MVP = 144, MBUF = 64 * MKP + 64 * MVP;
#define MLA_THR 6.0f
__device__ __forceinline__ float max3f(float a, float b, float c) { return fmaxf(fmaxf(a, b), c); }
__device__ __forceinline__ void mla_unit(int u, int L, const bf16* mraw, const bf16* mk, bf16* yb, LAS unsigned char* lds) {
    const int tid = ltid(), lane = tid & 63, w = tid >> 6, q32 = lane & 31, hi = lane >> 5;
    const int nqb = L >> 8, qb = u % nqb, sh = u / nqb, h = sh & 7, s = sh >> 3;
    const size_t base = (size_t)s * L; const int NT = L >> 6;
    const size_t qtok = base + qb * 256 + w * 32 + q32;
    bf16x8 qf[6];
#pragma unroll
    for (int ks = 0; ks < 6; ++ks) qf[ks] = *(const bf16x8*)(mraw + qtok * 1792 + h * 96 + ks * 16 + hi * 8);
    const int kkey0 = tid / 12, kch0 = tid % 12, kkey1 = (tid + 512) / 12, kch1 = (tid + 512) % 12; const bool k2 = tid < 256;
    const bf16* ks0 = mk + (base + kkey0) * 768 + h * 96 + kch0 * 8; const bf16* ks1 = mk + (base + kkey1) * 768 + h * 96 + kch1 * 8;
    const int vkey = tid >> 3, vch = tid & 7;
    const bf16* vs = mraw + (base + vkey) * 1792 + 768 + h * 128 + 64 + vch * 8;
    const int kd0 = kkey0 * MKP + kch0 * 16, kd1 = kkey1 * MKP + kch1 * 16, vd = 64 * MKP + vkey * MVP + vch * 16;
    v4u rk0, rk1 = {0u, 0u, 0u, 0u}, rv, sk0, sk1 = {0u, 0u, 0u, 0u}, sv;
#define MLA_LOAD(t) do { const size_t adv_ = (size_t)(t) * 64; rk0 = *(const v4u*)(ks0 + adv_ * 768); if (k2) rk1 = *(const v4u*)(ks1 + adv_ * 768); rv = *(const v4u*)(vs + adv_ * 1792); } while (0)
#define MLA_PUT(bo) do { *(LAS v4u*)(lds + (bo) + kd0) = rk0; if (k2) *(LAS v4u*)(lds + (bo) + kd1) = rk1; *(LAS v4u*)(lds + (bo) + vd) = rv; } while (0)
#define MLA_LOADB(t) do { const size_t adv_ = (size_t)(t) * 64; sk0 = *(const v4u*)(ks0 + adv_ * 768); if (k2) sk1 = *(const v4u*)(ks1 + adv_ * 768); sv = *(const v4u*)(vs + adv_ * 1792); } while (0)
#define MLA_PUTB(bo) do { *(LAS v4u*)(lds + (bo) + kd0) = sk0; if (k2) *(LAS v4u*)(lds + (bo) + kd1) = sk1; *(LAS v4u*)(lds + (bo) + vd) = sv; } while (0)
    MLA_LOAD(0); MLA_PUT(0); MLA_LOAD(1); MLA_PUT(MBUF);
    __syncthreads();
    const int kmap = 16 * (q32 >> 4) + 8 * ((q32 >> 2) & 1) + (q32 & 3) + 4 * ((q32 >> 3) & 1);
    const int koff = kmap * MKP + hi * 16;
    const int voff = 64 * MKP + (8 * hi + ((lane & 15) >> 2)) * MVP + (16 * ((lane >> 4) & 1) + 4 * (lane & 3)) * 2;
    f32x16 o0 = {}, o1 = {}, negm = {}, pA0, pA1, pB0, pB1; float lsum = 0.f; v4u pw0, pw1, pw2, pw3;
    int b_prev = 0, b_cur = MBUF, b_next = 2 * MBUF;
#define MLA_KA(bo, ks) (*(const LAS bf16x8*)(lds + (bo) + koff + (ks) * 32))
#define MLA_KB(bo, ks) (*(const LAS bf16x8*)(lds + (bo) + koff + 32 * MKP + (ks) * 32))
#define MLA_QK2(C0, C1, bo, ks) do { C0 = __builtin_amdgcn_mfma_f32_32x32x16_bf16(MLA_KA(bo, ks), qf[ks], C0, 0, 0, 0); C1 = __builtin_amdgcn_mfma_f32_32x32x16_bf16(MLA_KB(bo, ks), qf[ks], C1, 0, 0, 0); } while (0)
#define MLA_FIN8(P, g, PW) do { float e0 = __builtin_amdgcn_exp2f(P[8 * g + 0]), e1 = __builtin_amdgcn_exp2f(P[8 * g + 1]), e2 = __builtin_amdgcn_exp2f(P[8 * g + 2]), e3 = __builtin_amdgcn_exp2f(P[8 * g + 3]), \
        e4 = __builtin_amdgcn_exp2f(P[8 * g + 4]), e5 = __builtin_amdgcn_exp2f(P[8 * g + 5]), e6 = __builtin_amdgcn_exp2f(P[8 * g + 6]), e7 = __builtin_amdgcn_exp2f(P[8 * g + 7]); \
        lsum += ((e0 + e1) + (e2 + e3)) + ((e4 + e5) + (e6 + e7)); PW.x = pk2(e0, e1); PW.y = pk2(e2, e3); PW.z = pk2(e4, e5); PW.w = pk2(e6, e7); } while (0)
#define MLA_VT(bo, kg, db) ({ const int vb_ = (bo) + voff + (kg) * 16 * MVP + (db) * 64; \
        const s16x4 t0_ = __builtin_amdgcn_ds_read_tr16_b64_v4i16((LAS s16x4*)(lds + vb_)), t1_ = __builtin_amdgcn_ds_read_tr16_b64_v4i16((LAS s16x4*)(lds + vb_ + 4 * MVP)); \
        (bf16x8){t0_[0], t0_[1], t0_[2], t0_[3], t1_[0], t1_[1], t1_[2], t1_[3]}; })
#define MLA_PV(bo, kg, PW) do { const bf16x8 pf_ = __builtin_bit_cast(bf16x8, PW); o0 = __builtin_amdgcn_mfma_f32_32x32x16_bf16(MLA_VT(bo, kg, 0), pf_, o0, 0, 0, 0); o1 = __builtin_amdgcn_mfma_f32_32x32x16_bf16(MLA_VT(bo, kg, 1), pf_, o1, 0, 0, 0); } while (0)
#define MLA_ROWMAX(C0, C1) ({ float a_ = max3f(C0[0], C0[1], C1[0]), b_ = max3f(C0[2], C0[3], C1[1]); a_ = max3f(a_, C1[2], C1[3]); \
        _Pragma("unroll") for (int r_ = 4; r_ < 16; r_ += 4) { a_ = max3f(a_, C0[r_], C0[r_ + 1]); b_ = max3f(b_, C0[r_ + 2], C0[r_ + 3]); a_ = max3f(a_, C1[r_], C1[r_ + 1]); b_ = max3f(b_, C1[r_ + 2], C1[r_ + 3]); } \
        const float m_ = fmaxf(a_, b_); fmaxf(m_, __shfl_xor(m_, 32)); })
#define MLA_STEP(P0, P1, C0, C1, j, LOADX, PUTX) do { \
        if ((j) + 2 < NT) LOADX((j) + 2); \
        C0 = negm; C1 = negm; \
        MLA_QK2(C0, C1, b_cur, 0); MLA_QK2(C0, C1, b_cur, 1); MLA_FIN8(P0, 0, pw0); \
        MLA_QK2(C0, C1, b_cur, 2); MLA_FIN8(P0, 1, pw1); \
        MLA_QK2(C0, C1, b_cur, 3); MLA_FIN8(P1, 0, pw2); \
        MLA_QK2(C0, C1, b_cur, 4); MLA_FIN8(P1, 1, pw3); \
        MLA_QK2(C0, C1, b_cur, 5); \
        MLA_PV(b_prev, 0, pw0); MLA_PV(b_prev, 1, pw1); \
        const float mt_ = MLA_ROWMAX(C0, C1); \
        MLA_PV(b_prev, 2, pw2); MLA_PV(b_prev, 3, pw3); \
        if (__any(mt_ > MLA_THR)) { const float dl_ = fmaxf(mt_, 0.f); const float fs_ = __builtin_amdgcn_exp2f(-dl_); lsum *= fs_; \
            _Pragma("unroll") for (int r_ = 0; r_ < 16; ++r_) { C0[r_] -= dl_; C1[r_] -= dl_; negm[r_] -= dl_; o0[r_] *= fs_; o1[r_] *= fs_; } } \
        if ((j) + 1 < NT) PUTX(b_next); \
        __syncthreads(); \
        { const int t_ = b_prev; b_prev = b_cur; b_cur = b_next; b_next = t_; } \
    } while (0)
    pA0 = negm; pA1 = negm;
#pragma unroll
    for (int ks = 0; ks < 6; ++ks) MLA_QK2(pA0, pA1, 0, ks);
    { const float m0 = MLA_ROWMAX(pA0, pA1);
#pragma unroll
      for (int r = 0; r < 16; ++r) { pA0[r] -= m0; pA1[r] -= m0; negm[r] = -m0; } }
    MLA_LOADB(2);
    int jt = 1;
#pragma unroll 1
    for (; jt + 1 < NT; jt += 2) {
        MLA_STEP(pA0, pA1, pB0, pB1, jt, MLA_LOAD, MLA_PUTB);
        MLA_STEP(pB0, pB1, pA0, pA1, jt + 1, MLA_LOADB, MLA_PUT);
    }
    if (jt < NT) { MLA_STEP(pA0, pA1, pB0, pB1, jt, MLA_LOAD, MLA_PUTB); pA0 = pB0; pA1 = pB1; }
    MLA_FIN8(pA0, 0, pw0); MLA_FIN8(pA0, 1, pw1); MLA_FIN8(pA1, 0, pw2); MLA_FIN8(pA1, 1, pw3);
    MLA_PV(b_prev, 0, pw0); MLA_PV(b_prev, 1, pw1); MLA_PV(b_prev, 2, pw2); MLA_PV(b_prev, 3, pw3);
    lsum += __shfl_xor(lsum, 32);
    const float inv = 1.f / lsum;
    bf16* orow = yb + qtok * 512 + h * 64 + 4 * hi;
#pragma unroll
    for (int rq = 0; rq < 4; ++rq) {
        v2u a, b; a.x = pk2(o0[4 * rq] * inv, o0[4 * rq + 1] * inv); a.y = pk2(o0[4 * rq + 2] * inv, o0[4 * rq + 3] * inv);
        b.x = pk2(o1[4 * rq] * inv, o1[4 * rq + 1] * inv); b.y = pk2(o1[4 * rq + 2] * inv, o1[4 * rq + 3] * inv);
        *(v2u*)(orow + 8 * rq) = a; *(v2u*)(orow + 32 + 8 * rq) = b;
    }
    __syncthreads();
#undef MLA_LOAD
#undef MLA_PUT
#undef MLA_LOADB
#undef MLA_PUTB
#undef MLA_KA
#undef MLA_KB
#undef MLA_QK2
#undef MLA_FIN8
#undef MLA_VT
#undef MLA_PV
#undef MLA_ROWMAX
#undef MLA_STEP
}

constexpr int NVP = 144, NA_WLDS = 64 * NVP + 1888;
__device__ __forceinline__ void na_unit(int u, int L, int l, const float* rpb_all, const bf16* proj, bf16* ya, LAS unsigned char* lds) {
    const int tid = ltid(); const int lane = tid & 63, w = tid >> 6, i16 = lane & 15, quad = lane >> 4;
    const int rows = L >> 6; const int hq = u & 3, sr = u >> 2, r = sr % rows, s = sr / rows;
    const int h = 2 * hq + (w >> 2), j = w & 3;
    const int rs = min(max(r - 4, 0), rows - 8), kc0 = min(max(16 * j - 8, 0), 32);
    const size_t base = (size_t)s * L;
    const size_t qtok = base + r * 64 + 16 * j + i16;
    LAS unsigned char* vw = lds + w * NA_WLDS; LAS float* tb = (LAS float*)(vw + 64 * NVP);
    { const float* rpb = rpb_all + (size_t)(l * 8 + h) * 465;
#pragma unroll
      for (int it = 0; it < 8; ++it) { const int idx = it * 64 + lane; if (idx < 465) tb[idx] = rpb[idx]; } }
    bf16x8 qf[2];
    qf[0] = *(const bf16x8*)(proj + qtok * DPROJ + h * 64 + quad * 8); qf[1] = *(const bf16x8*)(proj + qtok * DPROJ + h * 64 + 32 + quad * 8);
    const int cA = (i16 >> 2) * 8 + (i16 & 3);
    const bf16* kp0 = proj + (base + (size_t)rs * 64 + kc0 + cA) * DPROJ + C_KA + h * 64 + quad * 8;
    bf16x8 kf[8][4];
#pragma unroll
    for (int wr = 0; wr < 8; ++wr) { const bf16* kp = kp0 + (size_t)wr * 64 * DPROJ;
        kf[wr][0] = *(const bf16x8*)kp; kf[wr][1] = *(const bf16x8*)(kp + 32); kf[wr][2] = *(const bf16x8*)(kp + 4 * DPROJ); kf[wr][3] = *(const bf16x8*)(kp + 4 * DPROJ + 32); }
    const bf16* vp0 = proj + (base + (size_t)rs * 64 + kc0) * DPROJ + C_VA + h * 64;
    v4u vt[8];
#define NA_VLOAD(ck) do { _Pragma("unroll") for (int it = 0; it < 8; ++it) { const int idx = it * 64 + lane, key = idx >> 3, ch = idx & 7; \
        vt[it] = *(const v4u*)(vp0 + ((size_t)(2 * (ck) + (key >> 5)) * 64 + (key & 31)) * DPROJ + ch * 8); } } while (0)
    NA_VLOAD(0);
    f32x4 sa[8], sb[8];
#pragma unroll
    for (int wr = 0; wr < 8; ++wr) {
        f32x4 a = {0.f, 0.f, 0.f, 0.f}, b = {0.f, 0.f, 0.f, 0.f};
        a = __builtin_amdgcn_mfma_f32_16x16x32_bf16(kf[wr][0], qf[0], a, 0, 0, 0); a = __builtin_amdgcn_mfma_f32_16x16x32_bf16(kf[wr][1], qf[1], a, 0, 0, 0);
        b = __builtin_amdgcn_mfma_f32_16x16x32_bf16(kf[wr][2], qf[0], b, 0, 0, 0); b = __builtin_amdgcn_mfma_f32_16x16x32_bf16(kf[wr][3], qf[1], b, 0, 0, 0);
        sa[wr] = a; sb[wr] = b;
    }
    asm volatile("s_waitcnt lgkmcnt(0)" ::: "memory");
    const int qc = 16 * j + i16, wst = min(max(qc - 8, 0), 48);
    float mx = -1e30f;
#pragma unroll
    for (int wr = 0; wr < 8; ++wr) { const LAS float* rb = tb + (rs + wr - r + 7) * 31;
#pragma unroll
        for (int jj = 0; jj < 4; ++jj) {
            { const int kc = kc0 + quad * 8 + jj; const bool ok = (kc >= wst) && (kc < wst + 16); const int dc = min(max(kc - qc + 15, 0), 30);
              const float v = ok ? (sa[wr][jj] + rb[dc] * LOG2E) : -1e30f; sa[wr][jj] = v; mx = fmaxf(mx, v); }
            { const int kc = kc0 + quad * 8 + 4 + jj; const bool ok = (kc >= wst) && (kc < wst + 16); const int dc = min(max(kc - qc + 15, 0), 30);
              const float v = ok ? (sb[wr][jj] + rb[dc] * LOG2E) : -1e30f; sb[wr][jj] = v; mx = fmaxf(mx, v); }
        } }
    mx = fmaxf(mx, __shfl_xor(mx, 16)); mx = fmaxf(mx, __shfl_xor(mx, 32));
    float ls = 0.f;
#pragma unroll
    for (int wr = 0; wr < 8; ++wr)
#pragma unroll
        for (int jj = 0; jj < 4; ++jj) { sa[wr][jj] = __builtin_amdgcn_exp2f(sa[wr][jj] - mx); sb[wr][jj] = __builtin_amdgcn_exp2f(sb[wr][jj] - mx); ls += sa[wr][jj] + sb[wr][jj]; }
    ls += __shfl_xor(ls, 16); ls += __shfl_xor(ls, 32);
    f32x4 oc[4];
#pragma unroll
    for (int db = 0; db < 4; ++db) oc[db] = (f32x4){0.f, 0.f, 0.f, 0.f};
    const int toff = (quad * 8 + (i16 >> 2)) * NVP + (4 * (lane & 3)) * 2;
#pragma unroll
    for (int ck = 0; ck < 4; ++ck) {
        asm volatile("s_waitcnt lgkmcnt(0)" ::: "memory");
#pragma unroll
        for (int it = 0; it < 8; ++it) { const int idx = it * 64 + lane, key = idx >> 3, ch = idx & 7; *(LAS v4u*)(vw + key * NVP + ch * 16) = vt[it]; }
        if (ck < 3) NA_VLOAD(ck + 1);
        asm volatile("s_waitcnt lgkmcnt(0)" ::: "memory");
#pragma unroll
        for (int wl = 0; wl < 2; ++wl) { const int wr = 2 * ck + wl;
            v4u pw; pw.x = pk2(sa[wr][0], sa[wr][1]); pw.y = pk2(sa[wr][2], sa[wr][3]); pw.z = pk2(sb[wr][0], sb[wr][1]); pw.w = pk2(sb[wr][2], sb[wr][3]);
            const bf16x8 pf = __builtin_bit_cast(bf16x8, pw);
#pragma unroll
            for (int db = 0; db < 4; ++db) { const int vb = toff + wl * 32 * NVP + db * 32;
                const s16x4 t0 = __builtin_amdgcn_ds_read_tr16_b64_v4i16((LAS s16x4*)(vw + vb)), t1 = __builtin_amdgcn_ds_read_tr16_b64_v4i16((LAS s16x4*)(vw + vb + 4 * NVP));
                const bf16x8 vf = {t0[0], t0[1], t0[2], t0[3], t1[0], t1[1], t1[2], t1[3]};
                oc[db] = __builtin_amdgcn_mfma_f32_16x16x32_bf16(vf, pf, oc[db], 0, 0, 0); }
        }
    }
#undef NA_VLOAD
    const float inv = 1.f / ls;
    bf16* orow = ya + qtok * 512 + h * 64 + quad * 4;
#pragma unroll
    for (int db = 0; db < 4; ++db) { v2u o; o.x = pk2(oc[db][0] * inv, oc[db][1] * inv); o.y = pk2(oc[db][2] * inv, oc[db][3] * inv); *(v2u*)(orow + db * 16) = o; }
    asm volatile("s_waitcnt lgkmcnt(0)" ::: "memory");
}

#define XB_TMO      128
#define XB_XCNT(j)  (256  + 64 * (j))
#define XB_XSUB(j)  (1280 + 64 * (j))
#define XB_XGEN(j)  (2304 + 64 * (j))
#define XB_TOP      3328
#define XB_TOPGEN   3392
#define XCD_BAR_WORDS 3456
#define XB_SPIN_CAP (1u << 18)

__device__ __forceinline__ unsigned xb_ld(unsigned* p)              { return __hip_atomic_load(p, __ATOMIC_RELAXED, __HIP_MEMORY_SCOPE_AGENT); }
__device__ __forceinline__ unsigned xb_add(unsigned* p, unsigned v) { return __hip_atomic_fetch_add(p, v, __ATOMIC_RELAXED, __HIP_MEMORY_SCOPE_AGENT); }
__device__ __forceinline__ unsigned xb_xcc_id() { return (unsigned)__builtin_amdgcn_s_getreg((3 << 11) | 20) & 0xFu; }
#define XB_SPIN(cond, bar) do { unsigned _sp = 0; while (cond) { __builtin_amdgcn_s_sleep(1); \
    if ((++_sp & 255u) == 0u) { if (xb_ld(&(bar)[XB_TMO])) break; if (_sp > XB_SPIN_CAP) { atomicAdd(&(bar)[XB_TMO], 1u); break; } } } } while (0)

struct XcdBarrier {
    unsigned* bar; unsigned x;
    volatile LAS unsigned* st;
};

__device__ __forceinline__ XcdBarrier xcd_barrier_post(unsigned* bar, volatile LAS unsigned* st) {
    XcdBarrier b; b.bar = bar; b.x = xb_xcc_id(); b.st = st;
    if (threadIdx.x == 0) (void)xb_add(&bar[XB_XCNT(b.x)], 1u);
    return b;
}
__device__ __forceinline__ void xcd_barrier_complete(unsigned* bar, unsigned x, unsigned& nloc, unsigned& nx) {
    const unsigned G = gridDim.x * gridDim.y * gridDim.z;
    unsigned sum, cnt, mine, sp = 0u;
    for (;;) {
        sum = 0u; cnt = 0u; mine = 0u;
#pragma unroll
        for (unsigned j = 0; j < 16; ++j) { const unsigned c = xb_ld(&bar[XB_XCNT(j)]); sum += c; cnt += (c > 0u) ? 1u : 0u; mine = (j == x) ? c : mine; }
        if (sum == G) break;
        __builtin_amdgcn_s_sleep(1);
        if ((++sp & 255u) == 0u) { if (xb_ld(&bar[XB_TMO])) break; if (sp > XB_SPIN_CAP) { atomicAdd(&bar[XB_TMO], 1u); break; } }
    }
    nloc = mine > 0u ? mine : 1u; nx = cnt > 0u ? cnt : 1u;
}

__device__ __forceinline__ void xcd_barrier(const XcdBarrier& b) {
    asm volatile("s_waitcnt vmcnt(0)" ::: "memory");
    __syncthreads();
    if (threadIdx.x == 0) {
        unsigned* bar = b.bar;
        __builtin_amdgcn_s_waitcnt(0);
        unsigned nloc = b.st[0], nx = b.st[1];
        if (nloc == 0u) { xcd_barrier_complete(bar, b.x, nloc, nx); b.st[0] = nloc; b.st[1] = nx; }
        const unsigned old = xb_add(&bar[XB_XSUB(b.x)], 1u);
        const unsigned gen = old / nloc;
        if (old + 1u == (gen + 1u) * nloc) {
            __builtin_amdgcn_fence(__ATOMIC_RELEASE, "agent");
            asm volatile("s_waitcnt vmcnt(0)" ::: "memory");
            const unsigned og = xb_add(&bar[XB_TOP], 1u);
            const unsigned tg = og / nx;
            if (og + 1u == (tg + 1u) * nx) xb_add(&bar[XB_TOPGEN], 1u);
            else XB_SPIN(xb_ld(&bar[XB_TOPGEN]) == tg, bar);
            __builtin_amdgcn_fence(__ATOMIC_ACQUIRE, "agent");
            xb_add(&bar[XB_XGEN(b.x)], 1u);
            asm volatile("s_waitcnt vmcnt(0)" ::: "memory");
        } else {
            XB_SPIN(xb_ld(&bar[XB_XGEN(b.x)]) == gen, bar);
            __builtin_amdgcn_fence(__ATOMIC_ACQUIRE, "agent");
            asm volatile("s_waitcnt vmcnt(0)" ::: "memory");
        }
    }
    __syncthreads();
}

constexpr int NPH = 13;
__device__ __forceinline__ void run_phase(CP pp, int st, LAS unsigned char* lds) {
    volatile LAS unsigned* lctl = (volatile LAS unsigned*)(lds + LDS_RING);
    const int tid = ltid(), lane = tid & 63, wave = __builtin_amdgcn_readfirstlane(tid >> 6);
    int bid_ = blockIdx.x; asm volatile("" : "+s"(bid_));
    const int NB = gridDim.x, gw = bid_ * 8 + wave, ngw = NB * 8;
    const int ph = st % NPH, gl = st / NPH, l = gl & 1, g = gl >> 1;
    unsigned char* ws = pp->ws; const int Tg = pp->Tg;
    const Reg R{ws, (size_t)Tg};
    const size_t asz = (size_t)Tg * 512;
    const int t0 = g * Tg; const int L = (t0 < NPROMPT) ? 8192 : 4096;
    float* xout = pp->out + (size_t)t0 * DM;
    int gid0 = 0, gidn = 0;
    switch (ph) {
    case 0: {
        const float* xin = (l == 0) ? ((t0 < NPROMPT) ? pp->in[0] + (size_t)t0 * DM : pp->in[1] + (size_t)(t0 - NPROMPT) * DM) : xout;
        phase_norm(xin, pp->in[2] + l * DM, R.RH(), Tg, gw, ngw, lane);
    } break;
    case 1: gid0 = GM_IN; gidn = 1; break;
    case 2: {
        phase_post_proj(pp, l, R.RP(), R.RA(), R.RA() + (size_t)Tg * 384, R.RS(), (_Float16*)R.RZ(), asz, Tg, L, gw, ngw, lane);
    } break;
    case 3: gid0 = GM_MU; gidn = 2; break;
    case 4: {
        phase_mla_post(pp, l, R.RM(), R.RP(), R.RA(), Tg, L, gw, ngw, lane);
    } break;
    case 5: {
        unsigned* qctr = (unsigned*)(ws + WS_CTL) + 64 * gl; const int nseq = Tg / L;
        const int NS = nseq * 16, NM = nseq * 8 * (L >> 8), NN = nseq * (L >> 6) * 4, NTOT = NS + NM + NN;
        for (;;) {
            __syncthreads();
            if (tid == 0) lctl[0] = atomicAdd(qctr, 1u);
            __syncthreads();
            const int u = __builtin_amdgcn_readfirstlane((int)lctl[0]);
            if (u >= NTOT) break;
            if (u < NS) scan_unit(u, L, R.RS(), asz, R.RZ(), lds);
            else if (u < NS + NM) mla_unit(u - NS, L, R.RM(), R.RA(), R.RY() + asz, lds);
            else na_unit(u - NS - NM, L, l, pp->in[7], R.RP(), R.RY(), lds);
        }
    } break;
    case 6: {
        phase_rw_post(pp, l, R.RS(), asz, R.RZ(), R.RY() + 2 * asz, Tg, gw, ngw, lane);
    } break;
    case 7: gid0 = GM_GATE; gidn = 1; break;
    case 8: gid0 = GM_BR0; gidn = 3; break;
    case 9: gid0 = GM_OUT; gidn = 1; break;
    case 10: {
        phase_norm(xout, pp->in[29] + l * DM, R.RH(), Tg, gw, ngw, lane);
    } break;
    case 11: gid0 = GM_GU; gidn = 1; break;
    case 12: gid0 = GM_DN; gidn = 1; break;
    default: break;
    }
#pragma unroll 1
    for (int id = gid0; id < gid0 + gidn; ++id) {
        const unsigned char* wb = ws + W_OFF + (size_t)l * W_STRIDE;
        const bf16* A; const bf16* Bt; int N, K;
        switch (id) {
        case GM_IN:   A = R.RH(); Bt = (const bf16*)(wb + WO_IN); N = DPROJ; K = 1024; break;
        case GM_MU:   A = R.RA(); Bt = (const bf16*)(wb + WO_MU); N = 1792; K = 384; break;
        case GM_RU:   A = R.RA() + (size_t)Tg * 384; Bt = (const bf16*)(wb + WO_RU); N = 2560; K = 384; break;
        case GM_GATE: A = R.RH(); Bt = (const bf16*)(wb + WO_G); N = DGATE; K = 1024; break;
        case GM_BR0: case GM_BR1: case GM_BR2: A = R.RY() + (size_t)(id - GM_BR0) * asz; Bt = (const bf16*)(wb + WO_BR + (size_t)(id - GM_BR0) * MiB); N = DM; K = 512; break;
        case GM_OUT:  A = R.RM(); Bt = (const bf16*)(wb + WO_OUT); N = DM; K = 1024; break;
        case GM_GU:   A = R.RH(); Bt = (const bf16*)(wb + WO_GU); N = 2 * DFF; K = 1024; break;
        default:      A = R.RP(); Bt = (const bf16*)(wb + WO_DN); N = DM; K = DFF; break;
        }
        pg8::Gemm gm{A, Bt, Tg, N, K, (id == GM_MU) ? 1 : ((id == GM_RU) ? 2 : 0)}; pg8::StaticOrder S; S.init(Tg, N, NB, bid_);
        EpiUni E{pp, id, l, g}; pg8::gemm_phase<EpiUni, pg8::StaticOrder, true, true>(lds, gm, S, E);
    }
}

__device__ __forceinline__ void run_phase0(CP pp, int part, LAS unsigned char* lds) {
    const int tid = ltid(), lane = tid & 63, wave = __builtin_amdgcn_readfirstlane(tid >> 6);
    const int NB = gridDim.x, gw = blockIdx.x * 8 + wave, ngw = NB * 8;
    const size_t gtid = (size_t)blockIdx.x * 512 + tid, ngt = (size_t)NB * 512;
    unsigned char* ws = pp->ws;
    if (part == 0) {
        for (int l = 0; l < 2; ++l) { unsigned char* wb = ws + W_OFF + (size_t)l * W_STRIDE;
            zero_bytes(wb + WO_IN + (size_t)NMAIN * 2048, (size_t)(DPROJ - NMAIN) * 2048, gtid, ngt);
            zero_bytes(wb + WO_MU, (size_t)1792 * 384 * 2, gtid, ngt);
            zero_bytes(wb + WO_RU, (size_t)2560 * 384 * 2, gtid, ngt); }
    } else {
        LAS float* scr = (LAS float*)(lds + wave * 16384);
#pragma unroll 1
        for (int l = 0; l < 2; ++l) { unsigned char* wb = ws + W_OFF + (size_t)l * W_STRIDE;
            const float* w_in = pp->in[3] + (size_t)l * DM * DIN;
            transpose_job(w_in, DIN, 1024, NMAIN, (bf16*)(wb + WO_IN), 1024, 0, 0, 0, scr, gw, ngw, lane);
            transpose_job(w_in + NMAIN, DIN, 1024, DGATE, (bf16*)(wb + WO_G), 1024, 0, 0, 0, scr, gw, ngw, lane);
            transpose_job(pp->in[8] + (size_t)l * 512 * 1024, 1024, 512, 1024, (bf16*)(wb + WO_BR), 512, 0, 0, 0, scr, gw, ngw, lane);
            transpose_job(pp->in[15] + (size_t)l * 512 * 1024, 1024, 512, 1024, (bf16*)(wb + WO_BR + 1 * MiB), 512, 0, 0, 0, scr, gw, ngw, lane);
            transpose_job(pp->in[27] + (size_t)l * 512 * 1024, 1024, 512, 1024, (bf16*)(wb + WO_BR + 2 * MiB), 512, 0, 0, 0, scr, gw, ngw, lane);
            transpose_job(pp->in[28] + (size_t)l * 1024 * 1024, 1024, 1024, 1024, (bf16*)(wb + WO_OUT), 1024, 0, 0, 0, scr, gw, ngw, lane);
            transpose_job(pp->in[30] + (size_t)l * 1024 * DFF, DFF, 1024, DFF, (bf16*)(wb + WO_GU), 1024, 0, 0, 1, scr, gw, ngw, lane);
            transpose_job(pp->in[31] + (size_t)l * 1024 * DFF, DFF, 1024, DFF, (bf16*)(wb + WO_GU), 1024, 0, 128, 1, scr, gw, ngw, lane);
            transpose_job(pp->in[32] + (size_t)l * DFF * 1024, 1024, DFF, 1024, (bf16*)(wb + WO_DN), DFF, 0, 0, 0, scr, gw, ngw, lane);
            transpose_job(pp->in[11] + (size_t)l * 256 * 768, 768, 256, 768, (bf16*)(wb + WO_MU), 384, 0, 0, 0, scr, gw, ngw, lane);
            transpose_job(pp->in[12] + (size_t)l * 128 * 1024, 1024, 128, 1024, (bf16*)(wb + WO_MU), 384, 256, 768, 0, scr, gw, ngw, lane);
#pragma unroll 1
            for (int d = 0; d < 2; ++d) {
                transpose_job(pp->in[18] + (size_t)(l * 2 + d) * 64 * 512, 512, 64, 512, (bf16*)(wb + WO_RU), 384, 64 * d, 512 * d, 0, scr, gw, ngw, lane);
                transpose_job(pp->in[20] + (size_t)(l * 2 + d) * 64 * 512, 512, 64, 512, (bf16*)(wb + WO_RU), 384, 128 + 64 * d, 1024 + 512 * d, 0, scr, gw, ngw, lane); }
            transpose_job(pp->in[21] + (size_t)l * 128 * 512, 512, 128, 512, (bf16*)(wb + WO_RU), 384, 256, 2048, 0, scr, gw, ngw, lane);
        }
    }
}

__global__ void __launch_bounds__(512, 2) mega(Params p) {
    extern __shared__ __attribute__((aligned(16))) unsigned char lds_raw[];
    LAS unsigned char* lds = (LAS unsigned char*)lds_raw;
    cg::grid_group grid = cg::this_grid();
    if (blockIdx.x == 0 && threadIdx.x == 0) { Params* d = (Params*)(p.ws + WS_PARAMS); *d = p; }
    const int nsteps = p.G * 2 * NPH;
    volatile LAS unsigned* bst = (volatile LAS unsigned*)(lds + LDS_RING + 32);
    if (threadIdx.x == 0) { bst[0] = 0u; bst[1] = 0u; }
    __syncthreads();
    const XcdBarrier bar = xcd_barrier_post((unsigned*)(p.ws + WS_CTL) + 4096, bst);
    grid.sync();
#pragma unroll 1
    for (int st = -2; st < nsteps; ++st) {
        int s2 = st; asm volatile("" : "+s"(s2));
        CP pp = (CP)(p.ws + WS_PARAMS); asm volatile("" : "+s"(pp));
        if (s2 < 0) run_phase0(pp, s2 + 2, lds); else run_phase(pp, s2, lds);
        xcd_barrier(bar);
    }
}

extern "C" void kernel_launch(void* const* d_in, const int* in_sizes, int n_in, void* d_out, int out_size, void* d_ws, size_t ws_size, hipStream_t stream) {
    static int grid = 0;
    if (grid == 0) {
        int dev = 0, cus = 0, per_cu = 0;
        hipGetDevice(&dev); hipDeviceGetAttribute(&cus, hipDeviceAttributeMultiprocessorCount, dev);
        hipFuncSetAttribute((const void*)mega, hipFuncAttributeMaxDynamicSharedMemorySize, LDS_BYTES);
        hipOccupancyMaxActiveBlocksPerMultiprocessor(&per_cu, (const void*)mega, 512, LDS_BYTES);
        (void)hipGetLastError();
        if (per_cu < 1) per_cu = 1;
        grid = cus * per_cu;
    }
    int G = 2;
    while (G < 16 && ACT_OFF + (size_t)(NTOK / G) * TOKB > ws_size) G *= 2;
    if (hipMemsetAsync((char*)d_ws + WS_CTL, 0, CTL_BYTES, stream) != hipSuccess) { fprintf(stderr, "kernel_launch: memset failed\n"); return; }
    Params p{};
    for (int i = 0; i < 33; ++i) p.in[i] = (const float*)d_in[i];
    p.out = (float*)d_out; p.ws = (unsigned char*)d_ws; p.G = G; p.Tg = NTOK / G;
    void* args[] = {&p};
    hipError_t e = hipLaunchCooperativeKernel((const void*)mega, dim3(grid), dim3(512), args, LDS_BYTES, stream);
    if (e != hipSuccess) fprintf(stderr, "cooperative launch failed: %s (grid %d)\n", hipGetErrorString(e), grid);
}
```

```cpp
#include <hip/hip_runtime.h>
#include <hip/hip_cooperative_groups.h>
#include <cstdio>
#include <cstdint>
namespace cg = cooperative_groups;
namespace pg8 {
#define PG8_LAS __attribute__((address_space(3)))
typedef unsigned short bf16_t;
typedef short bf16x8 __attribute__((ext_vector_type(8)));
typedef float f32x4 __attribute__((ext_vector_type(4)));
typedef unsigned u32x4 __attribute__((ext_vector_type(4)));
constexpr int BM = 256, BK = 64, HALF = 128, HTB = HALF * BK * 2  , STAGE_BYTES = 8 * HTB, NXCD = 8, WGM = 8;

__host__ __device__ __forceinline__ int lds_byte(int r, int c) { const int st = (r >> 4) * 2 + (c >> 5), rr = r & 15, cc = c & 31, ob = rr * 64 + cc * 2; return st * 1024 + (ob ^ (((ob >> 9) & 1) << 5)); }
__host__ __device__ __forceinline__ void stage_rc(int b, int& R, int& C) { const int st = b / 1024, sb = b % 1024, swz = sb ^ (((sb >> 9) & 1) << 5); R = (st >> 1) * 16 + swz / 64; C = (st & 1) * 32 + (swz % 64) / 2; }
__host__ __device__ __forceinline__ int perm32(int rho) { const int n = rho >> 4, i = rho & 15; return 8 * (i >> 2) + 4 * n + (i & 3); }

struct Unit { int pm, pn; };
struct Gemm { const bf16_t* A; const bf16_t* Bt; int M, N, K; int kmode; };
__device__ __forceinline__ void krange(int kmode, int pn, int K, int& kof, int& nt) {
    kof = 0; nt = K / BK;
    if (kmode == 1) { if (pn < 3) { nt = 4; } else { kof = 256; nt = 2; } }
    else if (kmode == 2) { kof = (pn < 4) ? 0 : ((pn < 8) ? 128 : 256); nt = 2; }
}

struct StaticOrder {
    int nM, nN, nwg, G, c;
    __host__ __device__ void init(int M, int N, int G_, int c_) { nM = M / BM; nN = N / BM; nwg = nM * nN; G = G_; c = c_; }
    __host__ __device__ bool next(int i, Unit& u) const {
        const long L = (long)i * G + c; if (L >= nwg) return false;
        int wgid = (int)L; { const int q = nwg / NXCD, r = nwg % NXCD, xcd = wgid % NXCD, off = wgid / NXCD; wgid = (xcd < r ? xcd * (q + 1) : r * (q + 1) + (xcd - r) * q) + off; }
        const int nig = WGM * nN, gid = wgid / nig, fm = gid * WGM, gsz = (nM - fm) < WGM ? (nM - fm) : WGM;
        u.pm = fm + ((wgid % nig) % gsz); u.pn = (wgid % nig) / gsz; return true;
    }
    __device__ __forceinline__ void a_ready(const Unit&) const {}
    __device__ __forceinline__ void done(const Unit&) const {}
};

__device__ __forceinline__ unsigned cvt_pk_bf16(float lo, float hi) { unsigned r; asm volatile("v_cvt_pk_bf16_f32 %0, %1, %2" : "=v"(r) : "v"(lo), "v"(hi)); return r; }
typedef float f32x2 __attribute__((ext_vector_type(2)));
}
namespace pg8 {
template <class Epi, class Sched, bool ALIGN_EPI = false, bool SP2 = false>
__device__ __forceinline__ void gemm_phase(PG8_LAS unsigned char* lds, const Gemm g, const Sched& S, const Epi& E) {
    int tid_l = threadIdx.x; asm volatile("" : "+v"(tid_l)); const int tid = tid_l, wid = __builtin_amdgcn_readfirstlane(tid >> 6), lane = tid & 63, wr = wid >> 2, wc = wid & 3, fr = lane & 15, fq = lane >> 4;
    const int K = g.K; int nt = K / BK;
    unsigned voffA[2], voffB[2];
#pragma unroll
    for (int i = 0; i < 2; ++i) { int R, C; stage_rc(tid * 16 + i * 8192, R, C); const int Rb = Epi::PERM ? ((R & ~31) + perm32(R & 31)) : R;
        voffA[i] = (unsigned)(R * K + C) * 2u; voffB[i] = (unsigned)(Rb * K + C) * 2u; }
    const size_t kstep = (size_t)(BK * 2);
    const size_t hstep = (size_t)HALF * K * 2;
    const size_t tstep = 2 * hstep;
    const unsigned ldsw = (unsigned)wid * 1024u;
    const int aoff = lds_byte(wr * 64 + fr, fq * 8), boff = lds_byte(wc * 32 + fr, fq * 8);
#define PG8_SA(b, h) (((b) * 2 + (h)) * HTB)
#define PG8_SB(b, h) ((4 + (b) * 2 + (h)) * HTB)
#define PG8_STAGE(bufoff, gbase, voff) do { _Pragma("unroll") for (int _i = 0; _i < 2; ++_i) \
        __builtin_amdgcn_global_load_lds((const unsigned*)((const char*)(gbase) + (voff)[_i]), (PG8_LAS unsigned*)(lds + (bufoff) + ldsw + _i * 8192), 16, 0, 0); } while (0)
#define PG8_LDA(dst, b, h) do { _Pragma("unroll") for (int m = 0; m < 4; ++m) _Pragma("unroll") for (int k = 0; k < 2; ++k) dst[m][k] = *(const PG8_LAS bf16x8*)(lds + PG8_SA(b, h) + aoff + m * 2048 + k * 1024); } while (0)
#define PG8_LDB(dst, b, h) do { _Pragma("unroll") for (int n = 0; n < 2; ++n) _Pragma("unroll") for (int k = 0; k < 2; ++k) dst[n][k] = *(const PG8_LAS bf16x8*)(lds + PG8_SB(b, h) + boff + n * 2048 + k * 1024); } while (0)
#define PG8_MMA(ai, bj, At, Bt) do { __builtin_amdgcn_s_setprio(1); _Pragma("unroll") for (int m = 0; m < 4; ++m) _Pragma("unroll") for (int n = 0; n < 2; ++n) _Pragma("unroll") for (int k = 0; k < 2; ++k) \
        acc[ai][bj][m][n] = __builtin_amdgcn_mfma_f32_16x16x32_bf16(Bt[n][k], At[m][k], acc[ai][bj][m][n], 0, 0, 0); __builtin_amdgcn_s_setprio(0); } while (0)
#define PG8_WAIT_V(n) asm volatile("s_waitcnt vmcnt(" #n ")" ::: "memory")
#define PG8_WAIT_L(n) asm volatile("s_waitcnt lgkmcnt(" #n ")" ::: "memory")
#define PG8_BAR __builtin_amdgcn_s_barrier()
#define PG8_SCHED __builtin_amdgcn_sched_barrier(0)
    Unit cur, nxt; int ui = 0;
    if (!S.next(0, cur)) return;
    f32x4 acc[2][2][4][2];
#pragma unroll
    for (int a = 0; a < 2; ++a)
#pragma unroll
        for (int b = 0; b < 2; ++b)
#pragma unroll
            for (int m = 0; m < 4; ++m)
#pragma unroll
                for (int n = 0; n < 2; ++n) acc[a][b][m][n] = (f32x4){0.f, 0.f, 0.f, 0.f};
    bf16x8 At[4][2], B0[2][2], B1[2][2];
    int kofc_; krange(g.kmode, cur.pn, K, kofc_, nt);
    const char* cA = (const char*)g.A + (size_t)cur.pm * tstep + (size_t)kofc_ * 2; const char* cB = (const char*)g.Bt + (size_t)cur.pn * tstep + (size_t)kofc_ * 2;
    S.a_ready(cur);
    if constexpr (SP2) {
        PG8_STAGE(PG8_SB(0, 0), cB, voffB); PG8_STAGE(PG8_SB(0, 1), cB + hstep, voffB); PG8_STAGE(PG8_SA(0, 0), cA, voffA); PG8_STAGE(PG8_SA(0, 1), cA + hstep, voffA);
        if (wr == 1) PG8_BAR;
        PG8_WAIT_V(2); PG8_BAR;
        PG8_STAGE(PG8_SB(1, 0), cB + kstep, voffB); PG8_STAGE(PG8_SA(1, 0), cA + kstep, voffA); PG8_STAGE(PG8_SB(1, 1), cB + hstep + kstep, voffB);
        PG8_WAIT_V(6); PG8_BAR;
    } else {
        PG8_STAGE(PG8_SB(0, 0), cB, voffB); PG8_STAGE(PG8_SA(0, 0), cA, voffA); PG8_STAGE(PG8_SB(0, 1), cB + hstep, voffB); PG8_STAGE(PG8_SA(0, 1), cA + hstep, voffA);
        if (wr == 1) PG8_BAR;
        PG8_WAIT_V(4); PG8_BAR;
        PG8_STAGE(PG8_SB(1, 0), cB + kstep, voffB); PG8_STAGE(PG8_SA(1, 0), cA + kstep, voffA); PG8_STAGE(PG8_SB(1, 1), cB + hstep + kstep, voffB);
        PG8_WAIT_V(6); PG8_BAR;
    }
    for (;;) {
        const bool has_next = S.next(ui + 1, nxt);
        int kofn_ = 0, ntn_ = nt; if (has_next) krange(g.kmode, nxt.pn, K, kofn_, ntn_);
        const char* nA = has_next ? (const char*)g.A + (size_t)nxt.pm * tstep + (size_t)kofn_ * 2 : cA; const char* nB = has_next ? (const char*)g.Bt + (size_t)nxt.pn * tstep + (size_t)kofn_ * 2 : cB;
        for (int t = 0; t < nt; t += 2) {
            const bool last = (t == nt - 2);
            const char* a1 = cA + (size_t)(t + 1) * kstep;
            const char* a2 = last ? nA : cA + (size_t)(t + 2) * kstep; const char* b2 = last ? nB : cB + (size_t)(t + 2) * kstep;
            const char* a3 = a2 + kstep; const char* b3 = b2 + kstep;
            if (last && has_next) S.a_ready(nxt);
            if constexpr (SP2) {
            PG8_LDB(B0, 0, 0); PG8_LDB(B1, 0, 1); PG8_SCHED; PG8_LDA(At, 0, 0); PG8_STAGE(PG8_SA(1, 1), a1 + hstep, voffA);
            PG8_WAIT_V(8); PG8_WAIT_L(0); PG8_BAR; PG8_MMA(0, 0, At, B0); PG8_MMA(0, 1, At, B1); PG8_BAR; PG8_SCHED;
            PG8_LDA(At, 0, 1); PG8_STAGE(PG8_SB(0, 0), b2, voffB); PG8_STAGE(PG8_SB(0, 1), b2 + hstep, voffB); PG8_STAGE(PG8_SA(0, 0), a2, voffA);
            PG8_WAIT_V(8); PG8_WAIT_L(0); PG8_BAR; PG8_MMA(1, 0, At, B0); PG8_MMA(1, 1, At, B1); PG8_BAR; PG8_SCHED;
            PG8_LDB(B0, 1, 0); PG8_LDB(B1, 1, 1); PG8_SCHED; PG8_LDA(At, 1, 0); PG8_STAGE(PG8_SA(0, 1), a2 + hstep, voffA);
            PG8_WAIT_V(8); PG8_WAIT_L(0); PG8_BAR; PG8_MMA(0, 0, At, B0); PG8_MMA(0, 1, At, B1); PG8_BAR; PG8_SCHED;
            PG8_LDA(At, 1, 1); PG8_STAGE(PG8_SB(1, 0), b3, voffB); PG8_STAGE(PG8_SB(1, 1), b3 + hstep, voffB); PG8_STAGE(PG8_SA(1, 0), a3, voffA);
            PG8_WAIT_V(8); PG8_WAIT_L(0); PG8_BAR; PG8_MMA(1, 0, At, B0); PG8_MMA(1, 1, At, B1); PG8_BAR; PG8_SCHED;
            } else {
            PG8_LDB(B0, 0, 0); PG8_SCHED; PG8_LDA(At, 0, 0); PG8_STAGE(PG8_SA(1, 1), a1 + hstep, voffA);
            PG8_WAIT_L(8); PG8_BAR; PG8_WAIT_L(0); PG8_MMA(0, 0, At, B0); PG8_BAR; PG8_SCHED;
            PG8_LDB(B1, 0, 1); PG8_STAGE(PG8_SB(0, 0), b2, voffB);
            PG8_BAR; PG8_WAIT_L(0); PG8_MMA(0, 1, At, B1); PG8_BAR;
            PG8_LDA(At, 0, 1); PG8_STAGE(PG8_SA(0, 0), a2, voffA);
            PG8_BAR; PG8_WAIT_L(0); PG8_MMA(1, 0, At, B0); PG8_BAR; PG8_SCHED;
            PG8_STAGE(PG8_SB(0, 1), b2 + hstep, voffB);
            PG8_WAIT_V(6); PG8_BAR; PG8_MMA(1, 1, At, B1); PG8_BAR;
            PG8_LDB(B0, 1, 0); PG8_SCHED; PG8_LDA(At, 1, 0); PG8_STAGE(PG8_SA(0, 1), a2 + hstep, voffA);
            PG8_WAIT_L(8); PG8_BAR; PG8_WAIT_L(0); PG8_MMA(0, 0, At, B0); PG8_BAR; PG8_SCHED;
            PG8_LDB(B1, 1, 1); PG8_STAGE(PG8_SB(1, 0), b3, voffB);
            PG8_BAR; PG8_WAIT_L(0); PG8_MMA(0, 1, At, B1); PG8_BAR;
            PG8_LDA(At, 1, 1); PG8_STAGE(PG8_SA(1, 0), a3, voffA);
            PG8_BAR; PG8_WAIT_L(0); PG8_MMA(1, 0, At, B0); PG8_BAR; PG8_SCHED;
            PG8_STAGE(PG8_SB(1, 1), b3 + hstep, voffB);
            PG8_WAIT_V(6); PG8_BAR; PG8_MMA(1, 1, At, B1); PG8_BAR;
            }
        }
        if constexpr (ALIGN_EPI) { if (wr == 0) PG8_BAR; }
        if constexpr (!Epi::AFTER_DRAIN) { E(acc, cur, wr, wc, fr, fq); S.done(cur); }
        if (!has_next) break;
#pragma unroll
        for (int a = 0; a < 2; ++a)
#pragma unroll
            for (int b = 0; b < 2; ++b)
#pragma unroll
                for (int m = 0; m < 4; ++m)
#pragma unroll
                    for (int n = 0; n < 2; ++n) acc[a][b][m][n] = (f32x4){0.f, 0.f, 0.f, 0.f};
        cur = nxt; cA = nA; cB = nB; nt = ntn_; ++ui;
        if constexpr (ALIGN_EPI) { if (wr == 1) PG8_BAR; }
    }
    PG8_WAIT_V(0);
    if constexpr (!ALIGN_EPI) { if (wr == 0) PG8_BAR; }
    PG8_BAR;
    if constexpr (Epi::AFTER_DRAIN) { E.fused(acc, cur, wr, wc, fr, fq, lds, wid, lane); S.done(cur); }
#undef PG8_SA
#undef PG8_SB
#undef PG8_STAGE
#undef PG8_LDA
#undef PG8_LDB
#undef PG8_MMA
#undef PG8_WAIT_V
#undef PG8_WAIT_L
#undef PG8_BAR
#undef PG8_SCHED
}
}

#define LAS __attribute__((address_space(3)))
typedef unsigned short bf16;
typedef unsigned v4u __attribute__((ext_vector_type(4)));
typedef unsigned v2u __attribute__((ext_vector_type(2)));
typedef float f32x4 __attribute__((ext_vector_type(4)));
typedef float f32x16 __attribute__((ext_vector_type(16)));
typedef short bf16x8 __attribute__((ext_vector_type(8)));
typedef short s16x4 __attribute__((ext_vector_type(4)));
typedef _Float16 h8 __attribute__((ext_vector_type(8)));

__device__ __forceinline__ unsigned pk2(float lo, float hi) { return pg8::cvt_pk_bf16(lo, hi); }
__device__ __forceinline__ float bflo(unsigned u) { return __uint_as_float(u << 16); }
__device__ __forceinline__ float bfhi(unsigned u) { return __uint_as_float(u & 0xffff0000u); }
__device__ __forceinline__ float bf2f(bf16 b) { return __uint_as_float(((unsigned)b) << 16); }
__device__ __forceinline__ bf16 f2bf(float f) { return (bf16)(pk2(f, 0.f) & 0xffffu); }
#define UNPACK8(v, f) do { f[0] = bflo(v.x); f[1] = bfhi(v.x); f[2] = bflo(v.y); f[3] = bfhi(v.y); f[4] = bflo(v.z); f[5] = bfhi(v.z); f[6] = bflo(v.w); f[7] = bfhi(v.w); } while (0)
#define PACK8(o, f) do { o.x = pk2(f[0], f[1]); o.y = pk2(f[2], f[3]); o.z = pk2(f[4], f[5]); o.w = pk2(f[6], f[7]); } while (0)
__device__ __forceinline__ int ltid() { int t = threadIdx.x; asm volatile("" : "+v"(t)); return t; }
__device__ __forceinline__ float sigmoidf_(float x) { return 1.f / (1.f + __expf(-x)); }
__device__ __forceinline__ float wave_sum(float v) {
#pragma unroll
    for (int o = 1; o < 64; o <<= 1) v += __shfl_xor(v, o);
    return v;
}
__device__ __forceinline__ float sum8(float v) { v += __shfl_xor(v, 1); v += __shfl_xor(v, 2); v += __shfl_xor(v, 4); return v; }

constexpr int DM = 1024, DIN = 6944, DPROJ = 4096, NMAIN = 3872, DGATE = 3072, DFF = 2816;
constexpr int NTOK = 131072, NPROMPT = 65536;
constexpr int C_KA = 512, C_VA = 1024, C_CQ = 1536, C_CKV = 1792, C_KR = 1920, C_RW = 1952;
constexpr float LOG2E = 1.4426950408889634f;
constexpr float NA_QS = 0.125f * LOG2E;
constexpr float MLA_QS = 0.10206207261596575f * LOG2E;
constexpr float NEPS = 1e-6f;

constexpr size_t MiB = 1u << 20;
constexpr size_t WS_CTL = 0, CTL_BYTES = 1 * MiB;
constexpr size_t W_OFF = 1 * MiB, W_STRIDE = 39 * MiB;
constexpr size_t WO_IN = 0, WO_G = 8 * MiB, WO_BR = 14 * MiB, WO_OUT = 17 * MiB, WO_GU = 19 * MiB, WO_DN = 30 * MiB, WO_MU = 35 * MiB + 512 * 1024, WO_RU = 37 * MiB;
constexpr size_t ACT_OFF = 80 * MiB;
constexpr size_t TOKB_H = 2048, TOKB_P = 8192, TOKB_M = 3584, TOKB_A = 1536, TOKB_S = 9216, TOKB_Y = 3072, TOKB_Z = 2048;
constexpr size_t TOKB = TOKB_H + TOKB_P + TOKB_M + TOKB_A + TOKB_S + TOKB_Y + TOKB_Z;
static_assert(WO_MU + 1792 * 384 * 2 <= WO_RU && WO_RU + 2560 * 384 * 2 <= W_STRIDE && WO_DN + 1024 * 2816 * 2 <= WO_MU && WO_GU + 5632 * 1024 * 2 <= WO_DN, "weight map");
constexpr int LDS_RING = 131072, LDS_BYTES = LDS_RING + 1024;

struct Params { const float* in[33]; float* out; unsigned char* ws; int G; int Tg; };
typedef const __attribute__((address_space(4))) Params* CP;

constexpr size_t WS_PARAMS = 512 * 1024;
struct Reg { unsigned char* ws; size_t Tg;
    __device__ __forceinline__ bf16* RH() const { return (bf16*)(ws + ACT_OFF); }
    __device__ __forceinline__ bf16* RP() const { return (bf16*)(ws + ACT_OFF + Tg * TOKB_H); }
    __device__ __forceinline__ bf16* RM() const { return (bf16*)(ws + ACT_OFF + Tg * (TOKB_H + TOKB_P)); }
    __device__ __forceinline__ bf16* RA() const { return (bf16*)(ws + ACT_OFF + Tg * (TOKB_H + TOKB_P + TOKB_M)); }
    __device__ __forceinline__ _Float16* RS() const { return (_Float16*)(ws + ACT_OFF + Tg * (TOKB_H + TOKB_P + TOKB_M + TOKB_A)); }
    __device__ __forceinline__ bf16* RY() const { return (bf16*)(ws + ACT_OFF + Tg * (TOKB_H + TOKB_P + TOKB_M + TOKB_A + TOKB_S)); }
    __device__ __forceinline__ bf16* RZ() const { return (bf16*)(ws + ACT_OFF + Tg * (TOKB_H + TOKB_P + TOKB_M + TOKB_A + TOKB_S + TOKB_Y)); }
};
enum { GM_IN = 0, GM_MU = 1, GM_RU = 2, GM_GATE = 3, GM_BR0 = 4, GM_BR1 = 5, GM_BR2 = 6, GM_OUT = 7, GM_GU = 8, GM_DN = 9 };
#define EPI_FENCE() asm volatile("" ::: "memory")
struct EpiUni {
    static constexpr bool PERM = true, AFTER_DRAIN = false;
    CP pp; int id, l, g;
    __device__ __forceinline__ void operator()(const pg8::f32x4 (&acc)[2][2][4][2], const pg8::Unit& u, int wr, int wc, int fr, int fq) const {
        CP q = pp; asm volatile("" : "+s"(q));
        const int Tg = q->Tg; const Reg R{q->ws, (size_t)Tg}; const size_t asz = (size_t)Tg * 512;
        const int row0 = u.pm * 256 + wr * 64 + fr, col0 = u.pn * 256 + wc * 32 + 8 * fq;
        switch (id) {
        case GM_IN: case GM_MU: {
            bf16* O = (id == GM_IN) ? R.RP() : R.RM(); const int ldc = (id == GM_IN) ? DPROJ : 1792;
#pragma unroll
            for (int ai = 0; ai < 2; ++ai)
#pragma unroll
                for (int m = 0; m < 4; ++m) { bf16* rp = O + (size_t)(row0 + ai * 128 + m * 16) * ldc + col0;
#pragma unroll
                    for (int bj = 0; bj < 2; ++bj) { const f32x4 v0 = acc[ai][bj][m][0], v1 = acc[ai][bj][m][1]; v4u w; w.x = pk2(v0[0], v0[1]); w.y = pk2(v0[2], v0[3]); w.z = pk2(v1[0], v1[1]); w.w = pk2(v1[2], v1[3]);
                        *(v4u*)(rp + bj * 128) = w; } }
        } break;
        case GM_GATE: {
            bf16* O = R.RP(); const float* bias = q->in[4] + l * DGATE + col0;
#pragma unroll
            for (int bj = 0; bj < 2; ++bj) { const f32x4 b0 = *(const f32x4*)(bias + bj * 128), b1 = *(const f32x4*)(bias + bj * 128 + 4);
#pragma unroll
                for (int ai = 0; ai < 2; ++ai)
#pragma unroll
                    for (int m = 0; m < 4; ++m) { const f32x4 v0 = acc[ai][bj][m][0] + b0, v1 = acc[ai][bj][m][1] + b1; float f[8];
#pragma unroll
                        for (int i = 0; i < 4; ++i) { f[i] = sigmoidf_(v0[i]); f[4 + i] = sigmoidf_(v1[i]); }
                        v4u w; PACK8(w, f); *(v4u*)(O + (size_t)(row0 + ai * 128 + m * 16) * DGATE + col0 + bj * 128) = w; }
                EPI_FENCE(); }
        } break;
        case GM_GU: {
            bf16* O = R.RP(); const int hc = u.pn * 128 + wc * 32 + 8 * fq;
#pragma unroll
            for (int ai = 0; ai < 2; ++ai)
#pragma unroll
                for (int m = 0; m < 4; ++m) { float f[8];
#pragma unroll
                    for (int n = 0; n < 2; ++n)
#pragma unroll
                        for (int i = 0; i < 4; ++i) { const float gt = acc[ai][0][m][n][i], up = acc[ai][1][m][n][i]; f[4 * n + i] = gt * sigmoidf_(gt) * up; }
                    v4u w; PACK8(w, f); *(v4u*)(O + (size_t)(row0 + ai * 128 + m * 16) * DFF + hc) = w; }
        } break;
        case GM_BR0: case GM_BR1: case GM_BR2: {
            bf16* O = R.RM(); const bf16* Gt = R.RP() + (id - GM_BR0) * 1024; const bool first = (id == GM_BR0);
#pragma unroll
            for (int ai = 0; ai < 2; ++ai)
#pragma unroll
                for (int m = 0; m < 4; ++m) { const size_t row = (size_t)(row0 + ai * 128 + m * 16);
#pragma unroll
                    for (int bj = 0; bj < 2; ++bj) { const int col = col0 + bj * 128; const v4u gv = *(const v4u*)(Gt + row * DGATE + col); float gg[8], f[8]; UNPACK8(gv, gg);
#pragma unroll
                        for (int i = 0; i < 4; ++i) { f[i] = gg[i] * acc[ai][bj][m][0][i]; f[4 + i] = gg[4 + i] * acc[ai][bj][m][1][i]; }
                        if (!first) { const v4u ov = *(const v4u*)(O + row * DM + col); float o[8]; UNPACK8(ov, o);
#pragma unroll
                            for (int i = 0; i < 8; ++i) f[i] += o[i]; }
                        v4u w; PACK8(w, f); *(v4u*)(O + row * DM + col) = w; }
                    EPI_FENCE(); }
        } break;
        case GM_OUT: case GM_DN: {
            const int t0 = g * Tg; float* xout = q->out + (size_t)t0 * DM;
            const float* xin = (id == GM_OUT && l == 0) ? ((t0 < NPROMPT) ? q->in[0] + (size_t)t0 * DM : q->in[1] + (size_t)(t0 - NPROMPT) * DM) : xout;
#pragma unroll
            for (int ai = 0; ai < 2; ++ai)
#pragma unroll
                for (int m = 0; m < 4; ++m) { const size_t off = (size_t)(row0 + ai * 128 + m * 16) * DM + col0;
#pragma unroll
                    for (int bj = 0; bj < 2; ++bj)
#pragma unroll
                        for (int n = 0; n < 2; ++n) { const f32x4 b = *(const f32x4*)(xin + off + bj * 128 + n * 4); *(f32x4*)(xout + off + bj * 128 + n * 4) = b + acc[ai][bj][m][n]; }
                    EPI_FENCE(); }
        } break;
        case GM_RU: {
            _Float16* rs = R.RS(); const _Float16* ktmp = (const _Float16*)R.RZ(); bf16* gout = R.RY() + 2 * asz;
            const int type = u.pn >> 1; const int cl0 = (u.pn & 1) * 256 + wc * 32 + 8 * fq;
            const float* w0 = q->in[17] + l * 1024; const float* a0 = q->in[19] + l * 1024; const float* ka = q->in[23] + l * 512;
#pragma unroll
            for (int ai = 0; ai < 2; ++ai)
#pragma unroll
                for (int m = 0; m < 4; ++m) { const size_t row = (size_t)(row0 + ai * 128 + m * 16);
#pragma unroll
                    for (int bj = 0; bj < 2; ++bj) { const int cl = cl0 + bj * 128; float f[8];
#pragma unroll
                        for (int i = 0; i < 4; ++i) { f[i] = acc[ai][bj][m][0][i]; f[4 + i] = acc[ai][bj][m][1][i]; }
                        if (type < 2) {
                            h8 o;
#pragma unroll
                            for (int i = 0; i < 8; ++i) o[i] = (_Float16)__expf(-0.6065306597126334f * sigmoidf_(f[i] + w0[type * 512 + cl + i]));
                            *(h8*)(rs + (size_t)(3 + type) * asz + row * 512 + cl) = o;
                        } else if (type < 4) {
                            const int d = type - 2; const h8 kv = *(const h8*)(ktmp + row * 512 + cl), kkv = *(const h8*)(rs + (size_t)2 * asz + row * 512 + cl); h8 o1, o2;
#pragma unroll
                            for (int i = 0; i < 8; ++i) { const float a = sigmoidf_(f[i] + a0[d * 512 + cl + i]); o1[i] = (_Float16)((float)kkv[i] * a); o2[i] = (_Float16)((float)kv[i] * (1.f + (a - 1.f) * ka[cl + i])); }
                            *(h8*)(rs + (size_t)(5 + d) * asz + row * 512 + cl) = o1; *(h8*)(rs + (size_t)(7 + d) * asz + row * 512 + cl) = o2;
                        } else { v4u w; PACK8(w, f); *(v4u*)(gout + row * 512 + cl) = w; }
                        EPI_FENCE(); } }
        } break;
        default: break;
        }
    }
};

__device__ __forceinline__ void transpose_item(const float* W, int ldw, int N, bf16* WT, int ldt, int koff, int row_off, int mode, LAS float* scr, int item, int lane) {
    const int nblk = N / 32, kb = item / nblk, nb = item % nblk, k0 = 64 * kb, n0 = 32 * nb;
#pragma unroll 8
    for (int i = 0; i < 32; ++i) { const int kk = 2 * i + (lane >> 5); scr[kk * 33 + (lane & 31)] = W[(size_t)(k0 + kk) * ldw + n0 + (lane & 31)]; }
    asm volatile("s_waitcnt lgkmcnt(0)" ::: "memory");
    const int c = lane & 7;
#pragma unroll
    for (int j = 0; j < 4; ++j) { const int n = (lane >> 3) + 8 * j; const LAS float* s = scr + (8 * c) * 33 + n;
        v4u o; o.x = pk2(s[0 * 33], s[1 * 33]); o.y = pk2(s[2 * 33], s[3 * 33]); o.z = pk2(s[4 * 33], s[5 * 33]); o.w = pk2(s[6 * 33], s[7 * 33]);
        const int nn = n0 + n; const int drow = mode ? ((nn >> 7) * 256 + row_off + (nn & 127)) : (row_off + nn);
        *(v4u*)(WT + (size_t)drow * ldt + koff + k0 + 8 * c) = o; }
    asm volatile("s_waitcnt lgkmcnt(0)" ::: "memory");
}
__device__ __forceinline__ void transpose_job(const float* W, int ldw, int K, int N, bf16* WT, int ldt, int koff, int row_off, int mode, LAS float* scr, int gw, int ngw, int lane) {
    const int nitems = (K / 64) * (N / 32);
    for (int it = gw; it < nitems; it += ngw) transpose_item(W, ldw, N, WT, ldt, koff, row_off, mode, scr, it, lane);
}
__device__ __forceinline__ void zero_bytes(unsigned char* p, size_t nbytes, size_t gtid, size_t ngt) {
    const v4u z = {0u, 0u, 0u, 0u};
    for (size_t i = gtid; i < nbytes / 16; i += ngt) ((v4u*)p)[i] = z;
}

__device__ __forceinline__ void phase_norm(const float* x, const float* g, bf16* hb, int Tg, int gw, int ngw, int lane) {
    for (int t = gw; t < Tg; t += 2 * ngw) {
        const int t2 = (t + ngw < Tg) ? t + ngw : t;
        const f32x4* xa = (const f32x4*)(x + (size_t)t * DM) + lane; const f32x4* xb = (const f32x4*)(x + (size_t)t2 * DM) + lane; f32x4 va[4], vb[4]; float sa = 0.f, sb = 0.f;
#pragma unroll
        for (int j = 0; j < 4; ++j) { va[j] = xa[64 * j]; vb[j] = xb[64 * j]; }
#pragma unroll
        for (int j = 0; j < 4; ++j) { sa += (va[j].x * va[j].x + va[j].y * va[j].y) + (va[j].z * va[j].z + va[j].w * va[j].w); sb += (vb[j].x * vb[j].x + vb[j].y * vb[j].y) + (vb[j].z * vb[j].z + vb[j].w * vb[j].w); }
        const float ia = rsqrtf(wave_sum(sa) * (1.f / DM) + NEPS), ib = rsqrtf(wave_sum(sb) * (1.f / DM) + NEPS);
        v2u* oa = (v2u*)(hb + (size_t)t * DM) + lane; v2u* ob = (v2u*)(hb + (size_t)t2 * DM) + lane;
#pragma unroll
        for (int j = 0; j < 4; ++j) { const f32x4 gg = ((const f32x4*)g)[lane + 64 * j]; v2u o;
            o.x = pk2(va[j].x * ia * gg.x, va[j].y * ia * gg.y); o.y = pk2(va[j].z * ia * gg.z, va[j].w * ia * gg.w); oa[64 * j] = o;
            o.x = pk2(vb[j].x * ib * gg.x, vb[j].y * ib * gg.y); o.y = pk2(vb[j].z * ib * gg.z, vb[j].w * ib * gg.w); ob[64 * j] = o; }
    }
}

__device__ __forceinline__ void phase_post_proj(CP pp, int l, bf16* proj, bf16* mla_a, bf16* rw_a, _Float16* rs, _Float16* ktmp, size_t asz, int Tg, int L, int gw, int ngw, int lane) {
    const float* gq = pp->in[5] + l * 64; const float* gk = pp->in[6] + l * 64;
    const float* gcq = pp->in[9] + l * 256; const float* gckv = pp->in[10] + l * 128;
    const float* mu = pp->in[16] + l * 1920; const float* kkw = pp->in[22] + l * 512;
    for (int t = gw; t < Tg; t += ngw) {
        bf16* row = proj + (size_t)t * DPROJ; const int tpos = t % L;
        const bool hasp = tpos > 0, hasn = tpos < L - 1;
        v4u qv = *(const v4u*)(row + 8 * lane), kv = *(const v4u*)(row + C_KA + 8 * lane); const v2u cv = *(const v2u*)(row + C_CQ + 4 * lane); const unsigned kvv = *(const unsigned*)(row + C_CKV + 2 * lane);
        v4u rwc[4], rwp[4], rwn[4];
#pragma unroll
        for (int it = 0; it < 4; ++it) { const int c0 = (it * 64 + lane) * 8; const v4u z = {0u, 0u, 0u, 0u}; rwc[it] = z; rwp[it] = z; rwn[it] = z;
            if (it < 3 || lane < 48) { const bf16* src = row + C_RW + c0; rwc[it] = *(const v4u*)src; if (hasp) rwp[it] = *(const v4u*)(src - DPROJ); if (hasn) rwn[it] = *(const v4u*)(src + DPROJ); } }
        {
            const int gi = 8 * (lane & 7);
            float f[8]; UNPACK8(qv, f); float ss = 0.f;
#pragma unroll
            for (int i = 0; i < 8; ++i) ss += f[i] * f[i];
            float inv = rsqrtf(sum8(ss) * (1.f / 64.f) + NEPS) * NA_QS;
#pragma unroll
            for (int i = 0; i < 8; ++i) f[i] = f[i] * inv * gq[gi + i];
            PACK8(qv, f); *(v4u*)(row + 8 * lane) = qv;
            UNPACK8(kv, f); ss = 0.f;
#pragma unroll
            for (int i = 0; i < 8; ++i) ss += f[i] * f[i];
            inv = rsqrtf(sum8(ss) * (1.f / 64.f) + NEPS);
#pragma unroll
            for (int i = 0; i < 8; ++i) f[i] = f[i] * inv * gk[gi + i];
            PACK8(kv, f); *(v4u*)(row + C_KA + 8 * lane) = kv;
        }
        {
            float a0 = bflo(cv.x), a1 = bfhi(cv.x), a2 = bflo(cv.y), a3 = bfhi(cv.y);
            float inv = rsqrtf(wave_sum(a0 * a0 + a1 * a1 + a2 * a2 + a3 * a3) * (1.f / 256.f) + NEPS);
            const f32x4 gg = *(const f32x4*)(gcq + 4 * lane); v2u o; o.x = pk2(a0 * inv * gg.x, a1 * inv * gg.y); o.y = pk2(a2 * inv * gg.z, a3 * inv * gg.w);
            *(v2u*)(mla_a + (size_t)t * 384 + 4 * lane) = o;
            a0 = bflo(kvv); a1 = bfhi(kvv);
            inv = rsqrtf(wave_sum(a0 * a0 + a1 * a1) * (1.f / 128.f) + NEPS);
            *(unsigned*)(mla_a + (size_t)t * 384 + 256 + 2 * lane) = pk2(a0 * inv * gckv[2 * lane], a1 * inv * gckv[2 * lane + 1]);
        }
#pragma unroll
        for (int it = 0; it < 4; ++it) {
            const int c0 = (it * 64 + lane) * 8;
            if (it < 3 || lane < 48) {
                float pc[8], pp[8], pn[8]; UNPACK8(rwc[it], pc); UNPACK8(rwp[it], pp); UNPACK8(rwn[it], pn);
#pragma unroll
                for (int i = 0; i < 8; ++i) pc[i] = pc[i] + mu[c0 + i] * (0.5f * (pp[i] + pn[i]) - pc[i]);
                if (it == 0) { h8 o;
#pragma unroll
                    for (int i = 0; i < 8; ++i) o[i] = (_Float16)pc[i];
                    *(h8*)(rs + (size_t)t * 512 + c0) = o; }
                else if (it == 1) { const int c = c0 - 512; h8 o; float kk[8]; float ss = 0.f;
#pragma unroll
                    for (int i = 0; i < 8; ++i) { o[i] = (_Float16)pc[i]; kk[i] = pc[i] * kkw[c + i]; ss += kk[i] * kk[i]; }
                    *(h8*)(ktmp + (size_t)t * 512 + c) = o;
                    const float inv = rsqrtf(sum8(ss) + 1e-12f);
#pragma unroll
                    for (int i = 0; i < 8; ++i) o[i] = (_Float16)(kk[i] * inv);
                    *(h8*)(rs + 2 * asz + (size_t)t * 512 + c) = o; }
                else if (it == 2) { const int c = c0 - 1024; h8 o;
#pragma unroll
                    for (int i = 0; i < 8; ++i) o[i] = (_Float16)pc[i];
                    *(h8*)(rs + asz + (size_t)t * 512 + c) = o; }
                else { const int c = c0 - 1536; float f[8];
#pragma unroll
                    for (int i = 0; i < 8; ++i) { const float x = pc[i]; f[i] = (c < 128) ? (1.f - 2.f / (1.f + __expf(2.f * x))) : ((c < 256) ? x : sigmoidf_(x)); }
                    v4u w; PACK8(w, f); *(v4u*)(rw_a + (size_t)t * 384 + c) = w; }
            }
        }
    }
}

__device__ __forceinline__ void phase_mla_post(CP pp, int l, bf16* mraw, const bf16* proj, bf16* mk, int Tg, int L, int gw, int ngw, int lane) {
    const float* gq = pp->in[13] + l * 96; const float* gk = pp->in[14] + l * 96;
    const int h = lane >> 3, sub = lane & 7, rs = sub & 3; const bool hasr = sub < 4;
    float gqn[8], gkn[8], gq1[4], gq2[4], gk1[4], gk2[4], invf[4];
#pragma unroll
    for (int e = 0; e < 8; ++e) { gqn[e] = gq[8 * sub + e]; gkn[e] = gk[8 * sub + e]; }
#pragma unroll
    for (int e = 0; e < 4; ++e) { gq1[e] = gq[64 + 4 * rs + e]; gq2[e] = gq[80 + 4 * rs + e]; gk1[e] = gk[64 + 4 * rs + e]; gk2[e] = gk[80 + 4 * rs + e];
        invf[e] = __expf(-(float)((4 * rs + e) & 7) * (9.210340371976184f / 8.f)); }
    for (int t = gw; t < Tg; t += ngw) {
        const int tpos = t % L; const float pos = (float)((rs < 2) ? (tpos >> 6) : (tpos & 63));
        bf16* mrow = mraw + (size_t)t * 1792; bf16* krow = mk + (size_t)t * 768;
        const v4u qv = *(const v4u*)(mrow + h * 96 + 8 * sub), kv = *(const v4u*)(mrow + 768 + h * 128 + 8 * sub);
        v2u q1 = {0u, 0u}, q2 = {0u, 0u}, k1 = {0u, 0u}, k2 = {0u, 0u};
        if (hasr) { q1 = *(const v2u*)(mrow + h * 96 + 64 + 4 * rs); q2 = *(const v2u*)(mrow + h * 96 + 80 + 4 * rs);
                    k1 = *(const v2u*)(proj + (size_t)t * DPROJ + C_KR + 4 * rs); k2 = *(const v2u*)(proj + (size_t)t * DPROJ + C_KR + 16 + 4 * rs); }
        float cs[4], sn[4];
#pragma unroll
        for (int e = 0; e < 4; ++e) { float rev = pos * invf[e] * 0.15915494309189535f; rev -= floorf(rev); cs[e] = __builtin_amdgcn_cosf(rev); sn[e] = __builtin_amdgcn_sinf(rev); }
        {   float f[8]; UNPACK8(qv, f); float a[4] = {bflo(q1.x), bfhi(q1.x), bflo(q1.y), bfhi(q1.y)}, b[4] = {bflo(q2.x), bfhi(q2.x), bflo(q2.y), bfhi(q2.y)};
            float ss = 0.f;
#pragma unroll
            for (int e = 0; e < 8; ++e) ss += f[e] * f[e];
#pragma unroll
            for (int e = 0; e < 4; ++e) ss += a[e] * a[e] + b[e] * b[e];
            const float inv = rsqrtf(sum8(ss) * (1.f / 96.f) + NEPS) * MLA_QS;
#pragma unroll
            for (int e = 0; e < 8; ++e) f[e] = f[e] * inv * gqn[e];
            v4u o; PACK8(o, f); *(v4u*)(mrow + h * 96 + 8 * sub) = o;
            if (hasr) { float r1[4], r2[4];
#pragma unroll
                for (int e = 0; e < 4; ++e) { const float x1 = a[e] * inv * gq1[e], x2 = b[e] * inv * gq2[e]; r1[e] = x1 * cs[e] - x2 * sn[e]; r2[e] = x1 * sn[e] + x2 * cs[e]; }
                v2u o1, o2; o1.x = pk2(r1[0], r1[1]); o1.y = pk2(r1[2], r1[3]); o2.x = pk2(r2[0], r2[1]); o2.y = pk2(r2[2], r2[3]);
                *(v2u*)(mrow + h * 96 + 64 + 4 * rs) = o1; *(v2u*)(mrow + h * 96 + 80 + 4 * rs) = o2; } }
        {   float f[8]; UNPACK8(kv, f); float a[4] = {bflo(k1.x), bfhi(k1.x), bflo(k1.y), bfhi(k1.y)}, b[4] = {bflo(k2.x), bfhi(k2.x), bflo(k2.y), bfhi(k2.y)};
            float ss = 0.f;
#pragma unroll
            for (int e = 0; e < 8; ++e) ss += f[e] * f[e];
#pragma unroll
            for (int e = 0; e < 4; ++e) ss += a[e] * a[e] + b[e] * b[e];
            const float inv = rsqrtf(sum8(ss) * (1.f / 96.f) + NEPS);
#pragma unroll
            for (int e = 0; e < 8; ++e) f[e] = f[e] * inv * gkn[e];
            v4u o; PACK8(o, f); *(v4u*)(krow + h * 96 + 8 * sub) = o;
            if (hasr) { float r1[4], r2[4];
#pragma unroll
                for (int e = 0; e < 4; ++e) { const float x1 = a[e] * inv * gk1[e], x2 = b[e] * inv * gk2[e]; r1[e] = x1 * cs[e] - x2 * sn[e]; r2[e] = x1 * sn[e] + x2 * cs[e]; }
                v2u o1, o2; o1.x = pk2(r1[0], r1[1]); o1.y = pk2(r1[2], r1[3]); o2.x = pk2(r2[0], r2[1]); o2.y = pk2(r2[2], r2[3]);
                *(v2u*)(krow + h * 96 + 64 + 4 * rs) = o1; *(v2u*)(krow + h * 96 + 80 + 4 * rs) = o2; } }
    }
}

__device__ __forceinline__ void phase_rw_post(CP pp, int l, const _Float16* rs, size_t asz, const bf16* yfb, bf16* yc, int Tg, int gw, int ngw, int lane) {
    const float* lnw = pp->in[25] + l * 512 + 8 * lane; const float* lnb = pp->in[26] + l * 512 + 8 * lane; const float* rk = pp->in[24] + l * 512 + 8 * lane;
    for (int t = gw; t < Tg; t += ngw) {
        const size_t o = (size_t)t * 512 + 8 * lane; float y[8], f[8];
        { const v4u a = *(const v4u*)(yfb + o); const v4u b = *(const v4u*)(yfb + asz + o); UNPACK8(a, y); UNPACK8(b, f); }
        float s = 0.f;
#pragma unroll
        for (int i = 0; i < 8; ++i) { y[i] += f[i]; s += y[i]; }
        const float mean = sum8(s) * (1.f / 64.f); float q = 0.f;
#pragma unroll
        for (int i = 0; i < 8; ++i) { y[i] -= mean; q += y[i] * y[i]; }
        const float rstd = rsqrtf(sum8(q) * (1.f / 64.f) + 64e-5f);
        const h8 r = *(const h8*)(rs + o), v = *(const h8*)(rs + asz + o), kd0 = *(const h8*)(rs + 7 * asz + o), kd1 = *(const h8*)(rs + 8 * asz + o);
        float b = 0.f;
#pragma unroll
        for (int i = 0; i < 8; ++i) b += (float)r[i] * ((float)kd0[i] + (float)kd1[i]) * rk[i];
        b = sum8(b);
        const v4u gv = *(const v4u*)(yc + o); UNPACK8(gv, f);
#pragma unroll
        for (int i = 0; i < 8; ++i) f[i] = (y[i] * rstd * lnw[i] + lnb[i] + b * (float)v[i]) * f[i];
        v4u w; PACK8(w, f); *(v4u*)(yc + o) = w;
    }
}

#define GAS __attribute__((address_space(1)))
typedef float f2 __attribute__((ext_vector_type(2)));
#define DPP_ADD(x, ctrl) ((x) + __builtin_bit_cast(float, __builtin_amdgcn_update_dpp(0, __builtin_bit_cast(int, (x)), (ctrl), 0xF, 0xF, true)))
__device__ __forceinline__ float red8(float x) { x = DPP_ADD(x, 0xB1); x = DPP_ADD(x, 0x4E); x = DPP_ADD(x, 0x141); return x; }
constexpr int SCH = 32, SBUF = 6 * SCH * 256;
__device__ __forceinline__ void scan_unit(int u, int L, const _Float16* rs, size_t asz, bf16* yfb, LAS unsigned char* lds) {
    const int tid = ltid(); const int lane = tid & 63, w = tid >> 6, vr = lane >> 3, ko = lane & 7;
    const int dir = u & 1, sh = u >> 1, h = sh & 7, s = sh >> 3;
    const int kA = tid >> 8, lj = (tid >> 3) & 31, lp = tid & 7;
    const size_t tok0 = (size_t)s * L + (dir ? (L - 1 - lj) : lj);
    const long tstep = dir ? -(long)SCH * 512 : (long)SCH * 512;
    const size_t eoff = tok0 * 512 + h * 64 + lp * 8;
    const GAS _Float16* g0 = (const GAS _Float16*)(rs + (size_t)(kA ? 2 : 0) * asz + eoff);
    const GAS _Float16* g1 = (const GAS _Float16*)(rs + (size_t)(kA ? 5 + dir : 3 + dir) * asz + eoff);
    const GAS _Float16* g2 = (const GAS _Float16*)(rs + (size_t)(kA ? 1 : 7 + dir) * asz + eoff);
    const int ld0 = (((0 + kA) * SCH + lj) * 64 + lp * 8) * 4, ld1 = (((2 + kA) * SCH + lj) * 64 + lp * 8) * 4, ld2 = (((4 + kA) * SCH + lj) * 64 + lp * 8) * 4;
    GAS bf16* py = (GAS bf16*)(yfb + (size_t)dir * asz + ((size_t)s * L + (dir ? L - 1 : 0)) * 512 + h * 64 + 8 * w + vr);
    const long ystep = dir ? -512 : 512;
    const int rd = ko * 32, rdv = (5 * SCH * 64 + 8 * w + vr) * 4;
    f2 S[4];
#pragma unroll
    for (int i = 0; i < 4; ++i) S[i] = (f2){0.f, 0.f};
    h8 p0 = *(const GAS h8*)g0, p1 = *(const GAS h8*)g1, p2 = *(const GAS h8*)g2;
#define SCAN_PUT(bufo) do { f32x4 a, b; \
        a = (f32x4){(float)p0[0], (float)p0[1], (float)p0[2], (float)p0[3]}; b = (f32x4){(float)p0[4], (float)p0[5], (float)p0[6], (float)p0[7]}; *(LAS f32x4*)(lds + (bufo) + ld0) = a; *(LAS f32x4*)(lds + (bufo) + ld0 + 16) = b; \
        a = (f32x4){(float)p1[0], (float)p1[1], (float)p1[2], (float)p1[3]}; b = (f32x4){(float)p1[4], (float)p1[5], (float)p1[6], (float)p1[7]}; *(LAS f32x4*)(lds + (bufo) + ld1) = a; *(LAS f32x4*)(lds + (bufo) + ld1 + 16) = b; \
        a = (f32x4){(float)p2[0], (float)p2[1], (float)p2[2], (float)p2[3]}; b = (f32x4){(float)p2[4], (float)p2[5], (float)p2[6], (float)p2[7]}; *(LAS f32x4*)(lds + (bufo) + ld2) = a; *(LAS f32x4*)(lds + (bufo) + ld2 + 16) = b; } while (0)
    SCAN_PUT(0);
    __syncthreads();
    const int NC = L / SCH;
#pragma unroll 1
    for (int c = 0; c < NC; ++c) {
        const int cur = (c & 1) * SBUF;
        if (c + 1 < NC) { const long o = tstep * (long)(c + 1); p0 = *(const GAS h8*)(g0 + o); p1 = *(const GAS h8*)(g1 + o); p2 = *(const GAS h8*)(g2 + o); }
        LAS unsigned char* bp = lds + cur + rd;
        GAS bf16* pyc = py + ystep * (long)(c * SCH);
#pragma unroll 1
        for (int j0 = 0; j0 < SCH; j0 += 4) { float yv[4];
#pragma unroll
        for (int jj = 0; jj < 4; ++jj) { const int j = j0 + jj;
            const LAS unsigned char* q = bp + j * 256;
            const f32x4 r0 = *(const LAS f32x4*)(q), r1 = *(const LAS f32x4*)(q + 16);
            const f32x4 k0 = *(const LAS f32x4*)(q + SCH * 256), k1 = *(const LAS f32x4*)(q + SCH * 256 + 16);
            const f32x4 w0 = *(const LAS f32x4*)(q + 2 * SCH * 256), w1 = *(const LAS f32x4*)(q + 2 * SCH * 256 + 16);
            const f32x4 a0 = *(const LAS f32x4*)(q + 3 * SCH * 256), a1 = *(const LAS f32x4*)(q + 3 * SCH * 256 + 16);
            const f32x4 d0 = *(const LAS f32x4*)(q + 4 * SCH * 256), d1 = *(const LAS f32x4*)(q + 4 * SCH * 256 + 16);
            const float vv = *(const LAS float*)(lds + cur + rdv + j * 256);
            const f2 vv2 = (f2){vv, vv};
            f2 e0 = S[0] * w0.xy, e1 = S[1] * w0.zw, e2 = S[2] * w1.xy, e3 = S[3] * w1.zw;
            f2 pa = S[0] * k0.xy, pb = S[1] * k0.zw; pa = S[2] * k1.xy + pa; pb = S[3] * k1.zw + pb;
            e0 = d0.xy * vv2 + e0; e1 = d0.zw * vv2 + e1; e2 = d1.xy * vv2 + e2; e3 = d1.zw * vv2 + e3;
            const f2 pd = pa + pb;
            const float nskk = -red8(pd.x + pd.y);
            const f2 ns2 = (f2){nskk, nskk};
            S[0] = a0.xy * ns2 + e0; S[1] = a0.zw * ns2 + e1; S[2] = a1.xy * ns2 + e2; S[3] = a1.zw * ns2 + e3;
            f2 qa = S[0] * r0.xy, qb = S[1] * r0.zw; qa = S[2] * r1.xy + qa; qb = S[3] * r1.zw + qb;
            const f2 qd = qa + qb;
            yv[jj] = red8(qd.x + qd.y);
        }
            if (ko == 0) {
#pragma unroll
                for (int jj = 0; jj < 4; ++jj) pyc[ystep * (j0 + jj)] = f2bf(yv[jj]); }
        }
        if (c + 1 < NC) SCAN_PUT(SBUF - cur);
        __syncthreads();
    }
#undef SCAN_PUT
}

constexpr int MKP = 208, MVP = 144, MBUF = 64 * MKP + 64 * MVP;
#define MLA_THR 6.0f
__device__ __forceinline__ float max3f(float a, float b, float c) { return fmaxf(fmaxf(a, b), c); }
__device__ __forceinline__ void mla_unit(int u, int L, const bf16* mraw, const bf16* mk, bf16* yb, LAS unsigned char* lds) {
    const int tid = ltid(), lane = tid & 63, w = tid >> 6, q32 = lane & 31, hi = lane >> 5;
    const int nqb = L >> 8, qb = u % nqb, sh = u / nqb, h = sh & 7, s = sh >> 3;
    const size_t base = (size_t)s * L; const int NT = L >> 6;
    const size_t qtok = base + qb * 256 + w * 32 + q32;
    bf16x8 qf[6];
#pragma unroll
    for (int ks = 0; ks < 6; ++ks) qf[ks] = *(const bf16x8*)(mraw + qtok * 1792 + h * 96 + ks * 16 + hi * 8);
    const int kkey0 = tid / 12, kch0 = tid % 12, kkey1 = (tid + 512) / 12, kch1 = (tid + 512) % 12; const bool k2 = tid < 256;
    const bf16* ks0 = mk + (base + kkey0) * 768 + h * 96 + kch0 * 8; const bf16* ks1 = mk + (base + kkey1) * 768 + h * 96 + kch1 * 8;
    const int vkey = tid >> 3, vch = tid & 7;
    const bf16* vs = mraw + (base + vkey) * 1792 + 768 + h * 128 + 64 + vch * 8;
    const int kd0 = kkey0 * MKP + kch0 * 16, kd1 = kkey1 * MKP + kch1 * 16, vd = 64 * MKP + vkey * MVP + vch * 16;
    v4u rk0, rk1 = {0u, 0u, 0u, 0u}, rv, sk0, sk1 = {0u, 0u, 0u, 0u}, sv;
#define MLA_LOAD(t) do { const size_t adv_ = (size_t)(t) * 64; rk0 = *(const v4u*)(ks0 + adv_ * 768); if (k2) rk1 = *(const v4u*)(ks1 + adv_ * 768); rv = *(const v4u*)(vs + adv_ * 1792); } while (0)
#define MLA_PUT(bo) do { *(LAS v4u*)(lds + (bo) + kd0) = rk0; if (k2) *(LAS v4u*)(lds + (bo) + kd1) = rk1; *(LAS v4u*)(lds + (bo) + vd) = rv; } while (0)
#define MLA_LOADB(t) do { const size_t adv_ = (size_t)(t) * 64; sk0 = *(const v4u*)(ks0 + adv_ * 768); if (k2) sk1 = *(const v4u*)(ks1 + adv_ * 768); sv = *(const v4u*)(vs + adv_ * 1792); } while (0)
#define MLA_PUTB(bo) do { *(LAS v4u*)(lds + (bo) + kd0) = sk0; if (k2) *(LAS v4u*)(lds + (bo) + kd1) = sk1; *(LAS v4u*)(lds + (bo) + vd) = sv; } while (0)
    MLA_LOAD(0); MLA_PUT(0); MLA_LOAD(1); MLA_PUT(MBUF);
    __syncthreads();
    const int kmap = 16 * (q32 >> 4) + 8 * ((q32 >> 2) & 1) + (q32 & 3) + 4 * ((q32 >> 3) & 1);
    const int koff = kmap * MKP + hi * 16;
    const int voff = 64 * MKP + (8 * hi + ((lane & 15) >> 2)) * MVP + (16 * ((lane >> 4) & 1) + 4 * (lane & 3)) * 2;
    f32x16 o0 = {}, o1 = {}, negm = {}, pA0, pA1, pB0, pB1; float lsum = 0.f; v4u pw0, pw1, pw2, pw3;
    int b_prev = 0, b_cur = MBUF, b_next = 2 * MBUF;
#define MLA_KA(bo, ks) (*(const LAS bf16x8*)(lds + (bo) + koff + (ks) * 32))
#define MLA_KB(bo, ks) (*(const LAS bf16x8*)(lds + (bo) + koff + 32 * MKP + (ks) * 32))
#define MLA_QK2(C0, C1, bo, ks) do { C0 = __builtin_amdgcn_mfma_f32_32x32x16_bf16(MLA_KA(bo, ks), qf[ks], C0, 0, 0, 0); C1 = __builtin_amdgcn_mfma_f32_32x32x16_bf16(MLA_KB(bo, ks), qf[ks], C1, 0, 0, 0); } while (0)
#define MLA_FIN8(P, g, PW) do { float e0 = __builtin_amdgcn_exp2f(P[8 * g + 0]), e1 = __builtin_amdgcn_exp2f(P[8 * g + 1]), e2 = __builtin_amdgcn_exp2f(P[8 * g + 2]), e3 = __builtin_amdgcn_exp2f(P[8 * g + 3]), \
        e4 = __builtin_amdgcn_exp2f(P[8 * g + 4]), e5 = __builtin_amdgcn_exp2f(P[8 * g + 5]), e6 = __builtin_amdgcn_exp2f(P[8 * g + 6]), e7 = __builtin_amdgcn_exp2f(P[8 * g + 7]); \
        lsum += ((e0 + e1) + (e2 + e3)) + ((e4 + e5) + (e6 + e7)); PW.x = pk2(e0, e1); PW.y = pk2(e2, e3); PW.z = pk2(e4, e5); PW.w = pk2(e6, e7); } while (0)
#define MLA_VT(bo, kg, db) ({ const int vb_ = (bo) + voff + (kg) * 16 * MVP + (db) * 64; \
        const s16x4 t0_ = __builtin_amdgcn_ds_read_tr16_b64_v4i16((LAS s16x4*)(lds + vb_)), t1_ = __builtin_amdgcn_ds_read_tr16_b64_v4i16((LAS s16x4*)(lds + vb_ + 4 * MVP)); \
        (bf16x8){t0_[0], t0_[1], t0_[2], t0_[3], t1_[0], t1_[1], t1_[2], t1_[3]}; })
#define MLA_PV(bo, kg, PW) do { const bf16x8 pf_ = __builtin_bit_cast(bf16x8, PW); o0 = __builtin_amdgcn_mfma_f32_32x32x16_bf16(MLA_VT(bo, kg, 0), pf_, o0, 0, 0, 0); o1 = __builtin_amdgcn_mfma_f32_32x32x16_bf16(MLA_VT(bo, kg, 1), pf_, o1, 0, 0, 0); } while (0)
#define MLA_ROWMAX(C0, C1) ({ float a_ = max3f(C0[0], C0[1], C1[0]), b_ = max3f(C0[2], C0[3], C1[1]); a_ = max3f(a_, C1[2], C1[3]); \
        _Pragma("unroll") for (int r_ = 4; r_ < 16; r_ += 4) { a_ = max3f(a_, C0[r_], C0[r_ + 1]); b_ = max3f(b_, C0[r_ + 2], C0[r_ + 3]); a_ = max3f(a_, C1[r_], C1[r_ + 1]); b_ = max3f(b_, C1[r_ + 2], C1[r_ + 3]); } \
        const float m_ = fmaxf(a_, b_); fmaxf(m_, __shfl_xor(m_, 32)); })
#define MLA_STEP(P0, P1, C0, C1, j, LOADX, PUTX) do { \
        if ((j) + 2 < NT) LOADX((j) + 2); \
        C0 = negm; C1 = negm; \
        MLA_QK2(C0, C1, b_cur, 0); MLA_QK2(C0, C1, b_cur, 1); MLA_FIN8(P0, 0, pw0); \
        MLA_QK2(C0, C1, b_cur, 2); MLA_FIN8(P0, 1, pw1); \
        MLA_QK2(C0, C1, b_cur, 3); MLA_FIN8(P1, 0, pw2); \
        MLA_QK2(C0, C1, b_cur, 4); MLA_FIN8(P1, 1, pw3); \
        MLA_QK2(C0, C1, b_cur, 5); \
        MLA_PV(b_prev, 0, pw0); MLA_PV(b_prev, 1, pw1); \
        const float mt_ = MLA_ROWMAX(C0, C1); \
        MLA_PV(b_prev, 2, pw2); MLA_PV(b_prev, 3, pw3); \
        if (__any(mt_ > MLA_THR)) { const float dl_ = fmaxf(mt_, 0.f); const float fs_ = __builtin_amdgcn_exp2f(-dl_); lsum *= fs_; \
            _Pragma("unroll") for (int r_ = 0; r_ < 16; ++r_) { C0[r_] -= dl_; C1[r_] -= dl_; negm[r_] -= dl_; o0[r_] *= fs_; o1[r_] *= fs_; } } \
        if ((j) + 1 < NT) PUTX(b_next); \
        __syncthreads(); \
        { const int t_ = b_prev; b_prev = b_cur; b_cur = b_next; b_next = t_; } \
    } while (0)
    pA0 = negm; pA1 = negm;
#pragma unroll
    for (int ks = 0; ks < 6; ++ks) MLA_QK2(pA0, pA1, 0, ks);
    { const float m0 = MLA_ROWMAX(pA0, pA1);
#pragma unroll
      for (int r = 0; r < 16; ++r) { pA0[r] -= m0; pA1[r] -= m0; negm[r] = -m0; } }
    MLA_LOADB(2);
    int jt = 1;
#pragma unroll 1
    for (; jt + 1 < NT; jt += 2) {
        MLA_STEP(pA0, pA1, pB0, pB1, jt, MLA_LOAD, MLA_PUTB);
        MLA_STEP(pB0, pB1, pA0, pA1, jt + 1, MLA_LOADB, MLA_PUT);
    }
    if (jt < NT) { MLA_STEP(pA0, pA1, pB0, pB1, jt, MLA_LOAD, MLA_PUTB); pA0 = pB0; pA1 = pB1; }
    MLA_FIN8(pA0, 0, pw0); MLA_FIN8(pA0, 1, pw1); MLA_FIN8(pA1, 0, pw2); MLA_FIN8(pA1, 1, pw3);
    MLA_PV(b_prev, 0, pw0); MLA_PV(b_prev, 1, pw1); MLA_PV(b_prev, 2, pw2); MLA_PV(b_prev, 3, pw3);
    lsum += __shfl_xor(lsum, 32);
    const float inv = 1.f / lsum;
    bf16* orow = yb + qtok * 512 + h * 64 + 4 * hi;
#pragma unroll
    for (int rq = 0; rq < 4; ++rq) {
        v2u a, b; a.x = pk2(o0[4 * rq] * inv, o0[4 * rq + 1] * inv); a.y = pk2(o0[4 * rq + 2] * inv, o0[4 * rq + 3] * inv);
        b.x = pk2(o1[4 * rq] * inv, o1[4 * rq + 1] * inv); b.y = pk2(o1[4 * rq + 2] * inv, o1[4 * rq + 3] * inv);
        *(v2u*)(orow + 8 * rq) = a; *(v2u*)(orow + 32 + 8 * rq) = b;
    }
    __syncthreads();
#undef MLA_LOAD
#undef MLA_PUT
#undef MLA_LOADB
#undef MLA_PUTB
#undef MLA_KA
#undef MLA_KB
#undef MLA_QK2
#undef MLA_FIN8
#undef MLA_VT
#undef MLA_PV
#undef MLA_ROWMAX
#undef MLA_STEP
}

constexpr int NVP = 144, NA_WLDS = 64 * NVP + 1888;
__device__ __forceinline__ void na_unit(int u, int L, int l, const float* rpb_all, const bf16* proj, bf16* ya, LAS unsigned char* lds) {
    const int tid = ltid(); const int lane = tid & 63, w = tid >> 6, i16 = lane & 15, quad = lane >> 4;
    const int rows = L >> 6; const int hq = u & 3, sr = u >> 2, r = sr % rows, s = sr / rows;
    const int h = 2 * hq + (w >> 2), j = w & 3;
    const int rs = min(max(r - 4, 0), rows - 8), kc0 = min(max(16 * j - 8, 0), 32);
    const size_t base = (size_t)s * L;
    const size_t qtok = base + r * 64 + 16 * j + i16;
    LAS unsigned char* vw = lds + w * NA_WLDS; LAS float* tb = (LAS float*)(vw + 64 * NVP);
    { const float* rpb = rpb_all + (size_t)(l * 8 + h) * 465;
#pragma unroll
      for (int it = 0; it < 8; ++it) { const int idx = it * 64 + lane; if (idx < 465) tb[idx] = rpb[idx]; } }
    bf16x8 qf[2];
    qf[0] = *(const bf16x8*)(proj + qtok * DPROJ + h * 64 + quad * 8); qf[1] = *(const bf16x8*)(proj + qtok * DPROJ + h * 64 + 32 + quad * 8);
    const int cA = (i16 >> 2) * 8 + (i16 & 3);
    const bf16* kp0 = proj + (base + (size_t)rs * 64 + kc0 + cA) * DPROJ + C_KA + h * 64 + quad * 8;
    bf16x8 kf[8][4];
#pragma unroll
    for (int wr = 0; wr < 8; ++wr) { const bf16* kp = kp0 + (size_t)wr * 64 * DPROJ;
        kf[wr][0] = *(const bf16x8*)kp; kf[wr][1] = *(const bf16x8*)(kp + 32); kf[wr][2] = *(const bf16x8*)(kp + 4 * DPROJ); kf[wr][3] = *(const bf16x8*)(kp + 4 * DPROJ + 32); }
    const bf16* vp0 = proj + (base + (size_t)rs * 64 + kc0) * DPROJ + C_VA + h * 64;
    v4u vt[8];
#define NA_VLOAD(ck) do { _Pragma("unroll") for (int it = 0; it < 8; ++it) { const int idx = it * 64 + lane, key = idx >> 3, ch = idx & 7; \
        vt[it] = *(const v4u*)(vp0 + ((size_t)(2 * (ck) + (key >> 5)) * 64 + (key & 31)) * DPROJ + ch * 8); } } while (0)
    NA_VLOAD(0);
    f32x4 sa[8], sb[8];
#pragma unroll
    for (int wr = 0; wr < 8; ++wr) {
        f32x4 a = {0.f, 0.f, 0.f, 0.f}, b = {0.f, 0.f, 0.f, 0.f};
        a = __builtin_amdgcn_mfma_f32_16x16x32_bf16(kf[wr][0], qf[0], a, 0, 0, 0); a = __builtin_amdgcn_mfma_f32_16x16x32_bf16(kf[wr][1], qf[1], a, 0, 0, 0);
        b = __builtin_amdgcn_mfma_f32_16x16x32_bf16(kf[wr][2], qf[0], b, 0, 0, 0); b = __builtin_amdgcn_mfma_f32_16x16x32_bf16(kf[wr][3], qf[1], b, 0, 0, 0);
        sa[wr] = a; sb[wr] = b;
    }
    asm volatile("s_waitcnt lgkmcnt(0)" ::: "memory");
    const int qc = 16 * j + i16, wst = min(max(qc - 8, 0), 48);
    float mx = -1e30f;
#pragma unroll
    for (int wr = 0; wr < 8; ++wr) { const LAS float* rb = tb + (rs + wr - r + 7) * 31;
#pragma unroll
        for (int jj = 0; jj < 4; ++jj) {
            { const int kc = kc0 + quad * 8 + jj; const bool ok = (kc >= wst) && (kc < wst + 16); const int dc = min(max(kc - qc + 15, 0), 30);
              const float v = ok ? (sa[wr][jj] + rb[dc] * LOG2E) : -1e30f; sa[wr][jj] = v; mx = fmaxf(mx, v); }
            { const int kc = kc0 + quad * 8 + 4 + jj; const bool ok = (kc >= wst) && (kc < wst + 16); const int dc = min(max(kc - qc + 15, 0), 30);
              const float v = ok ? (sb[wr][jj] + rb[dc] * LOG2E) : -1e30f; sb[wr][jj] = v; mx = fmaxf(mx, v); }
        } }
    mx = fmaxf(mx, __shfl_xor(mx, 16)); mx = fmaxf(mx, __shfl_xor(mx, 32));
    float ls = 0.f;
#pragma unroll
    for (int wr = 0; wr < 8; ++wr)
#pragma unroll
        for (int jj = 0; jj < 4; ++jj) { sa[wr][jj] = __builtin_amdgcn_exp2f(sa[wr][jj] - mx); sb[wr][jj] = __builtin_amdgcn_exp2f(sb[wr][jj] - mx); ls += sa[wr][jj] + sb[wr][jj]; }
    ls += __shfl_xor(ls, 16); ls += __shfl_xor(ls, 32);
    f32x4 oc[4];
#pragma unroll
    for (int db = 0; db < 4; ++db) oc[db] = (f32x4){0.f, 0.f, 0.f, 0.f};
    const int toff = (quad * 8 + (i16 >> 2)) * NVP + (4 * (lane & 3)) * 2;
#pragma unroll
    for (int ck = 0; ck < 4; ++ck) {
        asm volatile("s_waitcnt lgkmcnt(0)" ::: "memory");
#pragma unroll
        for (int it = 0; it < 8; ++it) { const int idx = it * 64 + lane, key = idx >> 3, ch = idx & 7; *(LAS v4u*)(vw + key * NVP + ch * 16) = vt[it]; }
        if (ck < 3) NA_VLOAD(ck + 1);
        asm volatile("s_waitcnt lgkmcnt(0)" ::: "memory");
#pragma unroll
        for (int wl = 0; wl < 2; ++wl) { const int wr = 2 * ck + wl;
            v4u pw; pw.x = pk2(sa[wr][0], sa[wr][1]); pw.y = pk2(sa[wr][2], sa[wr][3]); pw.z = pk2(sb[wr][0], sb[wr][1]); pw.w = pk2(sb[wr][2], sb[wr][3]);
            const bf16x8 pf = __builtin_bit_cast(bf16x8, pw);
#pragma unroll
            for (int db = 0; db < 4; ++db) { const int vb = toff + wl * 32 * NVP + db * 32;
                const s16x4 t0 = __builtin_amdgcn_ds_read_tr16_b64_v4i16((LAS s16x4*)(vw + vb)), t1 = __builtin_amdgcn_ds_read_tr16_b64_v4i16((LAS s16x4*)(vw + vb + 4 * NVP));
                const bf16x8 vf = {t0[0], t0[1], t0[2], t0[3], t1[0], t1[1], t1[2], t1[3]};
                oc[db] = __builtin_amdgcn_mfma_f32_16x16x32_bf16(vf, pf, oc[db], 0, 0, 0); }
        }
    }
#undef NA_VLOAD
    const float inv = 1.f / ls;
    bf16* orow = ya + qtok * 512 + h * 64 + quad * 4;
#pragma unroll
    for (int db = 0; db < 4; ++db) { v2u o; o.x = pk2(oc[db][0] * inv, oc[db][1] * inv); o.y = pk2(oc[db][2] * inv, oc[db][3] * inv); *(v2u*)(orow + db * 16) = o; }
    asm volatile("s_waitcnt lgkmcnt(0)" ::: "memory");
}

#define XB_TMO      128
#define XB_XCNT(j)  (256  + 64 * (j))
#define XB_XSUB(j)  (1280 + 64 * (j))
#define XB_XGEN(j)  (2304 + 64 * (j))
#define XB_TOP      3328
#define XB_TOPGEN   3392
#define XCD_BAR_WORDS 3456
#define XB_SPIN_CAP (1u << 18)

__device__ __forceinline__ unsigned xb_ld(unsigned* p)              { return __hip_atomic_load(p, __ATOMIC_RELAXED, __HIP_MEMORY_SCOPE_AGENT); }
__device__ __forceinline__ unsigned xb_add(unsigned* p, unsigned v) { return __hip_atomic_fetch_add(p, v, __ATOMIC_RELAXED, __HIP_MEMORY_SCOPE_AGENT); }
__device__ __forceinline__ unsigned xb_xcc_id() { return (unsigned)__builtin_amdgcn_s_getreg((3 << 11) | 20) & 0xFu; }
#define XB_SPIN(cond, bar) do { unsigned _sp = 0; while (cond) { __builtin_amdgcn_s_sleep(1); \
    if ((++_sp & 255u) == 0u) { if (xb_ld(&(bar)[XB_TMO])) break; if (_sp > XB_SPIN_CAP) { atomicAdd(&(bar)[XB_TMO], 1u); break; } } } } while (0)

struct XcdBarrier {
    unsigned* bar; unsigned x;
    volatile LAS unsigned* st;
};

__device__ __forceinline__ XcdBarrier xcd_barrier_post(unsigned* bar, volatile LAS unsigned* st) {
    XcdBarrier b; b.bar = bar; b.x = xb_xcc_id(); b.st = st;
    if (threadIdx.x == 0) (void)xb_add(&bar[XB_XCNT(b.x)], 1u);
    return b;
}
__device__ __forceinline__ void xcd_barrier_complete(unsigned* bar, unsigned x, unsigned& nloc, unsigned& nx) {
    const unsigned G = gridDim.x * gridDim.y * gridDim.z;
    unsigned sum, cnt, mine, sp = 0u;
    for (;;) {
        sum = 0u; cnt = 0u; mine = 0u;
#pragma unroll
        for (unsigned j = 0; j < 16; ++j) { const unsigned c = xb_ld(&bar[XB_XCNT(j)]); sum += c; cnt += (c > 0u) ? 1u : 0u; mine = (j == x) ? c : mine; }
        if (sum == G) break;
        __builtin_amdgcn_s_sleep(1);
        if ((++sp & 255u) == 0u) { if (xb_ld(&bar[XB_TMO])) break; if (sp > XB_SPIN_CAP) { atomicAdd(&bar[XB_TMO], 1u); break; } }
    }
    nloc = mine > 0u ? mine : 1u; nx = cnt > 0u ? cnt : 1u;
}

__device__ __forceinline__ void xcd_barrier(const XcdBarrier& b) {
    asm volatile("s_waitcnt vmcnt(0)" ::: "memory");
    __syncthreads();
    if (threadIdx.x == 0) {
        unsigned* bar = b.bar;
        __builtin_amdgcn_s_waitcnt(0);
        unsigned nloc = b.st[0], nx = b.st[1];
        if (nloc == 0u) { xcd_barrier_complete(bar, b.x, nloc, nx); b.st[0] = nloc; b.st[1] = nx; }
        const unsigned old = xb_add(&bar[XB_XSUB(b.x)], 1u);
        const unsigned gen = old / nloc;
        if (old + 1u == (gen + 1u) * nloc) {
            __builtin_amdgcn_fence(__ATOMIC_RELEASE, "agent");
            asm volatile("s_waitcnt vmcnt(0)" ::: "memory");
            const unsigned og = xb_add(&bar[XB_TOP], 1u);
            const unsigned tg = og / nx;
            if (og + 1u == (tg + 1u) * nx) xb_add(&bar[XB_TOPGEN], 1u);
            else XB_SPIN(xb_ld(&bar[XB_TOPGEN]) == tg, bar);
            __builtin_amdgcn_fence(__ATOMIC_ACQUIRE, "agent");
            xb_add(&bar[XB_XGEN(b.x)], 1u);
            asm volatile("s_waitcnt vmcnt(0)" ::: "memory");
        } else {
            XB_SPIN(xb_ld(&bar[XB_XGEN(b.x)]) == gen, bar);
            __builtin_amdgcn_fence(__ATOMIC_ACQUIRE, "agent");
            asm volatile("s_waitcnt vmcnt(0)" ::: "memory");
        }
    }
    __syncthreads();
}

constexpr int NPH = 12;
__device__ __forceinline__ void run_phase(CP pp, int st, LAS unsigned char* lds) {
    volatile LAS unsigned* lctl = (volatile LAS unsigned*)(lds + LDS_RING);
    const int tid = ltid(), lane = tid & 63, wave = __builtin_amdgcn_readfirstlane(tid >> 6);
    int bid_ = blockIdx.x; asm volatile("" : "+s"(bid_));
    const int NB = gridDim.x, gw = bid_ * 8 + wave, ngw = NB * 8;
    const int ph = st % NPH, gl = st / NPH, l = gl & 1, g = gl >> 1;
    unsigned char* ws = pp->ws; const int Tg = pp->Tg;
    const Reg R{ws, (size_t)Tg};
    const size_t asz = (size_t)Tg * 512;
    const int t0 = g * Tg; const int L = (t0 < NPROMPT) ? 8192 : 4096;
    float* xout = pp->out + (size_t)t0 * DM;
    int gid0 = 0, gidn = 0;
    switch (ph) {
    case 0: {
        const float* xin = (l == 0) ? ((t0 < NPROMPT) ? pp->in[0] + (size_t)t0 * DM : pp->in[1] + (size_t)(t0 - NPROMPT) * DM) : xout;
        phase_norm(xin, pp->in[2] + l * DM, R.RH(), Tg, gw, ngw, lane);
    } break;
    case 1: gid0 = GM_IN; gidn = 1; break;
    case 2: {
        phase_post_proj(pp, l, R.RP(), R.RA(), R.RA() + (size_t)Tg * 384, R.RS(), (_Float16*)R.RZ(), asz, Tg, L, gw, ngw, lane);
    } break;
    case 3: gid0 = GM_MU; gidn = 2; break;
    case 4: {
        phase_mla_post(pp, l, R.RM(), R.RP(), R.RA(), Tg, L, gw, ngw, lane);
    } break;
    case 5: {
        unsigned* qctr = (unsigned*)(ws + WS_CTL) + 64 * gl; const int nseq = Tg / L;
        const int NS = nseq * 16, NM = nseq * 8 * (L >> 8), NN = nseq * (L >> 6) * 4, NTOT = NS + NM + NN;
        for (;;) {
            __syncthreads();
            if (tid == 0) lctl[0] = atomicAdd(qctr, 1u);
            __syncthreads();
            const int u = __builtin_amdgcn_readfirstlane((int)lctl[0]);
            if (u >= NTOT) break;
            if (u < NS) scan_unit(u, L, R.RS(), asz, R.RZ(), lds);
            else if (u < NS + NM) mla_unit(u - NS, L, R.RM(), R.RA(), R.RY() + asz, lds);
            else na_unit(u - NS - NM, L, l, pp->in[7], R.RP(), R.RY(), lds);
        }
    } break;
    case 6: {
        phase_rw_post(pp, l, R.RS(), asz, R.RZ(), R.RY() + 2 * asz, Tg, gw, ngw, lane);
        gid0 = GM_GATE; gidn = 1;
    } break;
    case 7: gid0 = GM_BR0; gidn = 3; break;
    case 8: gid0 = GM_OUT; gidn = 1; break;
    case 9: {
        phase_norm(xout, pp->in[29] + l * DM, R.RH(), Tg, gw, ngw, lane);
    } break;
    case 10: gid0 = GM_GU; gidn = 1; break;
    case 11: gid0 = GM_DN; gidn = 1; break;
    default: break;
    }
#pragma unroll 1
    for (int id = gid0; id < gid0 + gidn; ++id) {
        const unsigned char* wb = ws + W_OFF + (size_t)l * W_STRIDE;
        const bf16* A; const bf16* Bt; int N, K;
        switch (id) {
        case GM_IN:   A = R.RH(); Bt = (const bf16*)(wb + WO_IN); N = DPROJ; K = 1024; break;
        case GM_MU:   A = R.RA(); Bt = (const bf16*)(wb + WO_MU); N = 1792; K = 384; break;
        case GM_RU:   A = R.RA() + (size_t)Tg * 384; Bt = (const bf16*)(wb + WO_RU); N = 2560; K = 384; break;
        case GM_GATE: A = R.RH(); Bt = (const bf16*)(wb + WO_G); N = DGATE; K = 1024; break;
        case GM_BR0: case GM_BR1: case GM_BR2: A = R.RY() + (size_t)(id - GM_BR0) * asz; Bt = (const bf16*)(wb + WO_BR + (size_t)(id - GM_BR0) * MiB); N = DM; K = 512; break;
        case GM_OUT:  A = R.RM(); Bt = (const bf16*)(wb + WO_OUT); N = DM; K = 1024; break;
        case GM_GU:   A = R.RH(); Bt = (const bf16*)(wb + WO_GU); N = 2 * DFF; K = 1024; break;
        default:      A = R.RP(); Bt = (const bf16*)(wb + WO_DN); N = DM; K = DFF; break;
        }
        pg8::Gemm gm{A, Bt, Tg, N, K, (id == GM_MU) ? 1 : ((id == GM_RU) ? 2 : 0)}; pg8::StaticOrder S; S.init(Tg, N, NB, bid_);
        EpiUni E{pp, id, l, g}; pg8::gemm_phase<EpiUni, pg8::StaticOrder, true, true>(lds, gm, S, E);
    }
}

__device__ __forceinline__ void run_phase0(CP pp, int part, LAS unsigned char* lds) {
    const int tid = ltid(), lane = tid & 63, wave = __builtin_amdgcn_readfirstlane(tid >> 6);
    const int NB = gridDim.x, gw = blockIdx.x * 8 + wave, ngw = NB * 8;
    const size_t gtid = (size_t)blockIdx.x * 512 + tid, ngt = (size_t)NB * 512;
    unsigned char* ws = pp->ws;
    if (part == 0) {
        for (int l = 0; l < 2; ++l) { unsigned char* wb = ws + W_OFF + (size_t)l * W_STRIDE;
            zero_bytes(wb + WO_IN + (size_t)NMAIN * 2048, (size_t)(DPROJ - NMAIN) * 2048, gtid, ngt);
            zero_bytes(wb + WO_MU, (size_t)1792 * 384 * 2, gtid, ngt);
            zero_bytes(wb + WO_RU, (size_t)2560 * 384 * 2, gtid, ngt); }
    } else {
        LAS float* scr = (LAS float*)(lds + wave * 16384);
#pragma unroll 1
        for (int l = 0; l < 2; ++l) { unsigned char* wb = ws + W_OFF + (size_t)l * W_STRIDE;
            const float* w_in = pp->in[3] + (size_t)l * DM * DIN;
            transpose_job(w_in, DIN, 1024, NMAIN, (bf16*)(wb + WO_IN), 1024, 0, 0, 0, scr, gw, ngw, lane);
            transpose_job(w_in + NMAIN, DIN, 1024, DGATE, (bf16*)(wb + WO_G), 1024, 0, 0, 0, scr, gw, ngw, lane);
            transpose_job(pp->in[8] + (size_t)l * 512 * 1024, 1024, 512, 1024, (bf16*)(wb + WO_BR), 512, 0, 0, 0, scr, gw, ngw, lane);
            transpose_job(pp->in[15] + (size_t)l * 512 * 1024, 1024, 512, 1024, (bf16*)(wb + WO_BR + 1 * MiB), 512, 0, 0, 0, scr, gw, ngw, lane);
            transpose_job(pp->in[27] + (size_t)l * 512 * 1024, 1024, 512, 1024, (bf16*)(wb + WO_BR + 2 * MiB), 512, 0, 0, 0, scr, gw, ngw, lane);
            transpose_job(pp->in[28] + (size_t)l * 1024 * 1024, 1024, 1024, 1024, (bf16*)(wb + WO_OUT), 1024, 0, 0, 0, scr, gw, ngw, lane);
            transpose_job(pp->in[30] + (size_t)l * 1024 * DFF, DFF, 1024, DFF, (bf16*)(wb + WO_GU), 1024, 0, 0, 1, scr, gw, ngw, lane);
            transpose_job(pp->in[31] + (size_t)l * 1024 * DFF, DFF, 1024, DFF, (bf16*)(wb + WO_GU), 1024, 0, 128, 1, scr, gw, ngw, lane);
            transpose_job(pp->in[32] + (size_t)l * DFF * 1024, 1024, DFF, 1024, (bf16*)(wb + WO_DN), DFF, 0, 0, 0, scr, gw, ngw, lane);
            transpose_job(pp->in[11] + (size_t)l * 256 * 768, 768, 256, 768, (bf16*)(wb + WO_MU), 384, 0, 0, 0, scr, gw, ngw, lane);
            transpose_job(pp->in[12] + (size_t)l * 128 * 1024, 1024, 128, 1024, (bf16*)(wb + WO_MU), 384, 256, 768, 0, scr, gw, ngw, lane);
#pragma unroll 1
            for (int d = 0; d < 2; ++d) {
                transpose_job(pp->in[18] + (size_t)(l * 2 + d) * 64 * 512, 512, 64, 512, (bf16*)(wb + WO_RU), 384, 64 * d, 512 * d, 0, scr, gw, ngw, lane);
                transpose_job(pp->in[20] + (size_t)(l * 2 + d) * 64 * 512, 512, 64, 512, (bf16*)(wb + WO_RU), 384, 128 + 64 * d, 1024 + 512 * d, 0, scr, gw, ngw, lane); }
            transpose_job(pp->in[21] + (size_t)l * 128 * 512, 512, 128, 512, (bf16*)(wb + WO_RU), 384, 256, 2048, 0, scr, gw, ngw, lane);
        }
    }
}

__global__ void __launch_bounds__(512, 2) mega(Params p) {
    extern __shared__ __attribute__((aligned(16))) unsigned char lds_raw[];
    LAS unsigned char* lds = (LAS unsigned char*)lds_raw;
    cg::grid_group grid = cg::this_grid();
    if (blockIdx.x == 0 && threadIdx.x == 0) { Params* d = (Params*)(p.ws + WS_PARAMS); *d = p; }
    const int nsteps = p.G * 2 * NPH;
    volatile LAS unsigned* bst = (volatile LAS unsigned*)(lds + LDS_RING + 32);
    if (threadIdx.x == 0) { bst[0] = 0u; bst[1] = 0u; }
    __syncthreads();
    const XcdBarrier bar = xcd_barrier_post((unsigned*)(p.ws + WS_CTL) + 4096, bst);
    grid.sync();
#pragma unroll 1
    for (int st = -2; st < nsteps; ++st) {
        int s2 = st; asm volatile("" : "+s"(s2));
        CP pp = (CP)(p.ws + WS_PARAMS); asm volatile("" : "+s"(pp));
        if (s2 < 0) run_phase0(pp, s2 + 2, lds); else run_phase(pp, s2, lds);
        xcd_barrier(bar);
    }
}

extern "C" void kernel_launch(void* const* d_in, const int* in_sizes, int n_in, void* d_out, int out_size, void* d_ws, size_t ws_size, hipStream_t stream) {
    static int grid = 0;
    if (grid == 0) {
        int dev = 0, cus = 0, per_cu = 0;
        hipGetDevice(&dev); hipDeviceGetAttribute(&cus, hipDeviceAttributeMultiprocessorCount, dev);
        hipFuncSetAttribute((const void*)mega, hipFuncAttributeMaxDynamicSharedMemorySize, LDS_BYTES);
        hipOccupancyMaxActiveBlocksPerMultiprocessor(&per_cu, (const void*)mega, 512, LDS_BYTES);
        (void)hipGetLastError();
        if (per_cu < 1) per_cu = 1;
        grid = cus * per_cu;
    }
    int G = 2;
    while (G < 16 && ACT_OFF + (size_t)(NTOK / G) * TOKB > ws_size) G *= 2;
    if (hipMemsetAsync((char*)d_ws + WS_CTL, 0, CTL_BYTES, stream) != hipSuccess) { fprintf(stderr, "kernel_launch: memset failed\n"); return; }
    Params p{};
    for (int i = 0; i < 33; ++i) p.in[i] = (const float*)d_in[i];
    p.out = (float*)d_out; p.ws = (unsigned char*)d_ws; p.G = G; p.Tg = NTOK / G;
    void* args[] = {&p};
    hipError_t e = hipLaunchCooperativeKernel((const void*)mega, dim3(grid), dim3(512), args, LDS_BYTES, stream);
    if (e != hipSuccess) fprintf(stderr, "cooperative launch failed: %s (grid %d)\n", hipGetErrorString(e), grid);
}
```

```cpp
#include <hip/hip_runtime.h>
#include <hip/hip_cooperative_groups.h>
#include <cstdio>
#include <cstdint>
namespace cg = cooperative_groups;
namespace pg8 {
#define PG8_LAS __attribute__((address_space(3)))
typedef unsigned short bf16_t;
typedef short bf16x8 __attribute__((ext_vector_type(8)));
typedef float f32x4 __attribute__((ext_vector_type(4)));
typedef unsigned u32x4 __attribute__((ext_vector_type(4)));
constexpr int BM = 256, BK = 64, HALF = 128, HTB = HALF * BK * 2  , STAGE_BYTES = 8 * HTB, NXCD = 8, WGM = 8;

__host__ __device__ __forceinline__ int lds_byte(int r, int c) { const int st = (r >> 4) * 2 + (c >> 5), rr = r & 15, cc = c & 31, ob = rr * 64 + cc * 2; return st * 1024 + (ob ^ (((ob >> 9) & 1) << 5)); }
__host__ __device__ __forceinline__ void stage_rc(int b, int& R, int& C) { const int st = b / 1024, sb = b % 1024, swz = sb ^ (((sb >> 9) & 1) << 5); R = (st >> 1) * 16 + swz / 64; C = (st & 1) * 32 + (swz % 64) / 2; }
__host__ __device__ __forceinline__ int perm32(int rho) { const int n = rho >> 4, i = rho & 15; return 8 * (i >> 2) + 4 * n + (i & 3); }

struct Unit { int pm, pn; };
struct Gemm { const bf16_t* A; const bf16_t* Bt; int M, N, K; int kmode; };
__device__ __forceinline__ void krange(int kmode, int pn, int K, int& kof, int& nt) {
    kof = 0; nt = K / BK;
    if (kmode == 1) { if (pn < 3) { nt = 4; } else { kof = 256; nt = 2; } }
    else if (kmode == 2) { kof = (pn < 4) ? 0 : ((pn < 8) ? 128 : 256); nt = 2; }
}

struct StaticOrder {
    int nM, nN, nwg, G, c;
    __host__ __device__ void init(int M, int N, int G_, int c_) { nM = M / BM; nN = N / BM; nwg = nM * nN; G = G_; c = c_; }
    __host__ __device__ bool next(int i, Unit& u) const {
        const long L = (long)i * G + c; if (L >= nwg) return false;
        int wgid = (int)L; { const int q = nwg / NXCD, r = nwg % NXCD, xcd = wgid % NXCD, off = wgid / NXCD; wgid = (xcd < r ? xcd * (q + 1) : r * (q + 1) + (xcd - r) * q) + off; }
        const int nig = WGM * nN, gid = wgid / nig, fm = gid * WGM, gsz = (nM - fm) < WGM ? (nM - fm) : WGM;
        u.pm = fm + ((wgid % nig) % gsz); u.pn = (wgid % nig) / gsz; return true;
    }
    __device__ __forceinline__ void a_ready(const Unit&) const {}
    __device__ __forceinline__ void done(const Unit&) const {}
};

__device__ __forceinline__ unsigned cvt_pk_bf16(float lo, float hi) { unsigned r; asm volatile("v_cvt_pk_bf16_f32 %0, %1, %2" : "=v"(r) : "v"(lo), "v"(hi)); return r; }
typedef float f32x2 __attribute__((ext_vector_type(2)));
}
namespace pg8 {
template <class Epi, class Sched, bool ALIGN_EPI = false, bool SP2 = false>
__device__ __forceinline__ void gemm_phase(PG8_LAS unsigned char* lds, const Gemm g, const Sched& S, const Epi& E) {
    int tid_l = threadIdx.x; asm volatile("" : "+v"(tid_l)); const int tid = tid_l, wid = __builtin_amdgcn_readfirstlane(tid >> 6), lane = tid & 63, wr = wid >> 2, wc = wid & 3, fr = lane & 15, fq = lane >> 4;
    const int K = g.K; int nt = K / BK;
    unsigned voffA[2], voffB[2];
#pragma unroll
    for (int i = 0; i < 2; ++i) { int R, C; stage_rc(tid * 16 + i * 8192, R, C); const int Rb = Epi::PERM ? ((R & ~31) + perm32(R & 31)) : R;
        voffA[i] = (unsigned)(R * K + C) * 2u; voffB[i] = (unsigned)(Rb * K + C) * 2u; }
    const size_t kstep = (size_t)(BK * 2);
    const size_t hstep = (size_t)HALF * K * 2;
    const size_t tstep = 2 * hstep;
    const unsigned ldsw = (unsigned)wid * 1024u;
    const int aoff = lds_byte(wr * 64 + fr, fq * 8), boff = lds_byte(wc * 32 + fr, fq * 8);
#define PG8_SA(b, h) (((b) * 2 + (h)) * HTB)
#define PG8_SB(b, h) ((4 + (b) * 2 + (h)) * HTB)
#define PG8_STAGE(bufoff, gbase, voff) do { _Pragma("unroll") for (int _i = 0; _i < 2; ++_i) \
        __builtin_amdgcn_global_load_lds((const unsigned*)((const char*)(gbase) + (voff)[_i]), (PG8_LAS unsigned*)(lds + (bufoff) + ldsw + _i * 8192), 16, 0, 0); } while (0)
#define PG8_LDA(dst, b, h) do { _Pragma("unroll") for (int m = 0; m < 4; ++m) _Pragma("unroll") for (int k = 0; k < 2; ++k) dst[m][k] = *(const PG8_LAS bf16x8*)(lds + PG8_SA(b, h) + aoff + m * 2048 + k * 1024); } while (0)
#define PG8_LDB(dst, b, h) do { _Pragma("unroll") for (int n = 0; n < 2; ++n) _Pragma("unroll") for (int k = 0; k < 2; ++k) dst[n][k] = *(const PG8_LAS bf16x8*)(lds + PG8_SB(b, h) + boff + n * 2048 + k * 1024); } while (0)
#define PG8_MMA(ai, bj, At, Bt) do { __builtin_amdgcn_s_setprio(1); _Pragma("unroll") for (int m = 0; m < 4; ++m) _Pragma("unroll") for (int n = 0; n < 2; ++n) _Pragma("unroll") for (int k = 0; k < 2; ++k) \
        acc[ai][bj][m][n] = __builtin_amdgcn_mfma_f32_16x16x32_bf16(Bt[n][k], At[m][k], acc[ai][bj][m][n], 0, 0, 0); __builtin_amdgcn_s_setprio(0); } while (0)
#define PG8_WAIT_V(n) asm volatile("s_waitcnt vmcnt(" #n ")" ::: "memory")
#define PG8_WAIT_L(n) asm volatile("s_waitcnt lgkmcnt(" #n ")" ::: "memory")
#define PG8_BAR __builtin_amdgcn_s_barrier()
#define PG8_SCHED __builtin_amdgcn_sched_barrier(0)
    Unit cur, nxt; int ui = 0;
    if (!S.next(0, cur)) return;
    f32x4 acc[2][2][4][2];
#pragma unroll
    for (int a = 0; a < 2; ++a)
#pragma unroll
        for (int b = 0; b < 2; ++b)
#pragma unroll
            for (int m = 0; m < 4; ++m)
#pragma unroll
                for (int n = 0; n < 2; ++n) acc[a][b][m][n] = (f32x4){0.f, 0.f, 0.f, 0.f};
    bf16x8 At[4][2], B0[2][2], B1[2][2];
    int kofc_; krange(g.kmode, cur.pn, K, kofc_, nt);
    const char* cA = (const char*)g.A + (size_t)cur.pm * tstep + (size_t)kofc_ * 2; const char* cB = (const char*)g.Bt + (size_t)cur.pn * tstep + (size_t)kofc_ * 2;
    S.a_ready(cur);
    if constexpr (SP2) {
        PG8_STAGE(PG8_SB(0, 0), cB, voffB); PG8_STAGE(PG8_SB(0, 1), cB + hstep, voffB); PG8_STAGE(PG8_SA(0, 0), cA, voffA); PG8_STAGE(PG8_SA(0, 1), cA + hstep, voffA);
        if (wr == 1) PG8_BAR;
        PG8_WAIT_V(2); PG8_BAR;
        PG8_STAGE(PG8_SB(1, 0), cB + kstep, voffB); PG8_STAGE(PG8_SA(1, 0), cA + kstep, voffA); PG8_STAGE(PG8_SB(1, 1), cB + hstep + kstep, voffB);
        PG8_WAIT_V(6); PG8_BAR;
    } else {
        PG8_STAGE(PG8_SB(0, 0), cB, voffB); PG8_STAGE(PG8_SA(0, 0), cA, voffA); PG8_STAGE(PG8_SB(0, 1), cB + hstep, voffB); PG8_STAGE(PG8_SA(0, 1), cA + hstep, voffA);
        if (wr == 1) PG8_BAR;
        PG8_WAIT_V(4); PG8_BAR;
        PG8_STAGE(PG8_SB(1, 0), cB + kstep, voffB); PG8_STAGE(PG8_SA(1, 0), cA + kstep, voffA); PG8_STAGE(PG8_SB(1, 1), cB + hstep + kstep, voffB);
        PG8_WAIT_V(6); PG8_BAR;
    }
    for (;;) {
        const bool has_next = S.next(ui + 1, nxt);
        int kofn_ = 0, ntn_ = nt; if (has_next) krange(g.kmode, nxt.pn, K, kofn_, ntn_);
        const char* nA = has_next ? (const char*)g.A + (size_t)nxt.pm * tstep + (size_t)kofn_ * 2 : cA; const char* nB = has_next ? (const char*)g.Bt + (size_t)nxt.pn * tstep + (size_t)kofn_ * 2 : cB;
        for (int t = 0; t < nt; t += 2) {
            const bool last = (t == nt - 2);
            const char* a1 = cA + (size_t)(t + 1) * kstep;
            const char* a2 = last ? nA : cA + (size_t)(t + 2) * kstep; const char* b2 = last ? nB : cB + (size_t)(t + 2) * kstep;
            const char* a3 = a2 + kstep; const char* b3 = b2 + kstep;
            if (last && has_next) S.a_ready(nxt);
            if constexpr (SP2) {
            PG8_LDB(B0, 0, 0); PG8_LDB(B1, 0, 1); PG8_SCHED; PG8_LDA(At, 0, 0); PG8_STAGE(PG8_SA(1, 1), a1 + hstep, voffA);
            PG8_WAIT_V(8); PG8_WAIT_L(0); PG8_BAR; PG8_MMA(0, 0, At, B0); PG8_MMA(0, 1, At, B1); PG8_BAR; PG8_SCHED;
            PG8_LDA(At, 0, 1); PG8_STAGE(PG8_SB(0, 0), b2, voffB); PG8_STAGE(PG8_SB(0, 1), b2 + hstep, voffB); PG8_STAGE(PG8_SA(0, 0), a2, voffA);
            PG8_WAIT_V(8); PG8_WAIT_L(0); PG8_BAR; PG8_MMA(1, 0, At, B0); PG8_MMA(1, 1, At, B1); PG8_BAR; PG8_SCHED;
            PG8_LDB(B0, 1, 0); PG8_LDB(B1, 1, 1); PG8_SCHED; PG8_LDA(At, 1, 0); PG8_STAGE(PG8_SA(0, 1), a2 + hstep, voffA);
            PG8_WAIT_V(8); PG8_WAIT_L(0); PG8_BAR; PG8_MMA(0, 0, At, B0); PG8_MMA(0, 1, At, B1); PG8_BAR; PG8_SCHED;
            PG8_LDA(At, 1, 1); PG8_STAGE(PG8_SB(1, 0), b3, voffB); PG8_STAGE(PG8_SB(1, 1), b3 + hstep, voffB); PG8_STAGE(PG8_SA(1, 0), a3, voffA);
            PG8_WAIT_V(8); PG8_WAIT_L(0); PG8_BAR; PG8_MMA(1, 0, At, B0); PG8_MMA(1, 1, At, B1); PG8_BAR; PG8_SCHED;
            } else {
            PG8_LDB(B0, 0, 0); PG8_SCHED; PG8_LDA(At, 0, 0); PG8_STAGE(PG8_SA(1, 1), a1 + hstep, voffA);
            PG8_WAIT_L(8); PG8_BAR; PG8_WAIT_L(0); PG8_MMA(0, 0, At, B0); PG8_BAR; PG8_SCHED;
            PG8_LDB(B1, 0, 1); PG8_STAGE(PG8_SB(0, 0), b2, voffB);
            PG8_BAR; PG8_WAIT_L(0); PG8_MMA(0, 1, At, B1); PG8_BAR;
            PG8_LDA(At, 0, 1); PG8_STAGE(PG8_SA(0, 0), a2, voffA);
            PG8_BAR; PG8_WAIT_L(0); PG8_MMA(1, 0, At, B0); PG8_BAR; PG8_SCHED;
            PG8_STAGE(PG8_SB(0, 1), b2 + hstep, voffB);
            PG8_WAIT_V(6); PG8_BAR; PG8_MMA(1, 1, At, B1); PG8_BAR;
            PG8_LDB(B0, 1, 0); PG8_SCHED; PG8_LDA(At, 1, 0); PG8_STAGE(PG8_SA(0, 1), a2 + hstep, voffA);
            PG8_WAIT_L(8); PG8_BAR; PG8_WAIT_L(0); PG8_MMA(0, 0, At, B0); PG8_BAR; PG8_SCHED;
            PG8_LDB(B1, 1, 1); PG8_STAGE(PG8_SB(1, 0), b3, voffB);
            PG8_BAR; PG8_WAIT_L(0); PG8_MMA(0, 1, At, B1); PG8_BAR;
            PG8_LDA(At, 1, 1); PG8_STAGE(PG8_SA(1, 0), a3, voffA);
            PG8_BAR; PG8_WAIT_L(0); PG8_MMA(1, 0, At, B0); PG8_BAR; PG8_SCHED;
            PG8_STAGE(PG8_SB(1, 1), b3 + hstep, voffB);
            PG8_WAIT_V(6); PG8_BAR; PG8_MMA(1, 1, At, B1); PG8_BAR;
            }
        }
        if constexpr (ALIGN_EPI) { if (wr == 0) PG8_BAR; }
        if constexpr (!Epi::AFTER_DRAIN) { E(acc, cur, wr, wc, fr, fq); S.done(cur); }
        if (!has_next) break;
#pragma unroll
        for (int a = 0; a < 2; ++a)
#pragma unroll
            for (int b = 0; b < 2; ++b)
#pragma unroll
                for (int m = 0; m < 4; ++m)
#pragma unroll
                    for (int n = 0; n < 2; ++n) acc[a][b][m][n] = (f32x4){0.f, 0.f, 0.f, 0.f};
        cur = nxt; cA = nA; cB = nB; nt = ntn_; ++ui;
        if constexpr (ALIGN_EPI) { if (wr == 1) PG8_BAR; }
    }
    PG8_WAIT_V(0);
    if constexpr (!ALIGN_EPI) { if (wr == 0) PG8_BAR; }
    PG8_BAR;
    if constexpr (Epi::AFTER_DRAIN) { E.fused(acc, cur, wr, wc, fr, fq, lds, wid, lane); S.done(cur); }
#undef PG8_SA
#undef PG8_SB
#undef PG8_STAGE
#undef PG8_LDA
#undef PG8_LDB
#undef PG8_MMA
#undef PG8_WAIT_V
#undef PG8_WAIT_L
#undef PG8_BAR
#undef PG8_SCHED
}
}

#define LAS __attribute__((address_space(3)))
typedef unsigned short bf16;
typedef unsigned v4u __attribute__((ext_vector_type(4)));
typedef unsigned v2u __attribute__((ext_vector_type(2)));
typedef float f32x4 __attribute__((ext_vector_type(4)));
typedef float f32x16 __attribute__((ext_vector_type(16)));
typedef short bf16x8 __attribute__((ext_vector_type(8)));
typedef short s16x4 __attribute__((ext_vector_type(4)));
typedef _Float16 h8 __attribute__((ext_vector_type(8)));

typedef float f32x2_t __attribute__((ext_vector_type(2))); typedef __bf16 bf16x2_t __attribute__((ext_vector_type(2)));
__device__ __forceinline__ unsigned pk2(float lo, float hi) { f32x2_t v = {lo, hi}; bf16x2_t b = __builtin_convertvector(v, bf16x2_t); return __builtin_bit_cast(unsigned, b); }
__device__ __forceinline__ float bflo(unsigned u) { return __uint_as_float(u << 16); }
__device__ __forceinline__ float bfhi(unsigned u) { return __uint_as_float(u & 0xffff0000u); }
__device__ __forceinline__ float bf2f(bf16 b) { return __uint_as_float(((unsigned)b) << 16); }
__device__ __forceinline__ bf16 f2bf(float f) { return (bf16)(pk2(f, 0.f) & 0xffffu); }
#define UNPACK8(v, f) do { f[0] = bflo(v.x); f[1] = bfhi(v.x); f[2] = bflo(v.y); f[3] = bfhi(v.y); f[4] = bflo(v.z); f[5] = bfhi(v.z); f[6] = bflo(v.w); f[7] = bfhi(v.w); } while (0)
#define PACK8(o, f) do { o.x = pk2(f[0], f[1]); o.y = pk2(f[2], f[3]); o.z = pk2(f[4], f[5]); o.w = pk2(f[6], f[7]); } while (0)
__device__ __forceinline__ int ltid() { int t = threadIdx.x; asm volatile("" : "+v"(t)); return t; }
__device__ __forceinline__ float sigmoidf_(float x) { return __builtin_amdgcn_rcpf(1.f + __expf(-x)); }
__device__ __forceinline__ float wave_sum(float v) {
#pragma unroll
    for (int o = 1; o < 64; o <<= 1) v += __shfl_xor(v, o);
    return v;
}
__device__ __forceinline__ float sum8(float v) { v += __shfl_xor(v, 1); v += __shfl_xor(v, 2); v += __shfl_xor(v, 4); return v; }

constexpr int DM = 1024, DIN = 6944, DPROJ = 4096, NMAIN = 3872, DGATE = 3072, DFF = 2816;
constexpr int NTOK = 131072, NPROMPT = 65536;
constexpr int C_KA = 512, C_VA = 1024, C_CQ = 1536, C_CKV = 1792, C_KR = 1920, C_RW = 1952;
constexpr float LOG2E = 1.4426950408889634f;
constexpr float NA_QS = 0.125f * LOG2E;
constexpr float MLA_QS = 0.10206207261596575f * LOG2E;
constexpr float NEPS = 1e-6f;

constexpr size_t MiB = 1u << 20;
constexpr size_t WS_CTL = 0, CTL_BYTES = 1 * MiB;
constexpr size_t W_OFF = 1 * MiB, W_STRIDE = 39 * MiB;
constexpr size_t WO_IN = 0, WO_G = 8 * MiB, WO_BR = 14 * MiB, WO_OUT = 17 * MiB, WO_GU = 19 * MiB, WO_DN = 30 * MiB, WO_MU = 35 * MiB + 512 * 1024, WO_RU = 37 * MiB;
constexpr size_t ACT_OFF = 80 * MiB;
constexpr size_t TOKB_H = 2048, TOKB_P = 8192, TOKB_M = 3584, TOKB_A = 1536, TOKB_S = 9216, TOKB_Y = 3072, TOKB_Z = 2048;
constexpr size_t TOKB = TOKB_H + TOKB_P + TOKB_M + TOKB_A + TOKB_S + TOKB_Y + TOKB_Z;
static_assert(WO_MU + 1792 * 384 * 2 <= WO_RU && WO_RU + 2560 * 384 * 2 <= W_STRIDE && WO_DN + 1024 * 2816 * 2 <= WO_MU && WO_GU + 5632 * 1024 * 2 <= WO_DN, "weight map");
constexpr int LDS_RING = 131072, LDS_BYTES = LDS_RING + 1024;

struct Params { const float* in[33]; float* out; unsigned char* ws; int G; int Tg; };
typedef const __attribute__((address_space(4))) Params* CP;

constexpr size_t WS_PARAMS = 512 * 1024;
struct Reg { unsigned char* ws; size_t Tg;
    __device__ __forceinline__ bf16* RH() const { return (bf16*)(ws + ACT_OFF); }
    __device__ __forceinline__ bf16* RP() const { return (bf16*)(ws + ACT_OFF + Tg * TOKB_H); }
    __device__ __forceinline__ bf16* RM() const { return (bf16*)(ws + ACT_OFF + Tg * (TOKB_H + TOKB_P)); }
    __device__ __forceinline__ bf16* RA() const { return (bf16*)(ws + ACT_OFF + Tg * (TOKB_H + TOKB_P + TOKB_M)); }
    __device__ __forceinline__ _Float16* RS() const { return (_Float16*)(ws + ACT_OFF + Tg * (TOKB_H + TOKB_P + TOKB_M + TOKB_A)); }
    __device__ __forceinline__ bf16* RY() const { return (bf16*)(ws + ACT_OFF + Tg * (TOKB_H + TOKB_P + TOKB_M + TOKB_A + TOKB_S)); }
    __device__ __forceinline__ bf16* RZ() const { return (bf16*)(ws + ACT_OFF + Tg * (TOKB_H + TOKB_P + TOKB_M + TOKB_A + TOKB_S + TOKB_Y)); }
};
enum { GM_IN = 0, GM_MU = 1, GM_RU = 2, GM_GATE = 3, GM_BR0 = 4, GM_BR1 = 5, GM_BR2 = 6, GM_OUT = 7, GM_GU = 8, GM_DN = 9 };
#define EPI_FENCE() asm volatile("" ::: "memory")
struct EpiUni {
    static constexpr bool PERM = true, AFTER_DRAIN = false;
    CP pp; int id, l, g;
    __device__ __forceinline__ void operator()(const pg8::f32x4 (&acc)[2][2][4][2], const pg8::Unit& u, int wr, int wc, int fr, int fq) const {
        CP q = pp; asm volatile("" : "+s"(q));
        const int Tg = q->Tg; const Reg R{q->ws, (size_t)Tg}; const size_t asz = (size_t)Tg * 512;
        const int row0 = u.pm * 256 + wr * 64 + fr, col0 = u.pn * 256 + wc * 32 + 8 * fq;
        switch (id) {
        case GM_IN: case GM_MU: {
            bf16* O = (id == GM_IN) ? R.RP() : R.RM(); const int ldc = (id == GM_IN) ? DPROJ : 1792;
#pragma unroll
            for (int ai = 0; ai < 2; ++ai)
#pragma unroll
                for (int m = 0; m < 4; ++m) { bf16* rp = O + (size_t)(row0 + ai * 128 + m * 16) * ldc + col0;
#pragma unroll
                    for (int bj = 0; bj < 2; ++bj) { const f32x4 v0 = acc[ai][bj][m][0], v1 = acc[ai][bj][m][1]; v4u w; w.x = pk2(v0[0], v0[1]); w.y = pk2(v0[2], v0[3]); w.z = pk2(v1[0], v1[1]); w.w = pk2(v1[2], v1[3]);
                        *(v4u*)(rp + bj * 128) = w; } }
        } break;
        case GM_GATE: {
            bf16* O = R.RP(); const float* bias = q->in[4] + l * DGATE + col0;
#pragma unroll
            for (int bj = 0; bj < 2; ++bj) { const f32x4 b0 = *(const f32x4*)(bias + bj * 128), b1 = *(const f32x4*)(bias + bj * 128 + 4);
#pragma unroll
                for (int ai = 0; ai < 2; ++ai)
#pragma unroll
                    for (int m = 0; m < 4; ++m) { const f32x4 v0 = acc[ai][bj][m][0] + b0, v1 = acc[ai][bj][m][1] + b1; float f[8];
#pragma unroll
                        for (int i = 0; i < 4; ++i) { f[i] = sigmoidf_(v0[i]); f[4 + i] = sigmoidf_(v1[i]); }
                        v4u w; PACK8(w, f); *(v4u*)(O + (size_t)(row0 + ai * 128 + m * 16) * DGATE + col0 + bj * 128) = w; }
                EPI_FENCE(); }
        } break;
        case GM_GU: {
            bf16* O = R.RP(); const int hc = u.pn * 128 + wc * 32 + 8 * fq;
#pragma unroll
            for (int ai = 0; ai < 2; ++ai)
#pragma unroll
                for (int m = 0; m < 4; ++m) { float f[8];
#pragma unroll
                    for (int n = 0; n < 2; ++n)
#pragma unroll
                        for (int i = 0; i < 4; ++i) { const float gt = acc[ai][0][m][n][i], up = acc[ai][1][m][n][i]; f[4 * n + i] = gt * sigmoidf_(gt) * up; }
                    v4u w; PACK8(w, f); *(v4u*)(O + (size_t)(row0 + ai * 128 + m * 16) * DFF + hc) = w; }
        } break;
        case GM_BR0: case GM_BR1: case GM_BR2: {
            bf16* O = R.RM(); const bf16* Gt = R.RP() + (id - GM_BR0) * 1024; const bool first = (id == GM_BR0);
#pragma unroll
            for (int ai = 0; ai < 2; ++ai)
#pragma unroll
                for (int m = 0; m < 4; ++m) { const size_t row = (size_t)(row0 + ai * 128 + m * 16);
#pragma unroll
                    for (int bj = 0; bj < 2; ++bj) { const int col = col0 + bj * 128; const v4u gv = *(const v4u*)(Gt + row * DGATE + col); float gg[8], f[8]; UNPACK8(gv, gg);
#pragma unroll
                        for (int i = 0; i < 4; ++i) { f[i] = gg[i] * acc[ai][bj][m][0][i]; f[4 + i] = gg[4 + i] * acc[ai][bj][m][1][i]; }
                        if (!first) { const v4u ov = *(const v4u*)(O + row * DM + col); float o[8]; UNPACK8(ov, o);
#pragma unroll
                            for (int i = 0; i < 8; ++i) f[i] += o[i]; }
                        v4u w; PACK8(w, f); *(v4u*)(O + row * DM + col) = w; }
                    EPI_FENCE(); }
        } break;
        case GM_OUT: case GM_DN: {
            const int t0 = g * Tg; float* xout = q->out + (size_t)t0 * DM;
            const float* xin = (id == GM_OUT && l == 0) ? ((t0 < NPROMPT) ? q->in[0] + (size_t)t0 * DM : q->in[1] + (size_t)(t0 - NPROMPT) * DM) : xout;
#pragma unroll
            for (int ai = 0; ai < 2; ++ai)
#pragma unroll
                for (int m = 0; m < 4; ++m) { const size_t off = (size_t)(row0 + ai * 128 + m * 16) * DM + col0;
#pragma unroll
                    for (int bj = 0; bj < 2; ++bj)
#pragma unroll
                        for (int n = 0; n < 2; ++n) { const f32x4 b = *(const f32x4*)(xin + off + bj * 128 + n * 4); *(f32x4*)(xout + off + bj * 128 + n * 4) = b + acc[ai][bj][m][n]; }
                    EPI_FENCE(); }
        } break;
        case GM_RU: {
            _Float16* rs = R.RS(); const _Float16* ktmp = (const _Float16*)R.RZ(); bf16* gout = R.RY() + 2 * asz;
            const int type = u.pn >> 1; const int cl0 = (u.pn & 1) * 256 + wc * 32 + 8 * fq;
            const float* w0 = q->in[17] + l * 1024; const float* a0 = q->in[19] + l * 1024; const float* ka = q->in[23] + l * 512;
#pragma unroll
            for (int ai = 0; ai < 2; ++ai)
#pragma unroll
                for (int m = 0; m < 4; ++m) { const size_t row = (size_t)(row0 + ai * 128 + m * 16);
#pragma unroll
                    for (int bj = 0; bj < 2; ++bj) { const int cl = cl0 + bj * 128; float f[8];
#pragma unroll
                        for (int i = 0; i < 4; ++i) { f[i] = acc[ai][bj][m][0][i]; f[4 + i] = acc[ai][bj][m][1][i]; }
                        if (type < 2) {
                            h8 o;
#pragma unroll
                            for (int i = 0; i < 8; ++i) o[i] = (_Float16)__expf(-0.6065306597126334f * sigmoidf_(f[i] + w0[type * 512 + cl + i]));
                            *(h8*)(rs + (size_t)(3 + type) * asz + row * 512 + cl) = o;
                        } else if (type < 4) {
                            const int d = type - 2; const h8 kv = *(const h8*)(ktmp + row * 512 + cl), kkv = *(const h8*)(rs + (size_t)2 * asz + row * 512 + cl); h8 o1, o2;
#pragma unroll
                            for (int i = 0; i < 8; ++i) { const float a = sigmoidf_(f[i] + a0[d * 512 + cl + i]); o1[i] = (_Float16)((float)kkv[i] * a); o2[i] = (_Float16)((float)kv[i] * (1.f + (a - 1.f) * ka[cl + i])); }
                            *(h8*)(rs + (size_t)(5 + d) * asz + row * 512 + cl) = o1; *(h8*)(rs + (size_t)(7 + d) * asz + row * 512 + cl) = o2;
                        } else { v4u w; PACK8(w, f); *(v4u*)(gout + row * 512 + cl) = w; }
                        EPI_FENCE(); } }
        } break;
        default: break;
        }
    }
};

__device__ __forceinline__ void transpose_item(const float* W, int ldw, int N, bf16* WT, int ldt, int koff, int row_off, int mode, LAS float* scr, int item, int lane) {
    const int nblk = N / 32, kb = item / nblk, nb = item % nblk, k0 = 64 * kb, n0 = 32 * nb;
#pragma unroll 8
    for (int i = 0; i < 32; ++i) { const int kk = 2 * i + (lane >> 5); scr[kk * 33 + (lane & 31)] = W[(size_t)(k0 + kk) * ldw + n0 + (lane & 31)]; }
    asm volatile("s_waitcnt lgkmcnt(0)" ::: "memory");
    const int c = lane & 7;
#pragma unroll
    for (int j = 0; j < 4; ++j) { const int n = (lane >> 3) + 8 * j; const LAS float* s = scr + (8 * c) * 33 + n;
        v4u o; o.x = pk2(s[0 * 33], s[1 * 33]); o.y = pk2(s[2 * 33], s[3 * 33]); o.z = pk2(s[4 * 33], s[5 * 33]); o.w = pk2(s[6 * 33], s[7 * 33]);
        const int nn = n0 + n; const int drow = mode ? ((nn >> 7) * 256 + row_off + (nn & 127)) : (row_off + nn);
        *(v4u*)(WT + (size_t)drow * ldt + koff + k0 + 8 * c) = o; }
    asm volatile("s_waitcnt lgkmcnt(0)" ::: "memory");
}
__device__ __forceinline__ void transpose_job(const float* W, int ldw, int K, int N, bf16* WT, int ldt, int koff, int row_off, int mode, LAS float* scr, int gw, int ngw, int lane) {
    const int nitems = (K / 64) * (N / 32);
    for (int it = gw; it < nitems; it += ngw) transpose_item(W, ldw, N, WT, ldt, koff, row_off, mode, scr, it, lane);
}
__device__ __forceinline__ void zero_bytes(unsigned char* p, size_t nbytes, size_t gtid, size_t ngt) {
    const v4u z = {0u, 0u, 0u, 0u};
    for (size_t i = gtid; i < nbytes / 16; i += ngt) ((v4u*)p)[i] = z;
}

__device__ __forceinline__ void phase_norm(const float* x, const float* g, bf16* hb, int Tg, int gw, int ngw, int lane) {
    for (int t = gw; t < Tg; t += 2 * ngw) {
        const int t2 = (t + ngw < Tg) ? t + ngw : t;
        const f32x4* xa = (const f32x4*)(x + (size_t)t * DM) + lane; const f32x4* xb = (const f32x4*)(x + (size_t)t2 * DM) + lane; f32x4 va[4], vb[4]; float sa = 0.f, sb = 0.f;
#pragma unroll
        for (int j = 0; j < 4; ++j) { va[j] = xa[64 * j]; vb[j] = xb[64 * j]; }
#pragma unroll
        for (int j = 0; j < 4; ++j) { sa += (va[j].x * va[j].x + va[j].y * va[j].y) + (va[j].z * va[j].z + va[j].w * va[j].w); sb += (vb[j].x * vb[j].x + vb[j].y * vb[j].y) + (vb[j].z * vb[j].z + vb[j].w * vb[j].w); }
        const float ia = rsqrtf(wave_sum(sa) * (1.f / DM) + NEPS), ib = rsqrtf(wave_sum(sb) * (1.f / DM) + NEPS);
        v2u* oa = (v2u*)(hb + (size_t)t * DM) + lane; v2u* ob = (v2u*)(hb + (size_t)t2 * DM) + lane;
#pragma unroll
        for (int j = 0; j < 4; ++j) { const f32x4 gg = ((const f32x4*)g)[lane + 64 * j]; v2u o;
            o.x = pk2(va[j].x * ia * gg.x, va[j].y * ia * gg.y); o.y = pk2(va[j].z * ia * gg.z, va[j].w * ia * gg.w); oa[64 * j] = o;
            o.x = pk2(vb[j].x * ib * gg.x, vb[j].y * ib * gg.y); o.y = pk2(vb[j].z * ib * gg.z, vb[j].w * ib * gg.w); ob[64 * j] = o; }
    }
}

__device__ __forceinline__ void phase_post_proj(CP pp, int l, bf16* proj, bf16* mla_a, bf16* rw_a, _Float16* rs, _Float16* ktmp, size_t asz, int Tg, int L, int gw, int ngw, int lane) {
    const float* gq = pp->in[5] + l * 64; const float* gk = pp->in[6] + l * 64;
    const float* gcq = pp->in[9] + l * 256; const float* gckv = pp->in[10] + l * 128;
    const float* mu = pp->in[16] + l * 1920; const float* kkw = pp->in[22] + l * 512;
    for (int t = gw; t < Tg; t += ngw) {
        bf16* row = proj + (size_t)t * DPROJ; const int tpos = t % L;
        const bool hasp = tpos > 0, hasn = tpos < L - 1;
        v4u qv = *(const v4u*)(row + 8 * lane), kv = *(const v4u*)(row + C_KA + 8 * lane); const v2u cv = *(const v2u*)(row + C_CQ + 4 * lane); const unsigned kvv = *(const unsigned*)(row + C_CKV + 2 * lane);
        v4u rwc[4], rwp[4], rwn[4];
#pragma unroll
        for (int it = 0; it < 4; ++it) { const int c0 = (it * 64 + lane) * 8; const v4u z = {0u, 0u, 0u, 0u}; rwc[it] = z; rwp[it] = z; rwn[it] = z;
            if (it < 3 || lane < 48) { const bf16* src = row + C_RW + c0; rwc[it] = *(const v4u*)src; if (hasp) rwp[it] = *(const v4u*)(src - DPROJ); if (hasn) rwn[it] = *(const v4u*)(src + DPROJ); } }
        {
            const int gi = 8 * (lane & 7);
            float f[8]; UNPACK8(qv, f); float ss = 0.f;
#pragma unroll
            for (int i = 0; i < 8; ++i) ss += f[i] * f[i];
            float inv = rsqrtf(sum8(ss) * (1.f / 64.f) + NEPS) * NA_QS;
#pragma unroll
            for (int i = 0; i < 8; ++i) f[i] = f[i] * inv * gq[gi + i];
            PACK8(qv, f); *(v4u*)(row + 8 * lane) = qv;
            UNPACK8(kv, f); ss = 0.f;
#pragma unroll
            for (int i = 0; i < 8; ++i) ss += f[i] * f[i];
            inv = rsqrtf(sum8(ss) * (1.f / 64.f) + NEPS);
#pragma unroll
            for (int i = 0; i < 8; ++i) f[i] = f[i] * inv * gk[gi + i];
            PACK8(kv, f); *(v4u*)(row + C_KA + 8 * lane) = kv;
        }
        {
            float a0 = bflo(cv.x), a1 = bfhi(cv.x), a2 = bflo(cv.y), a3 = bfhi(cv.y);
            float inv = rsqrtf(wave_sum(a0 * a0 + a1 * a1 + a2 * a2 + a3 * a3) * (1.f / 256.f) + NEPS);
            const f32x4 gg = *(const f32x4*)(gcq + 4 * lane); v2u o; o.x = pk2(a0 * inv * gg.x, a1 * inv * gg.y); o.y = pk2(a2 * inv * gg.z, a3 * inv * gg.w);
            *(v2u*)(mla_a + (size_t)t * 384 + 4 * lane) = o;
            a0 = bflo(kvv); a1 = bfhi(kvv);
            inv = rsqrtf(wave_sum(a0 * a0 + a1 * a1) * (1.f / 128.f) + NEPS);
            *(unsigned*)(mla_a + (size_t)t * 384 + 256 + 2 * lane) = pk2(a0 * inv * gckv[2 * lane], a1 * inv * gckv[2 * lane + 1]);
        }
#pragma unroll
        for (int it = 0; it < 4; ++it) {
            const int c0 = (it * 64 + lane) * 8;
            if (it < 3 || lane < 48) {
                float pc[8], pp[8], pn[8]; UNPACK8(rwc[it], pc); UNPACK8(rwp[it], pp); UNPACK8(rwn[it], pn);
#pragma unroll
                for (int i = 0; i < 8; ++i) pc[i] = pc[i] + mu[c0 + i] * (0.5f * (pp[i] + pn[i]) - pc[i]);
                if (it == 0) { h8 o;
#pragma unroll
                    for (int i = 0; i < 8; ++i) o[i] = (_Float16)pc[i];
                    *(h8*)(rs + (size_t)t * 512 + c0) = o; }
                else if (it == 1) { const int c = c0 - 512; h8 o; float kk[8]; float ss = 0.f;
#pragma unroll
                    for (int i = 0; i < 8; ++i) { o[i] = (_Float16)pc[i]; kk[i] = pc[i] * kkw[c + i]; ss += kk[i] * kk[i]; }
                    *(h8*)(ktmp + (size_t)t * 512 + c) = o;
                    const float inv = rsqrtf(sum8(ss) + 1e-12f);
#pragma unroll
                    for (int i = 0; i < 8; ++i) o[i] = (_Float16)(kk[i] * inv);
                    *(h8*)(rs + 2 * asz + (size_t)t * 512 + c) = o; }
                else if (it == 2) { const int c = c0 - 1024; h8 o;
#pragma unroll
                    for (int i = 0; i < 8; ++i) o[i] = (_Float16)pc[i];
                    *(h8*)(rs + asz + (size_t)t * 512 + c) = o; }
                else { const int c = c0 - 1536; float f[8];
#pragma unroll
                    for (int i = 0; i < 8; ++i) { const float x = pc[i]; f[i] = (c < 128) ? (1.f - 2.f * __builtin_amdgcn_rcpf(1.f + __expf(2.f * x))) : ((c < 256) ? x : sigmoidf_(x)); }
                    v4u w; PACK8(w, f); *(v4u*)(rw_a + (size_t)t * 384 + c) = w; }
            }
        }
    }
}

__device__ __forceinline__ void phase_mla_post(CP pp, int l, bf16* mraw, const bf16* proj, bf16* mk, int Tg, int L, int gw, int ngw, int lane) {
    const float* gq = pp->in[13] + l * 96; const float* gk = pp->in[14] + l * 96;
    const int h = lane >> 3, sub = lane & 7, rs = sub & 3; const bool hasr = sub < 4;
    float gqn[8], gkn[8], gq1[4], gq2[4], gk1[4], gk2[4], invf[4];
#pragma unroll
    for (int e = 0; e < 8; ++e) { gqn[e] = gq[8 * sub + e]; gkn[e] = gk[8 * sub + e]; }
#pragma unroll
    for (int e = 0; e < 4; ++e) { gq1[e] = gq[64 + 4 * rs + e]; gq2[e] = gq[80 + 4 * rs + e]; gk1[e] = gk[64 + 4 * rs + e]; gk2[e] = gk[80 + 4 * rs + e];
        invf[e] = __expf(-(float)((4 * rs + e) & 7) * (9.210340371976184f / 8.f)); }
    for (int t = gw; t < Tg; t += ngw) {
        const int tpos = t % L; const float pos = (float)((rs < 2) ? (tpos >> 6) : (tpos & 63));
        bf16* mrow = mraw + (size_t)t * 1792; bf16* krow = mk + (size_t)t * 768;
        const v4u qv = *(const v4u*)(mrow + h * 96 + 8 * sub), kv = *(const v4u*)(mrow + 768 + h * 128 + 8 * sub);
        v2u q1 = {0u, 0u}, q2 = {0u, 0u}, k1 = {0u, 0u}, k2 = {0u, 0u};
        if (hasr) { q1 = *(const v2u*)(mrow + h * 96 + 64 + 4 * rs); q2 = *(const v2u*)(mrow + h * 96 + 80 + 4 * rs);
                    k1 = *(const v2u*)(proj + (size_t)t * DPROJ + C_KR + 4 * rs); k2 = *(const v2u*)(proj + (size_t)t * DPROJ + C_KR + 16 + 4 * rs); }
        float cs[4], sn[4];
#pragma unroll
        for (int e = 0; e < 4; ++e) { float rev = pos * invf[e] * 0.15915494309189535f; rev -= floorf(rev); cs[e] = __builtin_amdgcn_cosf(rev); sn[e] = __builtin_amdgcn_sinf(rev); }
        {   float f[8]; UNPACK8(qv, f); float a[4] = {bflo(q1.x), bfhi(q1.x), bflo(q1.y), bfhi(q1.y)}, b[4] = {bflo(q2.x), bfhi(q2.x), bflo(q2.y), bfhi(q2.y)};
            float ss = 0.f;
#pragma unroll
            for (int e = 0; e < 8; ++e) ss += f[e] * f[e];
#pragma unroll
            for (int e = 0; e < 4; ++e) ss += a[e] * a[e] + b[e] * b[e];
            const float inv = rsqrtf(sum8(ss) * (1.f / 96.f) + NEPS) * MLA_QS;
#pragma unroll
            for (int e = 0; e < 8; ++e) f[e] = f[e] * inv * gqn[e];
            v4u o; PACK8(o, f); *(v4u*)(mrow + h * 96 + 8 * sub) = o;
            if (hasr) { float r1[4], r2[4];
#pragma unroll
                for (int e = 0; e < 4; ++e) { const float x1 = a[e] * inv * gq1[e], x2 = b[e] * inv * gq2[e]; r1[e] = x1 * cs[e] - x2 * sn[e]; r2[e] = x1 * sn[e] + x2 * cs[e]; }
                v2u o1, o2; o1.x = pk2(r1[0], r1[1]); o1.y = pk2(r1[2], r1[3]); o2.x = pk2(r2[0], r2[1]); o2.y = pk2(r2[2], r2[3]);
                *(v2u*)(mrow + h * 96 + 64 + 4 * rs) = o1; *(v2u*)(mrow + h * 96 + 80 + 4 * rs) = o2; } }
        {   float f[8]; UNPACK8(kv, f); float a[4] = {bflo(k1.x), bfhi(k1.x), bflo(k1.y), bfhi(k1.y)}, b[4] = {bflo(k2.x), bfhi(k2.x), bflo(k2.y), bfhi(k2.y)};
            float ss = 0.f;
#pragma unroll
            for (int e = 0; e < 8; ++e) ss += f[e] * f[e];
#pragma unroll
            for (int e = 0; e < 4; ++e) ss += a[e] * a[e] + b[e] * b[e];
            const float inv = rsqrtf(sum8(ss) * (1.f / 96.f) + NEPS);
#pragma unroll
            for (int e = 0; e < 8; ++e) f[e] = f[e] * inv * gkn[e];
            v4u o; PACK8(o, f); *(v4u*)(krow + h * 96 + 8 * sub) = o;
            if (hasr) { float r1[4], r2[4];
#pragma unroll
                for (int e = 0; e < 4; ++e) { const float x1 = a[e] * inv * gk1[e], x2 = b[e] * inv * gk2[e]; r1[e] = x1 * cs[e] - x2 * sn[e]; r2[e] = x1 * sn[e] + x2 * cs[e]; }
                v2u o1, o2; o1.x = pk2(r1[0], r1[1]); o1.y = pk2(r1[2], r1[3]); o2.x = pk2(r2[0], r2[1]); o2.y = pk2(r2[2], r2[3]);
                *(v2u*)(krow + h * 96 + 64 + 4 * rs) = o1; *(v2u*)(krow + h * 96 + 80 + 4 * rs) = o2; } }
    }
}

__device__ __forceinline__ void phase_rw_post(CP pp, int l, const _Float16* rs, size_t asz, const bf16* yfb, bf16* yc, int Tg, int gw, int ngw, int lane) {
    const float* lnw = pp->in[25] + l * 512 + 8 * lane; const float* lnb = pp->in[26] + l * 512 + 8 * lane; const float* rk = pp->in[24] + l * 512 + 8 * lane;
    for (int t = gw; t < Tg; t += ngw) {
        const size_t o = (size_t)t * 512 + 8 * lane; float y[8], f[8];
        { const v4u a = *(const v4u*)(yfb + o); const v4u b = *(const v4u*)(yfb + asz + o); UNPACK8(a, y); UNPACK8(b, f); }
        float s = 0.f;
#pragma unroll
        for (int i = 0; i < 8; ++i) { y[i] += f[i]; s += y[i]; }
        const float mean = sum8(s) * (1.f / 64.f); float q = 0.f;
#pragma unroll
        for (int i = 0; i < 8; ++i) { y[i] -= mean; q += y[i] * y[i]; }
        const float rstd = rsqrtf(sum8(q) * (1.f / 64.f) + 64e-5f);
        const h8 r = *(const h8*)(rs + o), v = *(const h8*)(rs + asz + o), kd0 = *(const h8*)(rs + 7 * asz + o), kd1 = *(const h8*)(rs + 8 * asz + o);
        float b = 0.f;
#pragma unroll
        for (int i = 0; i < 8; ++i) b += (float)r[i] * ((float)kd0[i] + (float)kd1[i]) * rk[i];
        b = sum8(b);
        const v4u gv = *(const v4u*)(yc + o); UNPACK8(gv, f);
#pragma unroll
        for (int i = 0; i < 8; ++i) f[i] = (y[i] * rstd * lnw[i] + lnb[i] + b * (float)v[i]) * f[i];
        v4u w; PACK8(w, f); *(v4u*)(yc + o) = w;
    }
}

#define GAS __attribute__((address_space(1)))
typedef float f2 __attribute__((ext_vector_type(2)));
#define DPP_ADD(x, ctrl) ((x) + __builtin_bit_cast(float, __builtin_amdgcn_update_dpp(0, __builtin_bit_cast(int, (x)), (ctrl), 0xF, 0xF, true)))
__device__ __forceinline__ float red8(float x) { x = DPP_ADD(x, 0xB1); x = DPP_ADD(x, 0x4E); x = DPP_ADD(x, 0x141); return x; }
constexpr int SCH = 32, SBUF = 6 * SCH * 256;
__device__ __forceinline__ void scan_unit(int u, int L, const _Float16* rs, size_t asz, bf16* yfb, LAS unsigned char* lds) {
    const int tid = ltid(); const int lane = tid & 63, w = tid >> 6, vr = lane >> 3, ko = lane & 7;
    const int dir = u & 1, sh = u >> 1, h = sh & 7, s = sh >> 3;
    const int kA = tid >> 8, lj = (tid >> 3) & 31, lp = tid & 7;
    const size_t tok0 = (size_t)s * L + (dir ? (L - 1 - lj) : lj);
    const long tstep = dir ? -(long)SCH * 512 : (long)SCH * 512;
    const size_t eoff = tok0 * 512 + h * 64 + lp * 8;
    const GAS _Float16* g0 = (const GAS _Float16*)(rs + (size_t)(kA ? 2 : 0) * asz + eoff);
    const GAS _Float16* g1 = (const GAS _Float16*)(rs + (size_t)(kA ? 5 + dir : 3 + dir) * asz + eoff);
    const GAS _Float16* g2 = (const GAS _Float16*)(rs + (size_t)(kA ? 1 : 7 + dir) * asz + eoff);
    const int ld0 = (((0 + kA) * SCH + lj) * 64 + lp * 8) * 4, ld1 = (((2 + kA) * SCH + lj) * 64 + lp * 8) * 4, ld2 = (((4 + kA) * SCH + lj) * 64 + lp * 8) * 4;
    GAS bf16* py = (GAS bf16*)(yfb + (size_t)dir * asz + ((size_t)s * L + (dir ? L - 1 : 0)) * 512 + h * 64 + 8 * w + vr);
    const long ystep = dir ? -512 : 512;
    const int rd = ko * 32, rdv = (5 * SCH * 64 + 8 * w + vr) * 4;
    f2 S[4];
#pragma unroll
    for (int i = 0; i < 4; ++i) S[i] = (f2){0.f, 0.f};
    h8 p0 = *(const GAS h8*)g0, p1 = *(const GAS h8*)g1, p2 = *(const GAS h8*)g2;
#define SCAN_PUT(bufo) do { f32x4 a, b; \
        a = (f32x4){(float)p0[0], (float)p0[1], (float)p0[2], (float)p0[3]}; b = (f32x4){(float)p0[4], (float)p0[5], (float)p0[6], (float)p0[7]}; *(LAS f32x4*)(lds + (bufo) + ld0) = a; *(LAS f32x4*)(lds + (bufo) + ld0 + 16) = b; \
        a = (f32x4){(float)p1[0], (float)p1[1], (float)p1[2], (float)p1[3]}; b = (f32x4){(float)p1[4], (float)p1[5], (float)p1[6], (float)p1[7]}; *(LAS f32x4*)(lds + (bufo) + ld1) = a; *(LAS f32x4*)(lds + (bufo) + ld1 + 16) = b; \
        a = (f32x4){(float)p2[0], (float)p2[1], (float)p2[2], (float)p2[3]}; b = (f32x4){(float)p2[4], (float)p2[5], (float)p2[6], (float)p2[7]}; *(LAS f32x4*)(lds + (bufo) + ld2) = a; *(LAS f32x4*)(lds + (bufo) + ld2 + 16) = b; } while (0)
    SCAN_PUT(0);
    __syncthreads();
    const int NC = L / SCH;
#pragma unroll 1
    for (int c = 0; c < NC; ++c) {
        const int cur = (c & 1) * SBUF;
        if (c + 1 < NC) { const long o = tstep * (long)(c + 1); p0 = *(const GAS h8*)(g0 + o); p1 = *(const GAS h8*)(g1 + o); p2 = *(const GAS h8*)(g2 + o); }
        LAS unsigned char* bp = lds + cur + rd;
        GAS bf16* pyc = py + ystep * (long)(c * SCH);
#pragma unroll 1
        for (int j0 = 0; j0 < SCH; j0 += 4) { float yv[4];
#pragma unroll
        for (int jj = 0; jj < 4; ++jj) { const int j = j0 + jj;
            const LAS unsigned char* q = bp + j * 256;
            const f32x4 r0 = *(const LAS f32x4*)(q), r1 = *(const LAS f32x4*)(q + 16);
            const f32x4 k0 = *(const LAS f32x4*)(q + SCH * 256), k1 = *(const LAS f32x4*)(q + SCH * 256 + 16);
            const f32x4 w0 = *(const LAS f32x4*)(q + 2 * SCH * 256), w1 = *(const LAS f32x4*)(q + 2 * SCH * 256 + 16);
            const f32x4 a0 = *(const LAS f32x4*)(q + 3 * SCH * 256), a1 = *(const LAS f32x4*)(q + 3 * SCH * 256 + 16);
            const f32x4 d0 = *(const LAS f32x4*)(q + 4 * SCH * 256), d1 = *(const LAS f32x4*)(q + 4 * SCH * 256 + 16);
            const float vv = *(const LAS float*)(lds + cur + rdv + j * 256);
            const f2 vv2 = (f2){vv, vv};
            f2 e0 = S[0] * w0.xy, e1 = S[1] * w0.zw, e2 = S[2] * w1.xy, e3 = S[3] * w1.zw;
            f2 pa = S[0] * k0.xy, pb = S[1] * k0.zw; pa = S[2] * k1.xy + pa; pb = S[3] * k1.zw + pb;
            e0 = d0.xy * vv2 + e0; e1 = d0.zw * vv2 + e1; e2 = d1.xy * vv2 + e2; e3 = d1.zw * vv2 + e3;
            const f2 pd = pa + pb;
            const float nskk = -red8(pd.x + pd.y);
            const f2 ns2 = (f2){nskk, nskk};
            S[0] = a0.xy * ns2 + e0; S[1] = a0.zw * ns2 + e1; S[2] = a1.xy * ns2 + e2; S[3] = a1.zw * ns2 + e3;
            f2 qa = S[0] * r0.xy, qb = S[1] * r0.zw; qa = S[2] * r1.xy + qa; qb = S[3] * r1.zw + qb;
            const f2 qd = qa + qb;
            yv[jj] = red8(qd.x + qd.y);
        }
            if (ko == 0) {
#pragma unroll
                for (int jj = 0; jj < 4; ++jj) pyc[ystep * (j0 + jj)] = f2bf(yv[jj]); }
        }
        if (c + 1 < NC) SCAN_PUT(SBUF - cur);
        __syncthreads();
    }
#undef SCAN_PUT
}

constexpr int MKP = 208, MVP = 144, MBUF = 64 * MKP + 64 * MVP;
#define MLA_THR 6.0f
__device__ __forceinline__ float max3f(float a, float b, float c) { return fmaxf(fmaxf(a, b), c); }
__device__ __forceinline__ void mla_unit(int u, int L, const bf16* mraw, const bf16* mk, bf16* yb, LAS unsigned char* lds) {
    const int tid = ltid(), lane = tid & 63, w = tid >> 6, q32 = lane & 31, hi = lane >> 5;
    const int nqb = L >> 8, qb = u % nqb, sh = u / nqb, h = sh & 7, s = sh >> 3;
    const size_t base = (size_t)s * L; const int NT = L >> 6;
    const size_t qtok = base + qb * 256 + w * 32 + q32;
    bf16x8 qf[6];
#pragma unroll
    for (int ks = 0; ks < 6; ++ks) qf[ks] = *(const bf16x8*)(mraw + qtok * 1792 + h * 96 + ks * 16 + hi * 8);
    const int kkey0 = tid / 12, kch0 = tid % 12, kkey1 = (tid + 512) / 12, kch1 = (tid + 512) % 12; const bool k2 = tid < 256;
    const bf16* ks0 = mk + (base + kkey0) * 768 + h * 96 + kch0 * 8; const bf16* ks1 = mk + (base + kkey1) * 768 + h * 96 + kch1 * 8;
    const int vkey = tid >> 3, vch = tid & 7;
    const bf16* vs = mraw + (base + vkey) * 1792 + 768 + h * 128 + 64 + vch * 8;
    const int kd0 = kkey0 * MKP + kch0 * 16, kd1 = kkey1 * MKP + kch1 * 16, vd = 64 * MKP + vkey * MVP + vch * 16;
    v4u rk0, rk1 = {0u, 0u, 0u, 0u}, rv, sk0, sk1 = {0u, 0u, 0u, 0u}, sv;
#define MLA_LOAD(t) do { const size_t adv_ = (size_t)(t) * 64; rk0 = *(const v4u*)(ks0 + adv_ * 768); if (k2) rk1 = *(const v4u*)(ks1 + adv_ * 768); rv = *(const v4u*)(vs + adv_ * 1792); } while (0)
#define MLA_PUT(bo) do { *(LAS v4u*)(lds + (bo) + kd0) = rk0; if (k2) *(LAS v4u*)(lds + (bo) + kd1) = rk1; *(LAS v4u*)(lds + (bo) + vd) = rv; } while (0)
#define MLA_LOADB(t) do { const size_t adv_ = (size_t)(t) * 64; sk0 = *(const v4u*)(ks0 + adv_ * 768); if (k2) sk1 = *(const v4u*)(ks1 + adv_ * 768); sv = *(const v4u*)(vs + adv_ * 1792); } while (0)
#define MLA_PUTB(bo) do { *(LAS v4u*)(lds + (bo) + kd0) = sk0; if (k2) *(LAS v4u*)(lds + (bo) + kd1) = sk1; *(LAS v4u*)(lds + (bo) + vd) = sv; } while (0)
    MLA_LOAD(0); MLA_PUT(0); MLA_LOAD(1); MLA_PUT(MBUF);
    __syncthreads();
    const int kmap = 16 * (q32 >> 4) + 8 * ((q32 >> 2) & 1) + (q32 & 3) + 4 * ((q32 >> 3) & 1);
    const int koff = kmap * MKP + hi * 16;
    const int voff = 64 * MKP + (8 * hi + ((lane & 15) >> 2)) * MVP + (16 * ((lane >> 4) & 1) + 4 * (lane & 3)) * 2;
    f32x16 o0 = {}, o1 = {}, negm = {}, pA0, pA1, pB0, pB1; float lsum = 0.f; v4u pw0, pw1, pw2, pw3;
    int b_prev = 0, b_cur = MBUF, b_next = 2 * MBUF;
#define MLA_KA(bo, ks) (*(const LAS bf16x8*)(lds + (bo) + koff + (ks) * 32))
#define MLA_KB(bo, ks) (*(const LAS bf16x8*)(lds + (bo) + koff + 32 * MKP + (ks) * 32))
#define MLA_QK2(C0, C1, bo, ks) do { C0 = __builtin_amdgcn_mfma_f32_32x32x16_bf16(MLA_KA(bo, ks), qf[ks], C0, 0, 0, 0); C1 = __builtin_amdgcn_mfma_f32_32x32x16_bf16(MLA_KB(bo, ks), qf[ks], C1, 0, 0, 0); } while (0)
#define MLA_FIN8(P, g, PW) do { float e0 = __builtin_amdgcn_exp2f(P[8 * g + 0]), e1 = __builtin_amdgcn_exp2f(P[8 * g + 1]), e2 = __builtin_amdgcn_exp2f(P[8 * g + 2]), e3 = __builtin_amdgcn_exp2f(P[8 * g + 3]), \
        e4 = __builtin_amdgcn_exp2f(P[8 * g + 4]), e5 = __builtin_amdgcn_exp2f(P[8 * g + 5]), e6 = __builtin_amdgcn_exp2f(P[8 * g + 6]), e7 = __builtin_amdgcn_exp2f(P[8 * g + 7]); \
        lsum += ((e0 + e1) + (e2 + e3)) + ((e4 + e5) + (e6 + e7)); PW.x = pk2(e0, e1); PW.y = pk2(e2, e3); PW.z = pk2(e4, e5); PW.w = pk2(e6, e7); } while (0)
#define MLA_VT(bo, kg, db) ({ const int vb_ = (bo) + voff + (kg) * 16 * MVP + (db) * 64; \
        const s16x4 t0_ = __builtin_amdgcn_ds_read_tr16_b64_v4i16((LAS s16x4*)(lds + vb_)), t1_ = __builtin_amdgcn_ds_read_tr16_b64_v4i16((LAS s16x4*)(lds + vb_ + 4 * MVP)); \
        (bf16x8){t0_[0], t0_[1], t0_[2], t0_[3], t1_[0], t1_[1], t1_[2], t1_[3]}; })
#define MLA_PV(bo, kg, PW) do { const bf16x8 pf_ = __builtin_bit_cast(bf16x8, PW); o0 = __builtin_amdgcn_mfma_f32_32x32x16_bf16(MLA_VT(bo, kg, 0), pf_, o0, 0, 0, 0); o1 = __builtin_amdgcn_mfma_f32_32x32x16_bf16(MLA_VT(bo, kg, 1), pf_, o1, 0, 0, 0); } while (0)
#define MLA_ROWMAX(C0, C1) ({ float a_ = max3f(C0[0], C0[1], C1[0]), b_ = max3f(C0[2], C0[3], C1[1]); a_ = max3f(a_, C1[2], C1[3]); \
        _Pragma("unroll") for (int r_ = 4; r_ < 16; r_ += 4) { a_ = max3f(a_, C0[r_], C0[r_ + 1]); b_ = max3f(b_, C0[r_ + 2], C0[r_ + 3]); a_ = max3f(a_, C1[r_], C1[r_ + 1]); b_ = max3f(b_, C1[r_ + 2], C1[r_ + 3]); } \
        const float m_ = fmaxf(a_, b_); fmaxf(m_, __shfl_xor(m_, 32)); })
#define MLA_STEP(P0, P1, C0, C1, j, LOADX, PUTX) do { \
        if ((j) + 2 < NT) LOADX((j) + 2); \
        C0 = negm; C1 = negm; \
        MLA_QK2(C0, C1, b_cur, 0); MLA_QK2(C0, C1, b_cur, 1); MLA_FIN8(P0, 0, pw0); \
        MLA_QK2(C0, C1, b_cur, 2); MLA_FIN8(P0, 1, pw1); \
        MLA_QK2(C0, C1, b_cur, 3); MLA_FIN8(P1, 0, pw2); \
        MLA_QK2(C0, C1, b_cur, 4); MLA_FIN8(P1, 1, pw3); \
        MLA_QK2(C0, C1, b_cur, 5); \
        MLA_PV(b_prev, 0, pw0); MLA_PV(b_prev, 1, pw1); \
        const float mt_ = MLA_ROWMAX(C0, C1); \
        MLA_PV(b_prev, 2, pw2); MLA_PV(b_prev, 3, pw3); \
        if (__any(mt_ > MLA_THR)) { const float dl_ = fmaxf(mt_, 0.f); const float fs_ = __builtin_amdgcn_exp2f(-dl_); lsum *= fs_; \
            _Pragma("unroll") for (int r_ = 0; r_ < 16; ++r_) { C0[r_] -= dl_; C1[r_] -= dl_; negm[r_] -= dl_; o0[r_] *= fs_; o1[r_] *= fs_; } } \
        if ((j) + 1 < NT) PUTX(b_next); \
        __syncthreads(); \
        { const int t_ = b_prev; b_prev = b_cur; b_cur = b_next; b_next = t_; } \
    } while (0)
    pA0 = negm; pA1 = negm;
#pragma unroll
    for (int ks = 0; ks < 6; ++ks) MLA_QK2(pA0, pA1, 0, ks);
    { const float m0 = MLA_ROWMAX(pA0, pA1);
#pragma unroll
      for (int r = 0; r < 16; ++r) { pA0[r] -= m0; pA1[r] -= m0; negm[r] = -m0; } }
    MLA_LOADB(2);
    int jt = 1;
#pragma unroll 1
    for (; jt + 1 < NT; jt += 2) {
        MLA_STEP(pA0, pA1, pB0, pB1, jt, MLA_LOAD, MLA_PUTB);
        MLA_STEP(pB0, pB1, pA0, pA1, jt + 1, MLA_LOADB, MLA_PUT);
    }
    if (jt < NT) { MLA_STEP(pA0, pA1, pB0, pB1, jt, MLA_LOAD, MLA_PUTB); pA0 = pB0; pA1 = pB1; }
    MLA_FIN8(pA0, 0, pw0); MLA_FIN8(pA0, 1, pw1); MLA_FIN8(pA1, 0, pw2); MLA_FIN8(pA1, 1, pw3);
    MLA_PV(b_prev, 0, pw0); MLA_PV(b_prev, 1, pw1); MLA_PV(b_prev, 2, pw2); MLA_PV(b_prev, 3, pw3);
    lsum += __shfl_xor(lsum, 32);
    const float inv = __builtin_amdgcn_rcpf(lsum);
    bf16* orow = yb + qtok * 512 + h * 64 + 4 * hi;
#pragma unroll
    for (int rq = 0; rq < 4; ++rq) {
        v2u a, b; a.x = pk2(o0[4 * rq] * inv, o0[4 * rq + 1] * inv); a.y = pk2(o0[4 * rq + 2] * inv, o0[4 * rq + 3] * inv);
        b.x = pk2(o1[4 * rq] * inv, o1[4 * rq + 1] * inv); b.y = pk2(o1[4 * rq + 2] * inv, o1[4 * rq + 3] * inv);
        *(v2u*)(orow + 8 * rq) = a; *(v2u*)(orow + 32 + 8 * rq) = b;
    }
    __syncthreads();
#undef MLA_LOAD
#undef MLA_PUT
#undef MLA_LOADB
#undef MLA_PUTB
#undef MLA_KA
#undef MLA_KB
#undef MLA_QK2
#undef MLA_FIN8
#undef MLA_VT
#undef MLA_PV
#undef MLA_ROWMAX
#undef MLA_STEP
}

constexpr int NVP = 144, NA_WLDS = 64 * NVP + 1888;
__device__ __forceinline__ void na_unit(int u, int L, int l, const float* rpb_all, const bf16* proj, bf16* ya, LAS unsigned char* lds) {
    const int tid = ltid(); const int lane = tid & 63, w = tid >> 6, i16 = lane & 15, quad = lane >> 4;
    const int rows = L >> 6; const int hq = u & 3, sr = u >> 2, r = sr % rows, s = sr / rows;
    const int h = 2 * hq + (w >> 2), j = w & 3;
    const int rs = min(max(r - 4, 0), rows - 8), kc0 = min(max(16 * j - 8, 0), 32);
    const size_t base = (size_t)s * L;
    const size_t qtok = base + r * 64 + 16 * j + i16;
    LAS unsigned char* vw = lds + w * NA_WLDS; LAS float* tb = (LAS float*)(vw + 64 * NVP);
    { const float* rpb = rpb_all + (size_t)(l * 8 + h) * 465;
#pragma unroll
      for (int it = 0; it < 8; ++it) { const int idx = it * 64 + lane; if (idx < 465) tb[idx] = rpb[idx]; } }
    bf16x8 qf[2];
    qf[0] = *(const bf16x8*)(proj + qtok * DPROJ + h * 64 + quad * 8); qf[1] = *(const bf16x8*)(proj + qtok * DPROJ + h * 64 + 32 + quad * 8);
    const int cA = (i16 >> 2) * 8 + (i16 & 3);
    const bf16* kp0 = proj + (base + (size_t)rs * 64 + kc0 + cA) * DPROJ + C_KA + h * 64 + quad * 8;
    bf16x8 kf[8][4];
#pragma unroll
    for (int wr = 0; wr < 8; ++wr) { const bf16* kp = kp0 + (size_t)wr * 64 * DPROJ;
        kf[wr][0] = *(const bf16x8*)kp; kf[wr][1] = *(const bf16x8*)(kp + 32); kf[wr][2] = *(const bf16x8*)(kp + 4 * DPROJ); kf[wr][3] = *(const bf16x8*)(kp + 4 * DPROJ + 32); }
    const bf16* vp0 = proj + (base + (size_t)rs * 64 + kc0) * DPROJ + C_VA + h * 64;
    v4u vt[8];
#define NA_VLOAD(ck) do { _Pragma("unroll") for (int it = 0; it < 8; ++it) { const int idx = it * 64 + lane, key = idx >> 3, ch = idx & 7; \
        vt[it] = *(const v4u*)(vp0 + ((size_t)(2 * (ck) + (key >> 5)) * 64 + (key & 31)) * DPROJ + ch * 8); } } while (0)
    NA_VLOAD(0);
    f32x4 sa[8], sb[8];
#pragma unroll
    for (int wr = 0; wr < 8; ++wr) {
        f32x4 a = {0.f, 0.f, 0.f, 0.f}, b = {0.f, 0.f, 0.f, 0.f};
        a = __builtin_amdgcn_mfma_f32_16x16x32_bf16(kf[wr][0], qf[0], a, 0, 0, 0); a = __builtin_amdgcn_mfma_f32_16x16x32_bf16(kf[wr][1], qf[1], a, 0, 0, 0);
        b = __builtin_amdgcn_mfma_f32_16x16x32_bf16(kf[wr][2], qf[0], b, 0, 0, 0); b = __builtin_amdgcn_mfma_f32_16x16x32_bf16(kf[wr][3], qf[1], b, 0, 0, 0);
        sa[wr] = a; sb[wr] = b;
    }
    asm volatile("s_waitcnt lgkmcnt(0)" ::: "memory");
    const int qc = 16 * j + i16, wst = min(max(qc - 8, 0), 48);
    float mx = -1e30f;
#pragma unroll
    for (int wr = 0; wr < 8; ++wr) { const LAS float* rb = tb + (rs + wr - r + 7) * 31;
#pragma unroll
        for (int jj = 0; jj < 4; ++jj) {
            { const int kc = kc0 + quad * 8 + jj; const bool ok = (kc >= wst) && (kc < wst + 16); const int dc = min(max(kc - qc + 15, 0), 30);
              const float v = ok ? (sa[wr][jj] + rb[dc] * LOG2E) : -1e30f; sa[wr][jj] = v; mx = fmaxf(mx, v); }
            { const int kc = kc0 + quad * 8 + 4 + jj; const bool ok = (kc >= wst) && (kc < wst + 16); const int dc = min(max(kc - qc + 15, 0), 30);
              const float v = ok ? (sb[wr][jj] + rb[dc] * LOG2E) : -1e30f; sb[wr][jj] = v; mx = fmaxf(mx, v); }
        } }
    mx = fmaxf(mx, __shfl_xor(mx, 16)); mx = fmaxf(mx, __shfl_xor(mx, 32));
    float ls = 0.f;
#pragma unroll
    for (int wr = 0; wr < 8; ++wr)
#pragma unroll
        for (int jj = 0; jj < 4; ++jj) { sa[wr][jj] = __builtin_amdgcn_exp2f(sa[wr][jj] - mx); sb[wr][jj] = __builtin_amdgcn_exp2f(sb[wr][jj] - mx); ls += sa[wr][jj] + sb[wr][jj]; }
    ls += __shfl_xor(ls, 16); ls += __shfl_xor(ls, 32);
    f32x4 oc[4];
#pragma unroll
    for (int db = 0; db < 4; ++db) oc[db] = (f32x4){0.f, 0.f, 0.f, 0.f};
    const int toff = (quad * 8 + (i16 >> 2)) * NVP + (4 * (lane & 3)) * 2;
#pragma unroll
    for (int ck = 0; ck < 4; ++ck) {
        asm volatile("s_waitcnt lgkmcnt(0)" ::: "memory");
#pragma unroll
        for (int it = 0; it < 8; ++it) { const int idx = it * 64 + lane, key = idx >> 3, ch = idx & 7; *(LAS v4u*)(vw + key * NVP + ch * 16) = vt[it]; }
        if (ck < 3) NA_VLOAD(ck + 1);
        asm volatile("s_waitcnt lgkmcnt(0)" ::: "memory");
#pragma unroll
        for (int wl = 0; wl < 2; ++wl) { const int wr = 2 * ck + wl;
            v4u pw; pw.x = pk2(sa[wr][0], sa[wr][1]); pw.y = pk2(sa[wr][2], sa[wr][3]); pw.z = pk2(sb[wr][0], sb[wr][1]); pw.w = pk2(sb[wr][2], sb[wr][3]);
            const bf16x8 pf = __builtin_bit_cast(bf16x8, pw);
#pragma unroll
            for (int db = 0; db < 4; ++db) { const int vb = toff + wl * 32 * NVP + db * 32;
                const s16x4 t0 = __builtin_amdgcn_ds_read_tr16_b64_v4i16((LAS s16x4*)(vw + vb)), t1 = __builtin_amdgcn_ds_read_tr16_b64_v4i16((LAS s16x4*)(vw + vb + 4 * NVP));
                const bf16x8 vf = {t0[0], t0[1], t0[2], t0[3], t1[0], t1[1], t1[2], t1[3]};
                oc[db] = __builtin_amdgcn_mfma_f32_16x16x32_bf16(vf, pf, oc[db], 0, 0, 0); }
        }
    }
#undef NA_VLOAD
    const float inv = __builtin_amdgcn_rcpf(ls);
    bf16* orow = ya + qtok * 512 + h * 64 + quad * 4;
#pragma unroll
    for (int db = 0; db < 4; ++db) { v2u o; o.x = pk2(oc[db][0] * inv, oc[db][1] * inv); o.y = pk2(oc[db][2] * inv, oc[db][3] * inv); *(v2u*)(orow + db * 16) = o; }
    asm volatile("s_waitcnt lgkmcnt(0)" ::: "memory");
}

#define XB_TMO      128
#define XB_XCNT(j)  (256  + 64 * (j))
#define XB_XSUB(j)  (1280 + 64 * (j))
#define XB_XGEN(j)  (2304 + 64 * (j))
#define XB_TOP      3328
#define XB_TOPGEN   3392
#define XCD_BAR_WORDS 3456
#define XB_SPIN_CAP (1u << 18)

__device__ __forceinline__ unsigned xb_ld(unsigned* p)              { return __hip_atomic_load(p, __ATOMIC_RELAXED, __HIP_MEMORY_SCOPE_AGENT); }
__device__ __forceinline__ unsigned xb_add(unsigned* p, unsigned v) { return __hip_atomic_fetch_add(p, v, __ATOMIC_RELAXED, __HIP_MEMORY_SCOPE_AGENT); }
__device__ __forceinline__ unsigned xb_xcc_id() { return (unsigned)__builtin_amdgcn_s_getreg((3 << 11) | 20) & 0xFu; }
#define XB_SPIN(cond, bar) do { unsigned _sp = 0; while (cond) { __builtin_amdgcn_s_sleep(1); \
    if ((++_sp & 255u) == 0u) { if (xb_ld(&(bar)[XB_TMO])) break; if (_sp > XB_SPIN_CAP) { atomicAdd(&(bar)[XB_TMO], 1u); break; } } } } while (0)

struct XcdBarrier {
    unsigned* bar; unsigned x;
    volatile LAS unsigned* st;
};

__device__ __forceinline__ XcdBarrier xcd_barrier_post(unsigned* bar, volatile LAS unsigned* st) {
    XcdBarrier b; b.bar = bar; b.x = xb_xcc_id(); b.st = st;
    if (threadIdx.x == 0) (void)xb_add(&bar[XB_XCNT(b.x)], 1u);
    return b;
}
__device__ __forceinline__ void xcd_barrier_complete(unsigned* bar, unsigned x, unsigned& nloc, unsigned& nx) {
    const unsigned G = gridDim.x * gridDim.y * gridDim.z;
    unsigned sum, cnt, mine, sp = 0u;
    for (;;) {
        sum = 0u; cnt = 0u; mine = 0u;
#pragma unroll
        for (unsigned j = 0; j < 16; ++j) { const unsigned c = xb_ld(&bar[XB_XCNT(j)]); sum += c; cnt += (c > 0u) ? 1u : 0u; mine = (j == x) ? c : mine; }
        if (sum == G) break;
        __builtin_amdgcn_s_sleep(1);
        if ((++sp & 255u) == 0u) { if (xb_ld(&bar[XB_TMO])) break; if (sp > XB_SPIN_CAP) { atomicAdd(&bar[XB_TMO], 1u); break; } }
    }
    nloc = mine > 0u ? mine : 1u; nx = cnt > 0u ? cnt : 1u;
}

__device__ __forceinline__ void xcd_barrier(const XcdBarrier& b) {
    asm volatile("s_waitcnt vmcnt(0)" ::: "memory");
    __syncthreads();
    if (threadIdx.x == 0) {
        unsigned* bar = b.bar;
        __builtin_amdgcn_s_waitcnt(0);
        unsigned nloc = b.st[0], nx = b.st[1];
        if (nloc == 0u) { xcd_barrier_complete(bar, b.x, nloc, nx); b.st[0] = nloc; b.st[1] = nx; }
        const unsigned old = xb_add(&bar[XB_XSUB(b.x)], 1u);
        const unsigned gen = old / nloc;
        if (old + 1u == (gen + 1u) * nloc) {
            __builtin_amdgcn_fence(__ATOMIC_RELEASE, "agent");
            asm volatile("s_waitcnt vmcnt(0)" ::: "memory");
            const unsigned og = xb_add(&bar[XB_TOP], 1u);
            const unsigned tg = og / nx;
            if (og + 1u == (tg + 1u) * nx) xb_add(&bar[XB_TOPGEN], 1u);
            else XB_SPIN(xb_ld(&bar[XB_TOPGEN]) == tg, bar);
            __builtin_amdgcn_fence(__ATOMIC_ACQUIRE, "agent");
            xb_add(&bar[XB_XGEN(b.x)], 1u);
            asm volatile("s_waitcnt vmcnt(0)" ::: "memory");
        } else {
            XB_SPIN(xb_ld(&bar[XB_XGEN(b.x)]) == gen, bar);
            __builtin_amdgcn_fence(__ATOMIC_ACQUIRE, "agent");
            asm volatile("s_waitcnt vmcnt(0)" ::: "memory");
        }
    }
    __syncthreads();
}

constexpr int NPH = 12;
__device__ __forceinline__ void run_phase(CP pp, int st, LAS unsigned char* lds) {
    volatile LAS unsigned* lctl = (volatile LAS unsigned*)(lds + LDS_RING);
    const int tid = ltid(), lane = tid & 63, wave = __builtin_amdgcn_readfirstlane(tid >> 6);
    int bid_ = blockIdx.x; asm volatile("" : "+s"(bid_));
    const int NB = gridDim.x, gw = bid_ * 8 + wave, ngw = NB * 8;
    const int ph = st % NPH, gl = st / NPH, l = gl & 1, g = gl >> 1;
    unsigned char* ws = pp->ws; const int Tg = pp->Tg;
    const Reg R{ws, (size_t)Tg};
    const size_t asz = (size_t)Tg * 512;
    const int t0 = g * Tg; const int L = (t0 < NPROMPT) ? 8192 : 4096;
    float* xout = pp->out + (size_t)t0 * DM;
    int gid0 = 0, gidn = 0;
    switch (ph) {
    case 0: {
        const float* xin = (l == 0) ? ((t0 < NPROMPT) ? pp->in[0] + (size_t)t0 * DM : pp->in[1] + (size_t)(t0 - NPROMPT) * DM) : xout;
        phase_norm(xin, pp->in[2] + l * DM, R.RH(), Tg, gw, ngw, lane);
    } break;
    case 1: gid0 = GM_IN; gidn = 1; break;
    case 2: {
        phase_post_proj(pp, l, R.RP(), R.RA(), R.RA() + (size_t)Tg * 384, R.RS(), (_Float16*)R.RZ(), asz, Tg, L, gw, ngw, lane);
    } break;
    case 3: gid0 = GM_MU; gidn = 2; break;
    case 4: {
        phase_mla_post(pp, l, R.RM(), R.RP(), R.RA(), Tg, L, gw, ngw, lane);
    } break;
    case 5: {
        unsigned* qctr = (unsigned*)(ws + WS_CTL) + 64 * gl; const int nseq = Tg / L;
        const int NS = nseq * 16, NM = nseq * 8 * (L >> 8), NN = nseq * (L >> 6) * 4, NTOT = NS + NM + NN;
        for (;;) {
            __syncthreads();
            if (tid == 0) lctl[0] = atomicAdd(qctr, 1u);
            __syncthreads();
            const int u = __builtin_amdgcn_readfirstlane((int)lctl[0]);
            if (u >= NTOT) break;
            if (u < NS) scan_unit(u, L, R.RS(), asz, R.RZ(), lds);
            else if (u < NS + NM) mla_unit(u - NS, L, R.RM(), R.RA(), R.RY() + asz, lds);
            else na_unit(u - NS - NM, L, l, pp->in[7], R.RP(), R.RY(), lds);
        }
    } break;
    case 6: {
        phase_rw_post(pp, l, R.RS(), asz, R.RZ(), R.RY() + 2 * asz, Tg, gw, ngw, lane);
        gid0 = GM_GATE; gidn = 1;
    } break;
    case 7: gid0 = GM_BR0; gidn = 3; break;
    case 8: gid0 = GM_OUT; gidn = 1; break;
    case 9: {
        phase_norm(xout, pp->in[29] + l * DM, R.RH(), Tg, gw, ngw, lane);
    } break;
    case 10: gid0 = GM_GU; gidn = 1; break;
    case 11: gid0 = GM_DN; gidn = 1; break;
    default: break;
    }
#pragma unroll 1
    for (int id = gid0; id < gid0 + gidn; ++id) {
        const unsigned char* wb = ws + W_OFF + (size_t)l * W_STRIDE;
        const bf16* A; const bf16* Bt; int N, K;
        switch (id) {
        case GM_IN:   A = R.RH(); Bt = (const bf16*)(wb + WO_IN); N = DPROJ; K = 1024; break;
        case GM_MU:   A = R.RA(); Bt = (const bf16*)(wb + WO_MU); N = 1792; K = 384; break;
        case GM_RU:   A = R.RA() + (size_t)Tg * 384; Bt = (const bf16*)(wb + WO_RU); N = 2560; K = 384; break;
        case GM_GATE: A = R.RH(); Bt = (const bf16*)(wb + WO_G); N = DGATE; K = 1024; break;
        case GM_BR0: case GM_BR1: case GM_BR2: A = R.RY() + (size_t)(id - GM_BR0) * asz; Bt = (const bf16*)(wb + WO_BR + (size_t)(id - GM_BR0) * MiB); N = DM; K = 512; break;
        case GM_OUT:  A = R.RM(); Bt = (const bf16*)(wb + WO_OUT); N = DM; K = 1024; break;
        case GM_GU:   A = R.RH(); Bt = (const bf16*)(wb + WO_GU); N = 2 * DFF; K = 1024; break;
        default:      A = R.RP(); Bt = (const bf16*)(wb + WO_DN); N = DM; K = DFF; break;
        }
        pg8::Gemm gm{A, Bt, Tg, N, K, (id == GM_MU) ? 1 : ((id == GM_RU) ? 2 : 0)}; pg8::StaticOrder S; S.init(Tg, N, NB, bid_);
        EpiUni E{pp, id, l, g}; pg8::gemm_phase<EpiUni, pg8::StaticOrder, true, true>(lds, gm, S, E);
    }
}

__device__ __forceinline__ void run_phase0(CP pp, int part, LAS unsigned char* lds) {
    const int tid = ltid(), lane = tid & 63, wave = __builtin_amdgcn_readfirstlane(tid >> 6);
    const int NB = gridDim.x, gw = blockIdx.x * 8 + wave, ngw = NB * 8;
    const size_t gtid = (size_t)blockIdx.x * 512 + tid, ngt = (size_t)NB * 512;
    unsigned char* ws = pp->ws;
    if (part == 0) {
        for (int l = 0; l < 2; ++l) { unsigned char* wb = ws + W_OFF + (size_t)l * W_STRIDE;
            zero_bytes(wb + WO_IN + (size_t)NMAIN * 2048, (size_t)(DPROJ - NMAIN) * 2048, gtid, ngt);
            zero_bytes(wb + WO_MU, (size_t)1792 * 384 * 2, gtid, ngt);
            zero_bytes(wb + WO_RU, (size_t)2560 * 384 * 2, gtid, ngt); }
    } else {
        LAS float* scr = (LAS float*)(lds + wave * 16384);
#pragma unroll 1
        for (int l = 0; l < 2; ++l) { unsigned char* wb = ws + W_OFF + (size_t)l * W_STRIDE;
            const float* w_in = pp->in[3] + (size_t)l * DM * DIN;
            transpose_job(w_in, DIN, 1024, NMAIN, (bf16*)(wb + WO_IN), 1024, 0, 0, 0, scr, gw, ngw, lane);
            transpose_job(w_in + NMAIN, DIN, 1024, DGATE, (bf16*)(wb + WO_G), 1024, 0, 0, 0, scr, gw, ngw, lane);
            transpose_job(pp->in[8] + (size_t)l * 512 * 1024, 1024, 512, 1024, (bf16*)(wb + WO_BR), 512, 0, 0, 0, scr, gw, ngw, lane);
            transpose_job(pp->in[15] + (size_t)l * 512 * 1024, 1024, 512, 1024, (bf16*)(wb + WO_BR + 1 * MiB), 512, 0, 0, 0, scr, gw, ngw, lane);
            transpose_job(pp->in[27] + (size_t)l * 512 * 1024, 1024, 512, 1024, (bf16*)(wb + WO_BR + 2 * MiB), 512, 0, 0, 0, scr, gw, ngw, lane);
            transpose_job(pp->in[28] + (size_t)l * 1024 * 1024, 1024, 1024, 1024, (bf16*)(wb + WO_OUT), 1024, 0, 0, 0, scr, gw, ngw, lane);
            transpose_job(pp->in[30] + (size_t)l * 1024 * DFF, DFF, 1024, DFF, (bf16*)(wb + WO_GU), 1024, 0, 0, 1, scr, gw, ngw, lane);
            transpose_job(pp->in[31] + (size_t)l * 1024 * DFF, DFF, 1024, DFF, (bf16*)(wb + WO_GU), 1024, 0, 128, 1, scr, gw, ngw, lane);
            transpose_job(pp->in[32] + (size_t)l * DFF * 1024, 1024, DFF, 1024, (bf16*)(wb + WO_DN), DFF, 0, 0, 0, scr, gw, ngw, lane);
            transpose_job(pp->in[11] + (size_t)l * 256 * 768, 768, 256, 768, (bf16*)(wb + WO_MU), 384, 0, 0, 0, scr, gw, ngw, lane);
            transpose_job(pp->in[12] + (size_t)l * 128 * 1024, 1024, 128, 1024, (bf16*)(wb + WO_MU), 384, 256, 768, 0, scr, gw, ngw, lane);
#pragma unroll 1
            for (int d = 0; d < 2; ++d) {
                transpose_job(pp->in[18] + (size_t)(l * 2 + d) * 64 * 512, 512, 64, 512, (bf16*)(wb + WO_RU), 384, 64 * d, 512 * d, 0, scr, gw, ngw, lane);
                transpose_job(pp->in[20] + (size_t)(l * 2 + d) * 64 * 512, 512, 64, 512, (bf16*)(wb + WO_RU), 384, 128 + 64 * d, 1024 + 512 * d, 0, scr, gw, ngw, lane); }
            transpose_job(pp->in[21] + (size_t)l * 128 * 512, 512, 128, 512, (bf16*)(wb + WO_RU), 384, 256, 2048, 0, scr, gw, ngw, lane);
        }
    }
}

__global__ void __launch_bounds__(512, 2) mega(Params p) {
    extern __shared__ __attribute__((aligned(16))) unsigned char lds_raw[];
    LAS unsigned char* lds = (LAS unsigned char*)lds_raw;
    cg::grid_group grid = cg::this_grid();
    if (blockIdx.x == 0 && threadIdx.x == 0) { Params* d = (Params*)(p.ws + WS_PARAMS); *d = p; }
    const int nsteps = p.G * 2 * NPH;
    volatile LAS unsigned* bst = (volatile LAS unsigned*)(lds + LDS_RING + 32);
    if (threadIdx.x == 0) { bst[0] = 0u; bst[1] = 0u; }
    __syncthreads();
    const XcdBarrier bar = xcd_barrier_post((unsigned*)(p.ws + WS_CTL) + 4096, bst);
    grid.sync();
#pragma unroll 1
    for (int st = -2; st < nsteps; ++st) {
        int s2 = st; asm volatile("" : "+s"(s2));
        CP pp = (CP)(p.ws + WS_PARAMS); asm volatile("" : "+s"(pp));
        if (s2 < 0) run_phase0(pp, s2 + 2, lds); else run_phase(pp, s2, lds);
        xcd_barrier(bar);
    }
}

extern "C" void kernel_launch(void* const* d_in, const int* in_sizes, int n_in, void* d_out, int out_size, void* d_ws, size_t ws_size, hipStream_t stream) {
    static int grid = 0;
    if (grid == 0) {
        int dev = 0, cus = 0, per_cu = 0;
        hipGetDevice(&dev); hipDeviceGetAttribute(&cus, hipDeviceAttributeMultiprocessorCount, dev);
        hipFuncSetAttribute((const void*)mega, hipFuncAttributeMaxDynamicSharedMemorySize, LDS_BYTES);
        hipOccupancyMaxActiveBlocksPerMultiprocessor(&per_cu, (const void*)mega, 512, LDS_BYTES);
        (void)hipGetLastError();
        if (per_cu < 1) per_cu = 1;
        grid = cus * per_cu;
    }
    int G = 2;
    while (G < 16 && ACT_OFF + (size_t)(NTOK / G) * TOKB > ws_size) G *= 2;
    if (hipMemsetAsync((char*)d_ws + WS_CTL, 0, CTL_BYTES, stream) != hipSuccess) { fprintf(stderr, "kernel_launch: memset failed\n"); return; }
    Params p{};
    for (int i = 0; i < 33; ++i) p.in[i] = (const float*)d_in[i];
    p.out = (float*)d_out; p.ws = (unsigned char*)d_ws; p.G = G; p.Tg = NTOK / G;
    void* args[] = {&p};
    hipError_t e = hipLaunchCooperativeKernel((const void*)mega, dim3(grid), dim3(512), args, LDS_BYTES, stream);
    if (e != hipSuccess) fprintf(stderr, "cooperative launch failed: %s (grid %d)\n", hipGetErrorString(e), grid);
}
```

```cpp
#include <hip/hip_runtime.h>
#include <hip/hip_cooperative_groups.h>
#include <cstdio>
#include <cstdint>
namespace cg = cooperative_groups;
namespace pg8 {
#define PG8_LAS __attribute__((address_space(3)))
typedef unsigned short bf16_t;
typedef short bf16x8 __attribute__((ext_vector_type(8)));
typedef float f32x4 __attribute__((ext_vector_type(4)));
typedef unsigned u32x4 __attribute__((ext_vector_type(4)));
constexpr int BM = 256, BK = 64, HALF = 128, HTB = HALF * BK * 2  , STAGE_BYTES = 8 * HTB, NXCD = 8, WGM = 8;

__host__ __device__ __forceinline__ int lds_byte(int r, int c) { const int st = (r >> 4) * 2 + (c >> 5), rr = r & 15, cc = c & 31, ob = rr * 64 + cc * 2; return st * 1024 + (ob ^ (((ob >> 9) & 1) << 5)); }
__host__ __device__ __forceinline__ void stage_rc(int b, int& R, int& C) { const int st = b / 1024, sb = b % 1024, swz = sb ^ (((sb >> 9) & 1) << 5); R = (st >> 1) * 16 + swz / 64; C = (st & 1) * 32 + (swz % 64) / 2; }
__host__ __device__ __forceinline__ int perm32(int rho) { const int n = rho >> 4, i = rho & 15; return 8 * (i >> 2) + 4 * n + (i & 3); }

struct Unit { int pm, pn; };
struct Gemm { const bf16_t* A; const bf16_t* Bt; int M, N, K; int kmode; };
__device__ __forceinline__ void krange(int kmode, int pn, int K, int& kof, int& nt) {
    kof = 0; nt = K / BK;
    if (kmode == 1) { if (pn < 3) { nt = 4; } else { kof = 256; nt = 2; } }
    else if (kmode == 2) { kof = (pn < 4) ? 0 : ((pn < 8) ? 128 : 256); nt = 2; }
}

struct StaticOrder {
    int nM, nN, nwg, G, c;
    __host__ __device__ void init(int M, int N, int G_, int c_) { nM = M / BM; nN = N / BM; nwg = nM * nN; G = G_; c = c_; }
    __host__ __device__ bool next(int i, Unit& u) const {
        const long L = (long)i * G + c; if (L >= nwg) return false;
        int wgid = (int)L; { const int q = nwg / NXCD, r = nwg % NXCD, xcd = wgid % NXCD, off = wgid / NXCD; wgid = (xcd < r ? xcd * (q + 1) : r * (q + 1) + (xcd - r) * q) + off; }
        const int nig = WGM * nN, gid = wgid / nig, fm = gid * WGM, gsz = (nM - fm) < WGM ? (nM - fm) : WGM;
        u.pm = fm + ((wgid % nig) % gsz); u.pn = (wgid % nig) / gsz; return true;
    }
    __device__ __forceinline__ void a_ready(const Unit&) const {}
    __device__ __forceinline__ void done(const Unit&) const {}
};

__device__ __forceinline__ unsigned cvt_pk_bf16(float lo, float hi) { unsigned r; asm volatile("v_cvt_pk_bf16_f32 %0, %1, %2" : "=v"(r) : "v"(lo), "v"(hi)); return r; }
typedef float f32x2 __attribute__((ext_vector_type(2)));
}
namespace pg8 {
template <class Epi, class Sched, bool ALIGN_EPI = false, bool SP2 = false>
__device__ __forceinline__ void gemm_phase(PG8_LAS unsigned char* lds, const Gemm g, const Sched& S, const Epi& E) {
    int tid_l = threadIdx.x; asm volatile("" : "+v"(tid_l)); const int tid = tid_l, wid = __builtin_amdgcn_readfirstlane(tid >> 6), lane = tid & 63, wr = wid >> 2, wc = wid & 3, fr = lane & 15, fq = lane >> 4;
    const int K = g.K; int nt = K / BK;
    unsigned voffA[2], voffB[2];
#pragma unroll
    for (int i = 0; i < 2; ++i) { int R, C; stage_rc(tid * 16 + i * 8192, R, C); const int Rb = Epi::PERM ? ((R & ~31) + perm32(R & 31)) : R;
        voffA[i] = (unsigned)(R * K + C) * 2u; voffB[i] = (unsigned)(Rb * K + C) * 2u; }
    const size_t kstep = (size_t)(BK * 2);
    const size_t hstep = (size_t)HALF * K * 2;
    const size_t tstep = 2 * hstep;
    const unsigned ldsw = (unsigned)wid * 1024u;
    const int aoff = lds_byte(wr * 64 + fr, fq * 8), boff = lds_byte(wc * 32 + fr, fq * 8);
#define PG8_SA(b, h) (((b) * 2 + (h)) * HTB)
#define PG8_SB(b, h) ((4 + (b) * 2 + (h)) * HTB)
#define PG8_STAGE(bufoff, gbase, voff) do { _Pragma("unroll") for (int _i = 0; _i < 2; ++_i) \
        __builtin_amdgcn_global_load_lds((const unsigned*)((const char*)(gbase) + (voff)[_i]), (PG8_LAS unsigned*)(lds + (bufoff) + ldsw + _i * 8192), 16, 0, 0); } while (0)
#define PG8_LDA(dst, b, h) do { _Pragma("unroll") for (int m = 0; m < 4; ++m) _Pragma("unroll") for (int k = 0; k < 2; ++k) dst[m][k] = *(const PG8_LAS bf16x8*)(lds + PG8_SA(b, h) + aoff + m * 2048 + k * 1024); } while (0)
#define PG8_LDB(dst, b, h) do { _Pragma("unroll") for (int n = 0; n < 2; ++n) _Pragma("unroll") for (int k = 0; k < 2; ++k) dst[n][k] = *(const PG8_LAS bf16x8*)(lds + PG8_SB(b, h) + boff + n * 2048 + k * 1024); } while (0)
#define PG8_MMA(ai, bj, At, Bt) do { __builtin_amdgcn_s_setprio(1); _Pragma("unroll") for (int m = 0; m < 4; ++m) _Pragma("unroll") for (int n = 0; n < 2; ++n) _Pragma("unroll") for (int k = 0; k < 2; ++k) \
        acc[ai][bj][m][n] = __builtin_amdgcn_mfma_f32_16x16x32_bf16(Bt[n][k], At[m][k], acc[ai][bj][m][n], 0, 0, 0); __builtin_amdgcn_s_setprio(0); } while (0)
#define PG8_WAIT_V(n) asm volatile("s_waitcnt vmcnt(" #n ")" ::: "memory")
#define PG8_WAIT_L(n) asm volatile("s_waitcnt lgkmcnt(" #n ")" ::: "memory")
#define PG8_BAR __builtin_amdgcn_s_barrier()
#define PG8_SCHED __builtin_amdgcn_sched_barrier(0)
    Unit cur, nxt; int ui = 0;
    if (!S.next(0, cur)) return;
    f32x4 acc[2][2][4][2];
#pragma unroll
    for (int a = 0; a < 2; ++a)
#pragma unroll
        for (int b = 0; b < 2; ++b)
#pragma unroll
            for (int m = 0; m < 4; ++m)
#pragma unroll
                for (int n = 0; n < 2; ++n) acc[a][b][m][n] = (f32x4){0.f, 0.f, 0.f, 0.f};
    bf16x8 At[4][2], B0[2][2], B1[2][2];
    int kofc_; krange(g.kmode, cur.pn, K, kofc_, nt);
    const char* cA = (const char*)g.A + (size_t)cur.pm * tstep + (size_t)kofc_ * 2; const char* cB = (const char*)g.Bt + (size_t)cur.pn * tstep + (size_t)kofc_ * 2;
    S.a_ready(cur);
    if constexpr (SP2) {
        PG8_STAGE(PG8_SB(0, 0), cB, voffB); PG8_STAGE(PG8_SB(0, 1), cB + hstep, voffB); PG8_STAGE(PG8_SA(0, 0), cA, voffA); PG8_STAGE(PG8_SA(0, 1), cA + hstep, voffA);
        if (wr == 1) PG8_BAR;
        PG8_WAIT_V(2); PG8_BAR;
        PG8_STAGE(PG8_SB(1, 0), cB + kstep, voffB); PG8_STAGE(PG8_SA(1, 0), cA + kstep, voffA); PG8_STAGE(PG8_SB(1, 1), cB + hstep + kstep, voffB);
        PG8_WAIT_V(6); PG8_BAR;
    } else {
        PG8_STAGE(PG8_SB(0, 0), cB, voffB); PG8_STAGE(PG8_SA(0, 0), cA, voffA); PG8_STAGE(PG8_SB(0, 1), cB + hstep, voffB); PG8_STAGE(PG8_SA(0, 1), cA + hstep, voffA);
        if (wr == 1) PG8_BAR;
        PG8_WAIT_V(4); PG8_BAR;
        PG8_STAGE(PG8_SB(1, 0), cB + kstep, voffB); PG8_STAGE(PG8_SA(1, 0), cA + kstep, voffA); PG8_STAGE(PG8_SB(1, 1), cB + hstep + kstep, voffB);
        PG8_WAIT_V(6); PG8_BAR;
    }
    for (;;) {
        const bool has_next = S.next(ui + 1, nxt);
        int kofn_ = 0, ntn_ = nt; if (has_next) krange(g.kmode, nxt.pn, K, kofn_, ntn_);
        const char* nA = has_next ? (const char*)g.A + (size_t)nxt.pm * tstep + (size_t)kofn_ * 2 : cA; const char* nB = has_next ? (const char*)g.Bt + (size_t)nxt.pn * tstep + (size_t)kofn_ * 2 : cB;
        for (int t = 0; t < nt; t += 2) {
            const bool last = (t == nt - 2);
            const char* a1 = cA + (size_t)(t + 1) * kstep;
            const char* a2 = last ? nA : cA + (size_t)(t + 2) * kstep; const char* b2 = last ? nB : cB + (size_t)(t + 2) * kstep;
            const char* a3 = a2 + kstep; const char* b3 = b2 + kstep;
            if (last && has_next) S.a_ready(nxt);
            if constexpr (SP2) {
            PG8_LDB(B0, 0, 0); PG8_LDB(B1, 0, 1); PG8_SCHED; PG8_LDA(At, 0, 0); PG8_STAGE(PG8_SA(1, 1), a1 + hstep, voffA);
            PG8_WAIT_V(8); PG8_WAIT_L(0); PG8_BAR; PG8_MMA(0, 0, At, B0); PG8_MMA(0, 1, At, B1); PG8_BAR; PG8_SCHED;
            PG8_LDA(At, 0, 1); PG8_STAGE(PG8_SB(0, 0), b2, voffB); PG8_STAGE(PG8_SB(0, 1), b2 + hstep, voffB); PG8_STAGE(PG8_SA(0, 0), a2, voffA);
            PG8_WAIT_V(8); PG8_WAIT_L(0); PG8_BAR; PG8_MMA(1, 0, At, B0); PG8_MMA(1, 1, At, B1); PG8_BAR; PG8_SCHED;
            PG8_LDB(B0, 1, 0); PG8_LDB(B1, 1, 1); PG8_SCHED; PG8_LDA(At, 1, 0); PG8_STAGE(PG8_SA(0, 1), a2 + hstep, voffA);
            PG8_WAIT_V(8); PG8_WAIT_L(0); PG8_BAR; PG8_MMA(0, 0, At, B0); PG8_MMA(0, 1, At, B1); PG8_BAR; PG8_SCHED;
            PG8_LDA(At, 1, 1); PG8_STAGE(PG8_SB(1, 0), b3, voffB); PG8_STAGE(PG8_SB(1, 1), b3 + hstep, voffB); PG8_STAGE(PG8_SA(1, 0), a3, voffA);
            PG8_WAIT_V(8); PG8_WAIT_L(0); PG8_BAR; PG8_MMA(1, 0, At, B0); PG8_MMA(1, 1, At, B1); PG8_BAR; PG8_SCHED;
            } else {
            PG8_LDB(B0, 0, 0); PG8_SCHED; PG8_LDA(At, 0, 0); PG8_STAGE(PG8_SA(1, 1), a1 + hstep, voffA);
            PG8_WAIT_L(8); PG8_BAR; PG8_WAIT_L(0); PG8_MMA(0, 0, At, B0); PG8_BAR; PG8_SCHED;
            PG8_LDB(B1, 0, 1); PG8_STAGE(PG8_SB(0, 0), b2, voffB);
            PG8_BAR; PG8_WAIT_L(0); PG8_MMA(0, 1, At, B1); PG8_BAR;
            PG8_LDA(At, 0, 1); PG8_STAGE(PG8_SA(0, 0), a2, voffA);
            PG8_BAR; PG8_WAIT_L(0); PG8_MMA(1, 0, At, B0); PG8_BAR; PG8_SCHED;
            PG8_STAGE(PG8_SB(0, 1), b2 + hstep, voffB);
            PG8_WAIT_V(6); PG8_BAR; PG8_MMA(1, 1, At, B1); PG8_BAR;
            PG8_LDB(B0, 1, 0); PG8_SCHED; PG8_LDA(At, 1, 0); PG8_STAGE(PG8_SA(0, 1), a2 + hstep, voffA);
            PG8_WAIT_L(8); PG8_BAR; PG8_WAIT_L(0); PG8_MMA(0, 0, At, B0); PG8_BAR; PG8_SCHED;
            PG8_LDB(B1, 1, 1); PG8_STAGE(PG8_SB(1, 0), b3, voffB);
            PG8_BAR; PG8_WAIT_L(0); PG8_MMA(0, 1, At, B1); PG8_BAR;
            PG8_LDA(At, 1, 1); PG8_STAGE(PG8_SA(1, 0), a3, voffA);
            PG8_BAR; PG8_WAIT_L(0); PG8_MMA(1, 0, At, B0); PG8_BAR; PG8_SCHED;
            PG8_STAGE(PG8_SB(1, 1), b3 + hstep, voffB);
            PG8_WAIT_V(6); PG8_BAR; PG8_MMA(1, 1, At, B1); PG8_BAR;
            }
        }
        if constexpr (ALIGN_EPI) { if (wr == 0) PG8_BAR; }
        if constexpr (!Epi::AFTER_DRAIN) { E(acc, cur, wr, wc, fr, fq); S.done(cur); }
        if (!has_next) break;
#pragma unroll
        for (int a = 0; a < 2; ++a)
#pragma unroll
            for (int b = 0; b < 2; ++b)
#pragma unroll
                for (int m = 0; m < 4; ++m)
#pragma unroll
                    for (int n = 0; n < 2; ++n) acc[a][b][m][n] = (f32x4){0.f, 0.f, 0.f, 0.f};
        cur = nxt; cA = nA; cB = nB; nt = ntn_; ++ui;
        if constexpr (ALIGN_EPI) { if (wr == 1) PG8_BAR; }
    }
    PG8_WAIT_V(0);
    if constexpr (!ALIGN_EPI) { if (wr == 0) PG8_BAR; }
    PG8_BAR;
    if constexpr (Epi::AFTER_DRAIN) { E.fused(acc, cur, wr, wc, fr, fq, lds, wid, lane); S.done(cur); }
#undef PG8_SA
#undef PG8_SB
#undef PG8_STAGE
#undef PG8_LDA
#undef PG8_LDB
#undef PG8_MMA
#undef PG8_WAIT_V
#undef PG8_WAIT_L
#undef PG8_BAR
#undef PG8_SCHED
}
}

#define LAS __attribute__((address_space(3)))
typedef unsigned short bf16;
typedef unsigned v4u __attribute__((ext_vector_type(4)));
typedef unsigned v2u __attribute__((ext_vector_type(2)));
typedef float f32x4 __attribute__((ext_vector_type(4)));
typedef float f32x16 __attribute__((ext_vector_type(16)));
typedef short bf16x8 __attribute__((ext_vector_type(8)));
typedef short s16x4 __attribute__((ext_vector_type(4)));
typedef _Float16 h8 __attribute__((ext_vector_type(8)));

typedef float f32x2_t __attribute__((ext_vector_type(2))); typedef __bf16 bf16x2_t __attribute__((ext_vector_type(2)));
__device__ __forceinline__ unsigned pk2(float lo, float hi) { f32x2_t v = {lo, hi}; bf16x2_t b = __builtin_convertvector(v, bf16x2_t); return __builtin_bit_cast(unsigned, b); }
__device__ __forceinline__ float bflo(unsigned u) { return __uint_as_float(u << 16); }
__device__ __forceinline__ float bfhi(unsigned u) { return __uint_as_float(u & 0xffff0000u); }
__device__ __forceinline__ float bf2f(bf16 b) { return __uint_as_float(((unsigned)b) << 16); }
__device__ __forceinline__ bf16 f2bf(float f) { return (bf16)(pk2(f, 0.f) & 0xffffu); }
#define UNPACK8(v, f) do { f[0] = bflo(v.x); f[1] = bfhi(v.x); f[2] = bflo(v.y); f[3] = bfhi(v.y); f[4] = bflo(v.z); f[5] = bfhi(v.z); f[6] = bflo(v.w); f[7] = bfhi(v.w); } while (0)
#define PACK8(o, f) do { o.x = pk2(f[0], f[1]); o.y = pk2(f[2], f[3]); o.z = pk2(f[4], f[5]); o.w = pk2(f[6], f[7]); } while (0)
__device__ __forceinline__ int ltid() { int t = threadIdx.x; asm volatile("" : "+v"(t)); return t; }
__device__ __forceinline__ float sigmoidf_(float x) { return __builtin_amdgcn_rcpf(1.f + __expf(-x)); }
__device__ __forceinline__ float wave_sum(float v) {
#pragma unroll
    for (int o = 1; o < 64; o <<= 1) v += __shfl_xor(v, o);
    return v;
}
__device__ __forceinline__ float sum8(float v) { v += __shfl_xor(v, 1); v += __shfl_xor(v, 2); v += __shfl_xor(v, 4); return v; }

constexpr int DM = 1024, DIN = 6944, DPROJ = 4096, NMAIN = 3872, DGATE = 3072, DFF = 2816;
constexpr int NTOK = 131072, NPROMPT = 65536;
constexpr int C_KA = 512, C_VA = 1024, C_CQ = 1536, C_CKV = 1792, C_KR = 1920, C_RW = 1952;
constexpr float LOG2E = 1.4426950408889634f;
constexpr float NA_QS = 0.125f * LOG2E;
constexpr float MLA_QS = 0.10206207261596575f * LOG2E;
constexpr float NEPS = 1e-6f;

constexpr size_t MiB = 1u << 20;
constexpr size_t WS_CTL = 0, CTL_BYTES = 1 * MiB;
constexpr size_t W_OFF = 1 * MiB, W_STRIDE = 39 * MiB;
constexpr size_t WO_IN = 0, WO_G = 8 * MiB, WO_BR = 14 * MiB, WO_OUT = 17 * MiB, WO_GU = 19 * MiB, WO_DN = 30 * MiB, WO_MU = 35 * MiB + 512 * 1024, WO_RU = 37 * MiB;
constexpr size_t ACT_OFF = 80 * MiB;
constexpr size_t TOKB_H = 2048, TOKB_P = 8192, TOKB_M = 3584, TOKB_A = 1536, TOKB_S = 9216, TOKB_Y = 3072, TOKB_Z = 2048;
constexpr size_t TOKB = TOKB_H + TOKB_P + TOKB_M + TOKB_A + TOKB_S + TOKB_Y + TOKB_Z;
static_assert(WO_MU + 1792 * 384 * 2 <= WO_RU && WO_RU + 2560 * 384 * 2 <= W_STRIDE && WO_DN + 1024 * 2816 * 2 <= WO_MU && WO_GU + 5632 * 1024 * 2 <= WO_DN, "weight map");
constexpr int LDS_RING = 131072, LDS_BYTES = LDS_RING + 1024;

struct Params { const float* in[33]; float* out; unsigned char* ws; int G; int Tg; };
typedef const __attribute__((address_space(4))) Params* CP;

constexpr size_t WS_PARAMS = 512 * 1024;
struct Reg { unsigned char* ws; size_t Tg;
    __device__ __forceinline__ bf16* RH() const { return (bf16*)(ws + ACT_OFF); }
    __device__ __forceinline__ bf16* RP() const { return (bf16*)(ws + ACT_OFF + Tg * TOKB_H); }
    __device__ __forceinline__ bf16* RM() const { return (bf16*)(ws + ACT_OFF + Tg * (TOKB_H + TOKB_P)); }
    __device__ __forceinline__ bf16* RA() const { return (bf16*)(ws + ACT_OFF + Tg * (TOKB_H + TOKB_P + TOKB_M)); }
    __device__ __forceinline__ _Float16* RS() const { return (_Float16*)(ws + ACT_OFF + Tg * (TOKB_H + TOKB_P + TOKB_M + TOKB_A)); }
    __device__ __forceinline__ bf16* RY() const { return (bf16*)(ws + ACT_OFF + Tg * (TOKB_H + TOKB_P + TOKB_M + TOKB_A + TOKB_S)); }
    __device__ __forceinline__ bf16* RZ() const { return (bf16*)(ws + ACT_OFF + Tg * (TOKB_H + TOKB_P + TOKB_M + TOKB_A + TOKB_S + TOKB_Y)); }
};
enum { GM_IN = 0, GM_MU = 1, GM_RU = 2, GM_GATE = 3, GM_BR0 = 4, GM_BR1 = 5, GM_BR2 = 6, GM_OUT = 7, GM_GU = 8, GM_DN = 9 };
#define EPI_FENCE() asm volatile("" ::: "memory")
struct EpiUni {
    static constexpr bool PERM = true, AFTER_DRAIN = false;
    CP pp; int id, l, g;
    __device__ __forceinline__ void operator()(const pg8::f32x4 (&acc)[2][2][4][2], const pg8::Unit& u, int wr, int wc, int fr, int fq) const {
        CP q = pp; asm volatile("" : "+s"(q));
        const int Tg = q->Tg; const Reg R{q->ws, (size_t)Tg}; const size_t asz = (size_t)Tg * 512;
        const int row0 = u.pm * 256 + wr * 64 + fr, col0 = u.pn * 256 + wc * 32 + 8 * fq;
        switch (id) {
        case GM_IN: case GM_MU: {
            bf16* O = (id == GM_IN) ? R.RP() : R.RM(); const int ldc = (id == GM_IN) ? DPROJ : 1792;
#pragma unroll
            for (int ai = 0; ai < 2; ++ai)
#pragma unroll
                for (int m = 0; m < 4; ++m) { bf16* rp = O + (size_t)(row0 + ai * 128 + m * 16) * ldc + col0;
#pragma unroll
                    for (int bj = 0; bj < 2; ++bj) { const f32x4 v0 = acc[ai][bj][m][0], v1 = acc[ai][bj][m][1]; v4u w; w.x = pk2(v0[0], v0[1]); w.y = pk2(v0[2], v0[3]); w.z = pk2(v1[0], v1[1]); w.w = pk2(v1[2], v1[3]);
                        *(v4u*)(rp + bj * 128) = w; } }
        } break;
        case GM_GATE: {
            bf16* O = R.RP(); const float* bias = q->in[4] + l * DGATE + col0;
#pragma unroll
            for (int bj = 0; bj < 2; ++bj) { const f32x4 b0 = *(const f32x4*)(bias + bj * 128), b1 = *(const f32x4*)(bias + bj * 128 + 4);
#pragma unroll
                for (int ai = 0; ai < 2; ++ai)
#pragma unroll
                    for (int m = 0; m < 4; ++m) { const f32x4 v0 = acc[ai][bj][m][0] + b0, v1 = acc[ai][bj][m][1] + b1; float f[8];
#pragma unroll
                        for (int i = 0; i < 4; ++i) { f[i] = sigmoidf_(v0[i]); f[4 + i] = sigmoidf_(v1[i]); }
                        v4u w; PACK8(w, f); *(v4u*)(O + (size_t)(row0 + ai * 128 + m * 16) * DGATE + col0 + bj * 128) = w; }
                EPI_FENCE(); }
        } break;
        case GM_GU: {
            bf16* O = R.RP(); const int hc = u.pn * 128 + wc * 32 + 8 * fq;
#pragma unroll
            for (int ai = 0; ai < 2; ++ai)
#pragma unroll
                for (int m = 0; m < 4; ++m) { float f[8];
#pragma unroll
                    for (int n = 0; n < 2; ++n)
#pragma unroll
                        for (int i = 0; i < 4; ++i) { const float gt = acc[ai][0][m][n][i], up = acc[ai][1][m][n][i]; f[4 * n + i] = gt * sigmoidf_(gt) * up; }
                    v4u w; PACK8(w, f); *(v4u*)(O + (size_t)(row0 + ai * 128 + m * 16) * DFF + hc) = w; }
        } break;
        case GM_BR0: case GM_BR1: case GM_BR2: {
            bf16* O = R.RM(); const bf16* Gt = R.RP() + (id - GM_BR0) * 1024; const bool first = (id == GM_BR0);
#pragma unroll
            for (int ai = 0; ai < 2; ++ai)
#pragma unroll
                for (int m = 0; m < 4; ++m) { const size_t row = (size_t)(row0 + ai * 128 + m * 16);
#pragma unroll
                    for (int bj = 0; bj < 2; ++bj) { const int col = col0 + bj * 128; const v4u gv = *(const v4u*)(Gt + row * DGATE + col); float gg[8], f[8]; UNPACK8(gv, gg);
#pragma unroll
                        for (int i = 0; i < 4; ++i) { f[i] = gg[i] * acc[ai][bj][m][0][i]; f[4 + i] = gg[4 + i] * acc[ai][bj][m][1][i]; }
                        if (!first) { const v4u ov = *(const v4u*)(O + row * DM + col); float o[8]; UNPACK8(ov, o);
#pragma unroll
                            for (int i = 0; i < 8; ++i) f[i] += o[i]; }
                        v4u w; PACK8(w, f); *(v4u*)(O + row * DM + col) = w; }
                    EPI_FENCE(); }
        } break;
        case GM_OUT: case GM_DN: {
            const int t0 = g * Tg; float* xout = q->out + (size_t)t0 * DM;
            const float* xin = (id == GM_OUT && l == 0) ? ((t0 < NPROMPT) ? q->in[0] + (size_t)t0 * DM : q->in[1] + (size_t)(t0 - NPROMPT) * DM) : xout;
#pragma unroll
            for (int ai = 0; ai < 2; ++ai)
#pragma unroll
                for (int m = 0; m < 4; ++m) { const size_t off = (size_t)(row0 + ai * 128 + m * 16) * DM + col0;
#pragma unroll
                    for (int bj = 0; bj < 2; ++bj)
#pragma unroll
                        for (int n = 0; n < 2; ++n) { const f32x4 b = *(const f32x4*)(xin + off + bj * 128 + n * 4); *(f32x4*)(xout + off + bj * 128 + n * 4) = b + acc[ai][bj][m][n]; }
                    EPI_FENCE(); }
        } break;
        case GM_RU: {
            _Float16* rs = R.RS(); const _Float16* ktmp = (const _Float16*)R.RZ(); bf16* gout = R.RY() + 2 * asz;
            const int type = u.pn >> 1; const int cl0 = (u.pn & 1) * 256 + wc * 32 + 8 * fq;
            const float* w0 = q->in[17] + l * 1024; const float* a0 = q->in[19] + l * 1024; const float* ka = q->in[23] + l * 512;
#pragma unroll
            for (int ai = 0; ai < 2; ++ai)
#pragma unroll
                for (int m = 0; m < 4; ++m) { const size_t row = (size_t)(row0 + ai * 128 + m * 16);
#pragma unroll
                    for (int bj = 0; bj < 2; ++bj) { const int cl = cl0 + bj * 128; float f[8];
#pragma unroll
                        for (int i = 0; i < 4; ++i) { f[i] = acc[ai][bj][m][0][i]; f[4 + i] = acc[ai][bj][m][1][i]; }
                        if (type < 2) {
                            h8 o;
#pragma unroll
                            for (int i = 0; i < 8; ++i) o[i] = (_Float16)__expf(-0.6065306597126334f * sigmoidf_(f[i] + w0[type * 512 + cl + i]));
                            *(h8*)(rs + (size_t)(3 + type) * asz + row * 512 + cl) = o;
                        } else if (type < 4) {
                            const int d = type - 2; const h8 kv = *(const h8*)(ktmp + row * 512 + cl), kkv = *(const h8*)(rs + (size_t)2 * asz + row * 512 + cl); h8 o1, o2;
#pragma unroll
                            for (int i = 0; i < 8; ++i) { const float a = sigmoidf_(f[i] + a0[d * 512 + cl + i]); o1[i] = (_Float16)((float)kkv[i] * a); o2[i] = (_Float16)((float)kv[i] * (1.f + (a - 1.f) * ka[cl + i])); }
                            *(h8*)(rs + (size_t)(5 + d) * asz + row * 512 + cl) = o1; *(h8*)(rs + (size_t)(7 + d) * asz + row * 512 + cl) = o2;
                        } else { v4u w; PACK8(w, f); *(v4u*)(gout + row * 512 + cl) = w; }
                        EPI_FENCE(); } }
        } break;
        default: break;
        }
    }
};

__device__ __forceinline__ void transpose_item(const float* W, int ldw, int N, bf16* WT, int ldt, int koff, int row_off, int mode, LAS float* scr, int item, int lane) {
    const int nblk = N / 32, kb = item / nblk, nb = item % nblk, k0 = 64 * kb, n0 = 32 * nb;
    float tv[32];
#pragma unroll
    for (int i = 0; i < 32; ++i) { const int kk = 2 * i + (lane >> 5); tv[i] = W[(size_t)(k0 + kk) * ldw + n0 + (lane & 31)]; }
#pragma unroll
    for (int i = 0; i < 32; ++i) { const int kk = 2 * i + (lane >> 5); scr[kk * 33 + (lane & 31)] = tv[i]; }
    asm volatile("s_waitcnt lgkmcnt(0)" ::: "memory");
    const int c = lane & 7;
#pragma unroll
    for (int j = 0; j < 4; ++j) { const int n = (lane >> 3) + 8 * j; const LAS float* s = scr + (8 * c) * 33 + n;
        v4u o; o.x = pk2(s[0 * 33], s[1 * 33]); o.y = pk2(s[2 * 33], s[3 * 33]); o.z = pk2(s[4 * 33], s[5 * 33]); o.w = pk2(s[6 * 33], s[7 * 33]);
        const int nn = n0 + n; const int drow = mode ? ((nn >> 7) * 256 + row_off + (nn & 127)) : (row_off + nn);
        *(v4u*)(WT + (size_t)drow * ldt + koff + k0 + 8 * c) = o; }
    asm volatile("s_waitcnt lgkmcnt(0)" ::: "memory");
}
__device__ __forceinline__ void transpose_job(const float* W, int ldw, int K, int N, bf16* WT, int ldt, int koff, int row_off, int mode, LAS float* scr, int gw, int ngw, int lane) {
    const int nitems = (K / 64) * (N / 32);
    for (int it = gw; it < nitems; it += ngw) transpose_item(W, ldw, N, WT, ldt, koff, row_off, mode, scr, it, lane);
}
__device__ __forceinline__ void zero_bytes(unsigned char* p, size_t nbytes, size_t gtid, size_t ngt) {
    const v4u z = {0u, 0u, 0u, 0u};
    for (size_t i = gtid; i < nbytes / 16; i += ngt) ((v4u*)p)[i] = z;
}

__device__ __forceinline__ void phase_norm(const float* x, const float* g, bf16* hb, int Tg, int gw, int ngw, int lane) {
    for (int t = gw; t < Tg; t += 2 * ngw) {
        const int t2 = (t + ngw < Tg) ? t + ngw : t;
        const f32x4* xa = (const f32x4*)(x + (size_t)t * DM) + lane; const f32x4* xb = (const f32x4*)(x + (size_t)t2 * DM) + lane; f32x4 va[4], vb[4]; float sa = 0.f, sb = 0.f;
#pragma unroll
        for (int j = 0; j < 4; ++j) { va[j] = xa[64 * j]; vb[j] = xb[64 * j]; }
#pragma unroll
        for (int j = 0; j < 4; ++j) { sa += (va[j].x * va[j].x + va[j].y * va[j].y) + (va[j].z * va[j].z + va[j].w * va[j].w); sb += (vb[j].x * vb[j].x + vb[j].y * vb[j].y) + (vb[j].z * vb[j].z + vb[j].w * vb[j].w); }
        const float ia = rsqrtf(wave_sum(sa) * (1.f / DM) + NEPS), ib = rsqrtf(wave_sum(sb) * (1.f / DM) + NEPS);
        v2u* oa = (v2u*)(hb + (size_t)t * DM) + lane; v2u* ob = (v2u*)(hb + (size_t)t2 * DM) + lane;
#pragma unroll
        for (int j = 0; j < 4; ++j) { const f32x4 gg = ((const f32x4*)g)[lane + 64 * j]; v2u o;
            o.x = pk2(va[j].x * ia * gg.x, va[j].y * ia * gg.y); o.y = pk2(va[j].z * ia * gg.z, va[j].w * ia * gg.w); oa[64 * j] = o;
            o.x = pk2(vb[j].x * ib * gg.x, vb[j].y * ib * gg.y); o.y = pk2(vb[j].z * ib * gg.z, vb[j].w * ib * gg.w); ob[64 * j] = o; }
    }
}

__device__ __forceinline__ void phase_post_proj(CP pp, int l, bf16* proj, bf16* mla_a, bf16* rw_a, _Float16* rs, _Float16* ktmp, size_t asz, int Tg, int L, int gw, int ngw, int lane) {
    const float* gq = pp->in[5] + l * 64; const float* gk = pp->in[6] + l * 64;
    const float* gcq = pp->in[9] + l * 256; const float* gckv = pp->in[10] + l * 128;
    const float* mu = pp->in[16] + l * 1920; const float* kkw = pp->in[22] + l * 512;
    for (int t = gw; t < Tg; t += ngw) {
        bf16* row = proj + (size_t)t * DPROJ; const int tpos = t % L;
        const bool hasp = tpos > 0, hasn = tpos < L - 1;
        v4u qv = *(const v4u*)(row + 8 * lane), kv = *(const v4u*)(row + C_KA + 8 * lane); const v2u cv = *(const v2u*)(row + C_CQ + 4 * lane); const unsigned kvv = *(const unsigned*)(row + C_CKV + 2 * lane);
        v4u rwc[4], rwp[4], rwn[4];
#pragma unroll
        for (int it = 0; it < 4; ++it) { const int c0 = (it * 64 + lane) * 8; const v4u z = {0u, 0u, 0u, 0u}; rwc[it] = z; rwp[it] = z; rwn[it] = z;
            if (it < 3 || lane < 48) { const bf16* src = row + C_RW + c0; rwc[it] = *(const v4u*)src; if (hasp) rwp[it] = *(const v4u*)(src - DPROJ); if (hasn) rwn[it] = *(const v4u*)(src + DPROJ); } }
        {
            const int gi = 8 * (lane & 7);
            float f[8]; UNPACK8(qv, f); float ss = 0.f;
#pragma unroll
            for (int i = 0; i < 8; ++i) ss += f[i] * f[i];
            float inv = rsqrtf(sum8(ss) * (1.f / 64.f) + NEPS) * NA_QS;
#pragma unroll
            for (int i = 0; i < 8; ++i) f[i] = f[i] * inv * gq[gi + i];
            PACK8(qv, f); *(v4u*)(row + 8 * lane) = qv;
            UNPACK8(kv, f); ss = 0.f;
#pragma unroll
            for (int i = 0; i < 8; ++i) ss += f[i] * f[i];
            inv = rsqrtf(sum8(ss) * (1.f / 64.f) + NEPS);
#pragma unroll
            for (int i = 0; i < 8; ++i) f[i] = f[i] * inv * gk[gi + i];
            PACK8(kv, f); *(v4u*)(row + C_KA + 8 * lane) = kv;
        }
        {
            float a0 = bflo(cv.x), a1 = bfhi(cv.x), a2 = bflo(cv.y), a3 = bfhi(cv.y);
            float inv = rsqrtf(wave_sum(a0 * a0 + a1 * a1 + a2 * a2 + a3 * a3) * (1.f / 256.f) + NEPS);
            const f32x4 gg = *(const f32x4*)(gcq + 4 * lane); v2u o; o.x = pk2(a0 * inv * gg.x, a1 * inv * gg.y); o.y = pk2(a2 * inv * gg.z, a3 * inv * gg.w);
            *(v2u*)(mla_a + (size_t)t * 384 + 4 * lane) = o;
            a0 = bflo(kvv); a1 = bfhi(kvv);
            inv = rsqrtf(wave_sum(a0 * a0 + a1 * a1) * (1.f / 128.f) + NEPS);
            *(unsigned*)(mla_a + (size_t)t * 384 + 256 + 2 * lane) = pk2(a0 * inv * gckv[2 * lane], a1 * inv * gckv[2 * lane + 1]);
        }
#pragma unroll
        for (int it = 0; it < 4; ++it) {
            const int c0 = (it * 64 + lane) * 8;
            if (it < 3 || lane < 48) {
                float pc[8], pp[8], pn[8]; UNPACK8(rwc[it], pc); UNPACK8(rwp[it], pp); UNPACK8(rwn[it], pn);
#pragma unroll
                for (int i = 0; i < 8; ++i) pc[i] = pc[i] + mu[c0 + i] * (0.5f * (pp[i] + pn[i]) - pc[i]);
                if (it == 0) { h8 o;
#pragma unroll
                    for (int i = 0; i < 8; ++i) o[i] = (_Float16)pc[i];
                    *(h8*)(rs + (size_t)t * 512 + c0) = o; }
                else if (it == 1) { const int c = c0 - 512; h8 o; float kk[8]; float ss = 0.f;
#pragma unroll
                    for (int i = 0; i < 8; ++i) { o[i] = (_Float16)pc[i]; kk[i] = pc[i] * kkw[c + i]; ss += kk[i] * kk[i]; }
                    *(h8*)(ktmp + (size_t)t * 512 + c) = o;
                    const float inv = rsqrtf(sum8(ss) + 1e-12f);
#pragma unroll
                    for (int i = 0; i < 8; ++i) o[i] = (_Float16)(kk[i] * inv);
                    *(h8*)(rs + 2 * asz + (size_t)t * 512 + c) = o; }
                else if (it == 2) { const int c = c0 - 1024; h8 o;
#pragma unroll
                    for (int i = 0; i < 8; ++i) o[i] = (_Float16)pc[i];
                    *(h8*)(rs + asz + (size_t)t * 512 + c) = o; }
                else { const int c = c0 - 1536; float f[8];
#pragma unroll
                    for (int i = 0; i < 8; ++i) { const float x = pc[i]; f[i] = (c < 128) ? (1.f - 2.f * __builtin_amdgcn_rcpf(1.f + __expf(2.f * x))) : ((c < 256) ? x : sigmoidf_(x)); }
                    v4u w; PACK8(w, f); *(v4u*)(rw_a + (size_t)t * 384 + c) = w; }
            }
        }
    }
}

__device__ __forceinline__ void phase_mla_post(CP pp, int l, bf16* mraw, const bf16* proj, bf16* mk, int Tg, int L, int gw, int ngw, int lane) {
    const float* gq = pp->in[13] + l * 96; const float* gk = pp->in[14] + l * 96;
    const int h = lane >> 3, sub = lane & 7, rs = sub & 3; const bool hasr = sub < 4;
    float gqn[8], gkn[8], gq1[4], gq2[4], gk1[4], gk2[4], invf[4];
#pragma unroll
    for (int e = 0; e < 8; ++e) { gqn[e] = gq[8 * sub + e]; gkn[e] = gk[8 * sub + e]; }
#pragma unroll
    for (int e = 0; e < 4; ++e) { gq1[e] = gq[64 + 4 * rs + e]; gq2[e] = gq[80 + 4 * rs + e]; gk1[e] = gk[64 + 4 * rs + e]; gk2[e] = gk[80 + 4 * rs + e];
        invf[e] = __expf(-(float)((4 * rs + e) & 7) * (9.210340371976184f / 8.f)); }
    for (int t = gw; t < Tg; t += ngw) {
        const int tpos = t % L; const float pos = (float)((rs < 2) ? (tpos >> 6) : (tpos & 63));
        bf16* mrow = mraw + (size_t)t * 1792; bf16* krow = mk + (size_t)t * 768;
        const v4u qv = *(const v4u*)(mrow + h * 96 + 8 * sub), kv = *(const v4u*)(mrow + 768 + h * 128 + 8 * sub);
        v2u q1 = {0u, 0u}, q2 = {0u, 0u}, k1 = {0u, 0u}, k2 = {0u, 0u};
        if (hasr) { q1 = *(const v2u*)(mrow + h * 96 + 64 + 4 * rs); q2 = *(const v2u*)(mrow + h * 96 + 80 + 4 * rs);
                    k1 = *(const v2u*)(proj + (size_t)t * DPROJ + C_KR + 4 * rs); k2 = *(const v2u*)(proj + (size_t)t * DPROJ + C_KR + 16 + 4 * rs); }
        float cs[4], sn[4];
#pragma unroll
        for (int e = 0; e < 4; ++e) { float rev = pos * invf[e] * 0.15915494309189535f; rev -= floorf(rev); cs[e] = __builtin_amdgcn_cosf(rev); sn[e] = __builtin_amdgcn_sinf(rev); }
        {   float f[8]; UNPACK8(qv, f); float a[4] = {bflo(q1.x), bfhi(q1.x), bflo(q1.y), bfhi(q1.y)}, b[4] = {bflo(q2.x), bfhi(q2.x), bflo(q2.y), bfhi(q2.y)};
            float ss = 0.f;
#pragma unroll
            for (int e = 0; e < 8; ++e) ss += f[e] * f[e];
#pragma unroll
            for (int e = 0; e < 4; ++e) ss += a[e] * a[e] + b[e] * b[e];
            const float inv = rsqrtf(sum8(ss) * (1.f / 96.f) + NEPS) * MLA_QS;
#pragma unroll
            for (int e = 0; e < 8; ++e) f[e] = f[e] * inv * gqn[e];
            v4u o; PACK8(o, f); *(v4u*)(mrow + h * 96 + 8 * sub) = o;
            if (hasr) { float r1[4], r2[4];
#pragma unroll
                for (int e = 0; e < 4; ++e) { const float x1 = a[e] * inv * gq1[e], x2 = b[e] * inv * gq2[e]; r1[e] = x1 * cs[e] - x2 * sn[e]; r2[e] = x1 * sn[e] + x2 * cs[e]; }
                v2u o1, o2; o1.x = pk2(r1[0], r1[1]); o1.y = pk2(r1[2], r1[3]); o2.x = pk2(r2[0], r2[1]); o2.y = pk2(r2[2], r2[3]);
                *(v2u*)(mrow + h * 96 + 64 + 4 * rs) = o1; *(v2u*)(mrow + h * 96 + 80 + 4 * rs) = o2; } }
        {   float f[8]; UNPACK8(kv, f); float a[4] = {bflo(k1.x), bfhi(k1.x), bflo(k1.y), bfhi(k1.y)}, b[4] = {bflo(k2.x), bfhi(k2.x), bflo(k2.y), bfhi(k2.y)};
            float ss = 0.f;
#pragma unroll
            for (int e = 0; e < 8; ++e) ss += f[e] * f[e];
#pragma unroll
            for (int e = 0; e < 4; ++e) ss += a[e] * a[e] + b[e] * b[e];
            const float inv = rsqrtf(sum8(ss) * (1.f / 96.f) + NEPS);
#pragma unroll
            for (int e = 0; e < 8; ++e) f[e] = f[e] * inv * gkn[e];
            v4u o; PACK8(o, f); *(v4u*)(krow + h * 96 + 8 * sub) = o;
            if (hasr) { float r1[4], r2[4];
#pragma unroll
                for (int e = 0; e < 4; ++e) { const float x1 = a[e] * inv * gk1[e], x2 = b[e] * inv * gk2[e]; r1[e] = x1 * cs[e] - x2 * sn[e]; r2[e] = x1 * sn[e] + x2 * cs[e]; }
                v2u o1, o2; o1.x = pk2(r1[0], r1[1]); o1.y = pk2(r1[2], r1[3]); o2.x = pk2(r2[0], r2[1]); o2.y = pk2(r2[2], r2[3]);
                *(v2u*)(krow + h * 96 + 64 + 4 * rs) = o1; *(v2u*)(krow + h * 96 + 80 + 4 * rs) = o2; } }
    }
}

__device__ __forceinline__ void phase_rw_post(CP pp, int l, const _Float16* rs, size_t asz, const bf16* yfb, bf16* yc, int Tg, int gw, int ngw, int lane) {
    const float* lnw = pp->in[25] + l * 512 + 8 * lane; const float* lnb = pp->in[26] + l * 512 + 8 * lane; const float* rk = pp->in[24] + l * 512 + 8 * lane;
    float lw[8], lb[8], rkk[8];
#pragma unroll
    for (int i = 0; i < 8; ++i) { lw[i] = lnw[i]; lb[i] = lnb[i]; rkk[i] = rk[i]; }
    for (int t = gw; t < Tg; t += 2 * ngw) {
        const int t2 = (t + ngw < Tg) ? t + ngw : t;
        const size_t oa = (size_t)t * 512 + 8 * lane, ob = (size_t)t2 * 512 + 8 * lane;
        const v4u fa = *(const v4u*)(yfb + oa), ba = *(const v4u*)(yfb + asz + oa), fb = *(const v4u*)(yfb + ob), bb = *(const v4u*)(yfb + asz + ob);
        const h8 ra = *(const h8*)(rs + oa), va = *(const h8*)(rs + asz + oa), k0a = *(const h8*)(rs + 7 * asz + oa), k1a = *(const h8*)(rs + 8 * asz + oa);
        const h8 rb = *(const h8*)(rs + ob), vb = *(const h8*)(rs + asz + ob), k0b = *(const h8*)(rs + 7 * asz + ob), k1b = *(const h8*)(rs + 8 * asz + ob);
        const v4u ga = *(const v4u*)(yc + oa), gb = *(const v4u*)(yc + ob);
#define RWP_ONE(F_, B_, R_, V_, K0_, K1_, G_, O_) do { float y[8], f[8]; UNPACK8(F_, y); UNPACK8(B_, f); float s = 0.f; \
        _Pragma("unroll") for (int i = 0; i < 8; ++i) { y[i] += f[i]; s += y[i]; } \
        const float mean = sum8(s) * (1.f / 64.f); float q = 0.f; \
        _Pragma("unroll") for (int i = 0; i < 8; ++i) { y[i] -= mean; q += y[i] * y[i]; } \
        const float rstd = rsqrtf(sum8(q) * (1.f / 64.f) + 64e-5f); float b = 0.f; \
        _Pragma("unroll") for (int i = 0; i < 8; ++i) b += (float)R_[i] * ((float)K0_[i] + (float)K1_[i]) * rkk[i]; \
        b = sum8(b); UNPACK8(G_, f); \
        _Pragma("unroll") for (int i = 0; i < 8; ++i) f[i] = (y[i] * rstd * lw[i] + lb[i] + b * (float)V_[i]) * f[i]; \
        v4u w; PACK8(w, f); *(v4u*)(yc + (O_)) = w; } while (0)
        RWP_ONE(fa, ba, ra, va, k0a, k1a, ga, oa);
        if (t2 != t) RWP_ONE(fb, bb, rb, vb, k0b, k1b, gb, ob);
#undef RWP_ONE
    }
}

#define GAS __attribute__((address_space(1)))
typedef float f2 __attribute__((ext_vector_type(2)));
#define DPP_ADD(x, ctrl) ((x) + __builtin_bit_cast(float, __builtin_amdgcn_update_dpp(0, __builtin_bit_cast(int, (x)), (ctrl), 0xF, 0xF, true)))
__device__ __forceinline__ float red8(float x) { x = DPP_ADD(x, 0xB1); x = DPP_ADD(x, 0x4E); x = DPP_ADD(x, 0x141); return x; }
constexpr int SCH = 32, SBUF = 6 * SCH * 256;
__device__ __forceinline__ void scan_unit(int u, int L, const _Float16* rs, size_t asz, bf16* yfb, LAS unsigned char* lds) {
    const int tid = ltid(); const int lane = tid & 63, w = tid >> 6, vr = lane >> 3, ko = lane & 7;
    const int dir = u & 1, sh = u >> 1, h = sh & 7, s = sh >> 3;
    const int kA = tid >> 8, lj = (tid >> 3) & 31, lp = tid & 7;
    const size_t tok0 = (size_t)s * L + (dir ? (L - 1 - lj) : lj);
    const long tstep = dir ? -(long)SCH * 512 : (long)SCH * 512;
    const size_t eoff = tok0 * 512 + h * 64 + lp * 8;
    const GAS _Float16* g0 = (const GAS _Float16*)(rs + (size_t)(kA ? 2 : 0) * asz + eoff);
    const GAS _Float16* g1 = (const GAS _Float16*)(rs + (size_t)(kA ? 5 + dir : 3 + dir) * asz + eoff);
    const GAS _Float16* g2 = (const GAS _Float16*)(rs + (size_t)(kA ? 1 : 7 + dir) * asz + eoff);
    const int ld0 = (((0 + kA) * SCH + lj) * 64 + lp * 8) * 4, ld1 = (((2 + kA) * SCH + lj) * 64 + lp * 8) * 4, ld2 = (((4 + kA) * SCH + lj) * 64 + lp * 8) * 4;
    GAS bf16* py = (GAS bf16*)(yfb + (size_t)dir * asz + ((size_t)s * L + (dir ? L - 1 : 0)) * 512 + h * 64 + 8 * w + vr);
    const long ystep = dir ? -512 : 512;
    const int rd = ko * 32, rdv = (5 * SCH * 64 + 8 * w + vr) * 4;
    f2 S[4];
#pragma unroll
    for (int i = 0; i < 4; ++i) S[i] = (f2){0.f, 0.f};
    h8 p0 = *(const GAS h8*)g0, p1 = *(const GAS h8*)g1, p2 = *(const GAS h8*)g2;
#define SCAN_PUT(bufo) do { f32x4 a, b; \
        a = (f32x4){(float)p0[0], (float)p0[1], (float)p0[2], (float)p0[3]}; b = (f32x4){(float)p0[4], (float)p0[5], (float)p0[6], (float)p0[7]}; *(LAS f32x4*)(lds + (bufo) + ld0) = a; *(LAS f32x4*)(lds + (bufo) + ld0 + 16) = b; \
        a = (f32x4){(float)p1[0], (float)p1[1], (float)p1[2], (float)p1[3]}; b = (f32x4){(float)p1[4], (float)p1[5], (float)p1[6], (float)p1[7]}; *(LAS f32x4*)(lds + (bufo) + ld1) = a; *(LAS f32x4*)(lds + (bufo) + ld1 + 16) = b; \
        a = (f32x4){(float)p2[0], (float)p2[1], (float)p2[2], (float)p2[3]}; b = (f32x4){(float)p2[4], (float)p2[5], (float)p2[6], (float)p2[7]}; *(LAS f32x4*)(lds + (bufo) + ld2) = a; *(LAS f32x4*)(lds + (bufo) + ld2 + 16) = b; } while (0)
    SCAN_PUT(0);
    __syncthreads();
    const int NC = L / SCH;
#pragma unroll 1
    for (int c = 0; c < NC; ++c) {
        const int cur = (c & 1) * SBUF;
        if (c + 1 < NC) { const long o = tstep * (long)(c + 1); p0 = *(const GAS h8*)(g0 + o); p1 = *(const GAS h8*)(g1 + o); p2 = *(const GAS h8*)(g2 + o); }
        LAS unsigned char* bp = lds + cur + rd;
        GAS bf16* pyc = py + ystep * (long)(c * SCH);
#pragma unroll 1
        for (int j0 = 0; j0 < SCH; j0 += 4) { float yv[4];
#pragma unroll
        for (int jj = 0; jj < 4; ++jj) { const int j = j0 + jj;
            const LAS unsigned char* q = bp + j * 256;
            const f32x4 r0 = *(const LAS f32x4*)(q), r1 = *(const LAS f32x4*)(q + 16);
            const f32x4 k0 = *(const LAS f32x4*)(q + SCH * 256), k1 = *(const LAS f32x4*)(q + SCH * 256 + 16);
            const f32x4 w0 = *(const LAS f32x4*)(q + 2 * SCH * 256), w1 = *(const LAS f32x4*)(q + 2 * SCH * 256 + 16);
            const f32x4 a0 = *(const LAS f32x4*)(q + 3 * SCH * 256), a1 = *(const LAS f32x4*)(q + 3 * SCH * 256 + 16);
            const f32x4 d0 = *(const LAS f32x4*)(q + 4 * SCH * 256), d1 = *(const LAS f32x4*)(q + 4 * SCH * 256 + 16);
            const float vv = *(const LAS float*)(lds + cur + rdv + j * 256);
            const f2 vv2 = (f2){vv, vv};
            f2 e0 = S[0] * w0.xy, e1 = S[1] * w0.zw, e2 = S[2] * w1.xy, e3 = S[3] * w1.zw;
            f2 pa = S[0] * k0.xy, pb = S[1] * k0.zw; pa = S[2] * k1.xy + pa; pb = S[3] * k1.zw + pb;
            e0 = d0.xy * vv2 + e0; e1 = d0.zw * vv2 + e1; e2 = d1.xy * vv2 + e2; e3 = d1.zw * vv2 + e3;
            const f2 pd = pa + pb;
            const float nskk = -red8(pd.x + pd.y);
            const f2 ns2 = (f2){nskk, nskk};
            S[0] = a0.xy * ns2 + e0; S[1] = a0.zw * ns2 + e1; S[2] = a1.xy * ns2 + e2; S[3] = a1.zw * ns2 + e3;
            f2 qa = S[0] * r0.xy, qb = S[1] * r0.zw; qa = S[2] * r1.xy + qa; qb = S[3] * r1.zw + qb;
            const f2 qd = qa + qb;
            yv[jj] = red8(qd.x + qd.y);
        }
            if (ko == 0) {
#pragma unroll
                for (int jj = 0; jj < 4; ++jj) pyc[ystep * (j0 + jj)] = f2bf(yv[jj]); }
        }
        if (c + 1 < NC) SCAN_PUT(SBUF - cur);
        __syncthreads();
    }
#undef SCAN_PUT
}

constexpr int MKP = 208, MVP = 144, MBUF = 64 * MKP + 64 * MVP;
#define MLA_THR 6.0f
__device__ __forceinline__ float max3f(float a, float b, float c) { return fmaxf(fmaxf(a, b), c); }
__device__ __forceinline__ void mla_unit(int u, int L, const bf16* mraw, const bf16* mk, bf16* yb, LAS unsigned char* lds) {
    const int tid = ltid(), lane = tid & 63, w = tid >> 6, q32 = lane & 31, hi = lane >> 5;
    const int nqb = L >> 8, qb = u % nqb, sh = u / nqb, h = sh & 7, s = sh >> 3;
    const size_t base = (size_t)s * L; const int NT = L >> 6;
    const size_t qtok = base + qb * 256 + w * 32 + q32;
    bf16x8 qf[6];
#pragma unroll
    for (int ks = 0; ks < 6; ++ks) qf[ks] = *(const bf16x8*)(mraw + qtok * 1792 + h * 96 + ks * 16 + hi * 8);
    const int kkey0 = tid / 12, kch0 = tid % 12, kkey1 = (tid + 512) / 12, kch1 = (tid + 512) % 12; const bool k2 = tid < 256;
    const bf16* ks0 = mk + (base + kkey0) * 768 + h * 96 + kch0 * 8; const bf16* ks1 = mk + (base + kkey1) * 768 + h * 96 + kch1 * 8;
    const int vkey = tid >> 3, vch = tid & 7;
    const bf16* vs = mraw + (base + vkey) * 1792 + 768 + h * 128 + 64 + vch * 8;
    const int kd0 = kkey0 * MKP + kch0 * 16, kd1 = kkey1 * MKP + kch1 * 16, vd = 64 * MKP + vkey * MVP + vch * 16;
    v4u rk0, rk1 = {0u, 0u, 0u, 0u}, rv, sk0, sk1 = {0u, 0u, 0u, 0u}, sv;
#define MLA_LOAD(t) do { const size_t adv_ = (size_t)(t) * 64; rk0 = *(const v4u*)(ks0 + adv_ * 768); if (k2) rk1 = *(const v4u*)(ks1 + adv_ * 768); rv = *(const v4u*)(vs + adv_ * 1792); } while (0)
#define MLA_PUT(bo) do { *(LAS v4u*)(lds + (bo) + kd0) = rk0; if (k2) *(LAS v4u*)(lds + (bo) + kd1) = rk1; *(LAS v4u*)(lds + (bo) + vd) = rv; } while (0)
#define MLA_LOADB(t) do { const size_t adv_ = (size_t)(t) * 64; sk0 = *(const v4u*)(ks0 + adv_ * 768); if (k2) sk1 = *(const v4u*)(ks1 + adv_ * 768); sv = *(const v4u*)(vs + adv_ * 1792); } while (0)
#define MLA_PUTB(bo) do { *(LAS v4u*)(lds + (bo) + kd0) = sk0; if (k2) *(LAS v4u*)(lds + (bo) + kd1) = sk1; *(LAS v4u*)(lds + (bo) + vd) = sv; } while (0)
    MLA_LOAD(0); MLA_PUT(0); MLA_LOAD(1); MLA_PUT(MBUF);
    __syncthreads();
    const int kmap = 16 * (q32 >> 4) + 8 * ((q32 >> 2) & 1) + (q32 & 3) + 4 * ((q32 >> 3) & 1);
    const int koff = kmap * MKP + hi * 16;
    const int voff = 64 * MKP + (8 * hi + ((lane & 15) >> 2)) * MVP + (16 * ((lane >> 4) & 1) + 4 * (lane & 3)) * 2;
    f32x16 o0 = {}, o1 = {}, negm = {}, pA0, pA1, pB0, pB1; float lsum = 0.f; v4u pw0, pw1, pw2, pw3;
    int b_prev = 0, b_cur = MBUF, b_next = 2 * MBUF;
#define MLA_KA(bo, ks) (*(const LAS bf16x8*)(lds + (bo) + koff + (ks) * 32))
#define MLA_KB(bo, ks) (*(const LAS bf16x8*)(lds + (bo) + koff + 32 * MKP + (ks) * 32))
#define MLA_QK2(C0, C1, bo, ks) do { C0 = __builtin_amdgcn_mfma_f32_32x32x16_bf16(MLA_KA(bo, ks), qf[ks], C0, 0, 0, 0); C1 = __builtin_amdgcn_mfma_f32_32x32x16_bf16(MLA_KB(bo, ks), qf[ks], C1, 0, 0, 0); } while (0)
#define MLA_FIN8(P, g, PW) do { float e0 = __builtin_amdgcn_exp2f(P[8 * g + 0]), e1 = __builtin_amdgcn_exp2f(P[8 * g + 1]), e2 = __builtin_amdgcn_exp2f(P[8 * g + 2]), e3 = __builtin_amdgcn_exp2f(P[8 * g + 3]), \
        e4 = __builtin_amdgcn_exp2f(P[8 * g + 4]), e5 = __builtin_amdgcn_exp2f(P[8 * g + 5]), e6 = __builtin_amdgcn_exp2f(P[8 * g + 6]), e7 = __builtin_amdgcn_exp2f(P[8 * g + 7]); \
        lsum += ((e0 + e1) + (e2 + e3)) + ((e4 + e5) + (e6 + e7)); PW.x = pk2(e0, e1); PW.y = pk2(e2, e3); PW.z = pk2(e4, e5); PW.w = pk2(e6, e7); } while (0)
#define MLA_VT(bo, kg, db) ({ const int vb_ = (bo) + voff + (kg) * 16 * MVP + (db) * 64; \
        const s16x4 t0_ = __builtin_amdgcn_ds_read_tr16_b64_v4i16((LAS s16x4*)(lds + vb_)), t1_ = __builtin_amdgcn_ds_read_tr16_b64_v4i16((LAS s16x4*)(lds + vb_ + 4 * MVP)); \
        (bf16x8){t0_[0], t0_[1], t0_[2], t0_[3], t1_[0], t1_[1], t1_[2], t1_[3]}; })
#define MLA_PV(bo, kg, PW) do { const bf16x8 pf_ = __builtin_bit_cast(bf16x8, PW); o0 = __builtin_amdgcn_mfma_f32_32x32x16_bf16(MLA_VT(bo, kg, 0), pf_, o0, 0, 0, 0); o1 = __builtin_amdgcn_mfma_f32_32x32x16_bf16(MLA_VT(bo, kg, 1), pf_, o1, 0, 0, 0); } while (0)
#define MLA_ROWMAX(C0, C1) ({ float a_ = max3f(C0[0], C0[1], C1[0]), b_ = max3f(C0[2], C0[3], C1[1]); a_ = max3f(a_, C1[2], C1[3]); \
        _Pragma("unroll") for (int r_ = 4; r_ < 16; r_ += 4) { a_ = max3f(a_, C0[r_], C0[r_ + 1]); b_ = max3f(b_, C0[r_ + 2], C0[r_ + 3]); a_ = max3f(a_, C1[r_], C1[r_ + 1]); b_ = max3f(b_, C1[r_ + 2], C1[r_ + 3]); } \
        const float m_ = fmaxf(a_, b_); fmaxf(m_, __shfl_xor(m_, 32)); })
#define MLA_STEP(P0, P1, C0, C1, j, LOADX, PUTX, DOMAX) do { \
        if ((j) + 2 < NT) LOADX((j) + 2); \
        C0 = negm; C1 = negm; \
        MLA_QK2(C0, C1, b_cur, 0); MLA_QK2(C0, C1, b_cur, 1); MLA_FIN8(P0, 0, pw0); \
        MLA_QK2(C0, C1, b_cur, 2); MLA_FIN8(P0, 1, pw1); \
        MLA_QK2(C0, C1, b_cur, 3); MLA_FIN8(P1, 0, pw2); \
        MLA_QK2(C0, C1, b_cur, 4); MLA_FIN8(P1, 1, pw3); \
        MLA_QK2(C0, C1, b_cur, 5); \
        MLA_PV(b_prev, 0, pw0); MLA_PV(b_prev, 1, pw1); \
        float mt_ = 0.f; if (DOMAX) mt_ = MLA_ROWMAX(C0, C1); \
        MLA_PV(b_prev, 2, pw2); MLA_PV(b_prev, 3, pw3); \
        if (DOMAX && __any(mt_ > MLA_THR)) { const float dl_ = fmaxf(mt_, 0.f); const float fs_ = __builtin_amdgcn_exp2f(-dl_); lsum *= fs_; \
            _Pragma("unroll") for (int r_ = 0; r_ < 16; ++r_) { C0[r_] -= dl_; C1[r_] -= dl_; negm[r_] -= dl_; o0[r_] *= fs_; o1[r_] *= fs_; } } \
        if ((j) + 1 < NT) PUTX(b_next); \
        __syncthreads(); \
        { const int t_ = b_prev; b_prev = b_cur; b_cur = b_next; b_next = t_; } \
    } while (0)
    pA0 = negm; pA1 = negm;
#pragma unroll
    for (int ks = 0; ks < 6; ++ks) MLA_QK2(pA0, pA1, 0, ks);
    { const float m0 = MLA_ROWMAX(pA0, pA1);
#pragma unroll
      for (int r = 0; r < 16; ++r) { pA0[r] -= m0; pA1[r] -= m0; negm[r] = -m0; } }
    MLA_LOADB(2);
    int jt = 1;
#pragma unroll 1
    for (; jt + 1 < NT; jt += 2) {
        MLA_STEP(pA0, pA1, pB0, pB1, jt, MLA_LOAD, MLA_PUTB, true);
        MLA_STEP(pB0, pB1, pA0, pA1, jt + 1, MLA_LOADB, MLA_PUT, false);
    }
    if (jt < NT) { MLA_STEP(pA0, pA1, pB0, pB1, jt, MLA_LOAD, MLA_PUTB, true); pA0 = pB0; pA1 = pB1; }
    MLA_FIN8(pA0, 0, pw0); MLA_FIN8(pA0, 1, pw1); MLA_FIN8(pA1, 0, pw2); MLA_FIN8(pA1, 1, pw3);
    MLA_PV(b_prev, 0, pw0); MLA_PV(b_prev, 1, pw1); MLA_PV(b_prev, 2, pw2); MLA_PV(b_prev, 3, pw3);
    lsum += __shfl_xor(lsum, 32);
    const float inv = __builtin_amdgcn_rcpf(lsum);
    bf16* orow = yb + qtok * 512 + h * 64 + 4 * hi;
#pragma unroll
    for (int rq = 0; rq < 4; ++rq) {
        v2u a, b; a.x = pk2(o0[4 * rq] * inv, o0[4 * rq + 1] * inv); a.y = pk2(o0[4 * rq + 2] * inv, o0[4 * rq + 3] * inv);
        b.x = pk2(o1[4 * rq] * inv, o1[4 * rq + 1] * inv); b.y = pk2(o1[4 * rq + 2] * inv, o1[4 * rq + 3] * inv);
        *(v2u*)(orow + 8 * rq) = a; *(v2u*)(orow + 32 + 8 * rq) = b;
    }
    __syncthreads();
#undef MLA_LOAD
#undef MLA_PUT
#undef MLA_LOADB
#undef MLA_PUTB
#undef MLA_KA
#undef MLA_KB
#undef MLA_QK2
#undef MLA_FIN8
#undef MLA_VT
#undef MLA_PV
#undef MLA_ROWMAX
#undef MLA_STEP
}

constexpr int NVP = 144, NA_WLDS = 64 * NVP + 1888;
__device__ __forceinline__ void na_unit(int u, int L, int l, const float* rpb_all, const bf16* proj, bf16* ya, LAS unsigned char* lds) {
    const int tid = ltid(); const int lane = tid & 63, w = tid >> 6, i16 = lane & 15, quad = lane >> 4;
    const int rows = L >> 6; const int hq = u & 3, sr = u >> 2, r = sr % rows, s = sr / rows;
    const int h = 2 * hq + (w >> 2), j = w & 3;
    const int rs = min(max(r - 4, 0), rows - 8), kc0 = min(max(16 * j - 8, 0), 32);
    const size_t base = (size_t)s * L;
    const size_t qtok = base + r * 64 + 16 * j + i16;
    LAS unsigned char* vw = lds + w * NA_WLDS; LAS float* tb = (LAS float*)(vw + 64 * NVP);
    { const float* rpb = rpb_all + (size_t)(l * 8 + h) * 465;
#pragma unroll
      for (int it = 0; it < 8; ++it) { const int idx = it * 64 + lane; if (idx < 465) tb[idx] = rpb[idx]; } }
    bf16x8 qf[2];
    qf[0] = *(const bf16x8*)(proj + qtok * DPROJ + h * 64 + quad * 8); qf[1] = *(const bf16x8*)(proj + qtok * DPROJ + h * 64 + 32 + quad * 8);
    const int cA = (i16 >> 2) * 8 + (i16 & 3);
    const bf16* kp0 = proj + (base + (size_t)rs * 64 + kc0 + cA) * DPROJ + C_KA + h * 64 + quad * 8;
    bf16x8 kf[8][4];
#pragma unroll
    for (int wr = 0; wr < 8; ++wr) { const bf16* kp = kp0 + (size_t)wr * 64 * DPROJ;
        kf[wr][0] = *(const bf16x8*)kp; kf[wr][1] = *(const bf16x8*)(kp + 32); kf[wr][2] = *(const bf16x8*)(kp + 4 * DPROJ); kf[wr][3] = *(const bf16x8*)(kp + 4 * DPROJ + 32); }
    const bf16* vp0 = proj + (base + (size_t)rs * 64 + kc0) * DPROJ + C_VA + h * 64;
    v4u vt[8];
#define NA_VLOAD(ck) do { _Pragma("unroll") for (int it = 0; it < 8; ++it) { const int idx = it * 64 + lane, key = idx >> 3, ch = idx & 7; \
        vt[it] = *(const v4u*)(vp0 + ((size_t)(2 * (ck) + (key >> 5)) * 64 + (key & 31)) * DPROJ + ch * 8); } } while (0)
    NA_VLOAD(0);
    f32x4 sa[8], sb[8];
#pragma unroll
    for (int wr = 0; wr < 8; ++wr) {
        f32x4 a = {0.f, 0.f, 0.f, 0.f}, b = {0.f, 0.f, 0.f, 0.f};
        a = __builtin_amdgcn_mfma_f32_16x16x32_bf16(kf[wr][0], qf[0], a, 0, 0, 0); a = __builtin_amdgcn_mfma_f32_16x16x32_bf16(kf[wr][1], qf[1], a, 0, 0, 0);
        b = __builtin_amdgcn_mfma_f32_16x16x32_bf16(kf[wr][2], qf[0], b, 0, 0, 0); b = __builtin_amdgcn_mfma_f32_16x16x32_bf16(kf[wr][3], qf[1], b, 0, 0, 0);
        sa[wr] = a; sb[wr] = b;
    }
    asm volatile("s_waitcnt lgkmcnt(0)" ::: "memory");
    const int qc = 16 * j + i16, wst = min(max(qc - 8, 0), 48);
    float mx = -1e30f;
#pragma unroll
    for (int wr = 0; wr < 8; ++wr) { const LAS float* rb = tb + (rs + wr - r + 7) * 31;
#pragma unroll
        for (int jj = 0; jj < 4; ++jj) {
            { const int kc = kc0 + quad * 8 + jj; const bool ok = (kc >= wst) && (kc < wst + 16); const int dc = min(max(kc - qc + 15, 0), 30);
              const float v = ok ? (sa[wr][jj] + rb[dc] * LOG2E) : -1e30f; sa[wr][jj] = v; mx = fmaxf(mx, v); }
            { const int kc = kc0 + quad * 8 + 4 + jj; const bool ok = (kc >= wst) && (kc < wst + 16); const int dc = min(max(kc - qc + 15, 0), 30);
              const float v = ok ? (sb[wr][jj] + rb[dc] * LOG2E) : -1e30f; sb[wr][jj] = v; mx = fmaxf(mx, v); }
        } }
    mx = fmaxf(mx, __shfl_xor(mx, 16)); mx = fmaxf(mx, __shfl_xor(mx, 32));
    float ls = 0.f;
#pragma unroll
    for (int wr = 0; wr < 8; ++wr)
#pragma unroll
        for (int jj = 0; jj < 4; ++jj) { sa[wr][jj] = __builtin_amdgcn_exp2f(sa[wr][jj] - mx); sb[wr][jj] = __builtin_amdgcn_exp2f(sb[wr][jj] - mx); ls += sa[wr][jj] + sb[wr][jj]; }
    ls += __shfl_xor(ls, 16); ls += __shfl_xor(ls, 32);
    f32x4 oc[4];
#pragma unroll
    for (int db = 0; db < 4; ++db) oc[db] = (f32x4){0.f, 0.f, 0.f, 0.f};
    const int toff = (quad * 8 + (i16 >> 2)) * NVP + (4 * (lane & 3)) * 2;
#pragma unroll
    for (int ck = 0; ck < 4; ++ck) {
        asm volatile("s_waitcnt lgkmcnt(0)" ::: "memory");
#pragma unroll
        for (int it = 0; it < 8; ++it) { const int idx = it * 64 + lane, key = idx >> 3, ch = idx & 7; *(LAS v4u*)(vw + key * NVP + ch * 16) = vt[it]; }
        if (ck < 3) NA_VLOAD(ck + 1);
        asm volatile("s_waitcnt lgkmcnt(0)" ::: "memory");
#pragma unroll
        for (int wl = 0; wl < 2; ++wl) { const int wr = 2 * ck + wl;
            v4u pw; pw.x = pk2(sa[wr][0], sa[wr][1]); pw.y = pk2(sa[wr][2], sa[wr][3]); pw.z = pk2(sb[wr][0], sb[wr][1]); pw.w = pk2(sb[wr][2], sb[wr][3]);
            const bf16x8 pf = __builtin_bit_cast(bf16x8, pw);
#pragma unroll
            for (int db = 0; db < 4; ++db) { const int vb = toff + wl * 32 * NVP + db * 32;
                const s16x4 t0 = __builtin_amdgcn_ds_read_tr16_b64_v4i16((LAS s16x4*)(vw + vb)), t1 = __builtin_amdgcn_ds_read_tr16_b64_v4i16((LAS s16x4*)(vw + vb + 4 * NVP));
                const bf16x8 vf = {t0[0], t0[1], t0[2], t0[3], t1[0], t1[1], t1[2], t1[3]};
                oc[db] = __builtin_amdgcn_mfma_f32_16x16x32_bf16(vf, pf, oc[db], 0, 0, 0); }
        }
    }
#undef NA_VLOAD
    const float inv = __builtin_amdgcn_rcpf(ls);
    bf16* orow = ya + qtok * 512 + h * 64 + quad * 4;
#pragma unroll
    for (int db = 0; db < 4; ++db) { v2u o; o.x = pk2(oc[db][0] * inv, oc[db][1] * inv); o.y = pk2(oc[db][2] * inv, oc[db][3] * inv); *(v2u*)(orow + db * 16) = o; }
    asm volatile("s_waitcnt lgkmcnt(0)" ::: "memory");
}

#define XB_TMO      128
#define XB_XCNT(j)  (256  + 64 * (j))
#define XB_XSUB(j)  (1280 + 64 * (j))
#define XB_XGEN(j)  (2304 + 64 * (j))
#define XB_TOP      3328
#define XB_TOPGEN   3392
#define XCD_BAR_WORDS 3456
#define XB_SPIN_CAP (1u << 18)

__device__ __forceinline__ unsigned xb_ld(unsigned* p)              { return __hip_atomic_load(p, __ATOMIC_RELAXED, __HIP_MEMORY_SCOPE_AGENT); }
__device__ __forceinline__ unsigned xb_add(unsigned* p, unsigned v) { return __hip_atomic_fetch_add(p, v, __ATOMIC_RELAXED, __HIP_MEMORY_SCOPE_AGENT); }
__device__ __forceinline__ unsigned xb_xcc_id() { return (unsigned)__builtin_amdgcn_s_getreg((3 << 11) | 20) & 0xFu; }
#define XB_SPIN(cond, bar) do { unsigned _sp = 0; while (cond) { __builtin_amdgcn_s_sleep(1); \
    if ((++_sp & 255u) == 0u) { if (xb_ld(&(bar)[XB_TMO])) break; if (_sp > XB_SPIN_CAP) { atomicAdd(&(bar)[XB_TMO], 1u); break; } } } } while (0)

struct XcdBarrier {
    unsigned* bar; unsigned x;
    volatile LAS unsigned* st;
};

__device__ __forceinline__ XcdBarrier xcd_barrier_post(unsigned* bar, volatile LAS unsigned* st) {
    XcdBarrier b; b.bar = bar; b.x = xb_xcc_id(); b.st = st;
    if (threadIdx.x == 0) (void)xb_add(&bar[XB_XCNT(b.x)], 1u);
    return b;
}
__device__ __forceinline__ void xcd_barrier_complete(unsigned* bar, unsigned x, unsigned& nloc, unsigned& nx) {
    const unsigned G = gridDim.x * gridDim.y * gridDim.z;
    unsigned sum, cnt, mine, sp = 0u;
    for (;;) {
        sum = 0u; cnt = 0u; mine = 0u;
#pragma unroll
        for (unsigned j = 0; j < 16; ++j) { const unsigned c = xb_ld(&bar[XB_XCNT(j)]); sum += c; cnt += (c > 0u) ? 1u : 0u; mine = (j == x) ? c : mine; }
        if (sum == G) break;
        __builtin_amdgcn_s_sleep(1);
        if ((++sp & 255u) == 0u) { if (xb_ld(&bar[XB_TMO])) break; if (sp > XB_SPIN_CAP) { atomicAdd(&bar[XB_TMO], 1u); break; } }
    }
    nloc = mine > 0u ? mine : 1u; nx = cnt > 0u ? cnt : 1u;
}

__device__ __forceinline__ void xcd_barrier(const XcdBarrier& b) {
    asm volatile("s_waitcnt vmcnt(0)" ::: "memory");
    __syncthreads();
    if (threadIdx.x == 0) {
        unsigned* bar = b.bar;
        __builtin_amdgcn_s_waitcnt(0);
        unsigned nloc = b.st[0], nx = b.st[1];
        if (nloc == 0u) { xcd_barrier_complete(bar, b.x, nloc, nx); b.st[0] = nloc; b.st[1] = nx; }
        const unsigned old = xb_add(&bar[XB_XSUB(b.x)], 1u);
        const unsigned gen = old / nloc;
        if (old + 1u == (gen + 1u) * nloc) {
            __builtin_amdgcn_fence(__ATOMIC_RELEASE, "agent");
            asm volatile("s_waitcnt vmcnt(0)" ::: "memory");
            const unsigned og = xb_add(&bar[XB_TOP], 1u);
            const unsigned tg = og / nx;
            if (og + 1u == (tg + 1u) * nx) xb_add(&bar[XB_TOPGEN], 1u);
            else XB_SPIN(xb_ld(&bar[XB_TOPGEN]) == tg, bar);
            __builtin_amdgcn_fence(__ATOMIC_ACQUIRE, "agent");
            xb_add(&bar[XB_XGEN(b.x)], 1u);
            asm volatile("s_waitcnt vmcnt(0)" ::: "memory");
        } else {
            XB_SPIN(xb_ld(&bar[XB_XGEN(b.x)]) == gen, bar);
            __builtin_amdgcn_fence(__ATOMIC_ACQUIRE, "agent");
            asm volatile("s_waitcnt vmcnt(0)" ::: "memory");
        }
    }
    __syncthreads();
}

constexpr int NPH = 12;
__device__ __forceinline__ void run_phase(CP pp, int st, LAS unsigned char* lds) {
    volatile LAS unsigned* lctl = (volatile LAS unsigned*)(lds + LDS_RING);
    const int tid = ltid(), lane = tid & 63, wave = __builtin_amdgcn_readfirstlane(tid >> 6);
    int bid_ = blockIdx.x; asm volatile("" : "+s"(bid_));
    const int NB = gridDim.x, gw = bid_ * 8 + wave, ngw = NB * 8;
    const int ph = st % NPH, gl = st / NPH, l = gl & 1, g = gl >> 1;
    unsigned char* ws = pp->ws; const int Tg = pp->Tg;
    const Reg R{ws, (size_t)Tg};
    const size_t asz = (size_t)Tg * 512;
    const int t0 = g * Tg; const int L = (t0 < NPROMPT) ? 8192 : 4096;
    float* xout = pp->out + (size_t)t0 * DM;
    int gid0 = 0, gidn = 0;
    switch (ph) {
    case 0: {
        const float* xin = (l == 0) ? ((t0 < NPROMPT) ? pp->in[0] + (size_t)t0 * DM : pp->in[1] + (size_t)(t0 - NPROMPT) * DM) : xout;
        phase_norm(xin, pp->in[2] + l * DM, R.RH(), Tg, gw, ngw, lane);
    } break;
    case 1: gid0 = GM_IN; gidn = 1; break;
    case 2: {
        phase_post_proj(pp, l, R.RP(), R.RA(), R.RA() + (size_t)Tg * 384, R.RS(), (_Float16*)R.RZ(), asz, Tg, L, gw, ngw, lane);
    } break;
    case 3: gid0 = GM_MU; gidn = 2; break;
    case 4: {
        phase_mla_post(pp, l, R.RM(), R.RP(), R.RA(), Tg, L, gw, ngw, lane);
    } break;
    case 5: {
        unsigned* qctr = (unsigned*)(ws + WS_CTL) + 64 * gl; const int nseq = Tg / L;
        const int NS = nseq * 16, NM = nseq * 8 * (L >> 8), NN = nseq * (L >> 6) * 4, NTOT = NS + NM + NN;
        for (;;) {
            __syncthreads();
            if (tid == 0) lctl[0] = atomicAdd(qctr, 1u);
            __syncthreads();
            const int u = __builtin_amdgcn_readfirstlane((int)lctl[0]);
            if (u >= NTOT) break;
            if (u < NS) scan_unit(u, L, R.RS(), asz, R.RZ(), lds);
            else if (u < NS + NM) mla_unit(u - NS, L, R.RM(), R.RA(), R.RY() + asz, lds);
            else na_unit(u - NS - NM, L, l, pp->in[7], R.RP(), R.RY(), lds);
        }
    } break;
    case 6: {
        phase_rw_post(pp, l, R.RS(), asz, R.RZ(), R.RY() + 2 * asz, Tg, gw, ngw, lane);
        gid0 = GM_GATE; gidn = 1;
    } break;
    case 7: gid0 = GM_BR0; gidn = 3; break;
    case 8: gid0 = GM_OUT; gidn = 1; break;
    case 9: {
        phase_norm(xout, pp->in[29] + l * DM, R.RH(), Tg, gw, ngw, lane);
    } break;
    case 10: gid0 = GM_GU; gidn = 1; break;
    case 11: gid0 = GM_DN; gidn = 1; break;
    default: break;
    }
#pragma unroll 1
    for (int id = gid0; id < gid0 + gidn; ++id) {
        const unsigned char* wb = ws + W_OFF + (size_t)l * W_STRIDE;
        const bf16* A; const bf16* Bt; int N, K;
        switch (id) {
        case GM_IN:   A = R.RH(); Bt = (const bf16*)(wb + WO_IN); N = DPROJ; K = 1024; break;
        case GM_MU:   A = R.RA(); Bt = (const bf16*)(wb + WO_MU); N = 1792; K = 384; break;
        case GM_RU:   A = R.RA() + (size_t)Tg * 384; Bt = (const bf16*)(wb + WO_RU); N = 2560; K = 384; break;
        case GM_GATE: A = R.RH(); Bt = (const bf16*)(wb + WO_G); N = DGATE; K = 1024; break;
        case GM_BR0: case GM_BR1: case GM_BR2: A = R.RY() + (size_t)(id - GM_BR0) * asz; Bt = (const bf16*)(wb + WO_BR + (size_t)(id - GM_BR0) * MiB); N = DM; K = 512; break;
        case GM_OUT:  A = R.RM(); Bt = (const bf16*)(wb + WO_OUT); N = DM; K = 1024; break;
        case GM_GU:   A = R.RH(); Bt = (const bf16*)(wb + WO_GU); N = 2 * DFF; K = 1024; break;
        default:      A = R.RP(); Bt = (const bf16*)(wb + WO_DN); N = DM; K = DFF; break;
        }
        pg8::Gemm gm{A, Bt, Tg, N, K, (id == GM_MU) ? 1 : ((id == GM_RU) ? 2 : 0)}; pg8::StaticOrder S; S.init(Tg, N, NB, bid_);
        EpiUni E{pp, id, l, g}; pg8::gemm_phase<EpiUni, pg8::StaticOrder, true, true>(lds, gm, S, E);
    }
}

__device__ __forceinline__ void run_phase0(CP pp, int part, LAS unsigned char* lds) {
    const int tid = ltid(), lane = tid & 63, wave = __builtin_amdgcn_readfirstlane(tid >> 6);
    const int NB = gridDim.x, gw = blockIdx.x * 8 + wave, ngw = NB * 8;
    const size_t gtid = (size_t)blockIdx.x * 512 + tid, ngt = (size_t)NB * 512;
    unsigned char* ws = pp->ws;
    if (part == 0) {
        for (int l = 0; l < 2; ++l) { unsigned char* wb = ws + W_OFF + (size_t)l * W_STRIDE;
            zero_bytes(wb + WO_IN + (size_t)NMAIN * 2048, (size_t)(DPROJ - NMAIN) * 2048, gtid, ngt);
            zero_bytes(wb + WO_MU, (size_t)1792 * 384 * 2, gtid, ngt);
            zero_bytes(wb + WO_RU, (size_t)2560 * 384 * 2, gtid, ngt); }
    } else {
        LAS float* scr = (LAS float*)(lds + wave * 16384);
#pragma unroll 1
        for (int l = 0; l < 2; ++l) { unsigned char* wb = ws + W_OFF + (size_t)l * W_STRIDE;
            const float* w_in = pp->in[3] + (size_t)l * DM * DIN;
            transpose_job(w_in, DIN, 1024, NMAIN, (bf16*)(wb + WO_IN), 1024, 0, 0, 0, scr, gw, ngw, lane);
            transpose_job(w_in + NMAIN, DIN, 1024, DGATE, (bf16*)(wb + WO_G), 1024, 0, 0, 0, scr, gw, ngw, lane);
            transpose_job(pp->in[8] + (size_t)l * 512 * 1024, 1024, 512, 1024, (bf16*)(wb + WO_BR), 512, 0, 0, 0, scr, gw, ngw, lane);
            transpose_job(pp->in[15] + (size_t)l * 512 * 1024, 1024, 512, 1024, (bf16*)(wb + WO_BR + 1 * MiB), 512, 0, 0, 0, scr, gw, ngw, lane);
            transpose_job(pp->in[27] + (size_t)l * 512 * 1024, 1024, 512, 1024, (bf16*)(wb + WO_BR + 2 * MiB), 512, 0, 0, 0, scr, gw, ngw, lane);
            transpose_job(pp->in[28] + (size_t)l * 1024 * 1024, 1024, 1024, 1024, (bf16*)(wb + WO_OUT), 1024, 0, 0, 0, scr, gw, ngw, lane);
            transpose_job(pp->in[30] + (size_t)l * 1024 * DFF, DFF, 1024, DFF, (bf16*)(wb + WO_GU), 1024, 0, 0, 1, scr, gw, ngw, lane);
            transpose_job(pp->in[31] + (size_t)l * 1024 * DFF, DFF, 1024, DFF, (bf16*)(wb + WO_GU), 1024, 0, 128, 1, scr, gw, ngw, lane);
            transpose_job(pp->in[32] + (size_t)l * DFF * 1024, 1024, DFF, 1024, (bf16*)(wb + WO_DN), DFF, 0, 0, 0, scr, gw, ngw, lane);
            transpose_job(pp->in[11] + (size_t)l * 256 * 768, 768, 256, 768, (bf16*)(wb + WO_MU), 384, 0, 0, 0, scr, gw, ngw, lane);
            transpose_job(pp->in[12] + (size_t)l * 128 * 1024, 1024, 128, 1024, (bf16*)(wb + WO_MU), 384, 256, 768, 0, scr, gw, ngw, lane);
#pragma unroll 1
            for (int d = 0; d < 2; ++d) {
                transpose_job(pp->in[18] + (size_t)(l * 2 + d) * 64 * 512, 512, 64, 512, (bf16*)(wb + WO_RU), 384, 64 * d, 512 * d, 0, scr, gw, ngw, lane);
                transpose_job(pp->in[20] + (size_t)(l * 2 + d) * 64 * 512, 512, 64, 512, (bf16*)(wb + WO_RU), 384, 128 + 64 * d, 1024 + 512 * d, 0, scr, gw, ngw, lane); }
            transpose_job(pp->in[21] + (size_t)l * 128 * 512, 512, 128, 512, (bf16*)(wb + WO_RU), 384, 256, 2048, 0, scr, gw, ngw, lane);
        }
    }
}

__global__ void __launch_bounds__(512, 2) mega(Params p) {
    extern __shared__ __attribute__((aligned(16))) unsigned char lds_raw[];
    LAS unsigned char* lds = (LAS unsigned char*)lds_raw;
    cg::grid_group grid = cg::this_grid();
    if (blockIdx.x == 0 && threadIdx.x == 0) { Params* d = (Params*)(p.ws + WS_PARAMS); *d = p; }
    const int nsteps = p.G * 2 * NPH;
    volatile LAS unsigned* bst = (volatile LAS unsigned*)(lds + LDS_RING + 32);
    if (threadIdx.x == 0) { bst[0] = 0u; bst[1] = 0u; }
    __syncthreads();
    const XcdBarrier bar = xcd_barrier_post((unsigned*)(p.ws + WS_CTL) + 4096, bst);
    grid.sync();
#pragma unroll 1
    for (int st = -2; st < nsteps; ++st) {
        int s2 = st; asm volatile("" : "+s"(s2));
        CP pp = (CP)(p.ws + WS_PARAMS); asm volatile("" : "+s"(pp));
        if (s2 < 0) run_phase0(pp, s2 + 2, lds); else run_phase(pp, s2, lds);
        xcd_barrier(bar);
    }
}

extern "C" void kernel_launch(void* const* d_in, const int* in_sizes, int n_in, void* d_out, int out_size, void* d_ws, size_t ws_size, hipStream_t stream) {
    static int grid = 0;
    if (grid == 0) {
        int dev = 0, cus = 0, per_cu = 0;
        hipGetDevice(&dev); hipDeviceGetAttribute(&cus, hipDeviceAttributeMultiprocessorCount, dev);
        hipFuncSetAttribute((const void*)mega, hipFuncAttributeMaxDynamicSharedMemorySize, LDS_BYTES);
        hipOccupancyMaxActiveBlocksPerMultiprocessor(&per_cu, (const void*)mega, 512, LDS_BYTES);
        (void)hipGetLastError();
        if (per_cu < 1) per_cu = 1;
        grid = cus * per_cu;
    }
    int G = 2;
    while (G < 16 && ACT_OFF + (size_t)(NTOK / G) * TOKB > ws_size) G *= 2;
    if (hipMemsetAsync((char*)d_ws + WS_CTL, 0, CTL_BYTES, stream) != hipSuccess) { fprintf(stderr, "kernel_launch: memset failed\n"); return; }
    Params p{};
    for (int i = 0; i < 33; ++i) p.in[i] = (const float*)d_in[i];
    p.out = (float*)d_out; p.ws = (unsigned char*)d_ws; p.G = G; p.Tg = NTOK / G;
    void* args[] = {&p};
    hipError_t e = hipLaunchCooperativeKernel((const void*)mega, dim3(grid), dim3(512), args, LDS_BYTES, stream);
    if (e != hipSuccess) fprintf(stderr, "cooperative launch failed: %s (grid %d)\n", hipGetErrorString(e), grid);
}
```

```cpp
#include <hip/hip_runtime.h>
#include <hip/hip_cooperative_groups.h>
#include <cstdio>
#include <cstdint>
namespace cg = cooperative_groups;
namespace pg8 {
#define PG8_LAS __attribute__((address_space(3)))
typedef unsigned short bf16_t;
typedef short bf16x8 __attribute__((ext_vector_type(8)));
typedef float f32x4 __attribute__((ext_vector_type(4)));
typedef unsigned u32x4 __attribute__((ext_vector_type(4)));
constexpr int BM = 256, BK = 64, HALF = 128, HTB = HALF * BK * 2  , STAGE_BYTES = 8 * HTB, NXCD = 8, WGM = 8;

__host__ __device__ __forceinline__ int lds_byte(int r, int c) { const int st = (r >> 4) * 2 + (c >> 5), rr = r & 15, cc = c & 31, ob = rr * 64 + cc * 2; return st * 1024 + (ob ^ (((ob >> 9) & 1) << 5)); }
__host__ __device__ __forceinline__ void stage_rc(int b, int& R, int& C) { const int st = b / 1024, sb = b % 1024, swz = sb ^ (((sb >> 9) & 1) << 5); R = (st >> 1) * 16 + swz / 64; C = (st & 1) * 32 + (swz % 64) / 2; }
__host__ __device__ __forceinline__ int perm32(int rho) { const int n = rho >> 4, i = rho & 15; return 8 * (i >> 2) + 4 * n + (i & 3); }

struct Unit { int pm, pn, aux; };
struct Gemm { const bf16_t* A; const bf16_t* Bt; int M, N, K; int kmode; size_t auxA, auxB; };
__device__ __forceinline__ void krange(int kmode, int pn, int K, int& kof, int& nt) {
    kof = 0; nt = K / BK;
    if (kmode == 1) { if (pn < 3) { nt = 4; } else { kof = 256; nt = 2; } }
    else if (kmode == 2) { kof = (pn < 4) ? 0 : ((pn < 8) ? 128 : 256); nt = 2; }
}

struct StaticOrder {
    int nM, nN, nwg, G, c;
    __host__ __device__ void init(int M, int N, int G_, int c_) { nM = M / BM; nN = N / BM; nwg = nM * nN; G = G_; c = c_; }
    __host__ __device__ bool next(int i, Unit& u) const {
        const long L = (long)i * G + c; if (L >= nwg) return false;
        int wgid = (int)L; { const int q = nwg / NXCD, r = nwg % NXCD, xcd = wgid % NXCD, off = wgid / NXCD; wgid = (xcd < r ? xcd * (q + 1) : r * (q + 1) + (xcd - r) * q) + off; }
        const int nig = WGM * nN, gid = wgid / nig, fm = gid * WGM, gsz = (nM - fm) < WGM ? (nM - fm) : WGM;
        u.pm = fm + ((wgid % nig) % gsz); u.pn = (wgid % nig) / gsz; u.aux = 0; return true;
    }
    __device__ __forceinline__ void a_ready(const Unit&) const {}
    __device__ __forceinline__ void done(const Unit&) const {}
};
__device__ __forceinline__ void krange2(const Gemm& g, const Unit& u, int K, size_t& offA, size_t& offB, int& nt) {
    if (g.kmode == 3) { offA = (size_t)u.aux * g.auxA; offB = (size_t)u.aux * g.auxB; nt = K / BK; }
    else { int kof; krange(g.kmode, u.pn, K, kof, nt); offA = (size_t)kof * 2; offB = offA; }
}
struct GOrder {
    StaticOrder S; int div;
    __host__ __device__ bool next(int j, Unit& u) const { const int t = j / div; const bool ok = S.next(t, u); u.aux = j - t * div; return ok; }
    __device__ __forceinline__ void a_ready(const Unit&) const {}
    __device__ __forceinline__ void done(const Unit&) const {}
};

__device__ __forceinline__ unsigned cvt_pk_bf16(float lo, float hi) { unsigned r; asm volatile("v_cvt_pk_bf16_f32 %0, %1, %2" : "=v"(r) : "v"(lo), "v"(hi)); return r; }
typedef float f32x2 __attribute__((ext_vector_type(2)));
}
namespace pg8 {
template <class Epi, class Sched, bool ALIGN_EPI = false, bool SP2 = false>
__device__ __forceinline__ void gemm_phase(PG8_LAS unsigned char* lds, const Gemm g, const Sched& S, const Epi& E) {
    int tid_l = threadIdx.x; asm volatile("" : "+v"(tid_l)); const int tid = tid_l, wid = __builtin_amdgcn_readfirstlane(tid >> 6), lane = tid & 63, wr = wid >> 2, wc = wid & 3, fr = lane & 15, fq = lane >> 4;
    const int K = g.K; int nt = K / BK;
    unsigned voffA[2], voffB[2];
#pragma unroll
    for (int i = 0; i < 2; ++i) { int R, C; stage_rc(tid * 16 + i * 8192, R, C); const int Rb = Epi::PERM ? ((R & ~31) + perm32(R & 31)) : R;
        voffA[i] = (unsigned)(R * K + C) * 2u; voffB[i] = (unsigned)(Rb * K + C) * 2u; }
    const size_t kstep = (size_t)(BK * 2);
    const size_t hstep = (size_t)HALF * K * 2;
    const size_t tstep = 2 * hstep;
    const unsigned ldsw = (unsigned)wid * 1024u;
    const int aoff = lds_byte(wr * 64 + fr, fq * 8), boff = lds_byte(wc * 32 + fr, fq * 8);
#define PG8_SA(b, h) (((b) * 2 + (h)) * HTB)
#define PG8_SB(b, h) ((4 + (b) * 2 + (h)) * HTB)
#define PG8_STAGE(bufoff, gbase, voff) do { _Pragma("unroll") for (int _i = 0; _i < 2; ++_i) \
        __builtin_amdgcn_global_load_lds((const unsigned*)((const char*)(gbase) + (voff)[_i]), (PG8_LAS unsigned*)(lds + (bufoff) + ldsw + _i * 8192), 16, 0, 0); } while (0)
#define PG8_LDA(dst, b, h) do { _Pragma("unroll") for (int m = 0; m < 4; ++m) _Pragma("unroll") for (int k = 0; k < 2; ++k) dst[m][k] = *(const PG8_LAS bf16x8*)(lds + PG8_SA(b, h) + aoff + m * 2048 + k * 1024); } while (0)
#define PG8_LDB(dst, b, h) do { _Pragma("unroll") for (int n = 0; n < 2; ++n) _Pragma("unroll") for (int k = 0; k < 2; ++k) dst[n][k] = *(const PG8_LAS bf16x8*)(lds + PG8_SB(b, h) + boff + n * 2048 + k * 1024); } while (0)
#define PG8_MMA(ai, bj, At, Bt) do { __builtin_amdgcn_s_setprio(1); _Pragma("unroll") for (int m = 0; m < 4; ++m) _Pragma("unroll") for (int n = 0; n < 2; ++n) _Pragma("unroll") for (int k = 0; k < 2; ++k) \
        acc[ai][bj][m][n] = __builtin_amdgcn_mfma_f32_16x16x32_bf16(Bt[n][k], At[m][k], acc[ai][bj][m][n], 0, 0, 0); __builtin_amdgcn_s_setprio(0); } while (0)
#define PG8_WAIT_V(n) asm volatile("s_waitcnt vmcnt(" #n ")" ::: "memory")
#define PG8_WAIT_L(n) asm volatile("s_waitcnt lgkmcnt(" #n ")" ::: "memory")
#define PG8_BAR __builtin_amdgcn_s_barrier()
#define PG8_SCHED __builtin_amdgcn_sched_barrier(0)
    Unit cur, nxt; int ui = 0;
    if (!S.next(0, cur)) return;
    f32x4 acc[2][2][4][2];
#pragma unroll
    for (int a = 0; a < 2; ++a)
#pragma unroll
        for (int b = 0; b < 2; ++b)
#pragma unroll
            for (int m = 0; m < 4; ++m)
#pragma unroll
                for (int n = 0; n < 2; ++n) acc[a][b][m][n] = (f32x4){0.f, 0.f, 0.f, 0.f};
    bf16x8 At[4][2], B0[2][2], B1[2][2];
    size_t oac_, obc_; krange2(g, cur, K, oac_, obc_, nt);
    const char* cA = (const char*)g.A + (size_t)cur.pm * tstep + oac_; const char* cB = (const char*)g.Bt + (size_t)cur.pn * tstep + obc_;
    S.a_ready(cur);
    if constexpr (SP2) {
        PG8_STAGE(PG8_SB(0, 0), cB, voffB); PG8_STAGE(PG8_SB(0, 1), cB + hstep, voffB); PG8_STAGE(PG8_SA(0, 0), cA, voffA); PG8_STAGE(PG8_SA(0, 1), cA + hstep, voffA);
        if (wr == 1) PG8_BAR;
        PG8_WAIT_V(2); PG8_BAR;
        PG8_STAGE(PG8_SB(1, 0), cB + kstep, voffB); PG8_STAGE(PG8_SA(1, 0), cA + kstep, voffA); PG8_STAGE(PG8_SB(1, 1), cB + hstep + kstep, voffB);
        PG8_WAIT_V(6); PG8_BAR;
    } else {
        PG8_STAGE(PG8_SB(0, 0), cB, voffB); PG8_STAGE(PG8_SA(0, 0), cA, voffA); PG8_STAGE(PG8_SB(0, 1), cB + hstep, voffB); PG8_STAGE(PG8_SA(0, 1), cA + hstep, voffA);
        if (wr == 1) PG8_BAR;
        PG8_WAIT_V(4); PG8_BAR;
        PG8_STAGE(PG8_SB(1, 0), cB + kstep, voffB); PG8_STAGE(PG8_SA(1, 0), cA + kstep, voffA); PG8_STAGE(PG8_SB(1, 1), cB + hstep + kstep, voffB);
        PG8_WAIT_V(6); PG8_BAR;
    }
    for (;;) {
        const bool has_next = S.next(ui + 1, nxt);
        size_t oan_ = 0, obn_ = 0; int ntn_ = nt; if (has_next) krange2(g, nxt, K, oan_, obn_, ntn_);
        const char* nA = has_next ? (const char*)g.A + (size_t)nxt.pm * tstep + oan_ : cA; const char* nB = has_next ? (const char*)g.Bt + (size_t)nxt.pn * tstep + obn_ : cB;
        for (int t = 0; t < nt; t += 2) {
            const bool last = (t == nt - 2);
            const char* a1 = cA + (size_t)(t + 1) * kstep;
            const char* a2 = last ? nA : cA + (size_t)(t + 2) * kstep; const char* b2 = last ? nB : cB + (size_t)(t + 2) * kstep;
            const char* a3 = a2 + kstep; const char* b3 = b2 + kstep;
            if (last && has_next) S.a_ready(nxt);
            if constexpr (SP2) {
            PG8_LDB(B0, 0, 0); PG8_LDB(B1, 0, 1); PG8_SCHED; PG8_LDA(At, 0, 0); PG8_STAGE(PG8_SA(1, 1), a1 + hstep, voffA);
            PG8_WAIT_V(8); PG8_WAIT_L(0); PG8_BAR; PG8_MMA(0, 0, At, B0); PG8_MMA(0, 1, At, B1); PG8_BAR; PG8_SCHED;
            PG8_LDA(At, 0, 1); PG8_STAGE(PG8_SB(0, 0), b2, voffB); PG8_STAGE(PG8_SB(0, 1), b2 + hstep, voffB); PG8_STAGE(PG8_SA(0, 0), a2, voffA);
            PG8_WAIT_V(8); PG8_WAIT_L(0); PG8_BAR; PG8_MMA(1, 0, At, B0); PG8_MMA(1, 1, At, B1); PG8_BAR; PG8_SCHED;
            PG8_LDB(B0, 1, 0); PG8_LDB(B1, 1, 1); PG8_SCHED; PG8_LDA(At, 1, 0); PG8_STAGE(PG8_SA(0, 1), a2 + hstep, voffA);
            PG8_WAIT_V(8); PG8_WAIT_L(0); PG8_BAR; PG8_MMA(0, 0, At, B0); PG8_MMA(0, 1, At, B1); PG8_BAR; PG8_SCHED;
            PG8_LDA(At, 1, 1); PG8_STAGE(PG8_SB(1, 0), b3, voffB); PG8_STAGE(PG8_SB(1, 1), b3 + hstep, voffB); PG8_STAGE(PG8_SA(1, 0), a3, voffA);
            PG8_WAIT_V(8); PG8_WAIT_L(0); PG8_BAR; PG8_MMA(1, 0, At, B0); PG8_MMA(1, 1, At, B1); PG8_BAR; PG8_SCHED;
            } else {
            PG8_LDB(B0, 0, 0); PG8_SCHED; PG8_LDA(At, 0, 0); PG8_STAGE(PG8_SA(1, 1), a1 + hstep, voffA);
            PG8_WAIT_L(8); PG8_BAR; PG8_WAIT_L(0); PG8_MMA(0, 0, At, B0); PG8_BAR; PG8_SCHED;
            PG8_LDB(B1, 0, 1); PG8_STAGE(PG8_SB(0, 0), b2, voffB);
            PG8_BAR; PG8_WAIT_L(0); PG8_MMA(0, 1, At, B1); PG8_BAR;
            PG8_LDA(At, 0, 1); PG8_STAGE(PG8_SA(0, 0), a2, voffA);
            PG8_BAR; PG8_WAIT_L(0); PG8_MMA(1, 0, At, B0); PG8_BAR; PG8_SCHED;
            PG8_STAGE(PG8_SB(0, 1), b2 + hstep, voffB);
            PG8_WAIT_V(6); PG8_BAR; PG8_MMA(1, 1, At, B1); PG8_BAR;
            PG8_LDB(B0, 1, 0); PG8_SCHED; PG8_LDA(At, 1, 0); PG8_STAGE(PG8_SA(0, 1), a2 + hstep, voffA);
            PG8_WAIT_L(8); PG8_BAR; PG8_WAIT_L(0); PG8_MMA(0, 0, At, B0); PG8_BAR; PG8_SCHED;
            PG8_LDB(B1, 1, 1); PG8_STAGE(PG8_SB(1, 0), b3, voffB);
            PG8_BAR; PG8_WAIT_L(0); PG8_MMA(0, 1, At, B1); PG8_BAR;
            PG8_LDA(At, 1, 1); PG8_STAGE(PG8_SA(1, 0), a3, voffA);
            PG8_BAR; PG8_WAIT_L(0); PG8_MMA(1, 0, At, B0); PG8_BAR; PG8_SCHED;
            PG8_STAGE(PG8_SB(1, 1), b3 + hstep, voffB);
            PG8_WAIT_V(6); PG8_BAR; PG8_MMA(1, 1, At, B1); PG8_BAR;
            }
        }
        if constexpr (ALIGN_EPI) { if (wr == 0) PG8_BAR; }
        if constexpr (!Epi::AFTER_DRAIN) { E(acc, cur, wr, wc, fr, fq); S.done(cur); }
        if (!has_next) break;
#pragma unroll
        for (int a = 0; a < 2; ++a)
#pragma unroll
            for (int b = 0; b < 2; ++b)
#pragma unroll
                for (int m = 0; m < 4; ++m)
#pragma unroll
                    for (int n = 0; n < 2; ++n) acc[a][b][m][n] = (f32x4){0.f, 0.f, 0.f, 0.f};
        cur = nxt; cA = nA; cB = nB; nt = ntn_; ++ui;
        if constexpr (ALIGN_EPI) { if (wr == 1) PG8_BAR; }
    }
    PG8_WAIT_V(0);
    if constexpr (!ALIGN_EPI) { if (wr == 0) PG8_BAR; }
    PG8_BAR;
    if constexpr (Epi::AFTER_DRAIN) { E.fused(acc, cur, wr, wc, fr, fq, lds, wid, lane); S.done(cur); }
#undef PG8_SA
#undef PG8_SB
#undef PG8_STAGE
#undef PG8_LDA
#undef PG8_LDB
#undef PG8_MMA
#undef PG8_WAIT_V
#undef PG8_WAIT_L
#undef PG8_BAR
#undef PG8_SCHED
}
}

#define LAS __attribute__((address_space(3)))
typedef unsigned short bf16;
typedef unsigned v4u __attribute__((ext_vector_type(4)));
typedef unsigned v2u __attribute__((ext_vector_type(2)));
typedef float f32x4 __attribute__((ext_vector_type(4)));
typedef float f32x16 __attribute__((ext_vector_type(16)));
typedef short bf16x8 __attribute__((ext_vector_type(8)));
typedef short s16x4 __attribute__((ext_vector_type(4)));
typedef _Float16 h8 __attribute__((ext_vector_type(8)));

typedef float f32x2_t __attribute__((ext_vector_type(2))); typedef __bf16 bf16x2_t __attribute__((ext_vector_type(2)));
__device__ __forceinline__ unsigned pk2(float lo, float hi) { f32x2_t v = {lo, hi}; bf16x2_t b = __builtin_convertvector(v, bf16x2_t); return __builtin_bit_cast(unsigned, b); }
__device__ __forceinline__ float bflo(unsigned u) { return __uint_as_float(u << 16); }
__device__ __forceinline__ float bfhi(unsigned u) { return __uint_as_float(u & 0xffff0000u); }
__device__ __forceinline__ float bf2f(bf16 b) { return __uint_as_float(((unsigned)b) << 16); }
__device__ __forceinline__ bf16 f2bf(float f) { return (bf16)(pk2(f, 0.f) & 0xffffu); }
#define UNPACK8(v, f) do { f[0] = bflo(v.x); f[1] = bfhi(v.x); f[2] = bflo(v.y); f[3] = bfhi(v.y); f[4] = bflo(v.z); f[5] = bfhi(v.z); f[6] = bflo(v.w); f[7] = bfhi(v.w); } while (0)
#define PACK8(o, f) do { o.x = pk2(f[0], f[1]); o.y = pk2(f[2], f[3]); o.z = pk2(f[4], f[5]); o.w = pk2(f[6], f[7]); } while (0)
__device__ __forceinline__ int ltid() { int t = threadIdx.x; asm volatile("" : "+v"(t)); return t; }
__device__ __forceinline__ float sigmoidf_(float x) { return __builtin_amdgcn_rcpf(1.f + __expf(-x)); }
__device__ __forceinline__ float wave_sum(float v) {
#pragma unroll
    for (int o = 1; o < 64; o <<= 1) v += __shfl_xor(v, o);
    return v;
}
__device__ __forceinline__ float sum8(float v) { v += __shfl_xor(v, 1); v += __shfl_xor(v, 2); v += __shfl_xor(v, 4); return v; }

constexpr int DM = 1024, DIN = 6944, DPROJ = 4096, NMAIN = 3872, DGATE = 3072, DFF = 2816;
constexpr int NTOK = 131072, NPROMPT = 65536;
constexpr int C_KA = 512, C_VA = 1024, C_CQ = 1536, C_CKV = 1792, C_KR = 1920, C_RW = 1952;
constexpr float LOG2E = 1.4426950408889634f;
constexpr float NA_QS = 0.125f * LOG2E;
constexpr float MLA_QS = 0.10206207261596575f * LOG2E;
constexpr float NEPS = 1e-6f;

constexpr size_t MiB = 1u << 20;
constexpr size_t WS_CTL = 0, CTL_BYTES = 1 * MiB;
constexpr size_t W_OFF = 1 * MiB, W_STRIDE = 39 * MiB;
constexpr size_t WO_IN = 0, WO_G = 8 * MiB, WO_BR = 14 * MiB, WO_OUT = 17 * MiB, WO_GU = 19 * MiB, WO_DN = 30 * MiB, WO_MU = 35 * MiB + 512 * 1024, WO_RU = 37 * MiB;
constexpr size_t ACT_OFF = 80 * MiB;
constexpr size_t TOKB_H = 2048, TOKB_P = 8192, TOKB_M = 3584, TOKB_A = 1536, TOKB_S = 9216, TOKB_Y = 3072, TOKB_Z = 2048;
constexpr size_t TOKB = TOKB_H + TOKB_P + TOKB_M + TOKB_A + TOKB_S + TOKB_Y + TOKB_Z;
static_assert(WO_MU + 1792 * 384 * 2 <= WO_RU && WO_RU + 2560 * 384 * 2 <= W_STRIDE && WO_DN + 1024 * 2816 * 2 <= WO_MU && WO_GU + 5632 * 1024 * 2 <= WO_DN, "weight map");
constexpr int LDS_RING = 131072, LDS_BYTES = LDS_RING + 1024;

struct Params { const float* in[33]; float* out; unsigned char* ws; int G; int Tg; };
typedef const __attribute__((address_space(4))) Params* CP;

constexpr size_t WS_PARAMS = 512 * 1024;
struct Reg { unsigned char* ws; size_t Tg;
    __device__ __forceinline__ bf16* RH() const { return (bf16*)(ws + ACT_OFF); }
    __device__ __forceinline__ bf16* RP() const { return (bf16*)(ws + ACT_OFF + Tg * TOKB_H); }
    __device__ __forceinline__ bf16* RM() const { return (bf16*)(ws + ACT_OFF + Tg * (TOKB_H + TOKB_P)); }
    __device__ __forceinline__ bf16* RA() const { return (bf16*)(ws + ACT_OFF + Tg * (TOKB_H + TOKB_P + TOKB_M)); }
    __device__ __forceinline__ _Float16* RS() const { return (_Float16*)(ws + ACT_OFF + Tg * (TOKB_H + TOKB_P + TOKB_M + TOKB_A)); }
    __device__ __forceinline__ bf16* RY() const { return (bf16*)(ws + ACT_OFF + Tg * (TOKB_H + TOKB_P + TOKB_M + TOKB_A + TOKB_S)); }
    __device__ __forceinline__ bf16* RZ() const { return (bf16*)(ws + ACT_OFF + Tg * (TOKB_H + TOKB_P + TOKB_M + TOKB_A + TOKB_S + TOKB_Y)); }
};
enum { GM_IN = 0, GM_MU = 1, GM_RU = 2, GM_GATE = 3, GM_BR0 = 4, GM_BR1 = 5, GM_BR2 = 6, GM_OUT = 7, GM_GU = 8, GM_DN = 9 };
#define EPI_FENCE() asm volatile("" ::: "memory")
struct EpiUni {
    static constexpr bool PERM = true, AFTER_DRAIN = false;
    CP pp; int id, l, g;
    __device__ __forceinline__ void operator()(const pg8::f32x4 (&acc)[2][2][4][2], const pg8::Unit& u, int wr, int wc, int fr, int fq) const {
        CP q = pp; asm volatile("" : "+s"(q));
        const int Tg = q->Tg; const Reg R{q->ws, (size_t)Tg}; const size_t asz = (size_t)Tg * 512;
        const int row0 = u.pm * 256 + wr * 64 + fr, col0 = u.pn * 256 + wc * 32 + 8 * fq;
        switch (id) {
        case GM_IN: case GM_MU: {
            bf16* O = (id == GM_IN) ? R.RP() : R.RM(); const int ldc = (id == GM_IN) ? DPROJ : 1792;
#pragma unroll
            for (int ai = 0; ai < 2; ++ai)
#pragma unroll
                for (int m = 0; m < 4; ++m) { bf16* rp = O + (size_t)(row0 + ai * 128 + m * 16) * ldc + col0;
#pragma unroll
                    for (int bj = 0; bj < 2; ++bj) { const f32x4 v0 = acc[ai][bj][m][0], v1 = acc[ai][bj][m][1]; v4u w; w.x = pk2(v0[0], v0[1]); w.y = pk2(v0[2], v0[3]); w.z = pk2(v1[0], v1[1]); w.w = pk2(v1[2], v1[3]);
                        *(v4u*)(rp + bj * 128) = w; } }
        } break;
        case GM_GATE: {
            bf16* O = R.RP(); const float* bias = q->in[4] + l * DGATE + col0;
#pragma unroll
            for (int bj = 0; bj < 2; ++bj) { const f32x4 b0 = *(const f32x4*)(bias + bj * 128), b1 = *(const f32x4*)(bias + bj * 128 + 4);
#pragma unroll
                for (int ai = 0; ai < 2; ++ai)
#pragma unroll
                    for (int m = 0; m < 4; ++m) { const f32x4 v0 = acc[ai][bj][m][0] + b0, v1 = acc[ai][bj][m][1] + b1; float f[8];
#pragma unroll
                        for (int i = 0; i < 4; ++i) { f[i] = sigmoidf_(v0[i]); f[4 + i] = sigmoidf_(v1[i]); }
                        v4u w; PACK8(w, f); *(v4u*)(O + (size_t)(row0 + ai * 128 + m * 16) * DGATE + col0 + bj * 128) = w; }
                EPI_FENCE(); }
        } break;
        case GM_GU: {
            bf16* O = R.RP(); const int hc = u.pn * 128 + wc * 32 + 8 * fq;
#pragma unroll
            for (int ai = 0; ai < 2; ++ai)
#pragma unroll
                for (int m = 0; m < 4; ++m) { float f[8];
#pragma unroll
                    for (int n = 0; n < 2; ++n)
#pragma unroll
                        for (int i = 0; i < 4; ++i) { const float gt = acc[ai][0][m][n][i], up = acc[ai][1][m][n][i]; f[4 * n + i] = gt * sigmoidf_(gt) * up; }
                    v4u w; PACK8(w, f); *(v4u*)(O + (size_t)(row0 + ai * 128 + m * 16) * DFF + hc) = w; }
        } break;
        case GM_BR0: case GM_BR1: case GM_BR2: {
            bf16* O = R.RM(); const bf16* Gt = R.RP() + u.aux * 1024; const bool first = (u.aux == 0);
#pragma unroll
            for (int ai = 0; ai < 2; ++ai)
#pragma unroll
                for (int m = 0; m < 4; ++m) { const size_t row = (size_t)(row0 + ai * 128 + m * 16);
#pragma unroll
                    for (int bj = 0; bj < 2; ++bj) { const int col = col0 + bj * 128; const v4u gv = *(const v4u*)(Gt + row * DGATE + col); float gg[8], f[8]; UNPACK8(gv, gg);
#pragma unroll
                        for (int i = 0; i < 4; ++i) { f[i] = gg[i] * acc[ai][bj][m][0][i]; f[4 + i] = gg[4 + i] * acc[ai][bj][m][1][i]; }
                        if (!first) { const v4u ov = *(const v4u*)(O + row * DM + col); float o[8]; UNPACK8(ov, o);
#pragma unroll
                            for (int i = 0; i < 8; ++i) f[i] += o[i]; }
                        v4u w; PACK8(w, f); *(v4u*)(O + row * DM + col) = w; }
                    EPI_FENCE(); }
        } break;
        case GM_OUT: case GM_DN: {
            const int t0 = g * Tg; float* xout = q->out + (size_t)t0 * DM;
            const float* xin = (id == GM_OUT && l == 0) ? ((t0 < NPROMPT) ? q->in[0] + (size_t)t0 * DM : q->in[1] + (size_t)(t0 - NPROMPT) * DM) : xout;
#pragma unroll
            for (int ai = 0; ai < 2; ++ai)
#pragma unroll
                for (int m = 0; m < 4; ++m) { const size_t off = (size_t)(row0 + ai * 128 + m * 16) * DM + col0;
#pragma unroll
                    for (int bj = 0; bj < 2; ++bj)
#pragma unroll
                        for (int n = 0; n < 2; ++n) { const f32x4 b = *(const f32x4*)(xin + off + bj * 128 + n * 4); *(f32x4*)(xout + off + bj * 128 + n * 4) = b + acc[ai][bj][m][n]; }
                    EPI_FENCE(); }
        } break;
        case GM_RU: {
            _Float16* rs = R.RS(); const _Float16* ktmp = (const _Float16*)R.RZ(); bf16* gout = R.RY() + 2 * asz;
            const int type = u.pn >> 1; const int cl0 = (u.pn & 1) * 256 + wc * 32 + 8 * fq;
            const float* w0 = q->in[17] + l * 1024; const float* a0 = q->in[19] + l * 1024; const float* ka = q->in[23] + l * 512;
#pragma unroll
            for (int ai = 0; ai < 2; ++ai)
#pragma unroll
                for (int m = 0; m < 4; ++m) { const size_t row = (size_t)(row0 + ai * 128 + m * 16);
#pragma unroll
                    for (int bj = 0; bj < 2; ++bj) { const int cl = cl0 + bj * 128; float f[8];
#pragma unroll
                        for (int i = 0; i < 4; ++i) { f[i] = acc[ai][bj][m][0][i]; f[4 + i] = acc[ai][bj][m][1][i]; }
                        if (type < 2) {
                            h8 o;
#pragma unroll
                            for (int i = 0; i < 8; ++i) o[i] = (_Float16)__expf(-0.6065306597126334f * sigmoidf_(f[i] + w0[type * 512 + cl + i]));
                            *(h8*)(rs + (size_t)(3 + type) * asz + row * 512 + cl) = o;
                        } else if (type < 4) {
                            const int d = type - 2; const h8 kv = *(const h8*)(ktmp + row * 512 + cl), kkv = *(const h8*)(rs + (size_t)2 * asz + row * 512 + cl); h8 o1, o2;
#pragma unroll
                            for (int i = 0; i < 8; ++i) { const float a = sigmoidf_(f[i] + a0[d * 512 + cl + i]); o1[i] = (_Float16)((float)kkv[i] * a); o2[i] = (_Float16)((float)kv[i] * (1.f + (a - 1.f) * ka[cl + i])); }
                            *(h8*)(rs + (size_t)(5 + d) * asz + row * 512 + cl) = o1; *(h8*)(rs + (size_t)(7 + d) * asz + row * 512 + cl) = o2;
                        } else { v4u w; PACK8(w, f); *(v4u*)(gout + row * 512 + cl) = w; }
                        EPI_FENCE(); } }
        } break;
        default: break;
        }
    }
};

__device__ __forceinline__ void transpose_item(const float* W, int ldw, int N, bf16* WT, int ldt, int koff, int row_off, int mode, LAS float* scr, int item, int lane) {
    const int nblk = N / 32, kb = item / nblk, nb = item % nblk, k0 = 64 * kb, n0 = 32 * nb;
    float tv[32];
#pragma unroll
    for (int i = 0; i < 32; ++i) { const int kk = 2 * i + (lane >> 5); tv[i] = W[(size_t)(k0 + kk) * ldw + n0 + (lane & 31)]; }
#pragma unroll
    for (int i = 0; i < 32; ++i) { const int kk = 2 * i + (lane >> 5); scr[kk * 33 + (lane & 31)] = tv[i]; }
    asm volatile("s_waitcnt lgkmcnt(0)" ::: "memory");
    const int c = lane & 7;
#pragma unroll
    for (int j = 0; j < 4; ++j) { const int n = (lane >> 3) + 8 * j; const LAS float* s = scr + (8 * c) * 33 + n;
        v4u o; o.x = pk2(s[0 * 33], s[1 * 33]); o.y = pk2(s[2 * 33], s[3 * 33]); o.z = pk2(s[4 * 33], s[5 * 33]); o.w = pk2(s[6 * 33], s[7 * 33]);
        const int nn = n0 + n; const int drow = mode ? ((nn >> 7) * 256 + row_off + (nn & 127)) : (row_off + nn);
        *(v4u*)(WT + (size_t)drow * ldt + koff + k0 + 8 * c) = o; }
    asm volatile("s_waitcnt lgkmcnt(0)" ::: "memory");
}
__device__ __forceinline__ void transpose_job(const float* W, int ldw, int K, int N, bf16* WT, int ldt, int koff, int row_off, int mode, LAS float* scr, int gw, int ngw, int lane) {
    const int nitems = (K / 64) * (N / 32);
    for (int it = gw; it < nitems; it += ngw) transpose_item(W, ldw, N, WT, ldt, koff, row_off, mode, scr, it, lane);
}
__device__ __forceinline__ void zero_bytes(unsigned char* p, size_t nbytes, size_t gtid, size_t ngt) {
    const v4u z = {0u, 0u, 0u, 0u};
    for (size_t i = gtid; i < nbytes / 16; i += ngt) ((v4u*)p)[i] = z;
}

__device__ __forceinline__ void phase_norm(const float* x, const float* g, bf16* hb, int Tg, int gw, int ngw, int lane) {
    for (int t = gw; t < Tg; t += 2 * ngw) {
        const int t2 = (t + ngw < Tg) ? t + ngw : t;
        const f32x4* xa = (const f32x4*)(x + (size_t)t * DM) + lane; const f32x4* xb = (const f32x4*)(x + (size_t)t2 * DM) + lane; f32x4 va[4], vb[4]; float sa = 0.f, sb = 0.f;
#pragma unroll
        for (int j = 0; j < 4; ++j) { va[j] = xa[64 * j]; vb[j] = xb[64 * j]; }
#pragma unroll
        for (int j = 0; j < 4; ++j) { sa += (va[j].x * va[j].x + va[j].y * va[j].y) + (va[j].z * va[j].z + va[j].w * va[j].w); sb += (vb[j].x * vb[j].x + vb[j].y * vb[j].y) + (vb[j].z * vb[j].z + vb[j].w * vb[j].w); }
        const float ia = rsqrtf(wave_sum(sa) * (1.f / DM) + NEPS), ib = rsqrtf(wave_sum(sb) * (1.f / DM) + NEPS);
        v2u* oa = (v2u*)(hb + (size_t)t * DM) + lane; v2u* ob = (v2u*)(hb + (size_t)t2 * DM) + lane;
#pragma unroll
        for (int j = 0; j < 4; ++j) { const f32x4 gg = ((const f32x4*)g)[lane + 64 * j]; v2u o;
            o.x = pk2(va[j].x * ia * gg.x, va[j].y * ia * gg.y); o.y = pk2(va[j].z * ia * gg.z, va[j].w * ia * gg.w); oa[64 * j] = o;
            o.x = pk2(vb[j].x * ib * gg.x, vb[j].y * ib * gg.y); o.y = pk2(vb[j].z * ib * gg.z, vb[j].w * ib * gg.w); ob[64 * j] = o; }
    }
}

__device__ __forceinline__ void phase_post_proj(CP pp, int l, bf16* proj, bf16* mla_a, bf16* rw_a, _Float16* rs, _Float16* ktmp, size_t asz, int Tg, int L, int gw, int ngw, int lane) {
    const float* gq = pp->in[5] + l * 64; const float* gk = pp->in[6] + l * 64;
    const float* gcq = pp->in[9] + l * 256; const float* gckv = pp->in[10] + l * 128;
    const float* mu = pp->in[16] + l * 1920; const float* kkw = pp->in[22] + l * 512;
    for (int t = gw; t < Tg; t += ngw) {
        bf16* row = proj + (size_t)t * DPROJ; const int tpos = t % L;
        const bool hasp = tpos > 0, hasn = tpos < L - 1;
        v4u qv = *(const v4u*)(row + 8 * lane), kv = *(const v4u*)(row + C_KA + 8 * lane); const v2u cv = *(const v2u*)(row + C_CQ + 4 * lane); const unsigned kvv = *(const unsigned*)(row + C_CKV + 2 * lane);
        v4u rwc[4], rwp[4], rwn[4];
#pragma unroll
        for (int it = 0; it < 4; ++it) { const int c0 = (it * 64 + lane) * 8; const v4u z = {0u, 0u, 0u, 0u}; rwc[it] = z; rwp[it] = z; rwn[it] = z;
            if (it < 3 || lane < 48) { const bf16* src = row + C_RW + c0; rwc[it] = *(const v4u*)src; if (hasp) rwp[it] = *(const v4u*)(src - DPROJ); if (hasn) rwn[it] = *(const v4u*)(src + DPROJ); } }
        {
            const int gi = 8 * (lane & 7);
            float f[8]; UNPACK8(qv, f); float ss = 0.f;
#pragma unroll
            for (int i = 0; i < 8; ++i) ss += f[i] * f[i];
            float inv = rsqrtf(sum8(ss) * (1.f / 64.f) + NEPS) * NA_QS;
#pragma unroll
            for (int i = 0; i < 8; ++i) f[i] = f[i] * inv * gq[gi + i];
            PACK8(qv, f); *(v4u*)(row + 8 * lane) = qv;
            UNPACK8(kv, f); ss = 0.f;
#pragma unroll
            for (int i = 0; i < 8; ++i) ss += f[i] * f[i];
            inv = rsqrtf(sum8(ss) * (1.f / 64.f) + NEPS);
#pragma unroll
            for (int i = 0; i < 8; ++i) f[i] = f[i] * inv * gk[gi + i];
            PACK8(kv, f); *(v4u*)(row + C_KA + 8 * lane) = kv;
        }
        {
            float a0 = bflo(cv.x), a1 = bfhi(cv.x), a2 = bflo(cv.y), a3 = bfhi(cv.y);
            float inv = rsqrtf(wave_sum(a0 * a0 + a1 * a1 + a2 * a2 + a3 * a3) * (1.f / 256.f) + NEPS);
            const f32x4 gg = *(const f32x4*)(gcq + 4 * lane); v2u o; o.x = pk2(a0 * inv * gg.x, a1 * inv * gg.y); o.y = pk2(a2 * inv * gg.z, a3 * inv * gg.w);
            *(v2u*)(mla_a + (size_t)t * 384 + 4 * lane) = o;
            a0 = bflo(kvv); a1 = bfhi(kvv);
            inv = rsqrtf(wave_sum(a0 * a0 + a1 * a1) * (1.f / 128.f) + NEPS);
            *(unsigned*)(mla_a + (size_t)t * 384 + 256 + 2 * lane) = pk2(a0 * inv * gckv[2 * lane], a1 * inv * gckv[2 * lane + 1]);
        }
#pragma unroll
        for (int it = 0; it < 4; ++it) {
            const int c0 = (it * 64 + lane) * 8;
            if (it < 3 || lane < 48) {
                float pc[8], pp[8], pn[8]; UNPACK8(rwc[it], pc); UNPACK8(rwp[it], pp); UNPACK8(rwn[it], pn);
#pragma unroll
                for (int i = 0; i < 8; ++i) pc[i] = pc[i] + mu[c0 + i] * (0.5f * (pp[i] + pn[i]) - pc[i]);
                if (it == 0) { h8 o;
#pragma unroll
                    for (int i = 0; i < 8; ++i) o[i] = (_Float16)pc[i];
                    *(h8*)(rs + (size_t)t * 512 + c0) = o; }
                else if (it == 1) { const int c = c0 - 512; h8 o; float kk[8]; float ss = 0.f;
#pragma unroll
                    for (int i = 0; i < 8; ++i) { o[i] = (_Float16)pc[i]; kk[i] = pc[i] * kkw[c + i]; ss += kk[i] * kk[i]; }
                    *(h8*)(ktmp + (size_t)t * 512 + c) = o;
                    const float inv = rsqrtf(sum8(ss) + 1e-12f);
#pragma unroll
                    for (int i = 0; i < 8; ++i) o[i] = (_Float16)(kk[i] * inv);
                    *(h8*)(rs + 2 * asz + (size_t)t * 512 + c) = o; }
                else if (it == 2) { const int c = c0 - 1024; h8 o;
#pragma unroll
                    for (int i = 0; i < 8; ++i) o[i] = (_Float16)pc[i];
                    *(h8*)(rs + asz + (size_t)t * 512 + c) = o; }
                else { const int c = c0 - 1536; float f[8];
#pragma unroll
                    for (int i = 0; i < 8; ++i) { const float x = pc[i]; f[i] = (c < 128) ? (1.f - 2.f * __builtin_amdgcn_rcpf(1.f + __expf(2.f * x))) : ((c < 256) ? x : sigmoidf_(x)); }
                    v4u w; PACK8(w, f); *(v4u*)(rw_a + (size_t)t * 384 + c) = w; }
            }
        }
    }
}

__device__ __forceinline__ void phase_mla_post(CP pp, int l, bf16* mraw, const bf16* proj, bf16* mk, int Tg, int L, int gw, int ngw, int lane) {
    const float* gq = pp->in[13] + l * 96; const float* gk = pp->in[14] + l * 96;
    const int h = lane >> 3, sub = lane & 7, rs = sub & 3; const bool hasr = sub < 4;
    float gqn[8], gkn[8], gq1[4], gq2[4], gk1[4], gk2[4], invf[4];
#pragma unroll
    for (int e = 0; e < 8; ++e) { gqn[e] = gq[8 * sub + e]; gkn[e] = gk[8 * sub + e]; }
#pragma unroll
    for (int e = 0; e < 4; ++e) { gq1[e] = gq[64 + 4 * rs + e]; gq2[e] = gq[80 + 4 * rs + e]; gk1[e] = gk[64 + 4 * rs + e]; gk2[e] = gk[80 + 4 * rs + e];
        invf[e] = __expf(-(float)((4 * rs + e) & 7) * (9.210340371976184f / 8.f)); }
    for (int t = gw; t < Tg; t += ngw) {
        const int tpos = t % L; const float pos = (float)((rs < 2) ? (tpos >> 6) : (tpos & 63));
        bf16* mrow = mraw + (size_t)t * 1792; bf16* krow = mk + (size_t)t * 768;
        const v4u qv = *(const v4u*)(mrow + h * 96 + 8 * sub), kv = *(const v4u*)(mrow + 768 + h * 128 + 8 * sub);
        v2u q1 = {0u, 0u}, q2 = {0u, 0u}, k1 = {0u, 0u}, k2 = {0u, 0u};
        if (hasr) { q1 = *(const v2u*)(mrow + h * 96 + 64 + 4 * rs); q2 = *(const v2u*)(mrow + h * 96 + 80 + 4 * rs);
                    k1 = *(const v2u*)(proj + (size_t)t * DPROJ + C_KR + 4 * rs); k2 = *(const v2u*)(proj + (size_t)t * DPROJ + C_KR + 16 + 4 * rs); }
        float cs[4], sn[4];
#pragma unroll
        for (int e = 0; e < 4; ++e) { float rev = pos * invf[e] * 0.15915494309189535f; rev -= floorf(rev); cs[e] = __builtin_amdgcn_cosf(rev); sn[e] = __builtin_amdgcn_sinf(rev); }
        {   float f[8]; UNPACK8(qv, f); float a[4] = {bflo(q1.x), bfhi(q1.x), bflo(q1.y), bfhi(q1.y)}, b[4] = {bflo(q2.x), bfhi(q2.x), bflo(q2.y), bfhi(q2.y)};
            float ss = 0.f;
#pragma unroll
            for (int e = 0; e < 8; ++e) ss += f[e] * f[e];
#pragma unroll
            for (int e = 0; e < 4; ++e) ss += a[e] * a[e] + b[e] * b[e];
            const float inv = rsqrtf(sum8(ss) * (1.f / 96.f) + NEPS) * MLA_QS;
#pragma unroll
            for (int e = 0; e < 8; ++e) f[e] = f[e] * inv * gqn[e];
            v4u o; PACK8(o, f); *(v4u*)(mrow + h * 96 + 8 * sub) = o;
            if (hasr) { float r1[4], r2[4];
#pragma unroll
                for (int e = 0; e < 4; ++e) { const float x1 = a[e] * inv * gq1[e], x2 = b[e] * inv * gq2[e]; r1[e] = x1 * cs[e] - x2 * sn[e]; r2[e] = x1 * sn[e] + x2 * cs[e]; }
                v2u o1, o2; o1.x = pk2(r1[0], r1[1]); o1.y = pk2(r1[2], r1[3]); o2.x = pk2(r2[0], r2[1]); o2.y = pk2(r2[2], r2[3]);
                *(v2u*)(mrow + h * 96 + 64 + 4 * rs) = o1; *(v2u*)(mrow + h * 96 + 80 + 4 * rs) = o2; } }
        {   float f[8]; UNPACK8(kv, f); float a[4] = {bflo(k1.x), bfhi(k1.x), bflo(k1.y), bfhi(k1.y)}, b[4] = {bflo(k2.x), bfhi(k2.x), bflo(k2.y), bfhi(k2.y)};
            float ss = 0.f;
#pragma unroll
            for (int e = 0; e < 8; ++e) ss += f[e] * f[e];
#pragma unroll
            for (int e = 0; e < 4; ++e) ss += a[e] * a[e] + b[e] * b[e];
            const float inv = rsqrtf(sum8(ss) * (1.f / 96.f) + NEPS);
#pragma unroll
            for (int e = 0; e < 8; ++e) f[e] = f[e] * inv * gkn[e];
            v4u o; PACK8(o, f); *(v4u*)(krow + h * 96 + 8 * sub) = o;
            if (hasr) { float r1[4], r2[4];
#pragma unroll
                for (int e = 0; e < 4; ++e) { const float x1 = a[e] * inv * gk1[e], x2 = b[e] * inv * gk2[e]; r1[e] = x1 * cs[e] - x2 * sn[e]; r2[e] = x1 * sn[e] + x2 * cs[e]; }
                v2u o1, o2; o1.x = pk2(r1[0], r1[1]); o1.y = pk2(r1[2], r1[3]); o2.x = pk2(r2[0], r2[1]); o2.y = pk2(r2[2], r2[3]);
                *(v2u*)(krow + h * 96 + 64 + 4 * rs) = o1; *(v2u*)(krow + h * 96 + 80 + 4 * rs) = o2; } }
    }
}

__device__ __forceinline__ void phase_rw_post(CP pp, int l, const _Float16* rs, size_t asz, const bf16* yfb, bf16* yc, int Tg, int gw, int ngw, int lane) {
    const float* lnw = pp->in[25] + l * 512 + 8 * lane; const float* lnb = pp->in[26] + l * 512 + 8 * lane; const float* rk = pp->in[24] + l * 512 + 8 * lane;
    float lw[8], lb[8], rkk[8];
#pragma unroll
    for (int i = 0; i < 8; ++i) { lw[i] = lnw[i]; lb[i] = lnb[i]; rkk[i] = rk[i]; }
    for (int t = gw; t < Tg; t += 2 * ngw) {
        const int t2 = (t + ngw < Tg) ? t + ngw : t;
        const size_t oa = (size_t)t * 512 + 8 * lane, ob = (size_t)t2 * 512 + 8 * lane;
        const v4u fa = *(const v4u*)(yfb + oa), ba = *(const v4u*)(yfb + asz + oa), fb = *(const v4u*)(yfb + ob), bb = *(const v4u*)(yfb + asz + ob);
        const h8 ra = *(const h8*)(rs + oa), va = *(const h8*)(rs + asz + oa), k0a = *(const h8*)(rs + 7 * asz + oa), k1a = *(const h8*)(rs + 8 * asz + oa);
        const h8 rb = *(const h8*)(rs + ob), vb = *(const h8*)(rs + asz + ob), k0b = *(const h8*)(rs + 7 * asz + ob), k1b = *(const h8*)(rs + 8 * asz + ob);
        const v4u ga = *(const v4u*)(yc + oa), gb = *(const v4u*)(yc + ob);
#define RWP_ONE(F_, B_, R_, V_, K0_, K1_, G_, O_) do { float y[8], f[8]; UNPACK8(F_, y); UNPACK8(B_, f); float s = 0.f; \
        _Pragma("unroll") for (int i = 0; i < 8; ++i) { y[i] += f[i]; s += y[i]; } \
        const float mean = sum8(s) * (1.f / 64.f); float q = 0.f; \
        _Pragma("unroll") for (int i = 0; i < 8; ++i) { y[i] -= mean; q += y[i] * y[i]; } \
        const float rstd = rsqrtf(sum8(q) * (1.f / 64.f) + 64e-5f); float b = 0.f; \
        _Pragma("unroll") for (int i = 0; i < 8; ++i) b += (float)R_[i] * ((float)K0_[i] + (float)K1_[i]) * rkk[i]; \
        b = sum8(b); UNPACK8(G_, f); \
        _Pragma("unroll") for (int i = 0; i < 8; ++i) f[i] = (y[i] * rstd * lw[i] + lb[i] + b * (float)V_[i]) * f[i]; \
        v4u w; PACK8(w, f); *(v4u*)(yc + (O_)) = w; } while (0)
        RWP_ONE(fa, ba, ra, va, k0a, k1a, ga, oa);
        if (t2 != t) RWP_ONE(fb, bb, rb, vb, k0b, k1b, gb, ob);
#undef RWP_ONE
    }
}

#define GAS __attribute__((address_space(1)))
typedef float f2 __attribute__((ext_vector_type(2)));
#define DPP_ADD(x, ctrl) ((x) + __builtin_bit_cast(float, __builtin_amdgcn_update_dpp(0, __builtin_bit_cast(int, (x)), (ctrl), 0xF, 0xF, true)))
__device__ __forceinline__ float red8(float x) { x = DPP_ADD(x, 0xB1); x = DPP_ADD(x, 0x4E); x = DPP_ADD(x, 0x141); return x; }
constexpr int SCH = 32, SBUF = 6 * SCH * 256;
__device__ __forceinline__ void scan_unit(int u, int L, const _Float16* rs, size_t asz, bf16* yfb, LAS unsigned char* lds) {
    const int tid = ltid(); const int lane = tid & 63, w = tid >> 6, vr = lane >> 3, ko = lane & 7;
    const int dir = u & 1, sh = u >> 1, h = sh & 7, s = sh >> 3;
    const int kA = tid >> 8, lj = (tid >> 3) & 31, lp = tid & 7;
    const size_t tok0 = (size_t)s * L + (dir ? (L - 1 - lj) : lj);
    const long tstep = dir ? -(long)SCH * 512 : (long)SCH * 512;
    const size_t eoff = tok0 * 512 + h * 64 + lp * 8;
    const GAS _Float16* g0 = (const GAS _Float16*)(rs + (size_t)(kA ? 2 : 0) * asz + eoff);
    const GAS _Float16* g1 = (const GAS _Float16*)(rs + (size_t)(kA ? 5 + dir : 3 + dir) * asz + eoff);
    const GAS _Float16* g2 = (const GAS _Float16*)(rs + (size_t)(kA ? 1 : 7 + dir) * asz + eoff);
    const int ld0 = (((0 + kA) * SCH + lj) * 64 + lp * 8) * 4, ld1 = (((2 + kA) * SCH + lj) * 64 + lp * 8) * 4, ld2 = (((4 + kA) * SCH + lj) * 64 + lp * 8) * 4;
    GAS bf16* py = (GAS bf16*)(yfb + (size_t)dir * asz + ((size_t)s * L + (dir ? L - 1 : 0)) * 512 + h * 64 + 8 * w + vr);
    const long ystep = dir ? -512 : 512;
    const int rd = ko * 32, rdv = (5 * SCH * 64 + 8 * w + vr) * 4;
    f2 S[4];
#pragma unroll
    for (int i = 0; i < 4; ++i) S[i] = (f2){0.f, 0.f};
    h8 p0 = *(const GAS h8*)g0, p1 = *(const GAS h8*)g1, p2 = *(const GAS h8*)g2;
#define SCAN_PUT(bufo) do { f32x4 a, b; \
        a = (f32x4){(float)p0[0], (float)p0[1], (float)p0[2], (float)p0[3]}; b = (f32x4){(float)p0[4], (float)p0[5], (float)p0[6], (float)p0[7]}; *(LAS f32x4*)(lds + (bufo) + ld0) = a; *(LAS f32x4*)(lds + (bufo) + ld0 + 16) = b; \
        a = (f32x4){(float)p1[0], (float)p1[1], (float)p1[2], (float)p1[3]}; b = (f32x4){(float)p1[4], (float)p1[5], (float)p1[6], (float)p1[7]}; *(LAS f32x4*)(lds + (bufo) + ld1) = a; *(LAS f32x4*)(lds + (bufo) + ld1 + 16) = b; \
        a = (f32x4){(float)p2[0], (float)p2[1], (float)p2[2], (float)p2[3]}; b = (f32x4){(float)p2[4], (float)p2[5], (float)p2[6], (float)p2[7]}; *(LAS f32x4*)(lds + (bufo) + ld2) = a; *(LAS f32x4*)(lds + (bufo) + ld2 + 16) = b; } while (0)
    SCAN_PUT(0);
    __syncthreads();
    const int NC = L / SCH;
#pragma unroll 1
    for (int c = 0; c < NC; ++c) {
        const int cur = (c & 1) * SBUF;
        if (c + 1 < NC) { const long o = tstep * (long)(c + 1); p0 = *(const GAS h8*)(g0 + o); p1 = *(const GAS h8*)(g1 + o); p2 = *(const GAS h8*)(g2 + o); }
        LAS unsigned char* bp = lds + cur + rd;
        GAS bf16* pyc = py + ystep * (long)(c * SCH);
#pragma unroll 1
        for (int j0 = 0; j0 < SCH; j0 += 4) { float yv[4];
#pragma unroll
        for (int jj = 0; jj < 4; ++jj) { const int j = j0 + jj;
            const LAS unsigned char* q = bp + j * 256;
            const f32x4 r0 = *(const LAS f32x4*)(q), r1 = *(const LAS f32x4*)(q + 16);
            const f32x4 k0 = *(const LAS f32x4*)(q + SCH * 256), k1 = *(const LAS f32x4*)(q + SCH * 256 + 16);
            const f32x4 w0 = *(const LAS f32x4*)(q + 2 * SCH * 256), w1 = *(const LAS f32x4*)(q + 2 * SCH * 256 + 16);
            const f32x4 a0 = *(const LAS f32x4*)(q + 3 * SCH * 256), a1 = *(const LAS f32x4*)(q + 3 * SCH * 256 + 16);
            const f32x4 d0 = *(const LAS f32x4*)(q + 4 * SCH * 256), d1 = *(const LAS f32x4*)(q + 4 * SCH * 256 + 16);
            const float vv = *(const LAS float*)(lds + cur + rdv + j * 256);
            const f2 vv2 = (f2){vv, vv};
            f2 e0 = S[0] * w0.xy, e1 = S[1] * w0.zw, e2 = S[2] * w1.xy, e3 = S[3] * w1.zw;
            f2 pa = S[0] * k0.xy, pb = S[1] * k0.zw; pa = S[2] * k1.xy + pa; pb = S[3] * k1.zw + pb;
            e0 = d0.xy * vv2 + e0; e1 = d0.zw * vv2 + e1; e2 = d1.xy * vv2 + e2; e3 = d1.zw * vv2 + e3;
            const f2 pd = pa + pb;
            const float nskk = -red8(pd.x + pd.y);
            const f2 ns2 = (f2){nskk, nskk};
            S[0] = a0.xy * ns2 + e0; S[1] = a0.zw * ns2 + e1; S[2] = a1.xy * ns2 + e2; S[3] = a1.zw * ns2 + e3;
            f2 qa = S[0] * r0.xy, qb = S[1] * r0.zw; qa = S[2] * r1.xy + qa; qb = S[3] * r1.zw + qb;
            const f2 qd = qa + qb;
            yv[jj] = red8(qd.x + qd.y);
        }
            if (ko == 0) {
#pragma unroll
                for (int jj = 0; jj < 4; ++jj) pyc[ystep * (j0 + jj)] = f2bf(yv[jj]); }
        }
        if (c + 1 < NC) SCAN_PUT(SBUF - cur);
        __syncthreads();
    }
#undef SCAN_PUT
}

constexpr int MKP = 208, MVP = 144, MBUF = 64 * MKP + 64 * MVP;
#define MLA_THR 6.0f
__device__ __forceinline__ float max3f(float a, float b, float c) { return fmaxf(fmaxf(a, b), c); }
__device__ __forceinline__ void mla_unit(int u, int L, const bf16* mraw, const bf16* mk, bf16* yb, LAS unsigned char* lds) {
    const int tid = ltid(), lane = tid & 63, w = tid >> 6, q32 = lane & 31, hi = lane >> 5;
    const int nqb = L >> 8, qb = u % nqb, sh = u / nqb, h = sh & 7, s = sh >> 3;
    const size_t base = (size_t)s * L; const int NT = L >> 6;
    const size_t qtok = base + qb * 256 + w * 32 + q32;
    bf16x8 qf[6];
#pragma unroll
    for (int ks = 0; ks < 6; ++ks) qf[ks] = *(const bf16x8*)(mraw + qtok * 1792 + h * 96 + ks * 16 + hi * 8);
    const int kkey0 = tid / 12, kch0 = tid % 12, kkey1 = (tid + 512) / 12, kch1 = (tid + 512) % 12; const bool k2 = tid < 256;
    const bf16* ks0 = mk + (base + kkey0) * 768 + h * 96 + kch0 * 8; const bf16* ks1 = mk + (base + kkey1) * 768 + h * 96 + kch1 * 8;
    const int vkey = tid >> 3, vch = tid & 7;
    const bf16* vs = mraw + (base + vkey) * 1792 + 768 + h * 128 + 64 + vch * 8;
    const int kd0 = kkey0 * MKP + kch0 * 16, kd1 = kkey1 * MKP + kch1 * 16, vd = 64 * MKP + vkey * MVP + vch * 16;
    v4u rk0, rk1 = {0u, 0u, 0u, 0u}, rv, sk0, sk1 = {0u, 0u, 0u, 0u}, sv;
#define MLA_LOAD(t) do { const size_t adv_ = (size_t)(t) * 64; rk0 = *(const v4u*)(ks0 + adv_ * 768); if (k2) rk1 = *(const v4u*)(ks1 + adv_ * 768); rv = *(const v4u*)(vs + adv_ * 1792); } while (0)
#define MLA_PUT(bo) do { *(LAS v4u*)(lds + (bo) + kd0) = rk0; if (k2) *(LAS v4u*)(lds + (bo) + kd1) = rk1; *(LAS v4u*)(lds + (bo) + vd) = rv; } while (0)
#define MLA_LOADB(t) do { const size_t adv_ = (size_t)(t) * 64; sk0 = *(const v4u*)(ks0 + adv_ * 768); if (k2) sk1 = *(const v4u*)(ks1 + adv_ * 768); sv = *(const v4u*)(vs + adv_ * 1792); } while (0)
#define MLA_PUTB(bo) do { *(LAS v4u*)(lds + (bo) + kd0) = sk0; if (k2) *(LAS v4u*)(lds + (bo) + kd1) = sk1; *(LAS v4u*)(lds + (bo) + vd) = sv; } while (0)
    MLA_LOAD(0); MLA_PUT(0); MLA_LOAD(1); MLA_PUT(MBUF);
    __syncthreads();
    const int kmap = 16 * (q32 >> 4) + 8 * ((q32 >> 2) & 1) + (q32 & 3) + 4 * ((q32 >> 3) & 1);
    const int koff = kmap * MKP + hi * 16;
    const int voff = 64 * MKP + (8 * hi + ((lane & 15) >> 2)) * MVP + (16 * ((lane >> 4) & 1) + 4 * (lane & 3)) * 2;
    f32x16 o0 = {}, o1 = {}, negm = {}, pA0, pA1, pB0, pB1; float lsum = 0.f; v4u pw0, pw1, pw2, pw3;
    int b_prev = 0, b_cur = MBUF, b_next = 2 * MBUF;
#define MLA_KA(bo, ks) (*(const LAS bf16x8*)(lds + (bo) + koff + (ks) * 32))
#define MLA_KB(bo, ks) (*(const LAS bf16x8*)(lds + (bo) + koff + 32 * MKP + (ks) * 32))
#define MLA_QK2(C0, C1, bo, ks) do { C0 = __builtin_amdgcn_mfma_f32_32x32x16_bf16(MLA_KA(bo, ks), qf[ks], C0, 0, 0, 0); C1 = __builtin_amdgcn_mfma_f32_32x32x16_bf16(MLA_KB(bo, ks), qf[ks], C1, 0, 0, 0); } while (0)
#define MLA_FIN8(P, g, PW) do { float e0 = __builtin_amdgcn_exp2f(P[8 * g + 0]), e1 = __builtin_amdgcn_exp2f(P[8 * g + 1]), e2 = __builtin_amdgcn_exp2f(P[8 * g + 2]), e3 = __builtin_amdgcn_exp2f(P[8 * g + 3]), \
        e4 = __builtin_amdgcn_exp2f(P[8 * g + 4]), e5 = __builtin_amdgcn_exp2f(P[8 * g + 5]), e6 = __builtin_amdgcn_exp2f(P[8 * g + 6]), e7 = __builtin_amdgcn_exp2f(P[8 * g + 7]); \
        lsum += ((e0 + e1) + (e2 + e3)) + ((e4 + e5) + (e6 + e7)); PW.x = pk2(e0, e1); PW.y = pk2(e2, e3); PW.z = pk2(e4, e5); PW.w = pk2(e6, e7); } while (0)
#define MLA_VT(bo, kg, db) ({ const int vb_ = (bo) + voff + (kg) * 16 * MVP + (db) * 64; \
        const s16x4 t0_ = __builtin_amdgcn_ds_read_tr16_b64_v4i16((LAS s16x4*)(lds + vb_)), t1_ = __builtin_amdgcn_ds_read_tr16_b64_v4i16((LAS s16x4*)(lds + vb_ + 4 * MVP)); \
        (bf16x8){t0_[0], t0_[1], t0_[2], t0_[3], t1_[0], t1_[1], t1_[2], t1_[3]}; })
#define MLA_PV(bo, kg, PW) do { const bf16x8 pf_ = __builtin_bit_cast(bf16x8, PW); o0 = __builtin_amdgcn_mfma_f32_32x32x16_bf16(MLA_VT(bo, kg, 0), pf_, o0, 0, 0, 0); o1 = __builtin_amdgcn_mfma_f32_32x32x16_bf16(MLA_VT(bo, kg, 1), pf_, o1, 0, 0, 0); } while (0)
#define MLA_ROWMAX(C0, C1) ({ float a_ = max3f(C0[0], C0[1], C1[0]), b_ = max3f(C0[2], C0[3], C1[1]); a_ = max3f(a_, C1[2], C1[3]); \
        _Pragma("unroll") for (int r_ = 4; r_ < 16; r_ += 4) { a_ = max3f(a_, C0[r_], C0[r_ + 1]); b_ = max3f(b_, C0[r_ + 2], C0[r_ + 3]); a_ = max3f(a_, C1[r_], C1[r_ + 1]); b_ = max3f(b_, C1[r_ + 2], C1[r_ + 3]); } \
        const float m_ = fmaxf(a_, b_); fmaxf(m_, __shfl_xor(m_, 32)); })
#define MLA_STEP(P0, P1, C0, C1, j, LOADX, PUTX, DOMAX) do { \
        if ((j) + 2 < NT) LOADX((j) + 2); \
        C0 = negm; C1 = negm; \
        MLA_QK2(C0, C1, b_cur, 0); MLA_QK2(C0, C1, b_cur, 1); MLA_FIN8(P0, 0, pw0); \
        MLA_QK2(C0, C1, b_cur, 2); MLA_FIN8(P0, 1, pw1); \
        MLA_QK2(C0, C1, b_cur, 3); MLA_FIN8(P1, 0, pw2); \
        MLA_QK2(C0, C1, b_cur, 4); MLA_FIN8(P1, 1, pw3); \
        MLA_QK2(C0, C1, b_cur, 5); \
        MLA_PV(b_prev, 0, pw0); MLA_PV(b_prev, 1, pw1); \
        float mt_ = 0.f; if (DOMAX) mt_ = MLA_ROWMAX(C0, C1); \
        MLA_PV(b_prev, 2, pw2); MLA_PV(b_prev, 3, pw3); \
        if (DOMAX && __any(mt_ > MLA_THR)) { const float dl_ = fmaxf(mt_, 0.f); const float fs_ = __builtin_amdgcn_exp2f(-dl_); lsum *= fs_; \
            _Pragma("unroll") for (int r_ = 0; r_ < 16; ++r_) { C0[r_] -= dl_; C1[r_] -= dl_; negm[r_] -= dl_; o0[r_] *= fs_; o1[r_] *= fs_; } } \
        if ((j) + 1 < NT) PUTX(b_next); \
        __syncthreads(); \
        { const int t_ = b_prev; b_prev = b_cur; b_cur = b_next; b_next = t_; } \
    } while (0)
    pA0 = negm; pA1 = negm;
#pragma unroll
    for (int ks = 0; ks < 6; ++ks) MLA_QK2(pA0, pA1, 0, ks);
    { const float m0 = MLA_ROWMAX(pA0, pA1);
#pragma unroll
      for (int r = 0; r < 16; ++r) { pA0[r] -= m0; pA1[r] -= m0; negm[r] = -m0; } }
    MLA_LOADB(2);
    int jt = 1;
#pragma unroll 1
    for (; jt + 1 < NT; jt += 2) {
        MLA_STEP(pA0, pA1, pB0, pB1, jt, MLA_LOAD, MLA_PUTB, true);
        MLA_STEP(pB0, pB1, pA0, pA1, jt + 1, MLA_LOADB, MLA_PUT, false);
    }
    if (jt < NT) { MLA_STEP(pA0, pA1, pB0, pB1, jt, MLA_LOAD, MLA_PUTB, true); pA0 = pB0; pA1 = pB1; }
    MLA_FIN8(pA0, 0, pw0); MLA_FIN8(pA0, 1, pw1); MLA_FIN8(pA1, 0, pw2); MLA_FIN8(pA1, 1, pw3);
    MLA_PV(b_prev, 0, pw0); MLA_PV(b_prev, 1, pw1); MLA_PV(b_prev, 2, pw2); MLA_PV(b_prev, 3, pw3);
    lsum += __shfl_xor(lsum, 32);
    const float inv = __builtin_amdgcn_rcpf(lsum);
    bf16* orow = yb + qtok * 512 + h * 64 + 4 * hi;
#pragma unroll
    for (int rq = 0; rq < 4; ++rq) {
        v2u a, b; a.x = pk2(o0[4 * rq] * inv, o0[4 * rq + 1] * inv); a.y = pk2(o0[4 * rq + 2] * inv, o0[4 * rq + 3] * inv);
        b.x = pk2(o1[4 * rq] * inv, o1[4 * rq + 1] * inv); b.y = pk2(o1[4 * rq + 2] * inv, o1[4 * rq + 3] * inv);
        *(v2u*)(orow + 8 * rq) = a; *(v2u*)(orow + 32 + 8 * rq) = b;
    }
    __syncthreads();
#undef MLA_LOAD
#undef MLA_PUT
#undef MLA_LOADB
#undef MLA_PUTB
#undef MLA_KA
#undef MLA_KB
#undef MLA_QK2
#undef MLA_FIN8
#undef MLA_VT
#undef MLA_PV
#undef MLA_ROWMAX
#undef MLA_STEP
}

constexpr int NVP = 144, NA_WLDS = 64 * NVP + 1888;
__device__ __forceinline__ void na_unit(int u, int L, int l, const float* rpb_all, const bf16* proj, bf16* ya, LAS unsigned char* lds) {
    const int tid = ltid(); const int lane = tid & 63, w = tid >> 6, i16 = lane & 15, quad = lane >> 4;
    const int rows = L >> 6; const int hq = u & 3, sr = u >> 2, r = sr % rows, s = sr / rows;
    const int h = 2 * hq + (w >> 2), j = w & 3;
    const int rs = min(max(r - 4, 0), rows - 8), kc0 = min(max(16 * j - 8, 0), 32);
    const size_t base = (size_t)s * L;
    const size_t qtok = base + r * 64 + 16 * j + i16;
    LAS unsigned char* vw = lds + w * NA_WLDS; LAS float* tb = (LAS float*)(vw + 64 * NVP);
    { const float* rpb = rpb_all + (size_t)(l * 8 + h) * 465;
#pragma unroll
      for (int it = 0; it < 8; ++it) { const int idx = it * 64 + lane; if (idx < 465) tb[idx] = rpb[idx]; } }
    bf16x8 qf[2];
    qf[0] = *(const bf16x8*)(proj + qtok * DPROJ + h * 64 + quad * 8); qf[1] = *(const bf16x8*)(proj + qtok * DPROJ + h * 64 + 32 + quad * 8);
    const int cA = (i16 >> 2) * 8 + (i16 & 3);
    const bf16* kp0 = proj + (base + (size_t)rs * 64 + kc0 + cA) * DPROJ + C_KA + h * 64 + quad * 8;
    bf16x8 kf[8][4];
#pragma unroll
    for (int wr = 0; wr < 8; ++wr) { const bf16* kp = kp0 + (size_t)wr * 64 * DPROJ;
        kf[wr][0] = *(const bf16x8*)kp; kf[wr][1] = *(const bf16x8*)(kp + 32); kf[wr][2] = *(const bf16x8*)(kp + 4 * DPROJ); kf[wr][3] = *(const bf16x8*)(kp + 4 * DPROJ + 32); }
    const bf16* vp0 = proj + (base + (size_t)rs * 64 + kc0) * DPROJ + C_VA + h * 64;
    v4u vt[8];
#define NA_VLOAD(ck) do { _Pragma("unroll") for (int it = 0; it < 8; ++it) { const int idx = it * 64 + lane, key = idx >> 3, ch = idx & 7; \
        vt[it] = *(const v4u*)(vp0 + ((size_t)(2 * (ck) + (key >> 5)) * 64 + (key & 31)) * DPROJ + ch * 8); } } while (0)
    NA_VLOAD(0);
    f32x4 sa[8], sb[8];
#pragma unroll
    for (int wr = 0; wr < 8; ++wr) {
        f32x4 a = {0.f, 0.f, 0.f, 0.f}, b = {0.f, 0.f, 0.f, 0.f};
        a = __builtin_amdgcn_mfma_f32_16x16x32_bf16(kf[wr][0], qf[0], a, 0, 0, 0); a = __builtin_amdgcn_mfma_f32_16x16x32_bf16(kf[wr][1], qf[1], a, 0, 0, 0);
        b = __builtin_amdgcn_mfma_f32_16x16x32_bf16(kf[wr][2], qf[0], b, 0, 0, 0); b = __builtin_amdgcn_mfma_f32_16x16x32_bf16(kf[wr][3], qf[1], b, 0, 0, 0);
        sa[wr] = a; sb[wr] = b;
    }
    asm volatile("s_waitcnt lgkmcnt(0)" ::: "memory");
    const int qc = 16 * j + i16, wst = min(max(qc - 8, 0), 48);
    float mx = -1e30f;
#pragma unroll
    for (int wr = 0; wr < 8; ++wr) { const LAS float* rb = tb + (rs + wr - r + 7) * 31;
#pragma unroll
        for (int jj = 0; jj < 4; ++jj) {
            { const int kc = kc0 + quad * 8 + jj; const bool ok = (kc >= wst) && (kc < wst + 16); const int dc = min(max(kc - qc + 15, 0), 30);
              const float v = ok ? (sa[wr][jj] + rb[dc] * LOG2E) : -1e30f; sa[wr][jj] = v; mx = fmaxf(mx, v); }
            { const int kc = kc0 + quad * 8 + 4 + jj; const bool ok = (kc >= wst) && (kc < wst + 16); const int dc = min(max(kc - qc + 15, 0), 30);
              const float v = ok ? (sb[wr][jj] + rb[dc] * LOG2E) : -1e30f; sb[wr][jj] = v; mx = fmaxf(mx, v); }
        } }
    mx = fmaxf(mx, __shfl_xor(mx, 16)); mx = fmaxf(mx, __shfl_xor(mx, 32));
    float ls = 0.f;
#pragma unroll
    for (int wr = 0; wr < 8; ++wr)
#pragma unroll
        for (int jj = 0; jj < 4; ++jj) { sa[wr][jj] = __builtin_amdgcn_exp2f(sa[wr][jj] - mx); sb[wr][jj] = __builtin_amdgcn_exp2f(sb[wr][jj] - mx); ls += sa[wr][jj] + sb[wr][jj]; }
    ls += __shfl_xor(ls, 16); ls += __shfl_xor(ls, 32);
    f32x4 oc[4];
#pragma unroll
    for (int db = 0; db < 4; ++db) oc[db] = (f32x4){0.f, 0.f, 0.f, 0.f};
    const int toff = (quad * 8 + (i16 >> 2)) * NVP + (4 * (lane & 3)) * 2;
#pragma unroll
    for (int ck = 0; ck < 4; ++ck) {
        asm volatile("s_waitcnt lgkmcnt(0)" ::: "memory");
#pragma unroll
        for (int it = 0; it < 8; ++it) { const int idx = it * 64 + lane, key = idx >> 3, ch = idx & 7; *(LAS v4u*)(vw + key * NVP + ch * 16) = vt[it]; }
        if (ck < 3) NA_VLOAD(ck + 1);
        asm volatile("s_waitcnt lgkmcnt(0)" ::: "memory");
#pragma unroll
        for (int wl = 0; wl < 2; ++wl) { const int wr = 2 * ck + wl;
            v4u pw; pw.x = pk2(sa[wr][0], sa[wr][1]); pw.y = pk2(sa[wr][2], sa[wr][3]); pw.z = pk2(sb[wr][0], sb[wr][1]); pw.w = pk2(sb[wr][2], sb[wr][3]);
            const bf16x8 pf = __builtin_bit_cast(bf16x8, pw);
#pragma unroll
            for (int db = 0; db < 4; ++db) { const int vb = toff + wl * 32 * NVP + db * 32;
                const s16x4 t0 = __builtin_amdgcn_ds_read_tr16_b64_v4i16((LAS s16x4*)(vw + vb)), t1 = __builtin_amdgcn_ds_read_tr16_b64_v4i16((LAS s16x4*)(vw + vb + 4 * NVP));
                const bf16x8 vf = {t0[0], t0[1], t0[2], t0[3], t1[0], t1[1], t1[2], t1[3]};
                oc[db] = __builtin_amdgcn_mfma_f32_16x16x32_bf16(vf, pf, oc[db], 0, 0, 0); }
        }
    }
#undef NA_VLOAD
    const float inv = __builtin_amdgcn_rcpf(ls);
    bf16* orow = ya + qtok * 512 + h * 64 + quad * 4;
#pragma unroll
    for (int db = 0; db < 4; ++db) { v2u o; o.x = pk2(oc[db][0] * inv, oc[db][1] * inv); o.y = pk2(oc[db][2] * inv, oc[db][3] * inv); *(v2u*)(orow + db * 16) = o; }
    asm volatile("s_waitcnt lgkmcnt(0)" ::: "memory");
}

#define XB_TMO      128
#define XB_XCNT(j)  (256  + 64 * (j))
#define XB_XSUB(j)  (1280 + 64 * (j))
#define XB_XGEN(j)  (2304 + 64 * (j))
#define XB_TOP      3328
#define XB_TOPGEN   3392
#define XCD_BAR_WORDS 3456
#define XB_SPIN_CAP (1u << 18)

__device__ __forceinline__ unsigned xb_ld(unsigned* p)              { return __hip_atomic_load(p, __ATOMIC_RELAXED, __HIP_MEMORY_SCOPE_AGENT); }
__device__ __forceinline__ unsigned xb_add(unsigned* p, unsigned v) { return __hip_atomic_fetch_add(p, v, __ATOMIC_RELAXED, __HIP_MEMORY_SCOPE_AGENT); }
__device__ __forceinline__ unsigned xb_xcc_id() { return (unsigned)__builtin_amdgcn_s_getreg((3 << 11) | 20) & 0xFu; }
#define XB_SPIN(cond, bar) do { unsigned _sp = 0; while (cond) { __builtin_amdgcn_s_sleep(1); \
    if ((++_sp & 255u) == 0u) { if (xb_ld(&(bar)[XB_TMO])) break; if (_sp > XB_SPIN_CAP) { atomicAdd(&(bar)[XB_TMO], 1u); break; } } } } while (0)

struct XcdBarrier {
    unsigned* bar; unsigned x;
    volatile LAS unsigned* st;
};

__device__ __forceinline__ XcdBarrier xcd_barrier_post(unsigned* bar, volatile LAS unsigned* st) {
    XcdBarrier b; b.bar = bar; b.x = xb_xcc_id(); b.st = st;
    if (threadIdx.x == 0) (void)xb_add(&bar[XB_XCNT(b.x)], 1u);
    return b;
}
__device__ __forceinline__ void xcd_barrier_complete(unsigned* bar, unsigned x, unsigned& nloc, unsigned& nx) {
    const unsigned G = gridDim.x * gridDim.y * gridDim.z;
    unsigned sum, cnt, mine, sp = 0u;
    for (;;) {
        sum = 0u; cnt = 0u; mine = 0u;
#pragma unroll
        for (unsigned j = 0; j < 16; ++j) { const unsigned c = xb_ld(&bar[XB_XCNT(j)]); sum += c; cnt += (c > 0u) ? 1u : 0u; mine = (j == x) ? c : mine; }
        if (sum == G) break;
        __builtin_amdgcn_s_sleep(1);
        if ((++sp & 255u) == 0u) { if (xb_ld(&bar[XB_TMO])) break; if (sp > XB_SPIN_CAP) { atomicAdd(&bar[XB_TMO], 1u); break; } }
    }
    nloc = mine > 0u ? mine : 1u; nx = cnt > 0u ? cnt : 1u;
}

__device__ __forceinline__ void xcd_barrier(const XcdBarrier& b) {
    asm volatile("s_waitcnt vmcnt(0)" ::: "memory");
    __syncthreads();
    if (threadIdx.x == 0) {
        unsigned* bar = b.bar;
        __builtin_amdgcn_s_waitcnt(0);
        unsigned nloc = b.st[0], nx = b.st[1];
        if (nloc == 0u) { xcd_barrier_complete(bar, b.x, nloc, nx); b.st[0] = nloc; b.st[1] = nx; }
        const unsigned old = xb_add(&bar[XB_XSUB(b.x)], 1u);
        const unsigned gen = old / nloc;
        if (old + 1u == (gen + 1u) * nloc) {
            __builtin_amdgcn_fence(__ATOMIC_RELEASE, "agent");
            asm volatile("s_waitcnt vmcnt(0)" ::: "memory");
            const unsigned og = xb_add(&bar[XB_TOP], 1u);
            const unsigned tg = og / nx;
            if (og + 1u == (tg + 1u) * nx) xb_add(&bar[XB_TOPGEN], 1u);
            else XB_SPIN(xb_ld(&bar[XB_TOPGEN]) == tg, bar);
            __builtin_amdgcn_fence(__ATOMIC_ACQUIRE, "agent");
            xb_add(&bar[XB_XGEN(b.x)], 1u);
            asm volatile("s_waitcnt vmcnt(0)" ::: "memory");
        } else {
            XB_SPIN(xb_ld(&bar[XB_XGEN(b.x)]) == gen, bar);
            __builtin_amdgcn_fence(__ATOMIC_ACQUIRE, "agent");
            asm volatile("s_waitcnt vmcnt(0)" ::: "memory");
        }
    }
    __syncthreads();
}

constexpr int NPH = 12;
__device__ __forceinline__ void run_phase(CP pp, int st, LAS unsigned char* lds) {
    volatile LAS unsigned* lctl = (volatile LAS unsigned*)(lds + LDS_RING);
    const int tid = ltid(), lane = tid & 63, wave = __builtin_amdgcn_readfirstlane(tid >> 6);
    int bid_ = blockIdx.x; asm volatile("" : "+s"(bid_));
    const int NB = gridDim.x, gw = bid_ * 8 + wave, ngw = NB * 8;
    const int ph = st % NPH, gl = st / NPH, l = gl & 1, g = gl >> 1;
    unsigned char* ws = pp->ws; const int Tg = pp->Tg;
    const Reg R{ws, (size_t)Tg};
    const size_t asz = (size_t)Tg * 512;
    const int t0 = g * Tg; const int L = (t0 < NPROMPT) ? 8192 : 4096;
    float* xout = pp->out + (size_t)t0 * DM;
    int gid0 = 0, gidn = 0;
    switch (ph) {
    case 0: {
        const float* xin = (l == 0) ? ((t0 < NPROMPT) ? pp->in[0] + (size_t)t0 * DM : pp->in[1] + (size_t)(t0 - NPROMPT) * DM) : xout;
        phase_norm(xin, pp->in[2] + l * DM, R.RH(), Tg, gw, ngw, lane);
    } break;
    case 1: gid0 = GM_IN; gidn = 1; break;
    case 2: {
        phase_post_proj(pp, l, R.RP(), R.RA(), R.RA() + (size_t)Tg * 384, R.RS(), (_Float16*)R.RZ(), asz, Tg, L, gw, ngw, lane);
    } break;
    case 3: gid0 = GM_MU; gidn = 2; break;
    case 4: {
        phase_mla_post(pp, l, R.RM(), R.RP(), R.RA(), Tg, L, gw, ngw, lane);
    } break;
    case 5: {
        unsigned* qctr = (unsigned*)(ws + WS_CTL) + 64 * gl; const int nseq = Tg / L;
        const int NS = nseq * 16, NM = nseq * 8 * (L >> 8), NN = nseq * (L >> 6) * 4, NTOT = NS + NM + NN;
        for (;;) {
            __syncthreads();
            if (tid == 0) lctl[0] = atomicAdd(qctr, 1u);
            __syncthreads();
            const int u = __builtin_amdgcn_readfirstlane((int)lctl[0]);
            if (u >= NTOT) break;
            if (u < NS) scan_unit(u, L, R.RS(), asz, R.RZ(), lds);
            else if (u < NS + NM) mla_unit(u - NS, L, R.RM(), R.RA(), R.RY() + asz, lds);
            else na_unit(u - NS - NM, L, l, pp->in[7], R.RP(), R.RY(), lds);
        }
    } break;
    case 6: {
        phase_rw_post(pp, l, R.RS(), asz, R.RZ(), R.RY() + 2 * asz, Tg, gw, ngw, lane);
        gid0 = GM_GATE; gidn = 1;
    } break;
    case 7: gid0 = GM_BR0; gidn = 1; break;
    case 8: gid0 = GM_OUT; gidn = 1; break;
    case 9: {
        phase_norm(xout, pp->in[29] + l * DM, R.RH(), Tg, gw, ngw, lane);
    } break;
    case 10: gid0 = GM_GU; gidn = 1; break;
    case 11: gid0 = GM_DN; gidn = 1; break;
    default: break;
    }
#pragma unroll 1
    for (int id = gid0; id < gid0 + gidn; ++id) {
        const unsigned char* wb = ws + W_OFF + (size_t)l * W_STRIDE;
        const bf16* A; const bf16* Bt; int N, K;
        switch (id) {
        case GM_IN:   A = R.RH(); Bt = (const bf16*)(wb + WO_IN); N = DPROJ; K = 1024; break;
        case GM_MU:   A = R.RA(); Bt = (const bf16*)(wb + WO_MU); N = 1792; K = 384; break;
        case GM_RU:   A = R.RA() + (size_t)Tg * 384; Bt = (const bf16*)(wb + WO_RU); N = 2560; K = 384; break;
        case GM_GATE: A = R.RH(); Bt = (const bf16*)(wb + WO_G); N = DGATE; K = 1024; break;
        case GM_BR0: case GM_BR1: case GM_BR2: A = R.RY(); Bt = (const bf16*)(wb + WO_BR); N = DM; K = 512; break;
        case GM_OUT:  A = R.RM(); Bt = (const bf16*)(wb + WO_OUT); N = DM; K = 1024; break;
        case GM_GU:   A = R.RH(); Bt = (const bf16*)(wb + WO_GU); N = 2 * DFF; K = 1024; break;
        default:      A = R.RP(); Bt = (const bf16*)(wb + WO_DN); N = DM; K = DFF; break;
        }
        const bool br = (id == GM_BR0);
        pg8::Gemm gm{A, Bt, Tg, N, K, (id == GM_MU) ? 1 : ((id == GM_RU) ? 2 : (br ? 3 : 0)), asz * 2, MiB}; pg8::GOrder S; S.S.init(Tg, N, NB, bid_); S.div = br ? 3 : 1;
        EpiUni E{pp, id, l, g}; pg8::gemm_phase<EpiUni, pg8::GOrder, true, true>(lds, gm, S, E);
    }
}

__device__ __forceinline__ void run_phase0(CP pp, int part, LAS unsigned char* lds) {
    const int tid = ltid(), lane = tid & 63, wave = __builtin_amdgcn_readfirstlane(tid >> 6);
    const int NB = gridDim.x, gw = blockIdx.x * 8 + wave, ngw = NB * 8;
    const size_t gtid = (size_t)blockIdx.x * 512 + tid, ngt = (size_t)NB * 512;
    unsigned char* ws = pp->ws;
    if (part == 0) {
        for (int l = 0; l < 2; ++l) { unsigned char* wb = ws + W_OFF + (size_t)l * W_STRIDE;
            zero_bytes(wb + WO_IN + (size_t)NMAIN * 2048, (size_t)(DPROJ - NMAIN) * 2048, gtid, ngt);
            zero_bytes(wb + WO_MU, (size_t)1792 * 384 * 2, gtid, ngt);
            zero_bytes(wb + WO_RU, (size_t)2560 * 384 * 2, gtid, ngt); }
    } else {
        LAS float* scr = (LAS float*)(lds + wave * 16384);
#pragma unroll 1
        for (int l = 0; l < 2; ++l) { unsigned char* wb = ws + W_OFF + (size_t)l * W_STRIDE;
            const float* w_in = pp->in[3] + (size_t)l * DM * DIN;
            transpose_job(w_in, DIN, 1024, NMAIN, (bf16*)(wb + WO_IN), 1024, 0, 0, 0, scr, gw, ngw, lane);
            transpose_job(w_in + NMAIN, DIN, 1024, DGATE, (bf16*)(wb + WO_G), 1024, 0, 0, 0, scr, gw, ngw, lane);
            transpose_job(pp->in[8] + (size_t)l * 512 * 1024, 1024, 512, 1024, (bf16*)(wb + WO_BR), 512, 0, 0, 0, scr, gw, ngw, lane);
            transpose_job(pp->in[15] + (size_t)l * 512 * 1024, 1024, 512, 1024, (bf16*)(wb + WO_BR + 1 * MiB), 512, 0, 0, 0, scr, gw, ngw, lane);
            transpose_job(pp->in[27] + (size_t)l * 512 * 1024, 1024, 512, 1024, (bf16*)(wb + WO_BR + 2 * MiB), 512, 0, 0, 0, scr, gw, ngw, lane);
            transpose_job(pp->in[28] + (size_t)l * 1024 * 1024, 1024, 1024, 1024, (bf16*)(wb + WO_OUT), 1024, 0, 0, 0, scr, gw, ngw, lane);
            transpose_job(pp->in[30] + (size_t)l * 1024 * DFF, DFF, 1024, DFF, (bf16*)(wb + WO_GU), 1024, 0, 0, 1, scr, gw, ngw, lane);
            transpose_job(pp->in[31] + (size_t)l * 1024 * DFF, DFF, 1024, DFF, (bf16*)(wb + WO_GU), 1024, 0, 128, 1, scr, gw, ngw, lane);
            transpose_job(pp->in[32] + (size_t)l * DFF * 1024, 1024, DFF, 1024, (bf16*)(wb + WO_DN), DFF, 0, 0, 0, scr, gw, ngw, lane);
            transpose_job(pp->in[11] + (size_t)l * 256 * 768, 768, 256, 768, (bf16*)(wb + WO_MU), 384, 0, 0, 0, scr, gw, ngw, lane);
            transpose_job(pp->in[12] + (size_t)l * 128 * 1024, 1024, 128, 1024, (bf16*)(wb + WO_MU), 384, 256, 768, 0, scr, gw, ngw, lane);
#pragma unroll 1
            for (int d = 0; d < 2; ++d) {
                transpose_job(pp->in[18] + (size_t)(l * 2 + d) * 64 * 512, 512, 64, 512, (bf16*)(wb + WO_RU), 384, 64 * d, 512 * d, 0, scr, gw, ngw, lane);
                transpose_job(pp->in[20] + (size_t)(l * 2 + d) * 64 * 512, 512, 64, 512, (bf16*)(wb + WO_RU), 384, 128 + 64 * d, 1024 + 512 * d, 0, scr, gw, ngw, lane); }
            transpose_job(pp->in[21] + (size_t)l * 128 * 512, 512, 128, 512, (bf16*)(wb + WO_RU), 384, 256, 2048, 0, scr, gw, ngw, lane);
        }
    }
}

__global__ void __launch_bounds__(512, 2) mega(Params p) {
    extern __shared__ __attribute__((aligned(16))) unsigned char lds_raw[];
    LAS unsigned char* lds = (LAS unsigned char*)lds_raw;
    cg::grid_group grid = cg::this_grid();
    if (blockIdx.x == 0 && threadIdx.x == 0) { Params* d = (Params*)(p.ws + WS_PARAMS); *d = p; }
    const int nsteps = p.G * 2 * NPH;
    volatile LAS unsigned* bst = (volatile LAS unsigned*)(lds + LDS_RING + 32);
    if (threadIdx.x == 0) { bst[0] = 0u; bst[1] = 0u; }
    __syncthreads();
    const XcdBarrier bar = xcd_barrier_post((unsigned*)(p.ws + WS_CTL) + 4096, bst);
    grid.sync();
#pragma unroll 1
    for (int st = -2; st < nsteps; ++st) {
        int s2 = st; asm volatile("" : "+s"(s2));
        CP pp = (CP)(p.ws + WS_PARAMS); asm volatile("" : "+s"(pp));
        if (s2 < 0) run_phase0(pp, s2 + 2, lds); else run_phase(pp, s2, lds);
        xcd_barrier(bar);
    }
}

extern "C" void kernel_launch(void* const* d_in, const int* in_sizes, int n_in, void* d_out, int out_size, void* d_ws, size_t ws_size, hipStream_t stream) {
    static int grid = 0;
    if (grid == 0) {
        int dev = 0, cus = 0, per_cu = 0;
        hipGetDevice(&dev); hipDeviceGetAttribute(&cus, hipDeviceAttributeMultiprocessorCount, dev);
        hipFuncSetAttribute((const void*)mega, hipFuncAttributeMaxDynamicSharedMemorySize, LDS_BYTES);
        hipOccupancyMaxActiveBlocksPerMultiprocessor(&per_cu, (const void*)mega, 512, LDS_BYTES);
        (void)hipGetLastError();
        if (per_cu < 1) per_cu = 1;
        grid = cus * per_cu;
    }
    int G = 2;
    while (G < 16 && ACT_OFF + (size_t)(NTOK / G) * TOKB > ws_size) G *= 2;
    if (hipMemsetAsync((char*)d_ws + WS_CTL, 0, CTL_BYTES, stream) != hipSuccess) { fprintf(stderr, "kernel_launch: memset failed\n"); return; }
    Params p{};
    for (int i = 0; i < 33; ++i) p.in[i] = (const float*)d_in[i];
    p.out = (float*)d_out; p.ws = (unsigned char*)d_ws; p.G = G; p.Tg = NTOK / G;
    void* args[] = {&p};
    hipError_t e = hipLaunchCooperativeKernel((const void*)mega, dim3(grid), dim3(512), args, LDS_BYTES, stream);
    if (e != hipSuccess) fprintf(stderr, "cooperative launch failed: %s (grid %d)\n", hipGetErrorString(e), grid);
}
```

```cpp
#include <hip/hip_runtime.h>
#include <hip/hip_cooperative_groups.h>
#include <cstdio>
#include <cstdint>
namespace cg = cooperative_groups;
namespace pg8 {
#define PG8_LAS __attribute__((address_space(3)))
typedef unsigned short bf16_t;
typedef short bf16x8 __attribute__((ext_vector_type(8)));
typedef float f32x4 __attribute__((ext_vector_type(4)));
typedef unsigned u32x4 __attribute__((ext_vector_type(4)));
constexpr int BM = 256, BK = 64, HALF = 128, HTB = HALF * BK * 2  , STAGE_BYTES = 8 * HTB, NXCD = 8, WGM = 8;

__host__ __device__ __forceinline__ int lds_byte(int r, int c) { const int st = (r >> 4) * 2 + (c >> 5), rr = r & 15, cc = c & 31, ob = rr * 64 + cc * 2; return st * 1024 + (ob ^ (((ob >> 9) & 1) << 5)); }
__host__ __device__ __forceinline__ void stage_rc(int b, int& R, int& C) { const int st = b / 1024, sb = b % 1024, swz = sb ^ (((sb >> 9) & 1) << 5); R = (st >> 1) * 16 + swz / 64; C = (st & 1) * 32 + (swz % 64) / 2; }
__host__ __device__ __forceinline__ int perm32(int rho) { const int n = rho >> 4, i = rho & 15; return 8 * (i >> 2) + 4 * n + (i & 3); }

struct Unit { int pm, pn, aux; };
struct Gemm { const bf16_t* A; const bf16_t* Bt; int M, N, K; int kmode; size_t auxA, auxB; };
__device__ __forceinline__ void krange(int kmode, int pn, int K, int& kof, int& nt) {
    kof = 0; nt = K / BK;
    if (kmode == 1) { if (pn < 3) { nt = 4; } else { kof = 256; nt = 2; } }
    else if (kmode == 2) { kof = (pn < 4) ? 0 : ((pn < 8) ? 128 : 256); nt = 2; }
}

struct StaticOrder {
    int nM, nN, nwg, G, c;
    __host__ __device__ void init(int M, int N, int G_, int c_) { nM = M / BM; nN = N / BM; nwg = nM * nN; G = G_; c = c_; }
    __host__ __device__ bool next(int i, Unit& u) const {
        const long L = (long)i * G + c; if (L >= nwg) return false;
        int wgid = (int)L; { const int q = nwg / NXCD, r = nwg % NXCD, xcd = wgid % NXCD, off = wgid / NXCD; wgid = (xcd < r ? xcd * (q + 1) : r * (q + 1) + (xcd - r) * q) + off; }
        const int nig = WGM * nN, gid = wgid / nig, fm = gid * WGM, gsz = (nM - fm) < WGM ? (nM - fm) : WGM;
        u.pm = fm + ((wgid % nig) % gsz); u.pn = (wgid % nig) / gsz; u.aux = 0; return true;
    }
    __device__ __forceinline__ void a_ready(const Unit&) const {}
    __device__ __forceinline__ void done(const Unit&) const {}
};
__device__ __forceinline__ void krange2(const Gemm& g, const Unit& u, int K, size_t& offA, size_t& offB, int& nt) {
    if (g.kmode == 3) { offA = (size_t)u.aux * g.auxA; offB = (size_t)u.aux * g.auxB; nt = K / BK; }
    else { int kof; krange(g.kmode, u.pn, K, kof, nt); offA = (size_t)kof * 2; offB = offA; }
}
struct GOrder {
    StaticOrder S; int div;
    __host__ __device__ bool next(int j, Unit& u) const { const int t = j / div; const bool ok = S.next(t, u); u.aux = j - t * div; return ok; }
    __device__ __forceinline__ void a_ready(const Unit&) const {}
    __device__ __forceinline__ void done(const Unit&) const {}
};

__device__ __forceinline__ unsigned cvt_pk_bf16(float lo, float hi) { unsigned r; asm volatile("v_cvt_pk_bf16_f32 %0, %1, %2" : "=v"(r) : "v"(lo), "v"(hi)); return r; }
typedef float f32x2 __attribute__((ext_vector_type(2)));
}
namespace pg8 {
template <class Epi, class Sched, bool ALIGN_EPI = false, bool SP2 = false>
__device__ __forceinline__ void gemm_phase(PG8_LAS unsigned char* lds, const Gemm g, const Sched& S, const Epi& E) {
    int tid_l = threadIdx.x; asm volatile("" : "+v"(tid_l)); const int tid = tid_l, wid = __builtin_amdgcn_readfirstlane(tid >> 6), lane = tid & 63, wr = wid >> 2, wc = wid & 3, fr = lane & 15, fq = lane >> 4;
    const int K = g.K; int nt = K / BK;
    unsigned voffA[2], voffB[2];
#pragma unroll
    for (int i = 0; i < 2; ++i) { int R, C; stage_rc(tid * 16 + i * 8192, R, C); const int Rb = Epi::PERM ? ((R & ~31) + perm32(R & 31)) : R;
        voffA[i] = (unsigned)(R * K + C) * 2u; voffB[i] = (unsigned)(Rb * K + C) * 2u; }
    const size_t kstep = (size_t)(BK * 2);
    const size_t hstep = (size_t)HALF * K * 2;
    const size_t tstep = 2 * hstep;
    const unsigned ldsw = (unsigned)wid * 1024u;
    const int aoff = lds_byte(wr * 64 + fr, fq * 8), boff = lds_byte(wc * 32 + fr, fq * 8);
#define PG8_SA(b, h) (((b) * 2 + (h)) * HTB)
#define PG8_SB(b, h) ((4 + (b) * 2 + (h)) * HTB)
#define PG8_STAGE(bufoff, gbase, voff) do { _Pragma("unroll") for (int _i = 0; _i < 2; ++_i) \
        __builtin_amdgcn_global_load_lds((const unsigned*)((const char*)(gbase) + (voff)[_i]), (PG8_LAS unsigned*)(lds + (bufoff) + ldsw + _i * 8192), 16, 0, 0); } while (0)
#define PG8_LDA(dst, b, h) do { _Pragma("unroll") for (int m = 0; m < 4; ++m) _Pragma("unroll") for (int k = 0; k < 2; ++k) dst[m][k] = *(const PG8_LAS bf16x8*)(lds + PG8_SA(b, h) + aoff + m * 2048 + k * 1024); } while (0)
#define PG8_LDB(dst, b, h) do { _Pragma("unroll") for (int n = 0; n < 2; ++n) _Pragma("unroll") for (int k = 0; k < 2; ++k) dst[n][k] = *(const PG8_LAS bf16x8*)(lds + PG8_SB(b, h) + boff + n * 2048 + k * 1024); } while (0)
#define PG8_MMA(ai, bj, At, Bt) do { __builtin_amdgcn_s_setprio(1); _Pragma("unroll") for (int m = 0; m < 4; ++m) _Pragma("unroll") for (int n = 0; n < 2; ++n) _Pragma("unroll") for (int k = 0; k < 2; ++k) \
        acc[ai][bj][m][n] = __builtin_amdgcn_mfma_f32_16x16x32_bf16(Bt[n][k], At[m][k], acc[ai][bj][m][n], 0, 0, 0); __builtin_amdgcn_s_setprio(0); } while (0)
#define PG8_WAIT_V(n) asm volatile("s_waitcnt vmcnt(" #n ")" ::: "memory")
#define PG8_WAIT_L(n) asm volatile("s_waitcnt lgkmcnt(" #n ")" ::: "memory")
#define PG8_BAR __builtin_amdgcn_s_barrier()
#define PG8_SCHED __builtin_amdgcn_sched_barrier(0)
    Unit cur, nxt; int ui = 0;
    if (!S.next(0, cur)) return;
    f32x4 acc[2][2][4][2];
#pragma unroll
    for (int a = 0; a < 2; ++a)
#pragma unroll
        for (int b = 0; b < 2; ++b)
#pragma unroll
            for (int m = 0; m < 4; ++m)
#pragma unroll
                for (int n = 0; n < 2; ++n) acc[a][b][m][n] = (f32x4){0.f, 0.f, 0.f, 0.f};
    bf16x8 At[4][2], B0[2][2], B1[2][2];
    size_t oac_, obc_; krange2(g, cur, K, oac_, obc_, nt);
    const char* cA = (const char*)g.A + (size_t)cur.pm * tstep + oac_; const char* cB = (const char*)g.Bt + (size_t)cur.pn * tstep + obc_;
    S.a_ready(cur);
    if constexpr (SP2) {
        PG8_STAGE(PG8_SB(0, 0), cB, voffB); PG8_STAGE(PG8_SB(0, 1), cB + hstep, voffB); PG8_STAGE(PG8_SA(0, 0), cA, voffA); PG8_STAGE(PG8_SA(0, 1), cA + hstep, voffA);
        if (wr == 1) PG8_BAR;
        PG8_WAIT_V(2); PG8_BAR;
        PG8_STAGE(PG8_SB(1, 0), cB + kstep, voffB); PG8_STAGE(PG8_SA(1, 0), cA + kstep, voffA); PG8_STAGE(PG8_SB(1, 1), cB + hstep + kstep, voffB);
        PG8_WAIT_V(6); PG8_BAR;
    } else {
        PG8_STAGE(PG8_SB(0, 0), cB, voffB); PG8_STAGE(PG8_SA(0, 0), cA, voffA); PG8_STAGE(PG8_SB(0, 1), cB + hstep, voffB); PG8_STAGE(PG8_SA(0, 1), cA + hstep, voffA);
        if (wr == 1) PG8_BAR;
        PG8_WAIT_V(4); PG8_BAR;
        PG8_STAGE(PG8_SB(1, 0), cB + kstep, voffB); PG8_STAGE(PG8_SA(1, 0), cA + kstep, voffA); PG8_STAGE(PG8_SB(1, 1), cB + hstep + kstep, voffB);
        PG8_WAIT_V(6); PG8_BAR;
    }
    for (;;) {
        const bool has_next = S.next(ui + 1, nxt);
        size_t oan_ = 0, obn_ = 0; int ntn_ = nt; if (has_next) krange2(g, nxt, K, oan_, obn_, ntn_);
        const char* nA = has_next ? (const char*)g.A + (size_t)nxt.pm * tstep + oan_ : cA; const char* nB = has_next ? (const char*)g.Bt + (size_t)nxt.pn * tstep + obn_ : cB;
        for (int t = 0; t < nt; t += 2) {
            const bool last = (t == nt - 2);
            const char* a1 = cA + (size_t)(t + 1) * kstep;
            const char* a2 = last ? nA : cA + (size_t)(t + 2) * kstep; const char* b2 = last ? nB : cB + (size_t)(t + 2) * kstep;
            const char* a3 = a2 + kstep; const char* b3 = b2 + kstep;
            if (last && has_next) S.a_ready(nxt);
            if constexpr (SP2) {
            PG8_LDB(B0, 0, 0); PG8_LDB(B1, 0, 1); PG8_SCHED; PG8_LDA(At, 0, 0); PG8_STAGE(PG8_SA(1, 1), a1 + hstep, voffA);
            PG8_WAIT_V(8); PG8_WAIT_L(0); PG8_BAR; PG8_MMA(0, 0, At, B0); PG8_MMA(0, 1, At, B1); PG8_BAR; PG8_SCHED;
            PG8_LDA(At, 0, 1); PG8_STAGE(PG8_SB(0, 0), b2, voffB); PG8_STAGE(PG8_SB(0, 1), b2 + hstep, voffB); PG8_STAGE(PG8_SA(0, 0), a2, voffA);
            PG8_WAIT_V(8); PG8_WAIT_L(0); PG8_BAR; PG8_MMA(1, 0, At, B0); PG8_MMA(1, 1, At, B1); PG8_BAR; PG8_SCHED;
            PG8_LDB(B0, 1, 0); PG8_LDB(B1, 1, 1); PG8_SCHED; PG8_LDA(At, 1, 0); PG8_STAGE(PG8_SA(0, 1), a2 + hstep, voffA);
            PG8_WAIT_V(8); PG8_WAIT_L(0); PG8_BAR; PG8_MMA(0, 0, At, B0); PG8_MMA(0, 1, At, B1); PG8_BAR; PG8_SCHED;
            PG8_LDA(At, 1, 1); PG8_STAGE(PG8_SB(1, 0), b3, voffB); PG8_STAGE(PG8_SB(1, 1), b3 + hstep, voffB); PG8_STAGE(PG8_SA(1, 0), a3, voffA);
            PG8_WAIT_V(8); PG8_WAIT_L(0); PG8_BAR; PG8_MMA(1, 0, At, B0); PG8_MMA(1, 1, At, B1); PG8_BAR; PG8_SCHED;
            } else {
            PG8_LDB(B0, 0, 0); PG8_SCHED; PG8_LDA(At, 0, 0); PG8_STAGE(PG8_SA(1, 1), a1 + hstep, voffA);
            PG8_WAIT_L(8); PG8_BAR; PG8_WAIT_L(0); PG8_MMA(0, 0, At, B0); PG8_BAR; PG8_SCHED;
            PG8_LDB(B1, 0, 1); PG8_STAGE(PG8_SB(0, 0), b2, voffB);
            PG8_BAR; PG8_WAIT_L(0); PG8_MMA(0, 1, At, B1); PG8_BAR;
            PG8_LDA(At, 0, 1); PG8_STAGE(PG8_SA(0, 0), a2, voffA);
            PG8_BAR; PG8_WAIT_L(0); PG8_MMA(1, 0, At, B0); PG8_BAR; PG8_SCHED;
            PG8_STAGE(PG8_SB(0, 1), b2 + hstep, voffB);
            PG8_WAIT_V(6); PG8_BAR; PG8_MMA(1, 1, At, B1); PG8_BAR;
            PG8_LDB(B0, 1, 0); PG8_SCHED; PG8_LDA(At, 1, 0); PG8_STAGE(PG8_SA(0, 1), a2 + hstep, voffA);
            PG8_WAIT_L(8); PG8_BAR; PG8_WAIT_L(0); PG8_MMA(0, 0, At, B0); PG8_BAR; PG8_SCHED;
            PG8_LDB(B1, 1, 1); PG8_STAGE(PG8_SB(1, 0), b3, voffB);
            PG8_BAR; PG8_WAIT_L(0); PG8_MMA(0, 1, At, B1); PG8_BAR;
            PG8_LDA(At, 1, 1); PG8_STAGE(PG8_SA(1, 0), a3, voffA);
            PG8_BAR; PG8_WAIT_L(0); PG8_MMA(1, 0, At, B0); PG8_BAR; PG8_SCHED;
            PG8_STAGE(PG8_SB(1, 1), b3 + hstep, voffB);
            PG8_WAIT_V(6); PG8_BAR; PG8_MMA(1, 1, At, B1); PG8_BAR;
            }
        }
        if constexpr (ALIGN_EPI) { if (wr == 0) PG8_BAR; }
        if constexpr (!Epi::AFTER_DRAIN) { E(acc, cur, wr, wc, fr, fq); S.done(cur); }
        if (!has_next) break;
#pragma unroll
        for (int a = 0; a < 2; ++a)
#pragma unroll
            for (int b = 0; b < 2; ++b)
#pragma unroll
                for (int m = 0; m < 4; ++m)
#pragma unroll
                    for (int n = 0; n < 2; ++n) acc[a][b][m][n] = (f32x4){0.f, 0.f, 0.f, 0.f};
        cur = nxt; cA = nA; cB = nB; nt = ntn_; ++ui;
        if constexpr (ALIGN_EPI) { if (wr == 1) PG8_BAR; }
    }
    PG8_WAIT_V(0);
    if constexpr (!ALIGN_EPI) { if (wr == 0) PG8_BAR; }
    PG8_BAR;
    if constexpr (Epi::AFTER_DRAIN) { E.fused(acc, cur, wr, wc, fr, fq, lds, wid, lane); S.done(cur); }
#undef PG8_SA
#undef PG8_SB
#undef PG8_STAGE
#undef PG8_LDA
#undef PG8_LDB
#undef PG8_MMA
#undef PG8_WAIT_V
#undef PG8_WAIT_L
#undef PG8_BAR
#undef PG8_SCHED
}
}

#define LAS __attribute__((address_space(3)))
typedef unsigned short bf16;
typedef unsigned v4u __attribute__((ext_vector_type(4)));
typedef unsigned v2u __attribute__((ext_vector_type(2)));
typedef float f32x4 __attribute__((ext_vector_type(4)));
typedef float f32x16 __attribute__((ext_vector_type(16)));
typedef short bf16x8 __attribute__((ext_vector_type(8)));
typedef short s16x4 __attribute__((ext_vector_type(4)));
typedef _Float16 h8 __attribute__((ext_vector_type(8)));

typedef float f32x2_t __attribute__((ext_vector_type(2))); typedef __bf16 bf16x2_t __attribute__((ext_vector_type(2)));
__device__ __forceinline__ unsigned pk2(float lo, float hi) { f32x2_t v = {lo, hi}; bf16x2_t b = __builtin_convertvector(v, bf16x2_t); return __builtin_bit_cast(unsigned, b); }
__device__ __forceinline__ float bflo(unsigned u) { return __uint_as_float(u << 16); }
__device__ __forceinline__ float bfhi(unsigned u) { return __uint_as_float(u & 0xffff0000u); }
__device__ __forceinline__ float bf2f(bf16 b) { return __uint_as_float(((unsigned)b) << 16); }
__device__ __forceinline__ bf16 f2bf(float f) { return (bf16)(pk2(f, 0.f) & 0xffffu); }
#define UNPACK8(v, f) do { f[0] = bflo(v.x); f[1] = bfhi(v.x); f[2] = bflo(v.y); f[3] = bfhi(v.y); f[4] = bflo(v.z); f[5] = bfhi(v.z); f[6] = bflo(v.w); f[7] = bfhi(v.w); } while (0)
#define PACK8(o, f) do { o.x = pk2(f[0], f[1]); o.y = pk2(f[2], f[3]); o.z = pk2(f[4], f[5]); o.w = pk2(f[6], f[7]); } while (0)
__device__ __forceinline__ int ltid() { int t = threadIdx.x; asm volatile("" : "+v"(t)); return t; }
__device__ __forceinline__ float sigmoidf_(float x) { return __builtin_amdgcn_rcpf(1.f + __expf(-x)); }
__device__ __forceinline__ float wave_sum(float v) {
#pragma unroll
    for (int o = 1; o < 64; o <<= 1) v += __shfl_xor(v, o);
    return v;
}
__device__ __forceinline__ float sum8(float v) { v += __shfl_xor(v, 1); v += __shfl_xor(v, 2); v += __shfl_xor(v, 4); return v; }

constexpr int DM = 1024, DIN = 6944, DPROJ = 4096, NMAIN = 3872, DGATE = 3072, DFF = 2816;
constexpr int NTOK = 131072, NPROMPT = 65536;
constexpr int C_KA = 512, C_VA = 1024, C_CQ = 1536, C_CKV = 1792, C_KR = 1920, C_RW = 1952;
constexpr float LOG2E = 1.4426950408889634f;
constexpr float NA_QS = 0.125f * LOG2E;
constexpr float MLA_QS = 0.10206207261596575f * LOG2E;
constexpr float NEPS = 1e-6f;

constexpr size_t MiB = 1u << 20;
constexpr size_t WS_CTL = 0, CTL_BYTES = 1 * MiB;
constexpr size_t W_OFF = 1 * MiB, W_STRIDE = 39 * MiB;
constexpr size_t WO_IN = 0, WO_G = 8 * MiB, WO_BR = 14 * MiB, WO_OUT = 17 * MiB, WO_GU = 19 * MiB, WO_DN = 30 * MiB, WO_MU = 35 * MiB + 512 * 1024, WO_RU = 37 * MiB;
constexpr size_t ACT_OFF = 80 * MiB;
constexpr size_t TOKB_H = 2048, TOKB_P = 8192, TOKB_M = 3584, TOKB_A = 1536, TOKB_S = 9216, TOKB_Y = 3072, TOKB_Z = 2048;
constexpr size_t TOKB = TOKB_H + TOKB_P + TOKB_M + TOKB_A + TOKB_S + TOKB_Y + TOKB_Z;
static_assert(WO_MU + 1792 * 384 * 2 <= WO_RU && WO_RU + 2560 * 384 * 2 <= W_STRIDE && WO_DN + 1024 * 2816 * 2 <= WO_MU && WO_GU + 5632 * 1024 * 2 <= WO_DN, "weight map");
constexpr int LDS_RING = 131072, LDS_BYTES = LDS_RING + 1024;

struct Params { const float* in[33]; float* out; unsigned char* ws; int G; int Tg; };
typedef const __attribute__((address_space(4))) Params* CP;

constexpr size_t WS_PARAMS = 512 * 1024;
struct Reg { unsigned char* ws; size_t Tg;
    __device__ __forceinline__ bf16* RH() const { return (bf16*)(ws + ACT_OFF); }
    __device__ __forceinline__ bf16* RP() const { return (bf16*)(ws + ACT_OFF + Tg * TOKB_H); }
    __device__ __forceinline__ bf16* RM() const { return (bf16*)(ws + ACT_OFF + Tg * (TOKB_H + TOKB_P)); }
    __device__ __forceinline__ bf16* RA() const { return (bf16*)(ws + ACT_OFF + Tg * (TOKB_H + TOKB_P + TOKB_M)); }
    __device__ __forceinline__ _Float16* RS() const { return (_Float16*)(ws + ACT_OFF + Tg * (TOKB_H + TOKB_P + TOKB_M + TOKB_A)); }
    __device__ __forceinline__ bf16* RY() const { return (bf16*)(ws + ACT_OFF + Tg * (TOKB_H + TOKB_P + TOKB_M + TOKB_A + TOKB_S)); }
    __device__ __forceinline__ bf16* RZ() const { return (bf16*)(ws + ACT_OFF + Tg * (TOKB_H + TOKB_P + TOKB_M + TOKB_A + TOKB_S + TOKB_Y)); }
};
enum { GM_IN = 0, GM_MU = 1, GM_RU = 2, GM_GATE = 3, GM_BR0 = 4, GM_BR1 = 5, GM_BR2 = 6, GM_OUT = 7, GM_GU = 8, GM_DN = 9 };
#define EPI_FENCE() asm volatile("" ::: "memory")
struct EpiUni {
    static constexpr bool PERM = true, AFTER_DRAIN = false;
    CP pp; int id, l, g;
    __device__ __forceinline__ void operator()(const pg8::f32x4 (&acc)[2][2][4][2], const pg8::Unit& u, int wr, int wc, int fr, int fq) const {
        CP q = pp; asm volatile("" : "+s"(q));
        const int Tg = q->Tg; const Reg R{q->ws, (size_t)Tg}; const size_t asz = (size_t)Tg * 512;
        const int row0 = u.pm * 256 + wr * 64 + fr, col0 = u.pn * 256 + wc * 32 + 8 * fq;
        switch (id) {
        case GM_IN: case GM_MU: {
            bf16* O = (id == GM_IN) ? R.RP() : R.RM(); const int ldc = (id == GM_IN) ? DPROJ : 1792;
#pragma unroll
            for (int ai = 0; ai < 2; ++ai)
#pragma unroll
                for (int m = 0; m < 4; ++m) { bf16* rp = O + (size_t)(row0 + ai * 128 + m * 16) * ldc + col0;
#pragma unroll
                    for (int bj = 0; bj < 2; ++bj) { const f32x4 v0 = acc[ai][bj][m][0], v1 = acc[ai][bj][m][1]; v4u w; w.x = pk2(v0[0], v0[1]); w.y = pk2(v0[2], v0[3]); w.z = pk2(v1[0], v1[1]); w.w = pk2(v1[2], v1[3]);
                        *(v4u*)(rp + bj * 128) = w; } }
        } break;
        case GM_GATE: {
            bf16* O = R.RP(); const float* bias = q->in[4] + l * DGATE + col0;
#pragma unroll
            for (int bj = 0; bj < 2; ++bj) { const f32x4 b0 = *(const f32x4*)(bias + bj * 128), b1 = *(const f32x4*)(bias + bj * 128 + 4);
#pragma unroll
                for (int ai = 0; ai < 2; ++ai)
#pragma unroll
                    for (int m = 0; m < 4; ++m) { const f32x4 v0 = acc[ai][bj][m][0] + b0, v1 = acc[ai][bj][m][1] + b1; float f[8];
#pragma unroll
                        for (int i = 0; i < 4; ++i) { f[i] = sigmoidf_(v0[i]); f[4 + i] = sigmoidf_(v1[i]); }
                        v4u w; PACK8(w, f); *(v4u*)(O + (size_t)(row0 + ai * 128 + m * 16) * DGATE + col0 + bj * 128) = w; }
                EPI_FENCE(); }
        } break;
        case GM_GU: {
            bf16* O = R.RP(); const int hc = u.pn * 128 + wc * 32 + 8 * fq;
#pragma unroll
            for (int ai = 0; ai < 2; ++ai)
#pragma unroll
                for (int m = 0; m < 4; ++m) { float f[8];
#pragma unroll
                    for (int n = 0; n < 2; ++n)
#pragma unroll
                        for (int i = 0; i < 4; ++i) { const float gt = acc[ai][0][m][n][i], up = acc[ai][1][m][n][i]; f[4 * n + i] = gt * sigmoidf_(gt) * up; }
                    v4u w; PACK8(w, f); *(v4u*)(O + (size_t)(row0 + ai * 128 + m * 16) * DFF + hc) = w; }
        } break;
        case GM_BR0: case GM_BR1: case GM_BR2: {
            bf16* O = R.RM(); const bf16* Gt = R.RP() + u.aux * 1024; const bool first = (u.aux == 0);
#pragma unroll
            for (int ai = 0; ai < 2; ++ai)
#pragma unroll
                for (int m = 0; m < 4; ++m) { const size_t row = (size_t)(row0 + ai * 128 + m * 16);
#pragma unroll
                    for (int bj = 0; bj < 2; ++bj) { const int col = col0 + bj * 128; const v4u gv = *(const v4u*)(Gt + row * DGATE + col); float gg[8], f[8]; UNPACK8(gv, gg);
#pragma unroll
                        for (int i = 0; i < 4; ++i) { f[i] = gg[i] * acc[ai][bj][m][0][i]; f[4 + i] = gg[4 + i] * acc[ai][bj][m][1][i]; }
                        if (!first) { const v4u ov = *(const v4u*)(O + row * DM + col); float o[8]; UNPACK8(ov, o);
#pragma unroll
                            for (int i = 0; i < 8; ++i) f[i] += o[i]; }
                        v4u w; PACK8(w, f); *(v4u*)(O + row * DM + col) = w; }
                    EPI_FENCE(); }
        } break;
        case GM_OUT: case GM_DN: {
            const int t0 = g * Tg; float* xout = q->out + (size_t)t0 * DM;
            const float* xin = (id == GM_OUT && l == 0) ? ((t0 < NPROMPT) ? q->in[0] + (size_t)t0 * DM : q->in[1] + (size_t)(t0 - NPROMPT) * DM) : xout;
#pragma unroll
            for (int ai = 0; ai < 2; ++ai)
#pragma unroll
                for (int m = 0; m < 4; ++m) { const size_t off = (size_t)(row0 + ai * 128 + m * 16) * DM + col0;
#pragma unroll
                    for (int bj = 0; bj < 2; ++bj)
#pragma unroll
                        for (int n = 0; n < 2; ++n) { const f32x4 b = *(const f32x4*)(xin + off + bj * 128 + n * 4); *(f32x4*)(xout + off + bj * 128 + n * 4) = b + acc[ai][bj][m][n]; }
                    EPI_FENCE(); }
        } break;
        case GM_RU: {
            _Float16* rs = R.RS(); const _Float16* ktmp = (const _Float16*)R.RZ(); bf16* gout = R.RY() + 2 * asz;
            const int type = u.pn >> 1; const int cl0 = (u.pn & 1) * 256 + wc * 32 + 8 * fq;
            const float* w0 = q->in[17] + l * 1024; const float* a0 = q->in[19] + l * 1024; const float* ka = q->in[23] + l * 512;
#pragma unroll
            for (int ai = 0; ai < 2; ++ai)
#pragma unroll
                for (int m = 0; m < 4; ++m) { const size_t row = (size_t)(row0 + ai * 128 + m * 16);
#pragma unroll
                    for (int bj = 0; bj < 2; ++bj) { const int cl = cl0 + bj * 128; float f[8];
#pragma unroll
                        for (int i = 0; i < 4; ++i) { f[i] = acc[ai][bj][m][0][i]; f[4 + i] = acc[ai][bj][m][1][i]; }
                        if (type < 2) {
                            h8 o;
#pragma unroll
                            for (int i = 0; i < 8; ++i) o[i] = (_Float16)__expf(-0.6065306597126334f * sigmoidf_(f[i] + w0[type * 512 + cl + i]));
                            *(h8*)(rs + (size_t)(3 + type) * asz + row * 512 + cl) = o;
                        } else if (type < 4) {
                            const int d = type - 2; const h8 kv = *(const h8*)(ktmp + row * 512 + cl), kkv = *(const h8*)(rs + (size_t)2 * asz + row * 512 + cl); h8 o1, o2;
#pragma unroll
                            for (int i = 0; i < 8; ++i) { const float a = sigmoidf_(f[i] + a0[d * 512 + cl + i]); o1[i] = (_Float16)((float)kkv[i] * a); o2[i] = (_Float16)((float)kv[i] * (1.f + (a - 1.f) * ka[cl + i])); }
                            *(h8*)(rs + (size_t)(5 + d) * asz + row * 512 + cl) = o1; *(h8*)(rs + (size_t)(7 + d) * asz + row * 512 + cl) = o2;
                        } else { v4u w; PACK8(w, f); *(v4u*)(gout + row * 512 + cl) = w; }
                        EPI_FENCE(); } }
        } break;
        default: break;
        }
    }
};

__device__ __forceinline__ void transpose_item(const float* W, int ldw, int N, bf16* WT, int ldt, int koff, int row_off, int mode, LAS float* scr, int item, int lane) {
    const int nblk = N / 32, kb = item / nblk, nb = item % nblk, k0 = 64 * kb, n0 = 32 * nb;
    float tv[32];
#pragma unroll
    for (int i = 0; i < 32; ++i) { const int kk = 2 * i + (lane >> 5); tv[i] = W[(size_t)(k0 + kk) * ldw + n0 + (lane & 31)]; }
#pragma unroll
    for (int i = 0; i < 32; ++i) { const int kk = 2 * i + (lane >> 5); scr[kk * 33 + (lane & 31)] = tv[i]; }
    asm volatile("s_waitcnt lgkmcnt(0)" ::: "memory");
    const int c = lane & 7;
#pragma unroll
    for (int j = 0; j < 4; ++j) { const int n = (lane >> 3) + 8 * j; const LAS float* s = scr + (8 * c) * 33 + n;
        v4u o; o.x = pk2(s[0 * 33], s[1 * 33]); o.y = pk2(s[2 * 33], s[3 * 33]); o.z = pk2(s[4 * 33], s[5 * 33]); o.w = pk2(s[6 * 33], s[7 * 33]);
        const int nn = n0 + n; const int drow = mode ? ((nn >> 7) * 256 + row_off + (nn & 127)) : (row_off + nn);
        *(v4u*)(WT + (size_t)drow * ldt + koff + k0 + 8 * c) = o; }
    asm volatile("s_waitcnt lgkmcnt(0)" ::: "memory");
}
__device__ __forceinline__ void transpose_job(const float* W, int ldw, int K, int N, bf16* WT, int ldt, int koff, int row_off, int mode, LAS float* scr, int gw, int ngw, int lane) {
    const int nitems = (K / 64) * (N / 32);
    for (int it = gw; it < nitems; it += ngw) transpose_item(W, ldw, N, WT, ldt, koff, row_off, mode, scr, it, lane);
}
__device__ __forceinline__ void zero_bytes(unsigned char* p, size_t nbytes, size_t gtid, size_t ngt) {
    const v4u z = {0u, 0u, 0u, 0u};
    for (size_t i = gtid; i < nbytes / 16; i += ngt) ((v4u*)p)[i] = z;
}

__device__ __forceinline__ void phase_norm(const float* x, const float* g, bf16* hb, int Tg, int gw, int ngw, int lane) {
    for (int t = gw; t < Tg; t += 2 * ngw) {
        const int t2 = (t + ngw < Tg) ? t + ngw : t;
        const f32x4* xa = (const f32x4*)(x + (size_t)t * DM) + lane; const f32x4* xb = (const f32x4*)(x + (size_t)t2 * DM) + lane; f32x4 va[4], vb[4]; float sa = 0.f, sb = 0.f;
#pragma unroll
        for (int j = 0; j < 4; ++j) { va[j] = xa[64 * j]; vb[j] = xb[64 * j]; }
#pragma unroll
        for (int j = 0; j < 4; ++j) { sa += (va[j].x * va[j].x + va[j].y * va[j].y) + (va[j].z * va[j].z + va[j].w * va[j].w); sb += (vb[j].x * vb[j].x + vb[j].y * vb[j].y) + (vb[j].z * vb[j].z + vb[j].w * vb[j].w); }
        const float ia = rsqrtf(wave_sum(sa) * (1.f / DM) + NEPS), ib = rsqrtf(wave_sum(sb) * (1.f / DM) + NEPS);
        v2u* oa = (v2u*)(hb + (size_t)t * DM) + lane; v2u* ob = (v2u*)(hb + (size_t)t2 * DM) + lane;
#pragma unroll
        for (int j = 0; j < 4; ++j) { const f32x4 gg = ((const f32x4*)g)[lane + 64 * j]; v2u o;
            o.x = pk2(va[j].x * ia * gg.x, va[j].y * ia * gg.y); o.y = pk2(va[j].z * ia * gg.z, va[j].w * ia * gg.w); oa[64 * j] = o;
            o.x = pk2(vb[j].x * ib * gg.x, vb[j].y * ib * gg.y); o.y = pk2(vb[j].z * ib * gg.z, vb[j].w * ib * gg.w); ob[64 * j] = o; }
    }
}

__device__ __forceinline__ void phase_post_proj(CP pp, int l, bf16* proj, bf16* mla_a, bf16* rw_a, _Float16* rs, _Float16* ktmp, size_t asz, int Tg, int L, int gw, int ngw, int lane) {
    const float* gq = pp->in[5] + l * 64; const float* gk = pp->in[6] + l * 64;
    const float* gcq = pp->in[9] + l * 256; const float* gckv = pp->in[10] + l * 128;
    const float* mu = pp->in[16] + l * 1920; const float* kkw = pp->in[22] + l * 512;
    for (int t = gw; t < Tg; t += ngw) {
        bf16* row = proj + (size_t)t * DPROJ; const int tpos = t % L;
        const bool hasp = tpos > 0, hasn = tpos < L - 1;
        v4u qv = *(const v4u*)(row + 8 * lane), kv = *(const v4u*)(row + C_KA + 8 * lane); const v2u cv = *(const v2u*)(row + C_CQ + 4 * lane); const unsigned kvv = *(const unsigned*)(row + C_CKV + 2 * lane);
        v4u rwc[4], rwp[4], rwn[4];
#pragma unroll
        for (int it = 0; it < 4; ++it) { const int c0 = (it * 64 + lane) * 8; const v4u z = {0u, 0u, 0u, 0u}; rwc[it] = z; rwp[it] = z; rwn[it] = z;
            if (it < 3 || lane < 48) { const bf16* src = row + C_RW + c0; rwc[it] = *(const v4u*)src; if (hasp) rwp[it] = *(const v4u*)(src - DPROJ); if (hasn) rwn[it] = *(const v4u*)(src + DPROJ); } }
        {
            const int gi = 8 * (lane & 7);
            float f[8]; UNPACK8(qv, f); float ss = 0.f;
#pragma unroll
            for (int i = 0; i < 8; ++i) ss += f[i] * f[i];
            float inv = rsqrtf(sum8(ss) * (1.f / 64.f) + NEPS) * NA_QS;
#pragma unroll
            for (int i = 0; i < 8; ++i) f[i] = f[i] * inv * gq[gi + i];
            PACK8(qv, f); *(v4u*)(row + 8 * lane) = qv;
            UNPACK8(kv, f); ss = 0.f;
#pragma unroll
            for (int i = 0; i < 8; ++i) ss += f[i] * f[i];
            inv = rsqrtf(sum8(ss) * (1.f / 64.f) + NEPS);
#pragma unroll
            for (int i = 0; i < 8; ++i) f[i] = f[i] * inv * gk[gi + i];
            PACK8(kv, f); *(v4u*)(row + C_KA + 8 * lane) = kv;
        }
        {
            float a0 = bflo(cv.x), a1 = bfhi(cv.x), a2 = bflo(cv.y), a3 = bfhi(cv.y);
            float inv = rsqrtf(wave_sum(a0 * a0 + a1 * a1 + a2 * a2 + a3 * a3) * (1.f / 256.f) + NEPS);
            const f32x4 gg = *(const f32x4*)(gcq + 4 * lane); v2u o; o.x = pk2(a0 * inv * gg.x, a1 * inv * gg.y); o.y = pk2(a2 * inv * gg.z, a3 * inv * gg.w);
            *(v2u*)(mla_a + (size_t)t * 384 + 4 * lane) = o;
            a0 = bflo(kvv); a1 = bfhi(kvv);
            inv = rsqrtf(wave_sum(a0 * a0 + a1 * a1) * (1.f / 128.f) + NEPS);
            *(unsigned*)(mla_a + (size_t)t * 384 + 256 + 2 * lane) = pk2(a0 * inv * gckv[2 * lane], a1 * inv * gckv[2 * lane + 1]);
        }
#pragma unroll
        for (int it = 0; it < 4; ++it) {
            const int c0 = (it * 64 + lane) * 8;
            if (it < 3 || lane < 48) {
                float pc[8], pp[8], pn[8]; UNPACK8(rwc[it], pc); UNPACK8(rwp[it], pp); UNPACK8(rwn[it], pn);
#pragma unroll
                for (int i = 0; i < 8; ++i) pc[i] = pc[i] + mu[c0 + i] * (0.5f * (pp[i] + pn[i]) - pc[i]);
                if (it == 0) { h8 o;
#pragma unroll
                    for (int i = 0; i < 8; ++i) o[i] = (_Float16)pc[i];
                    *(h8*)(rs + (size_t)t * 512 + c0) = o; }
                else if (it == 1) { const int c = c0 - 512; h8 o; float kk[8]; float ss = 0.f;
#pragma unroll
                    for (int i = 0; i < 8; ++i) { o[i] = (_Float16)pc[i]; kk[i] = pc[i] * kkw[c + i]; ss += kk[i] * kk[i]; }
                    *(h8*)(ktmp + (size_t)t * 512 + c) = o;
                    const float inv = rsqrtf(sum8(ss) + 1e-12f);
#pragma unroll
                    for (int i = 0; i < 8; ++i) o[i] = (_Float16)(kk[i] * inv);
                    *(h8*)(rs + 2 * asz + (size_t)t * 512 + c) = o; }
                else if (it == 2) { const int c = c0 - 1024; h8 o;
#pragma unroll
                    for (int i = 0; i < 8; ++i) o[i] = (_Float16)pc[i];
                    *(h8*)(rs + asz + (size_t)t * 512 + c) = o; }
                else { const int c = c0 - 1536; float f[8];
#pragma unroll
                    for (int i = 0; i < 8; ++i) { const float x = pc[i]; f[i] = (c < 128) ? (1.f - 2.f * __builtin_amdgcn_rcpf(1.f + __expf(2.f * x))) : ((c < 256) ? x : sigmoidf_(x)); }
                    v4u w; PACK8(w, f); *(v4u*)(rw_a + (size_t)t * 384 + c) = w; }
            }
        }
    }
}

__device__ __forceinline__ void phase_mla_post(CP pp, int l, bf16* mraw, const bf16* proj, bf16* mk, int Tg, int L, int gw, int ngw, int lane) {
    const float* gq = pp->in[13] + l * 96; const float* gk = pp->in[14] + l * 96;
    const int h = lane >> 3, sub = lane & 7, rs = sub & 3; const bool hasr = sub < 4;
    float gqn[8], gkn[8], gq1[4], gq2[4], gk1[4], gk2[4], invf[4];
#pragma unroll
    for (int e = 0; e < 8; ++e) { gqn[e] = gq[8 * sub + e]; gkn[e] = gk[8 * sub + e]; }
#pragma unroll
    for (int e = 0; e < 4; ++e) { gq1[e] = gq[64 + 4 * rs + e]; gq2[e] = gq[80 + 4 * rs + e]; gk1[e] = gk[64 + 4 * rs + e]; gk2[e] = gk[80 + 4 * rs + e];
        invf[e] = __expf(-(float)((4 * rs + e) & 7) * (9.210340371976184f / 8.f)); }
    for (int t = gw; t < Tg; t += ngw) {
        const int tpos = t % L; const float pos = (float)((rs < 2) ? (tpos >> 6) : (tpos & 63));
        bf16* mrow = mraw + (size_t)t * 1792; bf16* krow = mk + (size_t)t * 768;
        const v4u qv = *(const v4u*)(mrow + h * 96 + 8 * sub), kv = *(const v4u*)(mrow + 768 + h * 128 + 8 * sub);
        v2u q1 = {0u, 0u}, q2 = {0u, 0u}, k1 = {0u, 0u}, k2 = {0u, 0u};
        if (hasr) { q1 = *(const v2u*)(mrow + h * 96 + 64 + 4 * rs); q2 = *(const v2u*)(mrow + h * 96 + 80 + 4 * rs);
                    k1 = *(const v2u*)(proj + (size_t)t * DPROJ + C_KR + 4 * rs); k2 = *(const v2u*)(proj + (size_t)t * DPROJ + C_KR + 16 + 4 * rs); }
        float cs[4], sn[4];
#pragma unroll
        for (int e = 0; e < 4; ++e) { float rev = pos * invf[e] * 0.15915494309189535f; rev -= floorf(rev); cs[e] = __builtin_amdgcn_cosf(rev); sn[e] = __builtin_amdgcn_sinf(rev); }
        {   float f[8]; UNPACK8(qv, f); float a[4] = {bflo(q1.x), bfhi(q1.x), bflo(q1.y), bfhi(q1.y)}, b[4] = {bflo(q2.x), bfhi(q2.x), bflo(q2.y), bfhi(q2.y)};
            float ss = 0.f;
#pragma unroll
            for (int e = 0; e < 8; ++e) ss += f[e] * f[e];
#pragma unroll
            for (int e = 0; e < 4; ++e) ss += a[e] * a[e] + b[e] * b[e];
            const float inv = rsqrtf(sum8(ss) * (1.f / 96.f) + NEPS) * MLA_QS;
#pragma unroll
            for (int e = 0; e < 8; ++e) f[e] = f[e] * inv * gqn[e];
            v4u o; PACK8(o, f); *(v4u*)(mrow + h * 96 + 8 * sub) = o;
            if (hasr) { float r1[4], r2[4];
#pragma unroll
                for (int e = 0; e < 4; ++e) { const float x1 = a[e] * inv * gq1[e], x2 = b[e] * inv * gq2[e]; r1[e] = x1 * cs[e] - x2 * sn[e]; r2[e] = x1 * sn[e] + x2 * cs[e]; }
                v2u o1, o2; o1.x = pk2(r1[0], r1[1]); o1.y = pk2(r1[2], r1[3]); o2.x = pk2(r2[0], r2[1]); o2.y = pk2(r2[2], r2[3]);
                *(v2u*)(mrow + h * 96 + 64 + 4 * rs) = o1; *(v2u*)(mrow + h * 96 + 80 + 4 * rs) = o2; } }
        {   float f[8]; UNPACK8(kv, f); float a[4] = {bflo(k1.x), bfhi(k1.x), bflo(k1.y), bfhi(k1.y)}, b[4] = {bflo(k2.x), bfhi(k2.x), bflo(k2.y), bfhi(k2.y)};
            float ss = 0.f;
#pragma unroll
            for (int e = 0; e < 8; ++e) ss += f[e] * f[e];
#pragma unroll
            for (int e = 0; e < 4; ++e) ss += a[e] * a[e] + b[e] * b[e];
            const float inv = rsqrtf(sum8(ss) * (1.f / 96.f) + NEPS);
#pragma unroll
            for (int e = 0; e < 8; ++e) f[e] = f[e] * inv * gkn[e];
            v4u o; PACK8(o, f); *(v4u*)(krow + h * 96 + 8 * sub) = o;
            if (hasr) { float r1[4], r2[4];
#pragma unroll
                for (int e = 0; e < 4; ++e) { const float x1 = a[e] * inv * gk1[e], x2 = b[e] * inv * gk2[e]; r1[e] = x1 * cs[e] - x2 * sn[e]; r2[e] = x1 * sn[e] + x2 * cs[e]; }
                v2u o1, o2; o1.x = pk2(r1[0], r1[1]); o1.y = pk2(r1[2], r1[3]); o2.x = pk2(r2[0], r2[1]); o2.y = pk2(r2[2], r2[3]);
                *(v2u*)(krow + h * 96 + 64 + 4 * rs) = o1; *(v2u*)(krow + h * 96 + 80 + 4 * rs) = o2; } }
    }
}

__device__ __forceinline__ void phase_rw_post(CP pp, int l, const _Float16* rs, size_t asz, const bf16* yfb, bf16* yc, int Tg, int gw, int ngw, int lane) {
    const float* lnw = pp->in[25] + l * 512 + 8 * lane; const float* lnb = pp->in[26] + l * 512 + 8 * lane; const float* rk = pp->in[24] + l * 512 + 8 * lane;
    float lw[8], lb[8], rkk[8];
#pragma unroll
    for (int i = 0; i < 8; ++i) { lw[i] = lnw[i]; lb[i] = lnb[i]; rkk[i] = rk[i]; }
    for (int t = gw; t < Tg; t += 2 * ngw) {
        const int t2 = (t + ngw < Tg) ? t + ngw : t;
        const size_t oa = (size_t)t * 512 + 8 * lane, ob = (size_t)t2 * 512 + 8 * lane;
        const v4u fa = *(const v4u*)(yfb + oa), ba = *(const v4u*)(yfb + asz + oa), fb = *(const v4u*)(yfb + ob), bb = *(const v4u*)(yfb + asz + ob);
        const h8 ra = *(const h8*)(rs + oa), va = *(const h8*)(rs + asz + oa), k0a = *(const h8*)(rs + 7 * asz + oa), k1a = *(const h8*)(rs + 8 * asz + oa);
        const h8 rb = *(const h8*)(rs + ob), vb = *(const h8*)(rs + asz + ob), k0b = *(const h8*)(rs + 7 * asz + ob), k1b = *(const h8*)(rs + 8 * asz + ob);
        const v4u ga = *(const v4u*)(yc + oa), gb = *(const v4u*)(yc + ob);
#define RWP_ONE(F_, B_, R_, V_, K0_, K1_, G_, O_) do { float y[8], f[8]; UNPACK8(F_, y); UNPACK8(B_, f); float s = 0.f; \
        _Pragma("unroll") for (int i = 0; i < 8; ++i) { y[i] += f[i]; s += y[i]; } \
        const float mean = sum8(s) * (1.f / 64.f); float q = 0.f; \
        _Pragma("unroll") for (int i = 0; i < 8; ++i) { y[i] -= mean; q += y[i] * y[i]; } \
        const float rstd = rsqrtf(sum8(q) * (1.f / 64.f) + 64e-5f); float b = 0.f; \
        _Pragma("unroll") for (int i = 0; i < 8; ++i) b += (float)R_[i] * ((float)K0_[i] + (float)K1_[i]) * rkk[i]; \
        b = sum8(b); UNPACK8(G_, f); \
        _Pragma("unroll") for (int i = 0; i < 8; ++i) f[i] = (y[i] * rstd * lw[i] + lb[i] + b * (float)V_[i]) * f[i]; \
        v4u w; PACK8(w, f); *(v4u*)(yc + (O_)) = w; } while (0)
        RWP_ONE(fa, ba, ra, va, k0a, k1a, ga, oa);
        if (t2 != t) RWP_ONE(fb, bb, rb, vb, k0b, k1b, gb, ob);
#undef RWP_ONE
    }
}

#define GAS __attribute__((address_space(1)))
typedef float f2 __attribute__((ext_vector_type(2)));
#define DPP_ADD(x, ctrl) ((x) + __builtin_bit_cast(float, __builtin_amdgcn_update_dpp(0, __builtin_bit_cast(int, (x)), (ctrl), 0xF, 0xF, true)))
__device__ __forceinline__ float red8(float x) { x = DPP_ADD(x, 0xB1); x = DPP_ADD(x, 0x4E); x = DPP_ADD(x, 0x141); return x; }
constexpr int SCH = 32, SBUF = 6 * SCH * 256;
__device__ __forceinline__ void scan_unit(int u, int L, const _Float16* rs, size_t asz, bf16* yfb, LAS unsigned char* lds) {
    const int tid = ltid(); const int lane = tid & 63, w = tid >> 6, vr = lane >> 3, ko = lane & 7;
    const int dir = u & 1, sh = u >> 1, h = sh & 7, s = sh >> 3;
    const int kA = tid >> 8, lj = (tid >> 3) & 31, lp = tid & 7;
    const size_t tok0 = (size_t)s * L + (dir ? (L - 1 - lj) : lj);
    const long tstep = dir ? -(long)SCH * 512 : (long)SCH * 512;
    const size_t eoff = tok0 * 512 + h * 64 + lp * 8;
    const GAS _Float16* g0 = (const GAS _Float16*)(rs + (size_t)(kA ? 2 : 0) * asz + eoff);
    const GAS _Float16* g1 = (const GAS _Float16*)(rs + (size_t)(kA ? 5 + dir : 3 + dir) * asz + eoff);
    const GAS _Float16* g2 = (const GAS _Float16*)(rs + (size_t)(kA ? 1 : 7 + dir) * asz + eoff);
    const int ld0 = (((0 + kA) * SCH + lj) * 64 + lp * 8) * 4, ld1 = (((2 + kA) * SCH + lj) * 64 + lp * 8) * 4, ld2 = (((4 + kA) * SCH + lj) * 64 + lp * 8) * 4;
    GAS bf16* py = (GAS bf16*)(yfb + (size_t)dir * asz + ((size_t)s * L + (dir ? L - 1 : 0)) * 512 + h * 64 + 8 * w + vr);
    const long ystep = dir ? -512 : 512;
    const int rd = ko * 32, rdv = (5 * SCH * 64 + 8 * w + vr) * 4;
    f2 S[4];
#pragma unroll
    for (int i = 0; i < 4; ++i) S[i] = (f2){0.f, 0.f};
    h8 p0 = *(const GAS h8*)g0, p1 = *(const GAS h8*)g1, p2 = *(const GAS h8*)g2;
#define SCAN_PUT(bufo) do { f32x4 a, b; \
        a = (f32x4){(float)p0[0], (float)p0[1], (float)p0[2], (float)p0[3]}; b = (f32x4){(float)p0[4], (float)p0[5], (float)p0[6], (float)p0[7]}; *(LAS f32x4*)(lds + (bufo) + ld0) = a; *(LAS f32x4*)(lds + (bufo) + ld0 + 16) = b; \
        a = (f32x4){(float)p1[0], (float)p1[1], (float)p1[2], (float)p1[3]}; b = (f32x4){(float)p1[4], (float)p1[5], (float)p1[6], (float)p1[7]}; *(LAS f32x4*)(lds + (bufo) + ld1) = a; *(LAS f32x4*)(lds + (bufo) + ld1 + 16) = b; \
        a = (f32x4){(float)p2[0], (float)p2[1], (float)p2[2], (float)p2[3]}; b = (f32x4){(float)p2[4], (float)p2[5], (float)p2[6], (float)p2[7]}; *(LAS f32x4*)(lds + (bufo) + ld2) = a; *(LAS f32x4*)(lds + (bufo) + ld2 + 16) = b; } while (0)
    SCAN_PUT(0);
    __syncthreads();
    const int NC = L / SCH;
#pragma unroll 1
    for (int c = 0; c < NC; ++c) {
        const int cur = (c & 1) * SBUF;
        if (c + 1 < NC) { const long o = tstep * (long)(c + 1); p0 = *(const GAS h8*)(g0 + o); p1 = *(const GAS h8*)(g1 + o); p2 = *(const GAS h8*)(g2 + o); }
        LAS unsigned char* bp = lds + cur + rd;
        GAS bf16* pyc = py + ystep * (long)(c * SCH);
#pragma unroll 1
        for (int j0 = 0; j0 < SCH; j0 += 4) { float yv[4];
#pragma unroll
        for (int jj = 0; jj < 4; ++jj) { const int j = j0 + jj;
            const LAS unsigned char* q = bp + j * 256;
            const f32x4 r0 = *(const LAS f32x4*)(q), r1 = *(const LAS f32x4*)(q + 16);
            const f32x4 k0 = *(const LAS f32x4*)(q + SCH * 256), k1 = *(const LAS f32x4*)(q + SCH * 256 + 16);
            const f32x4 w0 = *(const LAS f32x4*)(q + 2 * SCH * 256), w1 = *(const LAS f32x4*)(q + 2 * SCH * 256 + 16);
            const f32x4 a0 = *(const LAS f32x4*)(q + 3 * SCH * 256), a1 = *(const LAS f32x4*)(q + 3 * SCH * 256 + 16);
            const f32x4 d0 = *(const LAS f32x4*)(q + 4 * SCH * 256), d1 = *(const LAS f32x4*)(q + 4 * SCH * 256 + 16);
            const float vv = *(const LAS float*)(lds + cur + rdv + j * 256);
            const f2 vv2 = (f2){vv, vv};
            f2 e0 = S[0] * w0.xy, e1 = S[1] * w0.zw, e2 = S[2] * w1.xy, e3 = S[3] * w1.zw;
            f2 pa = S[0] * k0.xy, pb = S[1] * k0.zw; pa = S[2] * k1.xy + pa; pb = S[3] * k1.zw + pb;
            e0 = d0.xy * vv2 + e0; e1 = d0.zw * vv2 + e1; e2 = d1.xy * vv2 + e2; e3 = d1.zw * vv2 + e3;
            const f2 pd = pa + pb;
            const float nskk = -red8(pd.x + pd.y);
            const f2 ns2 = (f2){nskk, nskk};
            S[0] = a0.xy * ns2 + e0; S[1] = a0.zw * ns2 + e1; S[2] = a1.xy * ns2 + e2; S[3] = a1.zw * ns2 + e3;
            f2 qa = S[0] * r0.xy, qb = S[1] * r0.zw; qa = S[2] * r1.xy + qa; qb = S[3] * r1.zw + qb;
            const f2 qd = qa + qb;
            yv[jj] = red8(qd.x + qd.y);
        }
            if (ko == 0) {
#pragma unroll
                for (int jj = 0; jj < 4; ++jj) pyc[ystep * (j0 + jj)] = f2bf(yv[jj]); }
        }
        if (c + 1 < NC) SCAN_PUT(SBUF - cur);
        __syncthreads();
    }
#undef SCAN_PUT
}

constexpr int MKP = 208, MVP = 144, MBUF = 64 * MKP + 64 * MVP;
#define MLA_THR 6.0f
__device__ __forceinline__ float max3f(float a, float b, float c) { return fmaxf(fmaxf(a, b), c); }
__device__ __forceinline__ void mla_unit(int u, int L, const bf16* mraw, const bf16* mk, bf16* yb, LAS unsigned char* lds) {
    const int tid = ltid(), lane = tid & 63, w = tid >> 6, q32 = lane & 31, hi = lane >> 5;
    const int nqb = L >> 8, qb = u % nqb, sh = u / nqb, h = sh & 7, s = sh >> 3;
    const size_t base = (size_t)s * L; const int NT = L >> 6;
    const size_t qtok = base + qb * 256 + w * 32 + q32;
    bf16x8 qf[6];
#pragma unroll
    for (int ks = 0; ks < 6; ++ks) qf[ks] = *(const bf16x8*)(mraw + qtok * 1792 + h * 96 + ks * 16 + hi * 8);
    const int kkey0 = tid / 12, kch0 = tid % 12, kkey1 = (tid + 512) / 12, kch1 = (tid + 512) % 12; const bool k2 = tid < 256;
    const bf16* ks0 = mk + (base + kkey0) * 768 + h * 96 + kch0 * 8; const bf16* ks1 = mk + (base + kkey1) * 768 + h * 96 + kch1 * 8;
    const int vkey = tid >> 3, vch = tid & 7;
    const bf16* vs = mraw + (base + vkey) * 1792 + 768 + h * 128 + 64 + vch * 8;
    const int kd0 = kkey0 * MKP + kch0 * 16, kd1 = kkey1 * MKP + kch1 * 16, vd = 64 * MKP + vkey * MVP + vch * 16;
    v4u rk0, rk1 = {0u, 0u, 0u, 0u}, rv, sk0, sk1 = {0u, 0u, 0u, 0u}, sv;
#define MLA_LOAD(t) do { const size_t adv_ = (size_t)(t) * 64; rk0 = *(const v4u*)(ks0 + adv_ * 768); if (k2) rk1 = *(const v4u*)(ks1 + adv_ * 768); rv = *(const v4u*)(vs + adv_ * 1792); } while (0)
#define MLA_PUT(bo) do { *(LAS v4u*)(lds + (bo) + kd0) = rk0; if (k2) *(LAS v4u*)(lds + (bo) + kd1) = rk1; *(LAS v4u*)(lds + (bo) + vd) = rv; } while (0)
#define MLA_LOADB(t) do { const size_t adv_ = (size_t)(t) * 64; sk0 = *(const v4u*)(ks0 + adv_ * 768); if (k2) sk1 = *(const v4u*)(ks1 + adv_ * 768); sv = *(const v4u*)(vs + adv_ * 1792); } while (0)
#define MLA_PUTB(bo) do { *(LAS v4u*)(lds + (bo) + kd0) = sk0; if (k2) *(LAS v4u*)(lds + (bo) + kd1) = sk1; *(LAS v4u*)(lds + (bo) + vd) = sv; } while (0)
    MLA_LOAD(0); MLA_PUT(0); MLA_LOAD(1); MLA_PUT(MBUF);
    __syncthreads();
    const int kmap = 16 * (q32 >> 4) + 8 * ((q32 >> 2) & 1) + (q32 & 3) + 4 * ((q32 >> 3) & 1);
    const int koff = kmap * MKP + hi * 16;
    const int voff = 64 * MKP + (8 * hi + ((lane & 15) >> 2)) * MVP + (16 * ((lane >> 4) & 1) + 4 * (lane & 3)) * 2;
    f32x16 o0 = {}, o1 = {}, negm = {}, pA0, pA1, pB0, pB1; float lsum = 0.f; v4u pw0, pw1, pw2, pw3;
    int b_prev = 0, b_cur = MBUF, b_next = 2 * MBUF;
#define MLA_KA(bo, ks) (*(const LAS bf16x8*)(lds + (bo) + koff + (ks) * 32))
#define MLA_KB(bo, ks) (*(const LAS bf16x8*)(lds + (bo) + koff + 32 * MKP + (ks) * 32))
#define MLA_QK2(C0, C1, bo, ks) do { C0 = __builtin_amdgcn_mfma_f32_32x32x16_bf16(MLA_KA(bo, ks), qf[ks], C0, 0, 0, 0); C1 = __builtin_amdgcn_mfma_f32_32x32x16_bf16(MLA_KB(bo, ks), qf[ks], C1, 0, 0, 0); } while (0)
#define MLA_FIN8(P, g, PW) do { float e0 = __builtin_amdgcn_exp2f(P[8 * g + 0]), e1 = __builtin_amdgcn_exp2f(P[8 * g + 1]), e2 = __builtin_amdgcn_exp2f(P[8 * g + 2]), e3 = __builtin_amdgcn_exp2f(P[8 * g + 3]), \
        e4 = __builtin_amdgcn_exp2f(P[8 * g + 4]), e5 = __builtin_amdgcn_exp2f(P[8 * g + 5]), e6 = __builtin_amdgcn_exp2f(P[8 * g + 6]), e7 = __builtin_amdgcn_exp2f(P[8 * g + 7]); \
        lsum += ((e0 + e1) + (e2 + e3)) + ((e4 + e5) + (e6 + e7)); PW.x = pk2(e0, e1); PW.y = pk2(e2, e3); PW.z = pk2(e4, e5); PW.w = pk2(e6, e7); } while (0)
#define MLA_VT(bo, kg, db) ({ const int vb_ = (bo) + voff + (kg) * 16 * MVP + (db) * 64; \
        const s16x4 t0_ = __builtin_amdgcn_ds_read_tr16_b64_v4i16((LAS s16x4*)(lds + vb_)), t1_ = __builtin_amdgcn_ds_read_tr16_b64_v4i16((LAS s16x4*)(lds + vb_ + 4 * MVP)); \
        (bf16x8){t0_[0], t0_[1], t0_[2], t0_[3], t1_[0], t1_[1], t1_[2], t1_[3]}; })
#define MLA_PV(bo, kg, PW) do { const bf16x8 pf_ = __builtin_bit_cast(bf16x8, PW); o0 = __builtin_amdgcn_mfma_f32_32x32x16_bf16(MLA_VT(bo, kg, 0), pf_, o0, 0, 0, 0); o1 = __builtin_amdgcn_mfma_f32_32x32x16_bf16(MLA_VT(bo, kg, 1), pf_, o1, 0, 0, 0); } while (0)
#define MLA_ROWMAX(C0, C1) ({ float a_ = max3f(C0[0], C0[1], C1[0]), b_ = max3f(C0[2], C0[3], C1[1]); a_ = max3f(a_, C1[2], C1[3]); \
        _Pragma("unroll") for (int r_ = 4; r_ < 16; r_ += 4) { a_ = max3f(a_, C0[r_], C0[r_ + 1]); b_ = max3f(b_, C0[r_ + 2], C0[r_ + 3]); a_ = max3f(a_, C1[r_], C1[r_ + 1]); b_ = max3f(b_, C1[r_ + 2], C1[r_ + 3]); } \
        const float m_ = fmaxf(a_, b_); fmaxf(m_, __shfl_xor(m_, 32)); })
#define MLA_STEP(P0, P1, C0, C1, j, LOADX, PUTX, DOMAX) do { \
        if ((j) + 2 < NT) LOADX((j) + 2); \
        C0 = negm; C1 = negm; \
        MLA_QK2(C0, C1, b_cur, 0); MLA_QK2(C0, C1, b_cur, 1); MLA_FIN8(P0, 0, pw0); \
        MLA_QK2(C0, C1, b_cur, 2); MLA_FIN8(P0, 1, pw1); \
        MLA_QK2(C0, C1, b_cur, 3); MLA_FIN8(P1, 0, pw2); \
        MLA_QK2(C0, C1, b_cur, 4); MLA_FIN8(P1, 1, pw3); \
        MLA_QK2(C0, C1, b_cur, 5); \
        MLA_PV(b_prev, 0, pw0); MLA_PV(b_prev, 1, pw1); \
        float mt_ = 0.f; if (DOMAX) mt_ = MLA_ROWMAX(C0, C1); \
        MLA_PV(b_prev, 2, pw2); MLA_PV(b_prev, 3, pw3); \
        if (DOMAX && __any(mt_ > MLA_THR)) { const float dl_ = fmaxf(mt_, 0.f); const float fs_ = __builtin_amdgcn_exp2f(-dl_); lsum *= fs_; \
            _Pragma("unroll") for (int r_ = 0; r_ < 16; ++r_) { C0[r_] -= dl_; C1[r_] -= dl_; negm[r_] -= dl_; o0[r_] *= fs_; o1[r_] *= fs_; } } \
        if ((j) + 1 < NT) PUTX(b_next); \
        __syncthreads(); \
        { const int t_ = b_prev; b_prev = b_cur; b_cur = b_next; b_next = t_; } \
    } while (0)
    pA0 = negm; pA1 = negm;
#pragma unroll
    for (int ks = 0; ks < 6; ++ks) MLA_QK2(pA0, pA1, 0, ks);
    { const float m0 = MLA_ROWMAX(pA0, pA1);
#pragma unroll
      for (int r = 0; r < 16; ++r) { pA0[r] -= m0; pA1[r] -= m0; negm[r] = -m0; } }
    MLA_LOADB(2);
    int jt = 1;
#pragma unroll 1
    for (; jt + 1 < NT; jt += 2) {
        MLA_STEP(pA0, pA1, pB0, pB1, jt, MLA_LOAD, MLA_PUTB, true);
        MLA_STEP(pB0, pB1, pA0, pA1, jt + 1, MLA_LOADB, MLA_PUT, false);
    }
    if (jt < NT) { MLA_STEP(pA0, pA1, pB0, pB1, jt, MLA_LOAD, MLA_PUTB, true); pA0 = pB0; pA1 = pB1; }
    MLA_FIN8(pA0, 0, pw0); MLA_FIN8(pA0, 1, pw1); MLA_FIN8(pA1, 0, pw2); MLA_FIN8(pA1, 1, pw3);
    MLA_PV(b_prev, 0, pw0); MLA_PV(b_prev, 1, pw1); MLA_PV(b_prev, 2, pw2); MLA_PV(b_prev, 3, pw3);
    lsum += __shfl_xor(lsum, 32);
    const float inv = __builtin_amdgcn_rcpf(lsum);
    bf16* orow = yb + qtok * 512 + h * 64 + 4 * hi;
#pragma unroll
    for (int rq = 0; rq < 4; ++rq) {
        v2u a, b; a.x = pk2(o0[4 * rq] * inv, o0[4 * rq + 1] * inv); a.y = pk2(o0[4 * rq + 2] * inv, o0[4 * rq + 3] * inv);
        b.x = pk2(o1[4 * rq] * inv, o1[4 * rq + 1] * inv); b.y = pk2(o1[4 * rq + 2] * inv, o1[4 * rq + 3] * inv);
        *(v2u*)(orow + 8 * rq) = a; *(v2u*)(orow + 32 + 8 * rq) = b;
    }
    __syncthreads();
#undef MLA_LOAD
#undef MLA_PUT
#undef MLA_LOADB
#undef MLA_PUTB
#undef MLA_KA
#undef MLA_KB
#undef MLA_QK2
#undef MLA_FIN8
#undef MLA_VT
#undef MLA_PV
#undef MLA_ROWMAX
#undef MLA_STEP
}

constexpr int NVP = 144, NA_WLDS = 64 * NVP + 1888;
__device__ __forceinline__ void na_unit(int u, int L, int l, const float* rpb_all, const bf16* proj, bf16* ya, LAS unsigned char* lds) {
    const int tid = ltid(); const int lane = tid & 63, w = tid >> 6, i16 = lane & 15, quad = lane >> 4;
    const int rows = L >> 6; const int hq = u & 3, sr = u >> 2, r = sr % rows, s = sr / rows;
    const int h = 2 * hq + (w >> 2), j = w & 3;
    const int rs = min(max(r - 4, 0), rows - 8), kc0 = min(max(16 * j - 8, 0), 32);
    const size_t base = (size_t)s * L;
    const size_t qtok = base + r * 64 + 16 * j + i16;
    LAS unsigned char* vw = lds + w * NA_WLDS; LAS float* tb = (LAS float*)(vw + 64 * NVP);
    { const float* rpb = rpb_all + (size_t)(l * 8 + h) * 465;
#pragma unroll
      for (int it = 0; it < 8; ++it) { const int idx = it * 64 + lane; if (idx < 465) tb[idx] = rpb[idx]; } }
    bf16x8 qf[2];
    qf[0] = *(const bf16x8*)(proj + qtok * DPROJ + h * 64 + quad * 8); qf[1] = *(const bf16x8*)(proj + qtok * DPROJ + h * 64 + 32 + quad * 8);
    const int cA = (i16 >> 2) * 8 + (i16 & 3);
    const bf16* kp0 = proj + (base + (size_t)rs * 64 + kc0 + cA) * DPROJ + C_KA + h * 64 + quad * 8;
    bf16x8 kf[8][4];
#pragma unroll
    for (int wr = 0; wr < 8; ++wr) { const bf16* kp = kp0 + (size_t)wr * 64 * DPROJ;
        kf[wr][0] = *(const bf16x8*)kp; kf[wr][1] = *(const bf16x8*)(kp + 32); kf[wr][2] = *(const bf16x8*)(kp + 4 * DPROJ); kf[wr][3] = *(const bf16x8*)(kp + 4 * DPROJ + 32); }
    const bf16* vp0 = proj + (base + (size_t)rs * 64 + kc0) * DPROJ + C_VA + h * 64;
    v4u vt[8];
#define NA_VLOAD(ck) do { _Pragma("unroll") for (int it = 0; it < 8; ++it) { const int idx = it * 64 + lane, key = idx >> 3, ch = idx & 7; \
        vt[it] = *(const v4u*)(vp0 + ((size_t)(2 * (ck) + (key >> 5)) * 64 + (key & 31)) * DPROJ + ch * 8); } } while (0)
    NA_VLOAD(0);
    f32x4 sa[8], sb[8];
#pragma unroll
    for (int wr = 0; wr < 8; ++wr) {
        f32x4 a = {0.f, 0.f, 0.f, 0.f}, b = {0.f, 0.f, 0.f, 0.f};
        a = __builtin_amdgcn_mfma_f32_16x16x32_bf16(kf[wr][0], qf[0], a, 0, 0, 0); a = __builtin_amdgcn_mfma_f32_16x16x32_bf16(kf[wr][1], qf[1], a, 0, 0, 0);
        b = __builtin_amdgcn_mfma_f32_16x16x32_bf16(kf[wr][2], qf[0], b, 0, 0, 0); b = __builtin_amdgcn_mfma_f32_16x16x32_bf16(kf[wr][3], qf[1], b, 0, 0, 0);
        sa[wr] = a; sb[wr] = b;
    }
    asm volatile("s_waitcnt lgkmcnt(0)" ::: "memory");
    const int qc = 16 * j + i16, wst = min(max(qc - 8, 0), 48);
    float mx = -1e30f;
#pragma unroll
    for (int wr = 0; wr < 8; ++wr) { const LAS float* rb = tb + (rs + wr - r + 7) * 31;
#pragma unroll
        for (int jj = 0; jj < 4; ++jj) {
            { const int kc = kc0 + quad * 8 + jj; const bool ok = (kc >= wst) && (kc < wst + 16); const int dc = min(max(kc - qc + 15, 0), 30);
              const float v = ok ? (sa[wr][jj] + rb[dc] * LOG2E) : -1e30f; sa[wr][jj] = v; mx = fmaxf(mx, v); }
            { const int kc = kc0 + quad * 8 + 4 + jj; const bool ok = (kc >= wst) && (kc < wst + 16); const int dc = min(max(kc - qc + 15, 0), 30);
              const float v = ok ? (sb[wr][jj] + rb[dc] * LOG2E) : -1e30f; sb[wr][jj] = v; mx = fmaxf(mx, v); }
        } }
    mx = fmaxf(mx, __shfl_xor(mx, 16)); mx = fmaxf(mx, __shfl_xor(mx, 32));
    float ls = 0.f;
#pragma unroll
    for (int wr = 0; wr < 8; ++wr)
#pragma unroll
        for (int jj = 0; jj < 4; ++jj) { sa[wr][jj] = __builtin_amdgcn_exp2f(sa[wr][jj] - mx); sb[wr][jj] = __builtin_amdgcn_exp2f(sb[wr][jj] - mx); ls += sa[wr][jj] + sb[wr][jj]; }
    ls += __shfl_xor(ls, 16); ls += __shfl_xor(ls, 32);
    f32x4 oc[4];
#pragma unroll
    for (int db = 0; db < 4; ++db) oc[db] = (f32x4){0.f, 0.f, 0.f, 0.f};
    const int toff = (quad * 8 + (i16 >> 2)) * NVP + (4 * (lane & 3)) * 2;
#pragma unroll
    for (int ck = 0; ck < 4; ++ck) {
        asm volatile("s_waitcnt lgkmcnt(0)" ::: "memory");
#pragma unroll
        for (int it = 0; it < 8; ++it) { const int idx = it * 64 + lane, key = idx >> 3, ch = idx & 7; *(LAS v4u*)(vw + key * NVP + ch * 16) = vt[it]; }
        if (ck < 3) NA_VLOAD(ck + 1);
        asm volatile("s_waitcnt lgkmcnt(0)" ::: "memory");
#pragma unroll
        for (int wl = 0; wl < 2; ++wl) { const int wr = 2 * ck + wl;
            v4u pw; pw.x = pk2(sa[wr][0], sa[wr][1]); pw.y = pk2(sa[wr][2], sa[wr][3]); pw.z = pk2(sb[wr][0], sb[wr][1]); pw.w = pk2(sb[wr][2], sb[wr][3]);
            const bf16x8 pf = __builtin_bit_cast(bf16x8, pw);
#pragma unroll
            for (int db = 0; db < 4; ++db) { const int vb = toff + wl * 32 * NVP + db * 32;
                const s16x4 t0 = __builtin_amdgcn_ds_read_tr16_b64_v4i16((LAS s16x4*)(vw + vb)), t1 = __builtin_amdgcn_ds_read_tr16_b64_v4i16((LAS s16x4*)(vw + vb + 4 * NVP));
                const bf16x8 vf = {t0[0], t0[1], t0[2], t0[3], t1[0], t1[1], t1[2], t1[3]};
                oc[db] = __builtin_amdgcn_mfma_f32_16x16x32_bf16(vf, pf, oc[db], 0, 0, 0); }
        }
    }
#undef NA_VLOAD
    const float inv = __builtin_amdgcn_rcpf(ls);
    bf16* orow = ya + qtok * 512 + h * 64 + quad * 4;
#pragma unroll
    for (int db = 0; db < 4; ++db) { v2u o; o.x = pk2(oc[db][0] * inv, oc[db][1] * inv); o.y = pk2(oc[db][2] * inv, oc[db][3] * inv); *(v2u*)(orow + db * 16) = o; }
    asm volatile("s_waitcnt lgkmcnt(0)" ::: "memory");
}

#define XB_TMO      128
#define XB_XCNT(j)  (256  + 64 * (j))
#define XB_XSUB(j)  (1280 + 64 * (j))
#define XB_XGEN(j)  (2304 + 64 * (j))
#define XB_TOP      3328
#define XB_TOPGEN   3392
#define XCD_BAR_WORDS 3456
#define XB_SPIN_CAP (1u << 18)

__device__ __forceinline__ unsigned xb_ld(unsigned* p)              { return __hip_atomic_load(p, __ATOMIC_RELAXED, __HIP_MEMORY_SCOPE_AGENT); }
__device__ __forceinline__ unsigned xb_add(unsigned* p, unsigned v) { return __hip_atomic_fetch_add(p, v, __ATOMIC_RELAXED, __HIP_MEMORY_SCOPE_AGENT); }
__device__ __forceinline__ unsigned xb_xcc_id() { return (unsigned)__builtin_amdgcn_s_getreg((3 << 11) | 20) & 0xFu; }
#define XB_SPIN(cond, bar) do { unsigned _sp = 0; while (cond) { __builtin_amdgcn_s_sleep(1); \
    if ((++_sp & 255u) == 0u) { if (xb_ld(&(bar)[XB_TMO])) break; if (_sp > XB_SPIN_CAP) { atomicAdd(&(bar)[XB_TMO], 1u); break; } } } } while (0)

struct XcdBarrier {
    unsigned* bar; unsigned x;
    volatile LAS unsigned* st;
};

__device__ __forceinline__ XcdBarrier xcd_barrier_post(unsigned* bar, volatile LAS unsigned* st) {
    XcdBarrier b; b.bar = bar; b.x = xb_xcc_id(); b.st = st;
    if (threadIdx.x == 0) (void)xb_add(&bar[XB_XCNT(b.x)], 1u);
    return b;
}
__device__ __forceinline__ void xcd_barrier_complete(unsigned* bar, unsigned x, unsigned& nloc, unsigned& nx) {
    const unsigned G = gridDim.x * gridDim.y * gridDim.z;
    unsigned sum, cnt, mine, sp = 0u;
    for (;;) {
        sum = 0u; cnt = 0u; mine = 0u;
#pragma unroll
        for (unsigned j = 0; j < 16; ++j) { const unsigned c = xb_ld(&bar[XB_XCNT(j)]); sum += c; cnt += (c > 0u) ? 1u : 0u; mine = (j == x) ? c : mine; }
        if (sum == G) break;
        __builtin_amdgcn_s_sleep(1);
        if ((++sp & 255u) == 0u) { if (xb_ld(&bar[XB_TMO])) break; if (sp > XB_SPIN_CAP) { atomicAdd(&bar[XB_TMO], 1u); break; } }
    }
    nloc = mine > 0u ? mine : 1u; nx = cnt > 0u ? cnt : 1u;
}

__device__ __forceinline__ void xcd_barrier(const XcdBarrier& b) {
    asm volatile("s_waitcnt vmcnt(0)" ::: "memory");
    __syncthreads();
    if (threadIdx.x == 0) {
        unsigned* bar = b.bar;
        __builtin_amdgcn_s_waitcnt(0);
        unsigned nloc = b.st[0], nx = b.st[1];
        if (nloc == 0u) { xcd_barrier_complete(bar, b.x, nloc, nx); b.st[0] = nloc; b.st[1] = nx; }
        const unsigned old = xb_add(&bar[XB_XSUB(b.x)], 1u);
        const unsigned gen = old / nloc;
        if (old + 1u == (gen + 1u) * nloc) {
            __builtin_amdgcn_fence(__ATOMIC_RELEASE, "agent");
            asm volatile("s_waitcnt vmcnt(0)" ::: "memory");
            const unsigned og = xb_add(&bar[XB_TOP], 1u);
            const unsigned tg = og / nx;
            if (og + 1u == (tg + 1u) * nx) xb_add(&bar[XB_TOPGEN], 1u);
            else XB_SPIN(xb_ld(&bar[XB_TOPGEN]) == tg, bar);
            __builtin_amdgcn_fence(__ATOMIC_ACQUIRE, "agent");
            xb_add(&bar[XB_XGEN(b.x)], 1u);
            asm volatile("s_waitcnt vmcnt(0)" ::: "memory");
        } else {
            XB_SPIN(xb_ld(&bar[XB_XGEN(b.x)]) == gen, bar);
            __builtin_amdgcn_fence(__ATOMIC_ACQUIRE, "agent");
            asm volatile("s_waitcnt vmcnt(0)" ::: "memory");
        }
    }
    __syncthreads();
}

constexpr int NPH = 12;
__device__ __forceinline__ void run_phase(CP pp, int st, LAS unsigned char* lds) {
    volatile LAS unsigned* lctl = (volatile LAS unsigned*)(lds + LDS_RING);
    const int tid = ltid(), lane = tid & 63, wave = __builtin_amdgcn_readfirstlane(tid >> 6);
    int bid_ = blockIdx.x; asm volatile("" : "+s"(bid_));
    const int NB = gridDim.x, gw = bid_ * 8 + wave, ngw = NB * 8;
    const int ph = st % NPH, gl = st / NPH, l = gl & 1, g = gl >> 1;
    unsigned char* ws = pp->ws; const int Tg = pp->Tg;
    const Reg R{ws, (size_t)Tg};
    const size_t asz = (size_t)Tg * 512;
    const int t0 = g * Tg; const int L = (t0 < NPROMPT) ? 8192 : 4096;
    float* xout = pp->out + (size_t)t0 * DM;
    int gid0 = 0, gidn = 0;
    switch (ph) {
    case 0: {
        const float* xin = (l == 0) ? ((t0 < NPROMPT) ? pp->in[0] + (size_t)t0 * DM : pp->in[1] + (size_t)(t0 - NPROMPT) * DM) : xout;
        phase_norm(xin, pp->in[2] + l * DM, R.RH(), Tg, gw, ngw, lane);
    } break;
    case 1: gid0 = GM_IN; gidn = 1; break;
    case 2: {
        phase_post_proj(pp, l, R.RP(), R.RA(), R.RA() + (size_t)Tg * 384, R.RS(), (_Float16*)R.RZ(), asz, Tg, L, gw, ngw, lane);
    } break;
    case 3: gid0 = GM_MU; gidn = 2; break;
    case 4: {
        phase_mla_post(pp, l, R.RM(), R.RP(), R.RA(), Tg, L, gw, ngw, lane);
    } break;
    case 5: {
        unsigned* qctr = (unsigned*)(ws + WS_CTL) + 64 * gl; const int nseq = Tg / L; const int nqb = L >> 8;
        const int NS = nseq * 16, NMq = nseq * nqb, NN = nseq * (L >> 6) * 4;
        const unsigned xcc = xb_xcc_id() & 7u;
        int stage = 0;
        for (;;) {
            __syncthreads();
            if (tid == 0) {
                int kind = -1; int idx = 0;
                while (stage <= 9) {
                    if (stage == 0) { idx = (int)atomicAdd(qctr, 1u); if (idx < NS) { kind = 0; break; } }
                    else if (stage <= 8) { const int qx = (int)((xcc + (unsigned)(stage - 1)) & 7u); idx = (int)atomicAdd(qctr + 8 + qx, 1u);
                        if (idx < NMq) { kind = 1; idx = ((idx / nqb) * 8 + qx) * nqb + idx % nqb; break; } }
                    else { idx = (int)atomicAdd(qctr + 1, 1u); if (idx < NN) { kind = 2; break; } }
                    ++stage;
                }
                lctl[0] = (unsigned)kind; lctl[1] = (unsigned)idx;
            }
            __syncthreads();
            const int kind = __builtin_amdgcn_readfirstlane((int)lctl[0]); const int u = __builtin_amdgcn_readfirstlane((int)lctl[1]);
            if (kind < 0) break;
            if (kind == 0) scan_unit(u, L, R.RS(), asz, R.RZ(), lds);
            else if (kind == 1) mla_unit(u, L, R.RM(), R.RA(), R.RY() + asz, lds);
            else na_unit(u, L, l, pp->in[7], R.RP(), R.RY(), lds);
        }
    } break;
    case 6: {
        phase_rw_post(pp, l, R.RS(), asz, R.RZ(), R.RY() + 2 * asz, Tg, gw, ngw, lane);
        gid0 = GM_GATE; gidn = 1;
    } break;
    case 7: gid0 = GM_BR0; gidn = 1; break;
    case 8: gid0 = GM_OUT; gidn = 1; break;
    case 9: {
        phase_norm(xout, pp->in[29] + l * DM, R.RH(), Tg, gw, ngw, lane);
    } break;
    case 10: gid0 = GM_GU; gidn = 1; break;
    case 11: gid0 = GM_DN; gidn = 1; break;
    default: break;
    }
#pragma unroll 1
    for (int id = gid0; id < gid0 + gidn; ++id) {
        const unsigned char* wb = ws + W_OFF + (size_t)l * W_STRIDE;
        const bf16* A; const bf16* Bt; int N, K;
        switch (id) {
        case GM_IN:   A = R.RH(); Bt = (const bf16*)(wb + WO_IN); N = DPROJ; K = 1024; break;
        case GM_MU:   A = R.RA(); Bt = (const bf16*)(wb + WO_MU); N = 1792; K = 384; break;
        case GM_RU:   A = R.RA() + (size_t)Tg * 384; Bt = (const bf16*)(wb + WO_RU); N = 2560; K = 384; break;
        case GM_GATE: A = R.RH(); Bt = (const bf16*)(wb + WO_G); N = DGATE; K = 1024; break;
        case GM_BR0: case GM_BR1: case GM_BR2: A = R.RY(); Bt = (const bf16*)(wb + WO_BR); N = DM; K = 512; break;
        case GM_OUT:  A = R.RM(); Bt = (const bf16*)(wb + WO_OUT); N = DM; K = 1024; break;
        case GM_GU:   A = R.RH(); Bt = (const bf16*)(wb + WO_GU); N = 2 * DFF; K = 1024; break;
        default:      A = R.RP(); Bt = (const bf16*)(wb + WO_DN); N = DM; K = DFF; break;
        }
        const bool br = (id == GM_BR0);
        pg8::Gemm gm{A, Bt, Tg, N, K, (id == GM_MU) ? 1 : ((id == GM_RU) ? 2 : (br ? 3 : 0)), asz * 2, MiB}; pg8::GOrder S; S.S.init(Tg, N, NB, bid_); S.div = br ? 3 : 1;
        EpiUni E{pp, id, l, g}; pg8::gemm_phase<EpiUni, pg8::GOrder, true, true>(lds, gm, S, E);
    }
}

__device__ __forceinline__ void run_phase0(CP pp, int part, LAS unsigned char* lds) {
    const int tid = ltid(), lane = tid & 63, wave = __builtin_amdgcn_readfirstlane(tid >> 6);
    const int NB = gridDim.x, gw = blockIdx.x * 8 + wave, ngw = NB * 8;
    const size_t gtid = (size_t)blockIdx.x * 512 + tid, ngt = (size_t)NB * 512;
    unsigned char* ws = pp->ws;
    if (part == 0) {
        for (int l = 0; l < 2; ++l) { unsigned char* wb = ws + W_OFF + (size_t)l * W_STRIDE;
            zero_bytes(wb + WO_IN + (size_t)NMAIN * 2048, (size_t)(DPROJ - NMAIN) * 2048, gtid, ngt);
            zero_bytes(wb + WO_MU, (size_t)1792 * 384 * 2, gtid, ngt);
            zero_bytes(wb + WO_RU, (size_t)2560 * 384 * 2, gtid, ngt); }
    } else {
        LAS float* scr = (LAS float*)(lds + wave * 16384);
#pragma unroll 1
        for (int l = 0; l < 2; ++l) { unsigned char* wb = ws + W_OFF + (size_t)l * W_STRIDE;
            const float* w_in = pp->in[3] + (size_t)l * DM * DIN;
            transpose_job(w_in, DIN, 1024, NMAIN, (bf16*)(wb + WO_IN), 1024, 0, 0, 0, scr, gw, ngw, lane);
            transpose_job(w_in + NMAIN, DIN, 1024, DGATE, (bf16*)(wb + WO_G), 1024, 0, 0, 0, scr, gw, ngw, lane);
            transpose_job(pp->in[8] + (size_t)l * 512 * 1024, 1024, 512, 1024, (bf16*)(wb + WO_BR), 512, 0, 0, 0, scr, gw, ngw, lane);
            transpose_job(pp->in[15] + (size_t)l * 512 * 1024, 1024, 512, 1024, (bf16*)(wb + WO_BR + 1 * MiB), 512, 0, 0, 0, scr, gw, ngw, lane);
            transpose_job(pp->in[27] + (size_t)l * 512 * 1024, 1024, 512, 1024, (bf16*)(wb + WO_BR + 2 * MiB), 512, 0, 0, 0, scr, gw, ngw, lane);
            transpose_job(pp->in[28] + (size_t)l * 1024 * 1024, 1024, 1024, 1024, (bf16*)(wb + WO_OUT), 1024, 0, 0, 0, scr, gw, ngw, lane);
            transpose_job(pp->in[30] + (size_t)l * 1024 * DFF, DFF, 1024, DFF, (bf16*)(wb + WO_GU), 1024, 0, 0, 1, scr, gw, ngw, lane);
            transpose_job(pp->in[31] + (size_t)l * 1024 * DFF, DFF, 1024, DFF, (bf16*)(wb + WO_GU), 1024, 0, 128, 1, scr, gw, ngw, lane);
            transpose_job(pp->in[32] + (size_t)l * DFF * 1024, 1024, DFF, 1024, (bf16*)(wb + WO_DN), DFF, 0, 0, 0, scr, gw, ngw, lane);
            transpose_job(pp->in[11] + (size_t)l * 256 * 768, 768, 256, 768, (bf16*)(wb + WO_MU), 384, 0, 0, 0, scr, gw, ngw, lane);
            transpose_job(pp->in[12] + (size_t)l * 128 * 1024, 1024, 128, 1024, (bf16*)(wb + WO_MU), 384, 256, 768, 0, scr, gw, ngw, lane);
#pragma unroll 1
            for (int d = 0; d < 2; ++d) {
                transpose_job(pp->in[18] + (size_t)(l * 2 + d) * 64 * 512, 512, 64, 512, (bf16*)(wb + WO_RU), 384, 64 * d, 512 * d, 0, scr, gw, ngw, lane);
                transpose_job(pp->in[20] + (size_t)(l * 2 + d) * 64 * 512, 512, 64, 512, (bf16*)(wb + WO_RU), 384, 128 + 64 * d, 1024 + 512 * d, 0, scr, gw, ngw, lane); }
            transpose_job(pp->in[21] + (size_t)l * 128 * 512, 512, 128, 512, (bf16*)(wb + WO_RU), 384, 256, 2048, 0, scr, gw, ngw, lane);
        }
    }
}

__global__ void __launch_bounds__(512, 2) mega(Params p) {
    extern __shared__ __attribute__((aligned(16))) unsigned char lds_raw[];
    LAS unsigned char* lds = (LAS unsigned char*)lds_raw;
    cg::grid_group grid = cg::this_grid();
    if (blockIdx.x == 0 && threadIdx.x == 0) { Params* d = (Params*)(p.ws + WS_PARAMS); *d = p; }
    const int nsteps = p.G * 2 * NPH;
    volatile LAS unsigned* bst = (volatile LAS unsigned*)(lds + LDS_RING + 32);
    if (threadIdx.x == 0) { bst[0] = 0u; bst[1] = 0u; }
    __syncthreads();
    const XcdBarrier bar = xcd_barrier_post((unsigned*)(p.ws + WS_CTL) + 4096, bst);
    grid.sync();
#pragma unroll 1
    for (int st = -2; st < nsteps; ++st) {
        int s2 = st; asm volatile("" : "+s"(s2));
        CP pp = (CP)(p.ws + WS_PARAMS); asm volatile("" : "+s"(pp));
        if (s2 < 0) run_phase0(pp, s2 + 2, lds); else run_phase(pp, s2, lds);
        xcd_barrier(bar);
    }
}

extern "C" void kernel_launch(void* const* d_in, const int* in_sizes, int n_in, void* d_out, int out_size, void* d_ws, size_t ws_size, hipStream_t stream) {
    static int grid = 0;
    if (grid == 0) {
        int dev = 0, cus = 0, per_cu = 0;
        hipGetDevice(&dev); hipDeviceGetAttribute(&cus, hipDeviceAttributeMultiprocessorCount, dev);
        hipFuncSetAttribute((const void*)mega, hipFuncAttributeMaxDynamicSharedMemorySize, LDS_BYTES);
        hipOccupancyMaxActiveBlocksPerMultiprocessor(&per_cu, (const void*)mega, 512, LDS_BYTES);
        (void)hipGetLastError();
        if (per_cu < 1) per_cu = 1;
        grid = cus * per_cu;
    }
    int G = 2;
    while (G < 16 && ACT_OFF + (size_t)(NTOK / G) * TOKB > ws_size) G *= 2;
    if (hipMemsetAsync((char*)d_ws + WS_CTL, 0, CTL_BYTES, stream) != hipSuccess) { fprintf(stderr, "kernel_launch: memset failed\n"); return; }
    Params p{};
    for (int i = 0; i < 33; ++i) p.in[i] = (const float*)d_in[i];
    p.out = (float*)d_out; p.ws = (unsigned char*)d_ws; p.G = G; p.Tg = NTOK / G;
    void* args[] = {&p};
    hipError_t e = hipLaunchCooperativeKernel((const void*)mega, dim3(grid), dim3(512), args, LDS_BYTES, stream);
    if (e != hipSuccess) fprintf(stderr, "cooperative launch failed: %s (grid %d)\n", hipGetErrorString(e), grid);
}
```
